# Optimizing an MI355X kernel written in HIP

```python
import math
import jax, jax.numpy as jnp
from jax import lax
import numpy as np

D_MODEL = 2048
BATCH = 2
SEQ = 4096
DEPTH = 4
DEC_BATCH = 8
DEC_SEQ = 4
PAST_LEN = 16384
PAGE_SIZE = 128

N_ATTN_LAYERS = (DEPTH + 1) // 2
N_SSM_LAYERS = DEPTH // 2
N_HEADS = 16
N_KV_HEADS = 4
HEAD_DIM = 128
ATTN_WIDTH = N_HEADS * HEAD_DIM
KV_GROUP = N_HEADS // N_KV_HEADS
N_IDX_HEADS = 16
IDX_DIM = 64
TOPK_MAX = 256
Q_BLOCK = 128
ATTN_SPLITS = (ATTN_WIDTH, N_KV_HEADS * HEAD_DIM, N_KV_HEADS * HEAD_DIM, ATTN_WIDTH,
               N_IDX_HEADS * IDX_DIM, IDX_DIM, N_IDX_HEADS)
ATTN_IN_COLS = sum(ATTN_SPLITS)
NUM_BUCKETS = 32
MAX_EXACT = NUM_BUCKETS // 2
MAX_DISTANCE = 128
SSM_WIDTH = D_MODEL
SSM_GROUP = 16
SSM_GROUPS = SSM_WIDTH // SSM_GROUP
SSM_STATE = 64
SSM_BLOCK = 128
DT_MIN = 0.001
DT_MAX = 0.1
PLE_DIM = 256
RMS_EPS = 1e-6

kernel_name = "dsa_s5_hybrid_decode_step"

F32 = jnp.float32


def rms_norm(x, w):
    x32 = x.astype(F32)
    y = x32 * lax.rsqrt(jnp.mean(x32 * x32, axis=-1, keepdims=True) + RMS_EPS)
    return (y * w.astype(F32)).astype(x.dtype)


def t5_bucket(n):
    nf = jnp.maximum(n, 1).astype(F32)
    large = MAX_EXACT + (jnp.log(nf / MAX_EXACT) / math.log(MAX_DISTANCE / MAX_EXACT)
                         * (NUM_BUCKETS - MAX_EXACT)).astype(jnp.int32)
    large = jnp.minimum(large, NUM_BUCKETS - 1)
    return jnp.where(n < MAX_EXACT, n, large)


def split_attn(z):
    cuts = [int(c) for c in np.cumsum(ATTN_SPLITS)[:-1]]
    return jnp.split(z, cuts, axis=-1)


def dsa_attend(q, q_idx, w_idx, t_pos, k_idx_all, gather_kv, top_k, rel_bias):
    b_, t_ = q.shape[:2]
    L = k_idx_all.shape[1]
    qk = jnp.einsum('bthd,bsd->bths', q_idx.astype(F32), k_idx_all.astype(F32)) * (IDX_DIM ** -0.5)
    score = jnp.einsum('bths,bth->bts', jax.nn.relu(qk), w_idx.astype(F32) * (N_IDX_HEADS ** -0.5))
    admissible = jnp.arange(L, dtype=jnp.int32)[None, :] <= t_pos[:, None]
    score = jnp.where(admissible[None], score, -jnp.inf)
    _, idx = lax.top_k(score, top_k)
    k_sel, v_sel = gather_kv(idx)
    dist = t_pos[None, :, None] - idx
    valid = dist >= 0
    bias = rel_bias[t5_bucket(jnp.maximum(dist, 0))].astype(F32)
    bias = bias.reshape(b_, t_, top_k, N_KV_HEADS, KV_GROUP).transpose(0, 1, 3, 4, 2)
    qg = q.reshape(b_, t_, N_KV_HEADS, KV_GROUP, HEAD_DIM)
    logits = jnp.einsum('btgrd,btkgd->btgrk', qg, k_sel).astype(F32) * (HEAD_DIM ** -0.5) + bias
    logits = jnp.where(valid[:, :, None, None, :], logits, -jnp.inf)
    probs = jax.nn.softmax(logits, axis=-1).astype(v_sel.dtype)
    o = jnp.einsum('btgrk,btkgd->btgrd', probs, v_sel)
    return o.reshape(b_, t_, ATTN_WIDTH)


def attn_project(xn, w_in):
    b_, t_, _ = xn.shape
    q, k, v, gate, qi, ki, wi = split_attn(xn @ w_in)
    q = q.reshape(b_, t_, N_HEADS, HEAD_DIM)
    k = k.reshape(b_, t_, N_KV_HEADS, HEAD_DIM)
    v = v.reshape(b_, t_, N_KV_HEADS, HEAD_DIM)
    qi = qi.reshape(b_, t_, N_IDX_HEADS, IDX_DIM)
    return q, k, v, gate, qi, ki, wi


def take_rows(a, i):
    return jax.vmap(lambda ab, ib: ab[ib])(a, i)


def attn_prompt(xn, w_in, w_out, rel_bias):
    b_, s_, _ = xn.shape
    q, k, v, gate, qi, ki, wi = attn_project(xn, w_in)
    top_k = min(TOPK_MAX, s_ // 4)
    nb = s_ // Q_BLOCK

    def gather_kv(idx):
        return take_rows(k, idx), take_rows(v, idx)

    def block(args):
        qb, qib, wib, t0 = args
        t_pos = t0 + jnp.arange(Q_BLOCK, dtype=jnp.int32)
        return dsa_attend(qb, qib, wib, t_pos, ki, gather_kv, top_k, rel_bias)

    def to_blocks(a):
        return a.reshape((b_, nb, Q_BLOCK) + a.shape[2:]).swapaxes(0, 1)

    o = lax.map(block, (to_blocks(q), to_blocks(qi), to_blocks(wi),
                        jnp.arange(nb, dtype=jnp.int32) * Q_BLOCK))
    o = o.swapaxes(0, 1).reshape(b_, s_, ATTN_WIDTH)
    out = (o * jax.nn.silu(gate)) @ w_out
    return out, (k, v, ki)


def attn_sample(xn, w_in, w_out, rel_bias, ck, cv, cki, page_table):
    b_, t_, _ = xn.shape
    q, k, v, gate, qi, ki, wi = attn_project(xn, w_in)
    past = page_table.shape[1] * PAGE_SIZE
    past_ki = cki[page_table].reshape(b_, past, IDX_DIM)
    ki_all = jnp.concatenate([past_ki, ki.astype(past_ki.dtype)], axis=1)
    t_pos = past + jnp.arange(t_, dtype=jnp.int32)
    top_k = min(TOPK_MAX, (past + t_) // 4)

    def gather_kv(idx):
        flat = idx.reshape(b_, t_ * top_k)
        pi = jnp.clip(flat, 0, past - 1)
        page = jnp.take_along_axis(page_table, pi // PAGE_SIZE, axis=1)
        off = pi % PAGE_SIZE
        ni = jnp.clip(flat - past, 0, t_ - 1)
        is_past = (flat < past)[:, :, None, None]

        def pick(cache, new):
            sel = jnp.where(is_past, cache[page, off], take_rows(new, ni).astype(cache.dtype))
            return sel.reshape(b_, t_, top_k, N_KV_HEADS, HEAD_DIM)
        return pick(ck, k), pick(cv, v)

    o = dsa_attend(q, qi, wi, t_pos, ki_all, gather_kv, top_k, rel_bias)
    out = (o * jax.nn.silu(gate)) @ w_out
    return out, (k, v, ki)


def complex_combine(e1, e2):
    a1r, a1i, b1r, b1i = e1
    a2r, a2i, b2r, b2i = e2
    return (a2r * a1r - a2i * a1i,
            a2r * a1i + a2i * a1r,
            a2r * b1r - a2i * b1i + b2r,
            a2r * b1i + a2i * b1r + b2i)


def s5_scan(u_g, h0_re, h0_im, a_re, a_im, bb_re, bb_im, c_re, c_im, d_g):
    b_, t_ = u_g.shape[:2]
    blk = SSM_BLOCK if t_ % SSM_BLOCK == 0 else t_
    nb = t_ // blk
    ub = u_g.reshape(b_, nb, blk, SSM_GROUPS, SSM_GROUP).swapaxes(0, 1)

    def step(carry, u_blk):
        hr, hi = carry
        br = jnp.einsum('btgj,gnj->btgn', u_blk, bb_re)
        bi = jnp.einsum('btgj,gnj->btgn', u_blk, bb_im)
        br = br.at[:, 0].add(a_re * hr - a_im * hi)
        bi = bi.at[:, 0].add(a_re * hi + a_im * hr)
        ar = jnp.broadcast_to(a_re, br.shape)
        ai = jnp.broadcast_to(a_im, bi.shape)
        _, _, xr, xi = lax.associative_scan(complex_combine, (ar, ai, br, bi), axis=1)
        y = (jnp.einsum('btgn,gjn->btgj', xr, c_re) - jnp.einsum('btgn,gjn->btgj', xi, c_im)
             + d_g * u_blk)
        return (xr[:, -1], xi[:, -1]), y

    (hr, hi), ys = lax.scan(step, (h0_re.astype(F32), h0_im.astype(F32)), ub)
    y = ys.swapaxes(0, 1).reshape(b_, t_, SSM_GROUPS, SSM_GROUP)
    return y, hr, hi


def s5_mixer(xn, h0_re, h0_im, w_in, lam_re, lam_im, log_dt, b_re, b_im, c_re, c_im, d,
             w_glu, b_glu, w_out):
    b_, t_, _ = xn.shape
    u, gate = jnp.split(xn @ w_in, 2, axis=-1)
    lre = jnp.minimum(lam_re.astype(F32), -1e-4)
    lim = lam_im.astype(F32)
    dt = jnp.exp(log_dt.astype(F32))[:, None]
    mag = jnp.exp(lre * dt)
    ang = lim * dt
    a_re = mag * jnp.cos(ang)
    a_im = mag * jnp.sin(ang)
    den = lre * lre + lim * lim
    coef_re = ((a_re - 1.0) * lre + a_im * lim) / den
    coef_im = (a_im * lre - (a_re - 1.0) * lim) / den
    br32, bi32 = b_re.astype(F32), b_im.astype(F32)
    bb_re = coef_re[..., None] * br32 - coef_im[..., None] * bi32
    bb_im = coef_re[..., None] * bi32 + coef_im[..., None] * br32
    u_g = u.astype(F32).reshape(b_, t_, SSM_GROUPS, SSM_GROUP)
    y, hr, hi = s5_scan(u_g, h0_re, h0_im, a_re, a_im, bb_re, bb_im,
                        c_re.astype(F32), c_im.astype(F32),
                        d.astype(F32).reshape(SSM_GROUPS, SSM_GROUP))
    y = jax.nn.gelu(y.reshape(b_, t_, SSM_WIDTH).astype(xn.dtype))
    y = y * jax.nn.sigmoid(y @ w_glu + b_glu)
    out = (y * jax.nn.silu(gate)) @ w_out
    return out, hr, hi


def setup_inputs(seed: int = 0) -> dict:
    key = jax.random.key(seed)
    ks = iter(jax.random.split(key, 40))

    def nrm(shape, scale=1.0):
        return jax.random.normal(next(ks), shape, F32) * scale

    n_pages = PAST_LEN // PAGE_SIZE
    n_used = DEC_BATCH * n_pages
    n_pool = n_used + max(1, n_used // 4)
    x_prompt = nrm((BATCH, SEQ, D_MODEL))
    x_sample = nrm((DEC_BATCH, DEC_SEQ, D_MODEL))
    cache_k = nrm((N_ATTN_LAYERS, n_pool, PAGE_SIZE, N_KV_HEADS, HEAD_DIM))
    cache_v = nrm((N_ATTN_LAYERS, n_pool, PAGE_SIZE, N_KV_HEADS, HEAD_DIM))
    cache_kidx = nrm((N_ATTN_LAYERS, n_pool, PAGE_SIZE, IDX_DIM))
    state_ssm_re = nrm((N_SSM_LAYERS, DEC_BATCH, SSM_GROUPS, SSM_STATE), 0.5)
    state_ssm_im = nrm((N_SSM_LAYERS, DEC_BATCH, SSM_GROUPS, SSM_STATE), 0.5)
    page_table = jax.random.permutation(next(ks), n_pool)[:n_used].reshape(DEC_BATCH, n_pages).astype(jnp.int32)
    p_prompt = nrm((DEPTH, BATCH, SEQ, PLE_DIM))
    p_sample = nrm((DEPTH, DEC_BATCH, DEC_SEQ, PLE_DIM))
    norm_w = 1.0 + nrm((DEPTH, D_MODEL), 0.01)
    final_norm_w = 1.0 + nrm((D_MODEL,), 0.01)
    rel_bias = nrm((NUM_BUCKETS, N_HEADS), 0.5)
    attn_w_in = nrm((N_ATTN_LAYERS, D_MODEL, ATTN_IN_COLS), D_MODEL ** -0.5)
    attn_w_out = nrm((N_ATTN_LAYERS, ATTN_WIDTH, D_MODEL), ATTN_WIDTH ** -0.5)
    ssm_w_in = nrm((N_SSM_LAYERS, D_MODEL, 2 * SSM_WIDTH), D_MODEL ** -0.5)
    ssm_lambda_re = -0.5 + nrm((N_SSM_LAYERS, SSM_GROUPS, SSM_STATE), 0.01)
    ssm_lambda_im = jnp.broadcast_to(math.pi * jnp.arange(SSM_STATE, dtype=F32),
                                     (N_SSM_LAYERS, SSM_GROUPS, SSM_STATE)) + nrm((N_SSM_LAYERS, SSM_GROUPS, SSM_STATE), 0.01)
    ssm_log_dt = jax.random.uniform(next(ks), (N_SSM_LAYERS, SSM_GROUPS), F32,
                                    minval=math.log(DT_MIN), maxval=math.log(DT_MAX))
    ssm_b_re = nrm((N_SSM_LAYERS, SSM_GROUPS, SSM_STATE, SSM_GROUP), (2 * SSM_GROUP) ** -0.5)
    ssm_b_im = nrm((N_SSM_LAYERS, SSM_GROUPS, SSM_STATE, SSM_GROUP), (2 * SSM_GROUP) ** -0.5)
    ssm_c_re = nrm((N_SSM_LAYERS, SSM_GROUPS, SSM_GROUP, SSM_STATE), (2 * SSM_STATE) ** -0.5)
    ssm_c_im = nrm((N_SSM_LAYERS, SSM_GROUPS, SSM_GROUP, SSM_STATE), (2 * SSM_STATE) ** -0.5)
    ssm_d = nrm((N_SSM_LAYERS, SSM_WIDTH))
    ssm_w_glu = nrm((N_SSM_LAYERS, SSM_WIDTH, SSM_WIDTH), SSM_WIDTH ** -0.5)
    ssm_b_glu = nrm((N_SSM_LAYERS, SSM_WIDTH), 0.01)
    ssm_w_out = nrm((N_SSM_LAYERS, SSM_WIDTH, D_MODEL), SSM_WIDTH ** -0.5)
    ple_norm_w = 1.0 + nrm((DEPTH, D_MODEL), 0.01)
    ple_w_gate = nrm((DEPTH, D_MODEL, D_MODEL), D_MODEL ** -0.5)
    ple_w_proj = nrm((DEPTH, PLE_DIM, D_MODEL), PLE_DIM ** -0.5)
    return {"x_prompt": x_prompt, "x_sample": x_sample, "cache_k": cache_k, "cache_v": cache_v,
            "cache_kidx": cache_kidx, "state_ssm_re": state_ssm_re, "state_ssm_im": state_ssm_im,
            "page_table": page_table, "p_prompt": p_prompt, "p_sample": p_sample,
            "norm_w": norm_w, "final_norm_w": final_norm_w, "rel_bias": rel_bias,
            "attn_w_in": attn_w_in, "attn_w_out": attn_w_out, "ssm_w_in": ssm_w_in,
            "ssm_lambda_re": ssm_lambda_re, "ssm_lambda_im": ssm_lambda_im, "ssm_log_dt": ssm_log_dt,
            "ssm_b_re": ssm_b_re, "ssm_b_im": ssm_b_im, "ssm_c_re": ssm_c_re, "ssm_c_im": ssm_c_im,
            "ssm_d": ssm_d, "ssm_w_glu": ssm_w_glu, "ssm_b_glu": ssm_b_glu, "ssm_w_out": ssm_w_out,
            "ple_norm_w": ple_norm_w, "ple_w_gate": ple_w_gate, "ple_w_proj": ple_w_proj}


def reference(x_prompt, x_sample, cache_k, cache_v, cache_kidx, state_ssm_re, state_ssm_im, page_table,
              p_prompt, p_sample, norm_w, final_norm_w, rel_bias, attn_w_in, attn_w_out, ssm_w_in,
              ssm_lambda_re, ssm_lambda_im, ssm_log_dt, ssm_b_re, ssm_b_im, ssm_c_re, ssm_c_im, ssm_d,
              ssm_w_glu, ssm_b_glu, ssm_w_out, ple_norm_w, ple_w_gate, ple_w_proj):

    def run(x, p, attn_apply, h0_re, h0_im):
        h = x
        ks_, vs_, kis_, hrs, his = [], [], [], [], []
        for i in range(DEPTH):
            xn = rms_norm(h, norm_w[i])
            l = i // 2
            if i % 2 == 0:
                out, (k_new, v_new, ki_new) = attn_apply(xn, l)
                ks_.append(k_new); vs_.append(v_new); kis_.append(ki_new)
            else:
                out, hr, hi = s5_mixer(xn, h0_re[l], h0_im[l], ssm_w_in[l], ssm_lambda_re[l],
                                       ssm_lambda_im[l], ssm_log_dt[l], ssm_b_re[l], ssm_b_im[l],
                                       ssm_c_re[l], ssm_c_im[l], ssm_d[l], ssm_w_glu[l], ssm_b_glu[l],
                                       ssm_w_out[l])
                hrs.append(hr); his.append(hi)
            h = h + out
            g = jax.nn.sigmoid(rms_norm(h, ple_norm_w[i]) @ ple_w_gate[i])
            h = h + g * (p[i].astype(h.dtype) @ ple_w_proj[i])
        y = rms_norm(h, final_norm_w)
        return y, jnp.stack(ks_), jnp.stack(vs_), jnp.stack(kis_), jnp.stack(hrs), jnp.stack(his)

    def prompt_attn(xn, l):
        return attn_prompt(xn, attn_w_in[l], attn_w_out[l], rel_bias)

    def sample_attn(xn, l):
        return attn_sample(xn, attn_w_in[l], attn_w_out[l], rel_bias,
                           cache_k[l], cache_v[l], cache_kidx[l], page_table)

    zeros = jnp.zeros((N_SSM_LAYERS, x_prompt.shape[0], SSM_GROUPS, SSM_STATE), F32)
    y_prompt, k_prompt, v_prompt, kidx_prompt, ssm_re_prompt, ssm_im_prompt = run(
        x_prompt, p_prompt, prompt_attn, zeros, zeros)
    y_sample, k_sample, v_sample, kidx_sample, ssm_re_sample, ssm_im_sample = run(
        x_sample, p_sample, sample_attn, state_ssm_re, state_ssm_im)
    return (y_prompt, y_sample, k_prompt, v_prompt, kidx_prompt, ssm_re_prompt, ssm_im_prompt,
            k_sample, v_sample, kidx_sample, ssm_re_sample, ssm_im_sample)
```

```cpp
#include <hip/hip_runtime.h>
#include <cstdio>
#include <cstdint>

namespace pg8 {
#define PG8_LAS __attribute__((address_space(3)))
typedef unsigned short bf16_t;
typedef short bf16x8 __attribute__((ext_vector_type(8)));
typedef float f32x4 __attribute__((ext_vector_type(4)));
typedef unsigned u32x4 __attribute__((ext_vector_type(4)));
constexpr int BM = 256, BK = 64, HALF = 128, HTB = HALF * BK * 2, STAGE_BYTES = 8 * HTB, NXCD = 8, WGM = 8;

__host__ __device__ __forceinline__ int lds_byte(int r, int c) { const int st = (r >> 4) * 2 + (c >> 5), rr = r & 15, cc = c & 31, ob = rr * 64 + cc * 2; return st * 1024 + (ob ^ (((ob >> 9) & 1) << 5)); }
__host__ __device__ __forceinline__ void stage_rc(int b, int& R, int& C) { const int st = b / 1024, sb = b % 1024, swz = sb ^ (((sb >> 9) & 1) << 5); R = (st >> 1) * 16 + swz / 64; C = (st & 1) * 32 + (swz % 64) / 2; }

struct Unit { int pm, pn; };
struct Gemm { const bf16_t* A; const bf16_t* Bt; int M, N, K; };

struct StaticOrder {
    int nM, nN, nwg, G, c;
    __host__ __device__ void init(int M, int N, int G_, int c_) { nM = M / BM; nN = N / BM; nwg = nM * nN; G = G_; c = c_; }
    __host__ __device__ bool next(int i, Unit& u) const {
        const long L = (long)i * G + c; if (L >= nwg) return false;
        int wgid = (int)L; { const int q = nwg / NXCD, r = nwg % NXCD, xcd = wgid % NXCD, off = wgid / NXCD; wgid = (xcd < r ? xcd * (q + 1) : r * (q + 1) + (xcd - r) * q) + off; }
        const int nig = WGM * nN, gid = wgid / nig, fm = gid * WGM, gsz = (nM - fm) < WGM ? (nM - fm) : WGM;
        u.pm = fm + ((wgid % nig) % gsz); u.pn = (wgid % nig) / gsz; return true;
    }
    __device__ __forceinline__ void a_ready(const Unit&) const {}
    __device__ __forceinline__ void done(const Unit&) const {}
};

struct EpiF32 {
    float* C; int ldc;
    __device__ __forceinline__ void operator()(const f32x4 (&acc)[2][2][4][2], const Unit& u, int wr, int wc, int fr, int fq) const {
        const int row0 = u.pm * BM + wr * 64 + fr, col0 = u.pn * BM + wc * 32 + 4 * fq;
#pragma unroll
        for (int ai = 0; ai < 2; ++ai)
#pragma unroll
            for (int m = 0; m < 4; ++m) { float* rowp = C + (size_t)(row0 + ai * HALF + m * 16) * ldc + col0;
#pragma unroll
                for (int bj = 0; bj < 2; ++bj)
#pragma unroll
                    for (int n = 0; n < 2; ++n) *(f32x4*)(rowp + bj * HALF + n * 16) = acc[ai][bj][m][n]; }
    }
};

template <class Epi, class Sched, bool ALIGN_EPI = false, bool SP2 = false>
__device__ __forceinline__ void gemm_phase(PG8_LAS unsigned char* lds, const Gemm g, const Sched& S, const Epi& E) {
    int tid = threadIdx.x; asm volatile("" : "+v"(tid));
    const int wid = __builtin_amdgcn_readfirstlane(tid >> 6), lane = tid & 63, wr = wid >> 2, wc = wid & 3, fr = lane & 15, fq = lane >> 4;
    const int K = g.K, nt = K / BK;
    unsigned voffA[2], voffB[2];
#pragma unroll
    for (int i = 0; i < 2; ++i) { int R, C; stage_rc(tid * 16 + i * 8192, R, C); const int Rb = R;
        voffA[i] = (unsigned)(R * K + C) * 2u; voffB[i] = (unsigned)(Rb * K + C) * 2u; }
    const size_t kstep = (size_t)(BK * 2);
    const size_t hstep = (size_t)HALF * K * 2;
    const size_t tstep = 2 * hstep;
    const unsigned ldsw = (unsigned)wid * 1024u;
    const int aoff = lds_byte(wr * 64 + fr, fq * 8), boff = lds_byte(wc * 32 + fr, fq * 8);
#define PG8_SA(b, h) (((b) * 2 + (h)) * HTB)
#define PG8_SB(b, h) ((4 + (b) * 2 + (h)) * HTB)
#define PG8_STAGE(bufoff, gbase, voff) do { _Pragma("unroll") for (int _i = 0; _i < 2; ++_i) \
        __builtin_amdgcn_global_load_lds((const unsigned*)((const char*)(gbase) + (voff)[_i]), (PG8_LAS unsigned*)(lds + (bufoff) + ldsw + _i * 8192), 16, 0, 0); } while (0)
#define PG8_LDA(dst, b, h) do { _Pragma("unroll") for (int m = 0; m < 4; ++m) _Pragma("unroll") for (int k = 0; k < 2; ++k) dst[m][k] = *(const PG8_LAS bf16x8*)(lds + PG8_SA(b, h) + aoff + m * 2048 + k * 1024); } while (0)
#define PG8_LDB(dst, b, h) do { _Pragma("unroll") for (int n = 0; n < 2; ++n) _Pragma("unroll") for (int k = 0; k < 2; ++k) dst[n][k] = *(const PG8_LAS bf16x8*)(lds + PG8_SB(b, h) + boff + n * 2048 + k * 1024); } while (0)
#define PG8_MMA(ai, bj, At, Bt) do { __builtin_amdgcn_s_setprio(1); _Pragma("unroll") for (int m = 0; m < 4; ++m) _Pragma("unroll") for (int n = 0; n < 2; ++n) _Pragma("unroll") for (int k = 0; k < 2; ++k) \
        acc[ai][bj][m][n] = __builtin_amdgcn_mfma_f32_16x16x32_bf16(Bt[n][k], At[m][k], acc[ai][bj][m][n], 0, 0, 0); __builtin_amdgcn_s_setprio(0); } while (0)
#define PG8_WAIT_V(n) asm volatile("s_waitcnt vmcnt(" #n ")" ::: "memory")
#define PG8_WAIT_L(n) asm volatile("s_waitcnt lgkmcnt(" #n ")" ::: "memory")
#define PG8_BAR __builtin_amdgcn_s_barrier()
#define PG8_SCHED __builtin_amdgcn_sched_barrier(0)
    Unit cur, nxt; int ui = 0;
    if (!S.next(0, cur)) return;
    f32x4 acc[2][2][4][2];
#pragma unroll
    for (int a = 0; a < 2; ++a)
#pragma unroll
        for (int b = 0; b < 2; ++b)
#pragma unroll
            for (int m = 0; m < 4; ++m)
#pragma unroll
                for (int n = 0; n < 2; ++n) acc[a][b][m][n] = (f32x4){0.f, 0.f, 0.f, 0.f};
    bf16x8 At[4][2], B0[2][2], B1[2][2];
    const char* cA = (const char*)g.A + (size_t)cur.pm * tstep; const char* cB = (const char*)g.Bt + (size_t)cur.pn * tstep;
    S.a_ready(cur);
    if constexpr (SP2) {
        PG8_STAGE(PG8_SB(0, 0), cB, voffB); PG8_STAGE(PG8_SB(0, 1), cB + hstep, voffB); PG8_STAGE(PG8_SA(0, 0), cA, voffA); PG8_STAGE(PG8_SA(0, 1), cA + hstep, voffA);
        if (wr == 1) PG8_BAR;
        PG8_WAIT_V(2); PG8_BAR;
        PG8_STAGE(PG8_SB(1, 0), cB + kstep, voffB); PG8_STAGE(PG8_SA(1, 0), cA + kstep, voffA); PG8_STAGE(PG8_SB(1, 1), cB + hstep + kstep, voffB);
        PG8_WAIT_V(6); PG8_BAR;
    } else {
        PG8_STAGE(PG8_SB(0, 0), cB, voffB); PG8_STAGE(PG8_SA(0, 0), cA, voffA); PG8_STAGE(PG8_SB(0, 1), cB + hstep, voffB); PG8_STAGE(PG8_SA(0, 1), cA + hstep, voffA);
        if (wr == 1) PG8_BAR;
        PG8_WAIT_V(4); PG8_BAR;
        PG8_STAGE(PG8_SB(1, 0), cB + kstep, voffB); PG8_STAGE(PG8_SA(1, 0), cA + kstep, voffA); PG8_STAGE(PG8_SB(1, 1), cB + hstep + kstep, voffB);
        PG8_WAIT_V(6); PG8_BAR;
    }
    for (;;) {
        const bool has_next = S.next(ui + 1, nxt);
        const char* nA = has_next ? (const char*)g.A + (size_t)nxt.pm * tstep : cA; const char* nB = has_next ? (const char*)g.Bt + (size_t)nxt.pn * tstep : cB;
        for (int t = 0; t < nt; t += 2) {
            const bool last = (t == nt - 2);
            const char* a1 = cA + (size_t)(t + 1) * kstep;
            const char* a2 = last ? nA : cA + (size_t)(t + 2) * kstep; const char* b2 = last ? nB : cB + (size_t)(t + 2) * kstep;
            const char* a3 = a2 + kstep; const char* b3 = b2 + kstep;
            if (last && has_next) S.a_ready(nxt);
            if constexpr (SP2) {
            PG8_LDB(B0, 0, 0); PG8_LDB(B1, 0, 1); PG8_SCHED; PG8_LDA(At, 0, 0); PG8_STAGE(PG8_SA(1, 1), a1 + hstep, voffA);
            PG8_WAIT_V(8); PG8_WAIT_L(0); PG8_BAR; PG8_MMA(0, 0, At, B0); PG8_MMA(0, 1, At, B1); PG8_BAR; PG8_SCHED;
            PG8_LDA(At, 0, 1); PG8_STAGE(PG8_SB(0, 0), b2, voffB); PG8_STAGE(PG8_SB(0, 1), b2 + hstep, voffB); PG8_STAGE(PG8_SA(0, 0), a2, voffA);
            PG8_WAIT_V(8); PG8_WAIT_L(0); PG8_BAR; PG8_MMA(1, 0, At, B0); PG8_MMA(1, 1, At, B1); PG8_BAR; PG8_SCHED;
            PG8_LDB(B0, 1, 0); PG8_LDB(B1, 1, 1); PG8_SCHED; PG8_LDA(At, 1, 0); PG8_STAGE(PG8_SA(0, 1), a2 + hstep, voffA);
            PG8_WAIT_V(8); PG8_WAIT_L(0); PG8_BAR; PG8_MMA(0, 0, At, B0); PG8_MMA(0, 1, At, B1); PG8_BAR; PG8_SCHED;
            PG8_LDA(At, 1, 1); PG8_STAGE(PG8_SB(1, 0), b3, voffB); PG8_STAGE(PG8_SB(1, 1), b3 + hstep, voffB); PG8_STAGE(PG8_SA(1, 0), a3, voffA);
            PG8_WAIT_V(8); PG8_WAIT_L(0); PG8_BAR; PG8_MMA(1, 0, At, B0); PG8_MMA(1, 1, At, B1); PG8_BAR; PG8_SCHED;
            } else {
            PG8_LDB(B0, 0, 0); PG8_SCHED; PG8_LDA(At, 0, 0); PG8_STAGE(PG8_SA(1, 1), a1 + hstep, voffA);
            PG8_WAIT_L(8); PG8_BAR; PG8_WAIT_L(0); PG8_MMA(0, 0, At, B0); PG8_BAR; PG8_SCHED;
            PG8_LDB(B1, 0, 1); PG8_STAGE(PG8_SB(0, 0), b2, voffB);
            PG8_BAR; PG8_WAIT_L(0); PG8_MMA(0, 1, At, B1); PG8_BAR;
            PG8_LDA(At, 0, 1); PG8_STAGE(PG8_SA(0, 0), a2, voffA);
            PG8_BAR; PG8_WAIT_L(0); PG8_MMA(1, 0, At, B0); PG8_BAR; PG8_SCHED;
            PG8_STAGE(PG8_SB(0, 1), b2 + hstep, voffB);
            PG8_WAIT_V(6); PG8_BAR; PG8_MMA(1, 1, At, B1); PG8_BAR;
            PG8_LDB(B0, 1, 0); PG8_SCHED; PG8_LDA(At, 1, 0); PG8_STAGE(PG8_SA(0, 1), a2 + hstep, voffA);
            PG8_WAIT_L(8); PG8_BAR; PG8_WAIT_L(0); PG8_MMA(0, 0, At, B0); PG8_BAR; PG8_SCHED;
            PG8_LDB(B1, 1, 1); PG8_STAGE(PG8_SB(1, 0), b3, voffB);
            PG8_BAR; PG8_WAIT_L(0); PG8_MMA(0, 1, At, B1); PG8_BAR;
            PG8_LDA(At, 1, 1); PG8_STAGE(PG8_SA(1, 0), a3, voffA);
            PG8_BAR; PG8_WAIT_L(0); PG8_MMA(1, 0, At, B0); PG8_BAR; PG8_SCHED;
            PG8_STAGE(PG8_SB(1, 1), b3 + hstep, voffB);
            PG8_WAIT_V(6); PG8_BAR; PG8_MMA(1, 1, At, B1); PG8_BAR;
            }
        }
        if constexpr (ALIGN_EPI) { if (wr == 0) PG8_BAR; }
        E(acc, cur, wr, wc, fr, fq); S.done(cur);
        if (!has_next) break;
#pragma unroll
        for (int a = 0; a < 2; ++a)
#pragma unroll
            for (int b = 0; b < 2; ++b)
#pragma unroll
                for (int m = 0; m < 4; ++m)
#pragma unroll
                    for (int n = 0; n < 2; ++n) acc[a][b][m][n] = (f32x4){0.f, 0.f, 0.f, 0.f};
        cur = nxt; cA = nA; cB = nB; ++ui;
        if constexpr (ALIGN_EPI) { if (wr == 1) PG8_BAR; }
    }
    PG8_WAIT_V(0);
    if constexpr (!ALIGN_EPI) { if (wr == 0) PG8_BAR; }
    PG8_BAR;
#undef PG8_SA
#undef PG8_SB
#undef PG8_STAGE
#undef PG8_LDA
#undef PG8_LDB
#undef PG8_MMA
#undef PG8_WAIT_V
#undef PG8_WAIT_L
#undef PG8_BAR
#undef PG8_SCHED
}
}

constexpr int NWAVES = 8, NTHR = NWAVES * 64;
constexpr int DM = 2048, NBATCH = 2, SEQ = 4096, DEPTH = 4, DBATCH = 8, DSEQ = 4, PAST = 16384, PAGE = 128;
constexpr int NPAGES = PAST / PAGE, NPOOL = 1280, NAL = 2, NSL = 2;
constexpr int NH = 16, NKV = 4, HD = 128, KVG = 4, NIH = 16, IDD = 64, TOPK = 256;
constexpr int ACOLS = 6224, ACOLS_PAD = 6400;
constexpr int C_Q = 0, C_K = 2048, C_V = 2560, C_G = 3072, C_QI = 5120, C_KI = 6144, C_WI = 6208;
constexpr int SGRP = 16, NGRP = 128, SST = 64, PLE = 256;
constexpr int MP = NBATCH * SEQ, MS = DBATCH * DSEQ, MR = MP + MS, MPAD = 8448;
constexpr float RMS_EPS = 1e-6f;
constexpr float LOG2E = 1.4426950408889634f;
constexpr float QSCALE = 0.088388347648318440f * LOG2E;
constexpr float WISCALE = 0.25f * 0.125f;
enum { I_XP = 0, I_XS, I_CK, I_CV, I_CKI, I_SRE, I_SIM, I_PT, I_PP, I_PS, I_NW, I_FNW, I_RB, I_AWI, I_AWO, I_SWI, I_LRE, I_LIM, I_LDT, I_BRE, I_BIM, I_CRE, I_CIM, I_SD, I_WGLU, I_BGLU, I_SWO, I_PNW, I_PWG, I_PWP, N_IN };
constexpr size_t O_YP = 0, O_YS = O_YP + (size_t)MP * DM, O_KP = O_YS + (size_t)MS * DM, O_VP = O_KP + (size_t)NAL * MP * 512, O_KIP = O_VP + (size_t)NAL * MP * 512,
    O_SRP = O_KIP + (size_t)NAL * MP * 64, O_SIP = O_SRP + (size_t)NSL * NBATCH * NGRP * SST, O_KS = O_SIP + (size_t)NSL * NBATCH * NGRP * SST, O_VS = O_KS + (size_t)NAL * MS * 512,
    O_KIS = O_VS + (size_t)NAL * MS * 512, O_SRS = O_KIS + (size_t)NAL * MS * 64, O_SIS = O_SRS + (size_t)NSL * DBATCH * NGRP * SST, O_END = O_SIS + (size_t)NSL * DBATCH * NGRP * SST;
static_assert(O_END == 35065856, "output size");

constexpr size_t MiB = 1u << 20;
constexpr size_t WS_CTL = 0, CTL_ZERO_BYTES = 1 * MiB;
constexpr size_t WS_WAIN = 2 * MiB;
constexpr size_t WS_WAOUT = WS_WAIN + 50 * MiB;
constexpr size_t WS_WSIN = WS_WAOUT + 16 * MiB;
constexpr size_t WS_WGLU = WS_WSIN + 32 * MiB;
constexpr size_t WS_WSOUT = WS_WGLU + 16 * MiB;
constexpr size_t WS_WPG = WS_WSOUT + 16 * MiB;
constexpr size_t WS_WPP = WS_WPG + 32 * MiB;
constexpr size_t WS_H = WS_WPP + 4 * MiB;
constexpr size_t WS_HBA = WS_H + 66 * MiB, WS_HBB = WS_HBA + 33 * MiB;
constexpr size_t WS_PB = WS_HBB + 33 * MiB;
constexpr size_t PB_STRIDE = (size_t)MPAD * PLE * 2;
constexpr size_t WS_QB = WS_PB + 17 * MiB;
constexpr size_t WS_KB = WS_QB + 33 * MiB, WS_VB = WS_KB + 9 * MiB;
constexpr size_t WS_GB = WS_VB + 9 * MiB;
constexpr size_t WS_QIB = WS_GB + 33 * MiB;
constexpr size_t WS_KIB = WS_QIB + 17 * MiB;
constexpr size_t WS_WI = WS_KIB + 2 * MiB;
constexpr size_t WS_AOB = WS_WI + 1 * MiB;
constexpr size_t WS_UG = WS_AOB + 33 * MiB;
constexpr size_t WS_US = WS_UG + 32 * MiB;
constexpr size_t WS_YB = WS_US + 1 * MiB;
constexpr size_t WS_RSTD = WS_YB + 33 * MiB;
constexpr size_t WS_C = WS_RSTD + 1 * MiB;
constexpr size_t WS_C2 = WS_C + 207 * MiB;
constexpr size_t WS_SC = WS_C2 + 66 * MiB;
constexpr size_t WS_SCS = WS_SC + 128 * MiB;
constexpr int SCS_LD = 16400;
constexpr size_t WS_SEL = WS_SCS + 3 * MiB;
constexpr size_t WS_END = WS_SEL + 9 * MiB;
constexpr int CW_BAR = 4096;

constexpr int LDS_BYTES = 147456;
constexpr int MISC_OFF = 131072 + 320;

#define GAS __attribute__((address_space(1)))
#define LAS __attribute__((address_space(3)))
typedef unsigned short bf16;
typedef unsigned v4u __attribute__((ext_vector_type(4)));
typedef unsigned v2u __attribute__((ext_vector_type(2)));
typedef float f32x4 __attribute__((ext_vector_type(4)));
#define LDS_WAIT() asm volatile("s_waitcnt lgkmcnt(0)" ::: "memory")
__device__ __forceinline__ unsigned f2bf(float f) { unsigned u = __builtin_bit_cast(unsigned, f); return (u + 0x7fffu + ((u >> 16) & 1u)) >> 16; }
__device__ __forceinline__ unsigned pk2(float lo, float hi) { return f2bf(lo) | (f2bf(hi) << 16); }
__device__ __forceinline__ float bf2f(unsigned short b) { return __builtin_bit_cast(float, ((unsigned)b) << 16); }
__device__ __forceinline__ float bflo(unsigned w) { return __builtin_bit_cast(float, w << 16); }
__device__ __forceinline__ float bfhi(unsigned w) { return __builtin_bit_cast(float, w & 0xffff0000u); }
__device__ __forceinline__ float sigmoidf_(float x) { return 1.0f / (1.0f + __expf(-x)); }
__device__ __forceinline__ float siluf_(float x) { return x * sigmoidf_(x); }
__device__ __forceinline__ float gelu_tanh(float x) { const float u = 0.7978845608028654f * (x + 0.044715f * x * x * x); return x * sigmoidf_(2.0f * u); }
__device__ __forceinline__ float wave_sum(float v) {
#pragma unroll
    for (int o = 1; o < 64; o <<= 1) v += __shfl_xor(v, o);
    return v;
}
__device__ __forceinline__ int t5_bucket(int n) {
    if (n < 16) return n;
    int b = 16;
    b += (n >= 19) + (n >= 21) + (n >= 24) + (n >= 27) + (n >= 31) + (n >= 35) + (n >= 40) + (n >= 46) + (n >= 52) + (n >= 59) + (n >= 67) + (n >= 77) + (n >= 87) + (n >= 99) + (n >= 113);
    return b;
}

#define XB_TMO      128
#define XB_XCNT(j)  (256  + 64 * (j))
#define XB_XSUB(j)  (1280 + 64 * (j))
#define XB_XGEN(j)  (2304 + 64 * (j))
#define XB_TOP      3328
#define XB_TOPGEN   3392
#define XCD_BAR_WORDS 3456
#define XB_SPIN_CAP (1u << 22)
__device__ __forceinline__ unsigned xb_ld(unsigned* p)              { return __hip_atomic_load(p, __ATOMIC_RELAXED, __HIP_MEMORY_SCOPE_AGENT); }
__device__ __forceinline__ unsigned xb_add(unsigned* p, unsigned v) { return __hip_atomic_fetch_add(p, v, __ATOMIC_RELAXED, __HIP_MEMORY_SCOPE_AGENT); }
__device__ __forceinline__ unsigned xb_xcc_id() { return (unsigned)__builtin_amdgcn_s_getreg((3 << 11) | 20) & 0xFu; }
#define XB_SPIN(cond, bar) do { unsigned _sp = 0; while (cond) { __builtin_amdgcn_s_sleep(1); \
    if ((++_sp & 255u) == 0u) { if (xb_ld(&(bar)[XB_TMO])) break; if (_sp > XB_SPIN_CAP) { atomicAdd(&(bar)[XB_TMO], 1u); break; } } } } while (0)
struct XcdBarrier { unsigned* bar; unsigned x; volatile LAS unsigned* st; };
__device__ __forceinline__ XcdBarrier xcd_barrier_post(unsigned* bar, volatile LAS unsigned* st) {
    XcdBarrier b; b.bar = bar; b.x = xb_xcc_id(); b.st = st;
    if (threadIdx.x == 0) (void)xb_add(&bar[XB_XCNT(b.x)], 1u);
    return b;
}
__device__ __forceinline__ void xcd_barrier_complete(unsigned* bar, unsigned x, unsigned& nloc, unsigned& nx) {
    const unsigned G = gridDim.x * gridDim.y * gridDim.z;
    unsigned sum, cnt, mine, sp = 0u;
    for (;;) {
        sum = 0u; cnt = 0u; mine = 0u;
#pragma unroll
        for (unsigned j = 0; j < 16; ++j) { const unsigned c = xb_ld(&bar[XB_XCNT(j)]); sum += c; cnt += (c > 0u) ? 1u : 0u; mine = (j == x) ? c : mine; }
        if (sum == G) break;
        __builtin_amdgcn_s_sleep(1);
        if ((++sp & 255u) == 0u) { if (xb_ld(&bar[XB_TMO])) break; if (sp > XB_SPIN_CAP) { atomicAdd(&bar[XB_TMO], 1u); break; } }
    }
    nloc = mine > 0u ? mine : 1u; nx = cnt > 0u ? cnt : 1u;
}
__device__ __forceinline__ void xcd_barrier(const XcdBarrier& b) {
    asm volatile("s_waitcnt vmcnt(0)" ::: "memory");
    __syncthreads();
    if (threadIdx.x == 0) {
        unsigned* bar = b.bar;
        __builtin_amdgcn_s_waitcnt(0);
        unsigned nloc = b.st[0], nx = b.st[1];
        if (nloc == 0u) { xcd_barrier_complete(bar, b.x, nloc, nx); b.st[0] = nloc; b.st[1] = nx; }
        const unsigned old = xb_add(&bar[XB_XSUB(b.x)], 1u);
        const unsigned gen = old / nloc;
        if (old + 1u == (gen + 1u) * nloc) {
            __builtin_amdgcn_fence(__ATOMIC_RELEASE, "agent");
            asm volatile("s_waitcnt vmcnt(0)" ::: "memory");
            const unsigned og = xb_add(&bar[XB_TOP], 1u);
            const unsigned tg = og / nx;
            if (og + 1u == (tg + 1u) * nx) xb_add(&bar[XB_TOPGEN], 1u);
            else XB_SPIN(xb_ld(&bar[XB_TOPGEN]) == tg, bar);
            __builtin_amdgcn_fence(__ATOMIC_ACQUIRE, "agent");
            xb_add(&bar[XB_XGEN(b.x)], 1u);
            asm volatile("s_waitcnt vmcnt(0)" ::: "memory");
        } else {
            XB_SPIN(xb_ld(&bar[XB_XGEN(b.x)]) == gen, bar);
            __builtin_amdgcn_fence(__ATOMIC_ACQUIRE, "agent");
            asm volatile("s_waitcnt vmcnt(0)" ::: "memory");
        }
    }
    __syncthreads();
}

struct Args { const void* in[N_IN]; float* out; unsigned char* ws; int ph_lo, ph_hi; };
#define TID_LOCAL() int tid = threadIdx.x; asm volatile("" : "+v"(tid)); const int lane = tid & 63, wave = __builtin_amdgcn_readfirstlane(tid >> 6); const int gw = blockIdx.x * NWAVES + wave, NGW = gridDim.x * NWAVES; (void)lane; (void)wave; (void)gw; (void)NGW
#define GTID_LOCAL() const size_t gtid = (size_t)blockIdx.x * NTHR + tid, GT = (size_t)gridDim.x * NTHR

__device__ __forceinline__ void transpose_item(const float* W, int K, int N, const float* scale, bf16* WT, LAS float* scr, int item, int lane) {
    const int nblk = (N + 31) / 32, kb = item / nblk, nb = item % nblk, k0 = 64 * kb, n0 = 32 * nb;
#pragma unroll 8
    for (int i = 0; i < 32; ++i) { const int kk = 2 * i + (lane >> 5); const int n = n0 + (lane & 31);
        float v = (n < N) ? W[(size_t)(k0 + kk) * N + n] : 0.f; if (scale) v *= scale[k0 + kk];
        scr[kk * 33 + (lane & 31)] = v; }
    LDS_WAIT(); asm volatile("" ::: "memory");
    const int c = lane & 7;
#pragma unroll
    for (int j = 0; j < 4; ++j) { const int n = (lane >> 3) + 8 * j; const LAS float* s = scr + (8 * c) * 33 + n;
        v4u o; o.x = pk2(s[0 * 33], s[1 * 33]); o.y = pk2(s[2 * 33], s[3 * 33]); o.z = pk2(s[4 * 33], s[5 * 33]); o.w = pk2(s[6 * 33], s[7 * 33]);
        *(v4u*)(WT + (size_t)(n0 + n) * K + k0 + 8 * c) = o; }
    LDS_WAIT(); asm volatile("" ::: "memory");
}

__device__ __forceinline__ void ph_prologue(const Args& a, LAS unsigned char* lds) {
    TID_LOCAL();
    LAS float* scr = (LAS float*)(lds + wave * 16384);
    unsigned char* ws = a.ws;
    for (int m = 0; m < 18; ++m) {
        const float* W; int K = DM, N = DM; const float* sc = nullptr; bf16* WT;
        if (m < 2)       { W = (const float*)a.in[I_AWI] + (size_t)m * DM * ACOLS; N = ACOLS; sc = (const float*)a.in[I_NW] + (size_t)(2 * m) * DM; WT = (bf16*)(ws + WS_WAIN) + (size_t)m * ACOLS_PAD * DM; }
        else if (m < 4)  { const int l = m - 2; W = (const float*)a.in[I_AWO] + (size_t)l * DM * DM; WT = (bf16*)(ws + WS_WAOUT) + (size_t)l * DM * DM; }
        else if (m < 6)  { const int l = m - 4; W = (const float*)a.in[I_SWI] + (size_t)l * DM * 4096; N = 4096; sc = (const float*)a.in[I_NW] + (size_t)(2 * l + 1) * DM; WT = (bf16*)(ws + WS_WSIN) + (size_t)l * 4096 * DM; }
        else if (m < 8)  { const int l = m - 6; W = (const float*)a.in[I_WGLU] + (size_t)l * DM * DM; WT = (bf16*)(ws + WS_WGLU) + (size_t)l * DM * DM; }
        else if (m < 10) { const int l = m - 8; W = (const float*)a.in[I_SWO] + (size_t)l * DM * DM; WT = (bf16*)(ws + WS_WSOUT) + (size_t)l * DM * DM; }
        else if (m < 14) { const int i = m - 10; W = (const float*)a.in[I_PWG] + (size_t)i * DM * DM; sc = (const float*)a.in[I_PNW] + (size_t)i * DM; WT = (bf16*)(ws + WS_WPG) + (size_t)i * DM * DM; }
        else             { const int i = m - 14; W = (const float*)a.in[I_PWP] + (size_t)i * PLE * DM; K = PLE; WT = (bf16*)(ws + WS_WPP) + (size_t)i * DM * PLE; }
        const int nitems = (K / 64) * ((N + 31) / 32);
        for (int it = gw; it < nitems; it += NGW) transpose_item(W, K, N, sc, WT, scr, it, lane);
    }
    float* H = (float*)(ws + WS_H); bf16* Hb = (bf16*)(ws + WS_HBA);
    for (int r = gw; r < MR; r += NGW) {
        const float* src = (r < MP) ? (const float*)a.in[I_XP] + (size_t)r * DM : (const float*)a.in[I_XS] + (size_t)(r - MP) * DM;
#pragma unroll
        for (int j = 0; j < 8; ++j) { const int c = (j * 64 + lane) * 4; const f32x4 v = *(const f32x4*)(src + c);
            *(f32x4*)(H + (size_t)r * DM + c) = v; v2u o; o.x = pk2(v[0], v[1]); o.y = pk2(v[2], v[3]); *(v2u*)(Hb + (size_t)r * DM + c) = o; }
    }
    for (int q = gw; q < DEPTH * MR; q += NGW) { const int i = q / MR, r = q % MR;
        const float* src = (r < MP) ? (const float*)a.in[I_PP] + ((size_t)i * MP + r) * PLE : (const float*)a.in[I_PS] + ((size_t)i * MS + (r - MP)) * PLE;
        const f32x4 v = *(const f32x4*)(src + lane * 4); v2u o; o.x = pk2(v[0], v[1]); o.y = pk2(v[2], v[3]);
        *(v2u*)((bf16*)(ws + WS_PB + (size_t)i * PB_STRIDE) + (size_t)r * PLE + lane * 4) = o; }
}

__device__ __forceinline__ void ph_rowstat(const Args& a) {
    TID_LOCAL();
    const float* H = (const float*)(a.ws + WS_H); float* rstd = (float*)(a.ws + WS_RSTD);
    for (int r = gw; r < MR; r += NGW) { float s = 0.f;
#pragma unroll
        for (int j = 0; j < 8; ++j) { const f32x4 v = *(const f32x4*)(H + (size_t)r * DM + (j * 64 + lane) * 4); s += v[0] * v[0] + v[1] * v[1] + v[2] * v[2] + v[3] * v[3]; }
        s = wave_sum(s); if (lane == 0) rstd[r] = 1.0f / sqrtf(s * (1.0f / DM) + RMS_EPS); }
}

__device__ __forceinline__ void ph_epi_attn_in(const Args& a, int l) {
    TID_LOCAL(); GTID_LOCAL();
    unsigned char* ws = a.ws; const float* C = (const float*)(ws + WS_C); const float* rstd = (const float*)(ws + WS_RSTD);
    constexpr int NG4 = ACOLS / 4;
    for (size_t e = gtid; e < (size_t)MR * NG4; e += GT) { const int r = (int)(e / NG4), c = (int)(e % NG4) * 4;
        f32x4 v = *(const f32x4*)(C + (size_t)r * ACOLS_PAD + c); const float rs = rstd[r]; v = v * rs;
        if (c < C_K) { v = v * QSCALE; v2u o; o.x = pk2(v[0], v[1]); o.y = pk2(v[2], v[3]); *(v2u*)((bf16*)(ws + WS_QB) + (size_t)r * 2048 + c) = o; }
        else if (c < C_G) { const bool isv = c >= C_V; const int cc = c - (isv ? C_V : C_K);
            float* o32 = a.out + (r < MP ? (isv ? O_VP : O_KP) + ((size_t)l * MP + r) * 512 : (isv ? O_VS : O_KS) + ((size_t)l * MS + (r - MP)) * 512) + cc;
            *(f32x4*)o32 = v; v2u o; o.x = pk2(v[0], v[1]); o.y = pk2(v[2], v[3]); *(v2u*)((bf16*)(ws + (isv ? WS_VB : WS_KB)) + (size_t)r * 512 + cc) = o; }
        else if (c < C_QI) { v2u o; o.x = pk2(siluf_(v[0]), siluf_(v[1])); o.y = pk2(siluf_(v[2]), siluf_(v[3])); *(v2u*)((bf16*)(ws + WS_GB) + (size_t)r * 2048 + (c - C_G)) = o; }
        else if (c < C_KI) { v2u o; o.x = pk2(v[0], v[1]); o.y = pk2(v[2], v[3]); *(v2u*)((bf16*)(ws + WS_QIB) + (size_t)r * 1024 + (c - C_QI)) = o; }
        else if (c < C_WI) { const int cc = c - C_KI; float* o32 = a.out + (r < MP ? O_KIP + ((size_t)l * MP + r) * 64 : O_KIS + ((size_t)l * MS + (r - MP)) * 64) + cc;
            *(f32x4*)o32 = v; v2u o; o.x = pk2(v[0], v[1]); o.y = pk2(v[2], v[3]); *(v2u*)((bf16*)(ws + WS_KIB) + (size_t)r * 64 + cc) = o; }
        else { *(f32x4*)((float*)(ws + WS_WI) + (size_t)r * 16 + (c - C_WI)) = v * WISCALE; }
    }
}

__device__ __forceinline__ void ph_idx_scores(const Args& a, int l, LAS unsigned char* lds) {
    TID_LOCAL();
    unsigned char* ws = a.ws; LAS float* qi = (LAS float*)lds; LAS float* wi = qi + 1024;
    const bf16* QIb = (const bf16*)(ws + WS_QIB); const bf16* KIb = (const bf16*)(ws + WS_KIB); const float* WI = (const float*)(ws + WS_WI);
    const int* pt = (const int*)a.in[I_PT]; const float* cki = (const float*)a.in[I_CKI] + (size_t)l * NPOOL * PAGE * IDD;
    for (int r = blockIdx.x; r < MR; r += gridDim.x) {
        __syncthreads();
        for (int i = tid; i < 1024; i += NTHR) qi[i] = bf2f(QIb[(size_t)r * 1024 + i]);
        if (tid < 16) wi[tid] = WI[(size_t)r * 16 + tid];
        __syncthreads();
        const bool pr = r < MP; const int b = pr ? r / SEQ : (r - MP) / DSEQ, t = pr ? r % SEQ : (r - MP) % DSEQ; const int n = pr ? t + 1 : PAST + t + 1;
        float* out = pr ? (float*)(ws + WS_SC) + (size_t)r * SEQ : (float*)(ws + WS_SCS) + (size_t)(r - MP) * SCS_LD;
        for (int s = tid; s < n; s += NTHR) {
            float kv[64];
            if (pr || s >= PAST) { const v4u* kp = (const v4u*)(KIb + (size_t)(pr ? b * SEQ + s : MP + b * DSEQ + (s - PAST)) * 64);
#pragma unroll
                for (int j = 0; j < 8; ++j) { const v4u w = kp[j]; kv[8 * j] = bflo(w.x); kv[8 * j + 1] = bfhi(w.x); kv[8 * j + 2] = bflo(w.y); kv[8 * j + 3] = bfhi(w.y); kv[8 * j + 4] = bflo(w.z); kv[8 * j + 5] = bfhi(w.z); kv[8 * j + 6] = bflo(w.w); kv[8 * j + 7] = bfhi(w.w); } }
            else { const f32x4* kp = (const f32x4*)(cki + ((size_t)pt[b * NPAGES + s / PAGE] * PAGE + (s % PAGE)) * IDD);
#pragma unroll
                for (int j = 0; j < 16; ++j) { const f32x4 w = kp[j]; kv[4 * j] = w[0]; kv[4 * j + 1] = w[1]; kv[4 * j + 2] = w[2]; kv[4 * j + 3] = w[3]; } }
            float sc = 0.f;
            for (int h = 0; h < NIH; ++h) { float d = 0.f;
#pragma unroll
                for (int j = 0; j < 64; ++j) d += qi[h * 64 + j] * kv[j];
                sc += wi[h] * fmaxf(d, 0.f); }
            out[s] = sc;
        }
    }
}

__device__ __forceinline__ void ph_idx_select(const Args& a, LAS unsigned char* lds) {
    TID_LOCAL();
    unsigned char* ws = a.ws; LAS float* sc = (LAS float*)lds; int* SEL = (int*)(ws + WS_SEL);
    for (int r = blockIdx.x; r < MR; r += gridDim.x) {
        const bool pr = r < MP; const int t = pr ? r % SEQ : (r - MP) % DSEQ; const int n = pr ? t + 1 : PAST + t + 1;
        const float* src = pr ? (const float*)(ws + WS_SC) + (size_t)r * SEQ : (const float*)(ws + WS_SCS) + (size_t)(r - MP) * SCS_LD;
        if (n <= TOPK) { for (int s = tid; s < n; s += NTHR) SEL[(size_t)r * TOPK + s] = s; continue; }
        __syncthreads();
        for (int s = tid; s < n; s += NTHR) sc[s] = src[s];
        __syncthreads();
        for (int s = tid; s < n; s += NTHR) { const float v = sc[s]; int rank = 0;
            for (int j = 0; j < n; ++j) { const float w = sc[j]; rank += (w > v || (w == v && j < s)) ? 1 : 0; }
            if (rank < TOPK) SEL[(size_t)r * TOPK + rank] = s; }
    }
}

__device__ __forceinline__ void ph_attn_naive(const Args& a, int l, LAS unsigned char* lds) {
    TID_LOCAL();
    unsigned char* ws = a.ws;
    LAS int* sidx = (LAS int*)lds; LAS float* pl = (LAS float*)(lds + 1024); LAS float* qh = (LAS float*)(lds + 2048); LAS float* red = (LAS float*)(lds + 2560);
    const bf16* Qb = (const bf16*)(ws + WS_QB); const bf16* Kb = (const bf16*)(ws + WS_KB); const bf16* Vb = (const bf16*)(ws + WS_VB); const bf16* Gb = (const bf16*)(ws + WS_GB);
    bf16* AOb = (bf16*)(ws + WS_AOB); const int* SEL = (const int*)(ws + WS_SEL); const int* pt = (const int*)a.in[I_PT]; const float* rb = (const float*)a.in[I_RB];
    const float* ck = (const float*)a.in[I_CK] + (size_t)l * NPOOL * PAGE * 512; const float* cv = (const float*)a.in[I_CV] + (size_t)l * NPOOL * PAGE * 512;
    for (int r = blockIdx.x; r < MR; r += gridDim.x) {
        const bool pr = r < MP; const int b = pr ? r / SEQ : (r - MP) / DSEQ, t = pr ? r % SEQ : (r - MP) % DSEQ; const int tpos = pr ? t : PAST + t; const int n = tpos + 1; const int cnt = n < TOPK ? n : TOPK;
        __syncthreads();
        if (tid < TOPK) sidx[tid] = (tid < cnt) ? SEL[(size_t)r * TOPK + tid] : 0;
        __syncthreads();
        for (int h = 0; h < NH; ++h) { const int g = h / KVG;
            if (tid < HD) qh[tid] = bf2f(Qb[(size_t)r * 2048 + h * HD + tid]);
            __syncthreads();
            float lg = -3.0e38f;
            if (tid < cnt) { const int s = sidx[tid]; float d = 0.f;
                if (pr) { const bf16* kp = Kb + (size_t)(b * SEQ + s) * 512 + g * HD; for (int j = 0; j < HD; ++j) d += qh[j] * bf2f(kp[j]); }
                else if (s < PAST) { const float* kp = ck + ((size_t)pt[b * NPAGES + s / PAGE] * PAGE + (s % PAGE)) * 512 + g * HD; for (int j = 0; j < HD; ++j) d += qh[j] * kp[j]; }
                else { const bf16* kp = Kb + (size_t)(MP + b * DSEQ + (s - PAST)) * 512 + g * HD; for (int j = 0; j < HD; ++j) d += qh[j] * bf2f(kp[j]); }
                lg = d + rb[t5_bucket(tpos - s) * NH + h] * LOG2E; }
            float m = lg;
#pragma unroll
            for (int o = 1; o < 64; o <<= 1) m = fmaxf(m, __shfl_xor(m, o));
            if (lane == 0) red[wave] = m;
            __syncthreads();
            m = fmaxf(fmaxf(fmaxf(red[0], red[1]), fmaxf(red[2], red[3])), fmaxf(fmaxf(red[4], red[5]), fmaxf(red[6], red[7])));
            const float p = (tid < cnt) ? exp2f(lg - m) : 0.f;
            if (tid < TOPK) pl[tid] = p;
            float sm = wave_sum(p);
            if (lane == 0) red[8 + wave] = sm;
            __syncthreads();
            sm = ((red[8] + red[9]) + (red[10] + red[11])) + ((red[12] + red[13]) + (red[14] + red[15]));
            if (tid < HD) { float o = 0.f;
                for (int k = 0; k < cnt; ++k) { const int s = sidx[k]; float vv;
                    if (pr) vv = bf2f(Vb[(size_t)(b * SEQ + s) * 512 + g * HD + tid]);
                    else if (s < PAST) vv = cv[((size_t)pt[b * NPAGES + s / PAGE] * PAGE + (s % PAGE)) * 512 + g * HD + tid];
                    else vv = bf2f(Vb[(size_t)(MP + b * DSEQ + (s - PAST)) * 512 + g * HD + tid]);
                    o += pl[k] * vv; }
                const size_t oi = (size_t)r * 2048 + h * HD + tid;
                AOb[oi] = (bf16)f2bf(o / sm * bf2f(Gb[oi])); }
            __syncthreads();
        }
    }
}

__device__ __forceinline__ void ph_epi_resid(const Args& a) {
    TID_LOCAL(); GTID_LOCAL();
    unsigned char* ws = a.ws; const float* C = (const float*)(ws + WS_C); float* H = (float*)(ws + WS_H); bf16* Hb = (bf16*)(ws + WS_HBB);
    for (size_t e = gtid; e < (size_t)MR * (DM / 4); e += GT) { const size_t o = e * 4; const f32x4 v = *(const f32x4*)(H + o) + *(const f32x4*)(C + o);
        *(f32x4*)(H + o) = v; v2u w; w.x = pk2(v[0], v[1]); w.y = pk2(v[2], v[3]); *(v2u*)(Hb + o) = w; }
}
__device__ __forceinline__ void ph_epi_ple(const Args& a) {
    TID_LOCAL(); GTID_LOCAL();
    unsigned char* ws = a.ws; const float* C = (const float*)(ws + WS_C); const float* C2 = (const float*)(ws + WS_C2); const float* rstd = (const float*)(ws + WS_RSTD);
    float* H = (float*)(ws + WS_H); bf16* Hb = (bf16*)(ws + WS_HBA);
    for (size_t e = gtid; e < (size_t)MR * (DM / 4); e += GT) { const size_t o = e * 4; const int r = (int)(e / (DM / 4)); const float rs = rstd[r];
        const f32x4 c = *(const f32x4*)(C + o), p = *(const f32x4*)(C2 + o); f32x4 v = *(const f32x4*)(H + o);
#pragma unroll
        for (int j = 0; j < 4; ++j) v[j] += sigmoidf_(c[j] * rs) * p[j];
        *(f32x4*)(H + o) = v; v2u w; w.x = pk2(v[0], v[1]); w.y = pk2(v[2], v[3]); *(v2u*)(Hb + o) = w; }
}
__device__ __forceinline__ void ph_epi_ssm_in(const Args& a) {
    TID_LOCAL(); GTID_LOCAL();
    unsigned char* ws = a.ws; const float* C = (const float*)(ws + WS_C); const float* rstd = (const float*)(ws + WS_RSTD);
    for (size_t e = gtid; e < (size_t)MR * 1024; e += GT) { const int r = (int)(e / 1024), c = (int)(e % 1024) * 4;
        f32x4 v = *(const f32x4*)(C + (size_t)r * 4096 + c); v = v * rstd[r];
        if (c < 2048) { v2u o; o.x = pk2(v[0], v[1]); o.y = pk2(v[2], v[3]);
            if (r < MP) { const int b = r / SEQ, t = r % SEQ, g = c / 16, j = c % 16; *(v2u*)((bf16*)(ws + WS_UG) + (((size_t)(b * NGRP + g) * SEQ + t) * 16 + j)) = o; }
            else *(v2u*)((bf16*)(ws + WS_US) + (size_t)(r - MP) * 2048 + c) = o; }
        else { v2u o; o.x = pk2(siluf_(v[0]), siluf_(v[1])); o.y = pk2(siluf_(v[2]), siluf_(v[3])); *(v2u*)((bf16*)(ws + WS_GB) + (size_t)r * 2048 + (c - 2048)) = o; }
    }
}
__device__ __forceinline__ void scan_item(const Args& a, int l, bool pr, int item, int lane) {
    unsigned char* ws = a.ws;
    const int b = item / NGRP, g = item % NGRP, n = lane;
    const size_t gn = ((size_t)l * NGRP + g) * SST + n;
    const float lre = fminf(((const float*)a.in[I_LRE])[gn], -1e-4f), lim = ((const float*)a.in[I_LIM])[gn];
    const float dt = expf(((const float*)a.in[I_LDT])[l * NGRP + g]);
    const float mag = expf(lre * dt), ang = lim * dt; const float are = mag * cosf(ang), aim = mag * sinf(ang);
    const float den = lre * lre + lim * lim; const float cre = ((are - 1.0f) * lre + aim * lim) / den, cim = (aim * lre - (are - 1.0f) * lim) / den;
    float bbr[16], bbi[16], ccr[16], cci[16];
#pragma unroll
    for (int j = 0; j < 16; ++j) { const float br = ((const float*)a.in[I_BRE])[gn * 16 + j], bi = ((const float*)a.in[I_BIM])[gn * 16 + j];
        bbr[j] = cre * br - cim * bi; bbi[j] = cre * bi + cim * br;
        const size_t ci = (((size_t)l * NGRP + g) * 16 + j) * SST + n; ccr[j] = ((const float*)a.in[I_CRE])[ci]; cci[j] = ((const float*)a.in[I_CIM])[ci]; }
    const float dj = ((const float*)a.in[I_SD])[(size_t)l * DM + g * 16 + (lane & 15)];
    float xr = 0.f, xi = 0.f;
    if (!pr) { const size_t si = (((size_t)l * DBATCH + b) * NGRP + g) * SST + n; xr = ((const float*)a.in[I_SRE])[si]; xi = ((const float*)a.in[I_SIM])[si]; }
    const int T = pr ? SEQ : DSEQ;
    const bf16* up = pr ? (const bf16*)(ws + WS_UG) + (size_t)(b * NGRP + g) * SEQ * 16 : (const bf16*)(ws + WS_US) + (size_t)(b * DSEQ) * 2048 + g * 16;
    const int ustride = pr ? 16 : 2048;
    bf16* Yb = (bf16*)(ws + WS_YB);
    for (int t = 0; t < T; ++t) {
        const v4u u0 = *(const v4u*)(up + (size_t)t * ustride), u1 = *(const v4u*)(up + (size_t)t * ustride + 8);
        const float u[16] = {bflo(u0.x), bfhi(u0.x), bflo(u0.y), bfhi(u0.y), bflo(u0.z), bfhi(u0.z), bflo(u0.w), bfhi(u0.w), bflo(u1.x), bfhi(u1.x), bflo(u1.y), bfhi(u1.y), bflo(u1.z), bfhi(u1.z), bflo(u1.w), bfhi(u1.w)};
        float br = 0.f, bi = 0.f;
#pragma unroll
        for (int j = 0; j < 16; ++j) { br += bbr[j] * u[j]; bi += bbi[j] * u[j]; }
        const float nr = are * xr - aim * xi + br, ni = are * xi + aim * xr + bi; xr = nr; xi = ni;
        float yj = 0.f, uj = 0.f;
#pragma unroll
        for (int j = 0; j < 16; ++j) { const float s = wave_sum(ccr[j] * xr - cci[j] * xi); if ((lane & 15) == j) { yj = s; uj = u[j]; } }
        if (lane < 16) { const float y = yj + dj * uj; const int row = pr ? b * SEQ + t : MP + b * DSEQ + t; Yb[(size_t)row * 2048 + g * 16 + lane] = (bf16)f2bf(gelu_tanh(y)); }
    }
    float* osr = a.out + (pr ? O_SRP + (((size_t)l * NBATCH + b) * NGRP + g) * SST : O_SRS + (((size_t)l * DBATCH + b) * NGRP + g) * SST);
    float* osi = a.out + (pr ? O_SIP + (((size_t)l * NBATCH + b) * NGRP + g) * SST : O_SIS + (((size_t)l * DBATCH + b) * NGRP + g) * SST);
    osr[n] = xr; osi[n] = xi;
}
__device__ __forceinline__ void ph_scan_naive(const Args& a, int l) {
    TID_LOCAL();
    for (int vb = blockIdx.x; vb < 256; vb += gridDim.x) {
        if (wave == 0) scan_item(a, l, true, vb, lane);
        else { const int item = vb * 7 + (wave - 1); if (item < DBATCH * NGRP) scan_item(a, l, false, item, lane); }
    }
}
__device__ __forceinline__ void ph_epi_glu(const Args& a, int l) {
    TID_LOCAL(); GTID_LOCAL();
    unsigned char* ws = a.ws; const float* C = (const float*)(ws + WS_C); const float* bg = (const float*)a.in[I_BGLU] + (size_t)l * DM;
    const bf16* Yb = (const bf16*)(ws + WS_YB); const bf16* Gb = (const bf16*)(ws + WS_GB); bf16* AOb = (bf16*)(ws + WS_AOB);
    for (size_t e = gtid; e < (size_t)MR * (DM / 4); e += GT) { const size_t o = e * 4; const int c = (int)(o % DM);
        const f32x4 cv = *(const f32x4*)(C + o), bv = *(const f32x4*)(bg + c); const v2u yw = *(const v2u*)(Yb + o), gw2 = *(const v2u*)(Gb + o);
        const float y[4] = {bflo(yw.x), bfhi(yw.x), bflo(yw.y), bfhi(yw.y)}, gg[4] = {bflo(gw2.x), bfhi(gw2.x), bflo(gw2.y), bfhi(gw2.y)};
        float r[4];
#pragma unroll
        for (int j = 0; j < 4; ++j) r[j] = y[j] * sigmoidf_(cv[j] + bv[j]) * gg[j];
        v2u w; w.x = pk2(r[0], r[1]); w.y = pk2(r[2], r[3]); *(v2u*)(AOb + o) = w; }
}
__device__ __forceinline__ void ph_final(const Args& a) {
    TID_LOCAL(); GTID_LOCAL();
    unsigned char* ws = a.ws; const float* H = (const float*)(ws + WS_H); const float* rstd = (const float*)(ws + WS_RSTD); const float* fw = (const float*)a.in[I_FNW];
    for (size_t e = gtid; e < (size_t)MR * (DM / 4); e += GT) { const size_t o = e * 4; const int r = (int)(e / (DM / 4)), c = (int)(o % DM);
        const f32x4 v = *(const f32x4*)(H + o) * rstd[r] * *(const f32x4*)(fw + c);
        *(f32x4*)(a.out + (r < MP ? O_YP + o : O_YS + (o - (size_t)MP * DM))) = v; }
}

__global__ void __launch_bounds__(NTHR, 2) fwd_kernel(Args args) {
    extern __shared__ __attribute__((aligned(16))) unsigned char lds_raw[];
    LAS unsigned char* lds = (LAS unsigned char*)lds_raw;
    volatile LAS unsigned* MISC = (volatile LAS unsigned*)(lds + MISC_OFF);
    for (int u = threadIdx.x; u < (LDS_BYTES - 131072) / 4; u += NTHR) ((LAS unsigned*)(lds + 131072))[u] = 0u;
    __syncthreads();
    unsigned char* ws = args.ws;
    XcdBarrier bar = xcd_barrier_post((unsigned*)(ws + WS_CTL) + CW_BAR, MISC + 8);
    int ph = 0;
    const int lo = args.ph_lo, hi = args.ph_hi;
    int lp = 0;
#define PH_BEGIN if (lo <= ph && ph < hi) { int l = lp; asm volatile("" : "+s"(l)); const int ia = 2 * l, is = 2 * l + 1; (void)ia; (void)is;
#define PH_END   if (ph + 1 < hi) xcd_barrier(bar); } ++ph;
#define GEMM_F32(Aptr, Bptr, Npad, Kdim, Cptr) do { pg8::Gemm g_{(const pg8::bf16_t*)(Aptr), (const pg8::bf16_t*)(Bptr), MPAD, (Npad), (Kdim)}; pg8::StaticOrder S_; S_.init(MPAD, (Npad), (int)gridDim.x, (int)blockIdx.x); \
        pg8::EpiF32 E_{(float*)(Cptr), (Npad)}; pg8::gemm_phase<pg8::EpiF32, pg8::StaticOrder, true, true>(lds, g_, S_, E_); } while (0)

    PH_BEGIN ph_prologue(args, lds); PH_END

    for (lp = 0; lp < 2; ++lp) {
        PH_BEGIN ph_rowstat(args); PH_END
        PH_BEGIN GEMM_F32(ws + WS_HBA, (bf16*)(ws + WS_WAIN) + (size_t)l * ACOLS_PAD * DM, ACOLS_PAD, DM, ws + WS_C); PH_END
        PH_BEGIN ph_epi_attn_in(args, l); PH_END
        PH_BEGIN ph_idx_scores(args, l, lds); PH_END
        PH_BEGIN ph_idx_select(args, lds); PH_END
        PH_BEGIN ph_attn_naive(args, l, lds); PH_END
        PH_BEGIN GEMM_F32(ws + WS_AOB, (bf16*)(ws + WS_WAOUT) + (size_t)l * DM * DM, DM, DM, ws + WS_C); PH_END
        PH_BEGIN ph_epi_resid(args); PH_END
        PH_BEGIN ph_rowstat(args); PH_END
        PH_BEGIN GEMM_F32(ws + WS_HBB, (bf16*)(ws + WS_WPG) + (size_t)ia * DM * DM, DM, DM, ws + WS_C); PH_END
        PH_BEGIN GEMM_F32(ws + WS_PB + (size_t)ia * PB_STRIDE, (bf16*)(ws + WS_WPP) + (size_t)ia * DM * PLE, DM, PLE, ws + WS_C2); PH_END
        PH_BEGIN ph_epi_ple(args); PH_END
        PH_BEGIN ph_rowstat(args); PH_END
        PH_BEGIN GEMM_F32(ws + WS_HBA, (bf16*)(ws + WS_WSIN) + (size_t)l * 4096 * DM, 4096, DM, ws + WS_C); PH_END
        PH_BEGIN ph_epi_ssm_in(args); PH_END
        PH_BEGIN ph_scan_naive(args, l); PH_END
        PH_BEGIN GEMM_F32(ws + WS_YB, (bf16*)(ws + WS_WGLU) + (size_t)l * DM * DM, DM, DM, ws + WS_C); PH_END
        PH_BEGIN ph_epi_glu(args, l); PH_END
        PH_BEGIN GEMM_F32(ws + WS_AOB, (bf16*)(ws + WS_WSOUT) + (size_t)l * DM * DM, DM, DM, ws + WS_C); PH_END
        PH_BEGIN ph_epi_resid(args); PH_END
        PH_BEGIN ph_rowstat(args); PH_END
        PH_BEGIN GEMM_F32(ws + WS_HBB, (bf16*)(ws + WS_WPG) + (size_t)is * DM * DM, DM, DM, ws + WS_C); PH_END
        PH_BEGIN GEMM_F32(ws + WS_PB + (size_t)is * PB_STRIDE, (bf16*)(ws + WS_WPP) + (size_t)is * DM * PLE, DM, PLE, ws + WS_C2); PH_END
        PH_BEGIN ph_epi_ple(args); PH_END
    }
    PH_BEGIN ph_rowstat(args); PH_END
    PH_BEGIN ph_final(args); PH_END
}
constexpr int N_PHASES = 1 + 2 * 24 + 2;

#ifndef MK_PER_PHASE
#define MK_PER_PHASE 0
#endif
extern "C" void kernel_launch(void* const* d_in, const int* in_sizes, int n_in, void* d_out, int out_size, void* d_ws, size_t ws_size, hipStream_t stream) {
    static int grid = 0;
    if (grid == 0) {
        if (n_in != N_IN || out_size != (int)O_END || ws_size < WS_END) { fprintf(stderr, "kernel_launch: unexpected shapes: n_in %d out %d ws %zu (need %zu)\n", n_in, out_size, ws_size, (size_t)WS_END); grid = -1; return; }
        int dev = 0, cus = 0, per_cu = 0;
        if (hipGetDevice(&dev) != hipSuccess || hipDeviceGetAttribute(&cus, hipDeviceAttributeMultiprocessorCount, dev) != hipSuccess) { grid = -1; return; }
        if (hipFuncSetAttribute((const void*)fwd_kernel, hipFuncAttributeMaxDynamicSharedMemorySize, LDS_BYTES) != hipSuccess) { fprintf(stderr, "kernel_launch: hipFuncSetAttribute failed\n"); grid = -1; return; }
        if (hipOccupancyMaxActiveBlocksPerMultiprocessor(&per_cu, (const void*)fwd_kernel, NTHR, LDS_BYTES) != hipSuccess || per_cu < 1) fprintf(stderr, "kernel_launch: occupancy query reports %d\n", per_cu);
        (void)hipGetLastError();
        grid = cus;
    }
    if (grid < 0) return;
    if (hipMemsetAsync((char*)d_ws + WS_CTL, 0, CTL_ZERO_BYTES, stream) != hipSuccess) return;
    Args a{};
    for (int i = 0; i < N_IN; ++i) a.in[i] = d_in[i];
    a.out = (float*)d_out; a.ws = (unsigned char*)d_ws;
#if MK_PER_PHASE
    for (int p = 0; p < N_PHASES; ++p) { a.ph_lo = p; a.ph_hi = p + 1; hipLaunchKernelGGL(fwd_kernel, dim3(grid), dim3(NTHR), LDS_BYTES, stream, a); }
#else
    a.ph_lo = 0; a.ph_hi = N_PHASES;
    hipLaunchKernelGGL(fwd_kernel, dim3(grid), dim3(NTHR), LDS_BYTES, stream, a);
#endif
    const hipError_t le = hipPeekAtLastError();
    if (le != hipSuccess) fprintf(stderr, "kernel_launch: launch failed: %s\n", hipGetErrorName(le));
}
```

```cpp
#include <hip/hip_runtime.h>
#include <cstdio>
#include <cstdint>

namespace pg8 {
#define PG8_LAS __attribute__((address_space(3)))
typedef unsigned short bf16_t;
typedef short bf16x8 __attribute__((ext_vector_type(8)));
typedef float f32x4 __attribute__((ext_vector_type(4)));
typedef unsigned u32x4 __attribute__((ext_vector_type(4)));
constexpr int BM = 256, BK = 64, HALF = 128, HTB = HALF * BK * 2, STAGE_BYTES = 8 * HTB, NXCD = 8, WGM = 8;

__host__ __device__ __forceinline__ int lds_byte(int r, int c) { const int st = (r >> 4) * 2 + (c >> 5), rr = r & 15, cc = c & 31, ob = rr * 64 + cc * 2; return st * 1024 + (ob ^ (((ob >> 9) & 1) << 5)); }
__host__ __device__ __forceinline__ void stage_rc(int b, int& R, int& C) { const int st = b / 1024, sb = b % 1024, swz = sb ^ (((sb >> 9) & 1) << 5); R = (st >> 1) * 16 + swz / 64; C = (st & 1) * 32 + (swz % 64) / 2; }

struct Unit { int pm, pn; };
struct Gemm { const bf16_t* A; const bf16_t* Bt; int M, N, K; };

struct StaticOrder {
    int nM, nN, nwg, G, c;
    __host__ __device__ void init(int M, int N, int G_, int c_) { nM = M / BM; nN = N / BM; nwg = nM * nN; G = G_; c = c_; }
    __host__ __device__ bool next(int i, Unit& u) const {
        const long L = (long)i * G + c; if (L >= nwg) return false;
        int wgid = (int)L; { const int q = nwg / NXCD, r = nwg % NXCD, xcd = wgid % NXCD, off = wgid / NXCD; wgid = (xcd < r ? xcd * (q + 1) : r * (q + 1) + (xcd - r) * q) + off; }
        const int nig = WGM * nN, gid = wgid / nig, fm = gid * WGM, gsz = (nM - fm) < WGM ? (nM - fm) : WGM;
        u.pm = fm + ((wgid % nig) % gsz); u.pn = (wgid % nig) / gsz; return true;
    }
    __device__ __forceinline__ void a_ready(const Unit&) const {}
    __device__ __forceinline__ void done(const Unit&) const {}
};

struct EpiF32 {
    float* C; int ldc;
    __device__ __forceinline__ void operator()(const f32x4 (&acc)[2][2][4][2], const Unit& u, int wr, int wc, int fr, int fq) const {
        const int row0 = u.pm * BM + wr * 64 + fr, col0 = u.pn * BM + wc * 32 + 4 * fq;
#pragma unroll
        for (int ai = 0; ai < 2; ++ai)
#pragma unroll
            for (int m = 0; m < 4; ++m) { float* rowp = C + (size_t)(row0 + ai * HALF + m * 16) * ldc + col0;
#pragma unroll
                for (int bj = 0; bj < 2; ++bj)
#pragma unroll
                    for (int n = 0; n < 2; ++n) *(f32x4*)(rowp + bj * HALF + n * 16) = acc[ai][bj][m][n]; }
    }
};

template <class Epi, class Sched, bool ALIGN_EPI = false, bool SP2 = false>
__device__ __forceinline__ void gemm_phase(PG8_LAS unsigned char* lds, const Gemm g, const Sched& S, const Epi& E) {
    int tid = threadIdx.x; asm volatile("" : "+v"(tid));
    const int wid = __builtin_amdgcn_readfirstlane(tid >> 6), lane = tid & 63, wr = wid >> 2, wc = wid & 3, fr = lane & 15, fq = lane >> 4;
    const int K = g.K, nt = K / BK;
    unsigned voffA[2], voffB[2];
#pragma unroll
    for (int i = 0; i < 2; ++i) { int R, C; stage_rc(tid * 16 + i * 8192, R, C); const int Rb = R;
        voffA[i] = (unsigned)(R * K + C) * 2u; voffB[i] = (unsigned)(Rb * K + C) * 2u; }
    const size_t kstep = (size_t)(BK * 2);
    const size_t hstep = (size_t)HALF * K * 2;
    const size_t tstep = 2 * hstep;
    const unsigned ldsw = (unsigned)wid * 1024u;
    const int aoff = lds_byte(wr * 64 + fr, fq * 8), boff = lds_byte(wc * 32 + fr, fq * 8);
#define PG8_SA(b, h) (((b) * 2 + (h)) * HTB)
#define PG8_SB(b, h) ((4 + (b) * 2 + (h)) * HTB)
#define PG8_STAGE(bufoff, gbase, voff) do { _Pragma("unroll") for (int _i = 0; _i < 2; ++_i) \
        __builtin_amdgcn_global_load_lds((const unsigned*)((const char*)(gbase) + (voff)[_i]), (PG8_LAS unsigned*)(lds + (bufoff) + ldsw + _i * 8192), 16, 0, 0); } while (0)
#define PG8_LDA(dst, b, h) do { _Pragma("unroll") for (int m = 0; m < 4; ++m) _Pragma("unroll") for (int k = 0; k < 2; ++k) dst[m][k] = *(const PG8_LAS bf16x8*)(lds + PG8_SA(b, h) + aoff + m * 2048 + k * 1024); } while (0)
#define PG8_LDB(dst, b, h) do { _Pragma("unroll") for (int n = 0; n < 2; ++n) _Pragma("unroll") for (int k = 0; k < 2; ++k) dst[n][k] = *(const PG8_LAS bf16x8*)(lds + PG8_SB(b, h) + boff + n * 2048 + k * 1024); } while (0)
#define PG8_MMA(ai, bj, At, Bt) do { __builtin_amdgcn_s_setprio(1); _Pragma("unroll") for (int m = 0; m < 4; ++m) _Pragma("unroll") for (int n = 0; n < 2; ++n) _Pragma("unroll") for (int k = 0; k < 2; ++k) \
        acc[ai][bj][m][n] = __builtin_amdgcn_mfma_f32_16x16x32_bf16(Bt[n][k], At[m][k], acc[ai][bj][m][n], 0, 0, 0); __builtin_amdgcn_s_setprio(0); } while (0)
#define PG8_WAIT_V(n) asm volatile("s_waitcnt vmcnt(" #n ")" ::: "memory")
#define PG8_WAIT_L(n) asm volatile("s_waitcnt lgkmcnt(" #n ")" ::: "memory")
#define PG8_BAR __builtin_amdgcn_s_barrier()
#define PG8_SCHED __builtin_amdgcn_sched_barrier(0)
    Unit cur, nxt; int ui = 0;
    if (!S.next(0, cur)) return;
    f32x4 acc[2][2][4][2];
#pragma unroll
    for (int a = 0; a < 2; ++a)
#pragma unroll
        for (int b = 0; b < 2; ++b)
#pragma unroll
            for (int m = 0; m < 4; ++m)
#pragma unroll
                for (int n = 0; n < 2; ++n) acc[a][b][m][n] = (f32x4){0.f, 0.f, 0.f, 0.f};
    bf16x8 At[4][2], B0[2][2], B1[2][2];
    const char* cA = (const char*)g.A + (size_t)cur.pm * tstep; const char* cB = (const char*)g.Bt + (size_t)cur.pn * tstep;
    S.a_ready(cur);
    if constexpr (SP2) {
        PG8_STAGE(PG8_SB(0, 0), cB, voffB); PG8_STAGE(PG8_SB(0, 1), cB + hstep, voffB); PG8_STAGE(PG8_SA(0, 0), cA, voffA); PG8_STAGE(PG8_SA(0, 1), cA + hstep, voffA);
        if (wr == 1) PG8_BAR;
        PG8_WAIT_V(2); PG8_BAR;
        PG8_STAGE(PG8_SB(1, 0), cB + kstep, voffB); PG8_STAGE(PG8_SA(1, 0), cA + kstep, voffA); PG8_STAGE(PG8_SB(1, 1), cB + hstep + kstep, voffB);
        PG8_WAIT_V(6); PG8_BAR;
    } else {
        PG8_STAGE(PG8_SB(0, 0), cB, voffB); PG8_STAGE(PG8_SA(0, 0), cA, voffA); PG8_STAGE(PG8_SB(0, 1), cB + hstep, voffB); PG8_STAGE(PG8_SA(0, 1), cA + hstep, voffA);
        if (wr == 1) PG8_BAR;
        PG8_WAIT_V(4); PG8_BAR;
        PG8_STAGE(PG8_SB(1, 0), cB + kstep, voffB); PG8_STAGE(PG8_SA(1, 0), cA + kstep, voffA); PG8_STAGE(PG8_SB(1, 1), cB + hstep + kstep, voffB);
        PG8_WAIT_V(6); PG8_BAR;
    }
    for (;;) {
        const bool has_next = S.next(ui + 1, nxt);
        const char* nA = has_next ? (const char*)g.A + (size_t)nxt.pm * tstep : cA; const char* nB = has_next ? (const char*)g.Bt + (size_t)nxt.pn * tstep : cB;
        for (int t = 0; t < nt; t += 2) {
            const bool last = (t == nt - 2);
            const char* a1 = cA + (size_t)(t + 1) * kstep;
            const char* a2 = last ? nA : cA + (size_t)(t + 2) * kstep; const char* b2 = last ? nB : cB + (size_t)(t + 2) * kstep;
            const char* a3 = a2 + kstep; const char* b3 = b2 + kstep;
            if (last && has_next) S.a_ready(nxt);
            if constexpr (SP2) {
            PG8_LDB(B0, 0, 0); PG8_LDB(B1, 0, 1); PG8_SCHED; PG8_LDA(At, 0, 0); PG8_STAGE(PG8_SA(1, 1), a1 + hstep, voffA);
            PG8_WAIT_V(8); PG8_WAIT_L(0); PG8_BAR; PG8_MMA(0, 0, At, B0); PG8_MMA(0, 1, At, B1); PG8_BAR; PG8_SCHED;
            PG8_LDA(At, 0, 1); PG8_STAGE(PG8_SB(0, 0), b2, voffB); PG8_STAGE(PG8_SB(0, 1), b2 + hstep, voffB); PG8_STAGE(PG8_SA(0, 0), a2, voffA);
            PG8_WAIT_V(8); PG8_WAIT_L(0); PG8_BAR; PG8_MMA(1, 0, At, B0); PG8_MMA(1, 1, At, B1); PG8_BAR; PG8_SCHED;
            PG8_LDB(B0, 1, 0); PG8_LDB(B1, 1, 1); PG8_SCHED; PG8_LDA(At, 1, 0); PG8_STAGE(PG8_SA(0, 1), a2 + hstep, voffA);
            PG8_WAIT_V(8); PG8_WAIT_L(0); PG8_BAR; PG8_MMA(0, 0, At, B0); PG8_MMA(0, 1, At, B1); PG8_BAR; PG8_SCHED;
            PG8_LDA(At, 1, 1); PG8_STAGE(PG8_SB(1, 0), b3, voffB); PG8_STAGE(PG8_SB(1, 1), b3 + hstep, voffB); PG8_STAGE(PG8_SA(1, 0), a3, voffA);
            PG8_WAIT_V(8); PG8_WAIT_L(0); PG8_BAR; PG8_MMA(1, 0, At, B0); PG8_MMA(1, 1, At, B1); PG8_BAR; PG8_SCHED;
            } else {
            PG8_LDB(B0, 0, 0); PG8_SCHED; PG8_LDA(At, 0, 0); PG8_STAGE(PG8_SA(1, 1), a1 + hstep, voffA);
            PG8_WAIT_L(8); PG8_BAR; PG8_WAIT_L(0); PG8_MMA(0, 0, At, B0); PG8_BAR; PG8_SCHED;
            PG8_LDB(B1, 0, 1); PG8_STAGE(PG8_SB(0, 0), b2, voffB);
            PG8_BAR; PG8_WAIT_L(0); PG8_MMA(0, 1, At, B1); PG8_BAR;
            PG8_LDA(At, 0, 1); PG8_STAGE(PG8_SA(0, 0), a2, voffA);
            PG8_BAR; PG8_WAIT_L(0); PG8_MMA(1, 0, At, B0); PG8_BAR; PG8_SCHED;
            PG8_STAGE(PG8_SB(0, 1), b2 + hstep, voffB);
            PG8_WAIT_V(6); PG8_BAR; PG8_MMA(1, 1, At, B1); PG8_BAR;
            PG8_LDB(B0, 1, 0); PG8_SCHED; PG8_LDA(At, 1, 0); PG8_STAGE(PG8_SA(0, 1), a2 + hstep, voffA);
            PG8_WAIT_L(8); PG8_BAR; PG8_WAIT_L(0); PG8_MMA(0, 0, At, B0); PG8_BAR; PG8_SCHED;
            PG8_LDB(B1, 1, 1); PG8_STAGE(PG8_SB(1, 0), b3, voffB);
            PG8_BAR; PG8_WAIT_L(0); PG8_MMA(0, 1, At, B1); PG8_BAR;
            PG8_LDA(At, 1, 1); PG8_STAGE(PG8_SA(1, 0), a3, voffA);
            PG8_BAR; PG8_WAIT_L(0); PG8_MMA(1, 0, At, B0); PG8_BAR; PG8_SCHED;
            PG8_STAGE(PG8_SB(1, 1), b3 + hstep, voffB);
            PG8_WAIT_V(6); PG8_BAR; PG8_MMA(1, 1, At, B1); PG8_BAR;
            }
        }
        if constexpr (ALIGN_EPI) { if (wr == 0) PG8_BAR; }
        E(acc, cur, wr, wc, fr, fq); S.done(cur);
        if (!has_next) break;
#pragma unroll
        for (int a = 0; a < 2; ++a)
#pragma unroll
            for (int b = 0; b < 2; ++b)
#pragma unroll
                for (int m = 0; m < 4; ++m)
#pragma unroll
                    for (int n = 0; n < 2; ++n) acc[a][b][m][n] = (f32x4){0.f, 0.f, 0.f, 0.f};
        cur = nxt; cA = nA; cB = nB; ++ui;
        if constexpr (ALIGN_EPI) { if (wr == 1) PG8_BAR; }
    }
    PG8_WAIT_V(0);
    if constexpr (!ALIGN_EPI) { if (wr == 0) PG8_BAR; }
    PG8_BAR;
#undef PG8_SA
#undef PG8_SB
#undef PG8_STAGE
#undef PG8_LDA
#undef PG8_LDB
#undef PG8_MMA
#undef PG8_WAIT_V
#undef PG8_WAIT_L
#undef PG8_BAR
#undef PG8_SCHED
}
}

constexpr int NWAVES = 8, NTHR = NWAVES * 64;
constexpr int DM = 2048, NBATCH = 2, SEQ = 4096, DEPTH = 4, DBATCH = 8, DSEQ = 4, PAST = 16384, PAGE = 128;
constexpr int NPAGES = PAST / PAGE, NPOOL = 1280, NAL = 2, NSL = 2;
constexpr int NH = 16, NKV = 4, HD = 128, KVG = 4, NIH = 16, IDD = 64, TOPK = 256;
constexpr int ACOLS = 6224, ACOLS_PAD = 6400;
constexpr int C_Q = 0, C_K = 2048, C_V = 2560, C_G = 3072, C_QI = 5120, C_KI = 6144, C_WI = 6208;
constexpr int SGRP = 16, NGRP = 128, SST = 64, PLE = 256;
constexpr int MP = NBATCH * SEQ, MS = DBATCH * DSEQ, MR = MP + MS, MPAD = 8448;
constexpr float RMS_EPS = 1e-6f;
constexpr float LOG2E = 1.4426950408889634f;
constexpr float QSCALE = 0.088388347648318440f * LOG2E;
constexpr float WISCALE = 0.25f * 0.125f;
enum { I_XP = 0, I_XS, I_CK, I_CV, I_CKI, I_SRE, I_SIM, I_PT, I_PP, I_PS, I_NW, I_FNW, I_RB, I_AWI, I_AWO, I_SWI, I_LRE, I_LIM, I_LDT, I_BRE, I_BIM, I_CRE, I_CIM, I_SD, I_WGLU, I_BGLU, I_SWO, I_PNW, I_PWG, I_PWP, N_IN };
constexpr size_t O_YP = 0, O_YS = O_YP + (size_t)MP * DM, O_KP = O_YS + (size_t)MS * DM, O_VP = O_KP + (size_t)NAL * MP * 512, O_KIP = O_VP + (size_t)NAL * MP * 512,
    O_SRP = O_KIP + (size_t)NAL * MP * 64, O_SIP = O_SRP + (size_t)NSL * NBATCH * NGRP * SST, O_KS = O_SIP + (size_t)NSL * NBATCH * NGRP * SST, O_VS = O_KS + (size_t)NAL * MS * 512,
    O_KIS = O_VS + (size_t)NAL * MS * 512, O_SRS = O_KIS + (size_t)NAL * MS * 64, O_SIS = O_SRS + (size_t)NSL * DBATCH * NGRP * SST, O_END = O_SIS + (size_t)NSL * DBATCH * NGRP * SST;
static_assert(O_END == 35065856, "output size");

constexpr size_t MiB = 1u << 20;
constexpr size_t WS_CTL = 0, CTL_ZERO_BYTES = 1 * MiB;
constexpr size_t WS_WAIN = 2 * MiB;
constexpr size_t WS_WAOUT = WS_WAIN + 50 * MiB;
constexpr size_t WS_WSIN = WS_WAOUT + 16 * MiB;
constexpr size_t WS_WGLU = WS_WSIN + 32 * MiB;
constexpr size_t WS_WSOUT = WS_WGLU + 16 * MiB;
constexpr size_t WS_WPG = WS_WSOUT + 16 * MiB;
constexpr size_t WS_WPP = WS_WPG + 32 * MiB;
constexpr size_t WS_H = WS_WPP + 4 * MiB;
constexpr size_t WS_HBA = WS_H + 66 * MiB, WS_HBB = WS_HBA + 33 * MiB;
constexpr size_t WS_PB = WS_HBB + 33 * MiB;
constexpr size_t PB_STRIDE = (size_t)MPAD * PLE * 2;
constexpr size_t WS_QB = WS_PB + 17 * MiB;
constexpr size_t WS_KB = WS_QB + 33 * MiB, WS_VB = WS_KB + 9 * MiB;
constexpr size_t WS_GB = WS_VB + 9 * MiB;
constexpr size_t WS_QIB = WS_GB + 33 * MiB;
constexpr size_t WS_KIB = WS_QIB + 17 * MiB;
constexpr size_t WS_WI = WS_KIB + 2 * MiB;
constexpr size_t WS_AOB = WS_WI + 1 * MiB;
constexpr size_t WS_UG = WS_AOB + 33 * MiB;
constexpr size_t WS_US = WS_UG + 32 * MiB;
constexpr size_t WS_YB = WS_US + 1 * MiB;
constexpr size_t WS_RSTD = WS_YB + 33 * MiB;
constexpr size_t WS_C = WS_RSTD + 1 * MiB;
constexpr size_t WS_C2 = WS_C + 207 * MiB;
constexpr size_t WS_SC = WS_C2 + 66 * MiB;
constexpr size_t WS_SCS = WS_SC + 128 * MiB;
constexpr int SCS_LD = 16400;
constexpr size_t WS_SEL = WS_SCS + 3 * MiB;
constexpr size_t WS_KM = WS_SEL + 9 * MiB;
constexpr size_t WS_END = WS_KM + 4 * MiB;
constexpr int CW_BAR = 4096;

constexpr int LDS_BYTES = 147456;
constexpr int MISC_OFF = 131072 + 320;

#define GAS __attribute__((address_space(1)))
#define LAS __attribute__((address_space(3)))
typedef unsigned short bf16;
typedef unsigned v4u __attribute__((ext_vector_type(4)));
typedef unsigned v2u __attribute__((ext_vector_type(2)));
typedef float f32x4 __attribute__((ext_vector_type(4)));
#define LDS_WAIT() asm volatile("s_waitcnt lgkmcnt(0)" ::: "memory")
__device__ __forceinline__ unsigned f2bf(float f) { unsigned u = __builtin_bit_cast(unsigned, f); return (u + 0x7fffu + ((u >> 16) & 1u)) >> 16; }
__device__ __forceinline__ unsigned pk2(float lo, float hi) { return f2bf(lo) | (f2bf(hi) << 16); }
__device__ __forceinline__ float bf2f(unsigned short b) { return __builtin_bit_cast(float, ((unsigned)b) << 16); }
__device__ __forceinline__ float bflo(unsigned w) { return __builtin_bit_cast(float, w << 16); }
__device__ __forceinline__ float bfhi(unsigned w) { return __builtin_bit_cast(float, w & 0xffff0000u); }
__device__ __forceinline__ float sigmoidf_(float x) { return 1.0f / (1.0f + __expf(-x)); }
__device__ __forceinline__ float siluf_(float x) { return x * sigmoidf_(x); }
__device__ __forceinline__ float gelu_tanh(float x) { const float u = 0.7978845608028654f * (x + 0.044715f * x * x * x); return x * sigmoidf_(2.0f * u); }
__device__ __forceinline__ float wave_sum(float v) {
#pragma unroll
    for (int o = 1; o < 64; o <<= 1) v += __shfl_xor(v, o);
    return v;
}
__device__ __forceinline__ int t5_bucket(int n) {
    if (n < 16) return n;
    int b = 16;
    b += (n >= 19) + (n >= 21) + (n >= 24) + (n >= 27) + (n >= 31) + (n >= 35) + (n >= 40) + (n >= 46) + (n >= 52) + (n >= 59) + (n >= 67) + (n >= 77) + (n >= 87) + (n >= 99) + (n >= 113);
    return b;
}

#define XB_TMO      128
#define XB_XCNT(j)  (256  + 64 * (j))
#define XB_XSUB(j)  (1280 + 64 * (j))
#define XB_XGEN(j)  (2304 + 64 * (j))
#define XB_TOP      3328
#define XB_TOPGEN   3392
#define XCD_BAR_WORDS 3456
#define XB_SPIN_CAP (1u << 22)
__device__ __forceinline__ unsigned xb_ld(unsigned* p)              { return __hip_atomic_load(p, __ATOMIC_RELAXED, __HIP_MEMORY_SCOPE_AGENT); }
__device__ __forceinline__ unsigned xb_add(unsigned* p, unsigned v) { return __hip_atomic_fetch_add(p, v, __ATOMIC_RELAXED, __HIP_MEMORY_SCOPE_AGENT); }
__device__ __forceinline__ unsigned xb_xcc_id() { return (unsigned)__builtin_amdgcn_s_getreg((3 << 11) | 20) & 0xFu; }
#define XB_SPIN(cond, bar) do { unsigned _sp = 0; while (cond) { __builtin_amdgcn_s_sleep(1); \
    if ((++_sp & 255u) == 0u) { if (xb_ld(&(bar)[XB_TMO])) break; if (_sp > XB_SPIN_CAP) { atomicAdd(&(bar)[XB_TMO], 1u); break; } } } } while (0)
struct XcdBarrier { unsigned* bar; unsigned x; volatile LAS unsigned* st; };
__device__ __forceinline__ XcdBarrier xcd_barrier_post(unsigned* bar, volatile LAS unsigned* st) {
    XcdBarrier b; b.bar = bar; b.x = xb_xcc_id(); b.st = st;
    if (threadIdx.x == 0) (void)xb_add(&bar[XB_XCNT(b.x)], 1u);
    return b;
}
__device__ __forceinline__ void xcd_barrier_complete(unsigned* bar, unsigned x, unsigned& nloc, unsigned& nx) {
    const unsigned G = gridDim.x * gridDim.y * gridDim.z;
    unsigned sum, cnt, mine, sp = 0u;
    for (;;) {
        sum = 0u; cnt = 0u; mine = 0u;
#pragma unroll
        for (unsigned j = 0; j < 16; ++j) { const unsigned c = xb_ld(&bar[XB_XCNT(j)]); sum += c; cnt += (c > 0u) ? 1u : 0u; mine = (j == x) ? c : mine; }
        if (sum == G) break;
        __builtin_amdgcn_s_sleep(1);
        if ((++sp & 255u) == 0u) { if (xb_ld(&bar[XB_TMO])) break; if (sp > XB_SPIN_CAP) { atomicAdd(&bar[XB_TMO], 1u); break; } }
    }
    nloc = mine > 0u ? mine : 1u; nx = cnt > 0u ? cnt : 1u;
}
__device__ __forceinline__ void xcd_barrier(const XcdBarrier& b) {
    asm volatile("s_waitcnt vmcnt(0)" ::: "memory");
    __syncthreads();
    if (threadIdx.x == 0) {
        unsigned* bar = b.bar;
        __builtin_amdgcn_s_waitcnt(0);
        unsigned nloc = b.st[0], nx = b.st[1];
        if (nloc == 0u) { xcd_barrier_complete(bar, b.x, nloc, nx); b.st[0] = nloc; b.st[1] = nx; }
        const unsigned old = xb_add(&bar[XB_XSUB(b.x)], 1u);
        const unsigned gen = old / nloc;
        if (old + 1u == (gen + 1u) * nloc) {
            __builtin_amdgcn_fence(__ATOMIC_RELEASE, "agent");
            asm volatile("s_waitcnt vmcnt(0)" ::: "memory");
            const unsigned og = xb_add(&bar[XB_TOP], 1u);
            const unsigned tg = og / nx;
            if (og + 1u == (tg + 1u) * nx) xb_add(&bar[XB_TOPGEN], 1u);
            else XB_SPIN(xb_ld(&bar[XB_TOPGEN]) == tg, bar);
            __builtin_amdgcn_fence(__ATOMIC_ACQUIRE, "agent");
            xb_add(&bar[XB_XGEN(b.x)], 1u);
            asm volatile("s_waitcnt vmcnt(0)" ::: "memory");
        } else {
            XB_SPIN(xb_ld(&bar[XB_XGEN(b.x)]) == gen, bar);
            __builtin_amdgcn_fence(__ATOMIC_ACQUIRE, "agent");
            asm volatile("s_waitcnt vmcnt(0)" ::: "memory");
        }
    }
    __syncthreads();
}

struct Args { const void* in[N_IN]; float* out; unsigned char* ws; int ph_lo, ph_hi; };
typedef const __attribute__((address_space(4))) Args* ArgP;
#define TID_LOCAL() ArgP a = a_; asm volatile("" : "+s"(a)); int tid = threadIdx.x; asm volatile("" : "+v"(tid)); const int lane = tid & 63, wave = __builtin_amdgcn_readfirstlane(tid >> 6); const int gw = blockIdx.x * NWAVES + wave, NGW = gridDim.x * NWAVES; (void)lane; (void)wave; (void)gw; (void)NGW
#define GTID_LOCAL() const size_t gtid = (size_t)blockIdx.x * NTHR + tid, GT = (size_t)gridDim.x * NTHR

__device__ __forceinline__ void transpose_item(const float* W, int K, int N, const float* scale, bf16* WT, LAS float* scr, int item, int lane) {
    const int nblk = (N + 31) / 32, kb = item / nblk, nb = item % nblk, k0 = 64 * kb, n0 = 32 * nb;
#pragma unroll 8
    for (int i = 0; i < 32; ++i) { const int kk = 2 * i + (lane >> 5); const int n = n0 + (lane & 31);
        float v = (n < N) ? W[(size_t)(k0 + kk) * N + n] : 0.f; if (scale) v *= scale[k0 + kk];
        scr[kk * 33 + (lane & 31)] = v; }
    LDS_WAIT(); asm volatile("" ::: "memory");
    const int c = lane & 7;
#pragma unroll
    for (int j = 0; j < 4; ++j) { const int n = (lane >> 3) + 8 * j; const LAS float* s = scr + (8 * c) * 33 + n;
        v4u o; o.x = pk2(s[0 * 33], s[1 * 33]); o.y = pk2(s[2 * 33], s[3 * 33]); o.z = pk2(s[4 * 33], s[5 * 33]); o.w = pk2(s[6 * 33], s[7 * 33]);
        *(v4u*)(WT + (size_t)(n0 + n) * K + k0 + 8 * c) = o; }
    LDS_WAIT(); asm volatile("" ::: "memory");
}

__device__ __forceinline__ void ph_prologue(ArgP a_, LAS unsigned char* lds) {
    TID_LOCAL();
    LAS float* scr = (LAS float*)(lds + wave * 16384);
    unsigned char* ws = a->ws;
    for (int m = 0; m < 18; ++m) {
        const float* W; int K = DM, N = DM; const float* sc = nullptr; bf16* WT;
        if (m < 2)       { W = (const float*)a->in[I_AWI] + (size_t)m * DM * ACOLS; N = ACOLS; sc = (const float*)a->in[I_NW] + (size_t)(2 * m) * DM; WT = (bf16*)(ws + WS_WAIN) + (size_t)m * ACOLS_PAD * DM; }
        else if (m < 4)  { const int l = m - 2; W = (const float*)a->in[I_AWO] + (size_t)l * DM * DM; WT = (bf16*)(ws + WS_WAOUT) + (size_t)l * DM * DM; }
        else if (m < 6)  { const int l = m - 4; W = (const float*)a->in[I_SWI] + (size_t)l * DM * 4096; N = 4096; sc = (const float*)a->in[I_NW] + (size_t)(2 * l + 1) * DM; WT = (bf16*)(ws + WS_WSIN) + (size_t)l * 4096 * DM; }
        else if (m < 8)  { const int l = m - 6; W = (const float*)a->in[I_WGLU] + (size_t)l * DM * DM; WT = (bf16*)(ws + WS_WGLU) + (size_t)l * DM * DM; }
        else if (m < 10) { const int l = m - 8; W = (const float*)a->in[I_SWO] + (size_t)l * DM * DM; WT = (bf16*)(ws + WS_WSOUT) + (size_t)l * DM * DM; }
        else if (m < 14) { const int i = m - 10; W = (const float*)a->in[I_PWG] + (size_t)i * DM * DM; sc = (const float*)a->in[I_PNW] + (size_t)i * DM; WT = (bf16*)(ws + WS_WPG) + (size_t)i * DM * DM; }
        else             { const int i = m - 14; W = (const float*)a->in[I_PWP] + (size_t)i * PLE * DM; K = PLE; WT = (bf16*)(ws + WS_WPP) + (size_t)i * DM * PLE; }
        const int nitems = (K / 64) * ((N + 31) / 32);
        for (int it = gw; it < nitems; it += NGW) transpose_item(W, K, N, sc, WT, scr, it, lane);
    }
    float* H = (float*)(ws + WS_H); bf16* Hb = (bf16*)(ws + WS_HBA);
    for (int r = gw; r < MR; r += NGW) {
        const float* src = (r < MP) ? (const float*)a->in[I_XP] + (size_t)r * DM : (const float*)a->in[I_XS] + (size_t)(r - MP) * DM;
#pragma unroll
        for (int j = 0; j < 8; ++j) { const int c = (j * 64 + lane) * 4; const f32x4 v = *(const f32x4*)(src + c);
            *(f32x4*)(H + (size_t)r * DM + c) = v; v2u o; o.x = pk2(v[0], v[1]); o.y = pk2(v[2], v[3]); *(v2u*)(Hb + (size_t)r * DM + c) = o; }
    }
    for (int q = gw; q < DEPTH * MR; q += NGW) { const int i = q / MR, r = q % MR;
        const float* src = (r < MP) ? (const float*)a->in[I_PP] + ((size_t)i * MP + r) * PLE : (const float*)a->in[I_PS] + ((size_t)i * MS + (r - MP)) * PLE;
        const f32x4 v = *(const f32x4*)(src + lane * 4); v2u o; o.x = pk2(v[0], v[1]); o.y = pk2(v[2], v[3]);
        *(v2u*)((bf16*)(ws + WS_PB + (size_t)i * PB_STRIDE) + (size_t)r * PLE + lane * 4) = o; }
}

__device__ __forceinline__ void ph_rowstat(ArgP a_) {
    TID_LOCAL();
    const float* H = (const float*)(a->ws + WS_H); float* rstd = (float*)(a->ws + WS_RSTD);
    for (int r = gw; r < MR; r += NGW) { float s = 0.f;
#pragma unroll
        for (int j = 0; j < 8; ++j) { const f32x4 v = *(const f32x4*)(H + (size_t)r * DM + (j * 64 + lane) * 4); s += v[0] * v[0] + v[1] * v[1] + v[2] * v[2] + v[3] * v[3]; }
        s = wave_sum(s); if (lane == 0) rstd[r] = 1.0f / sqrtf(s * (1.0f / DM) + RMS_EPS); }
}

__device__ __forceinline__ void ph_epi_attn_in(ArgP a_, int l) {
    TID_LOCAL(); GTID_LOCAL();
    unsigned char* ws = a->ws; const float* C = (const float*)(ws + WS_C); const float* rstd = (const float*)(ws + WS_RSTD);
    constexpr int NG4 = ACOLS / 4;
    for (size_t e = gtid; e < (size_t)MR * NG4; e += GT) { const int r = (int)(e / NG4), c = (int)(e % NG4) * 4;
        f32x4 v = *(const f32x4*)(C + (size_t)r * ACOLS_PAD + c); const float rs = rstd[r]; v = v * rs;
        if (c < C_K) { v = v * QSCALE; v2u o; o.x = pk2(v[0], v[1]); o.y = pk2(v[2], v[3]); *(v2u*)((bf16*)(ws + WS_QB) + (size_t)r * 2048 + c) = o; }
        else if (c < C_G) { const bool isv = c >= C_V; const int cc = c - (isv ? C_V : C_K);
            float* o32 = a->out + (r < MP ? (isv ? O_VP : O_KP) + ((size_t)l * MP + r) * 512 : (isv ? O_VS : O_KS) + ((size_t)l * MS + (r - MP)) * 512) + cc;
            *(f32x4*)o32 = v; v2u o; o.x = pk2(v[0], v[1]); o.y = pk2(v[2], v[3]); *(v2u*)((bf16*)(ws + (isv ? WS_VB : WS_KB)) + (size_t)r * 512 + cc) = o; }
        else if (c < C_QI) { v2u o; o.x = pk2(siluf_(v[0]), siluf_(v[1])); o.y = pk2(siluf_(v[2]), siluf_(v[3])); *(v2u*)((bf16*)(ws + WS_GB) + (size_t)r * 2048 + (c - C_G)) = o; }
        else if (c < C_KI) { v2u o; o.x = pk2(v[0], v[1]); o.y = pk2(v[2], v[3]); *(v2u*)((bf16*)(ws + WS_QIB) + (size_t)r * 1024 + (c - C_QI)) = o; }
        else if (c < C_WI) { const int cc = c - C_KI; float* o32 = a->out + (r < MP ? O_KIP + ((size_t)l * MP + r) * 64 : O_KIS + ((size_t)l * MS + (r - MP)) * 64) + cc;
            *(f32x4*)o32 = v; v2u o; o.x = pk2(v[0], v[1]); o.y = pk2(v[2], v[3]); *(v2u*)((bf16*)(ws + WS_KIB) + (size_t)r * 64 + cc) = o; }
        else { *(f32x4*)((float*)(ws + WS_WI) + (size_t)r * 16 + (c - C_WI)) = v * WISCALE; }
    }
}

__device__ __forceinline__ void ph_idx_scores(ArgP a_, int l, LAS unsigned char* lds) {
    TID_LOCAL();
    unsigned char* ws = a->ws; LAS float* qi = (LAS float*)lds; LAS float* wi = qi + 1024;
    const bf16* QIb = (const bf16*)(ws + WS_QIB); const bf16* KIb = (const bf16*)(ws + WS_KIB); const float* WI = (const float*)(ws + WS_WI);
    const int* pt = (const int*)a->in[I_PT]; const float* cki = (const float*)a->in[I_CKI] + (size_t)l * NPOOL * PAGE * IDD;
    for (int r = MP + blockIdx.x; r < MR; r += gridDim.x) {
        __syncthreads();
        for (int i = tid; i < 1024; i += NTHR) qi[i] = bf2f(QIb[(size_t)r * 1024 + i]);
        if (tid < 16) wi[tid] = WI[(size_t)r * 16 + tid];
        __syncthreads();
        const bool pr = r < MP; const int b = pr ? r / SEQ : (r - MP) / DSEQ, t = pr ? r % SEQ : (r - MP) % DSEQ; const int n = pr ? t + 1 : PAST + t + 1;
        float* out = pr ? (float*)(ws + WS_SC) + (size_t)r * SEQ : (float*)(ws + WS_SCS) + (size_t)(r - MP) * SCS_LD;
        for (int s = tid; s < n; s += NTHR) {
            float kv[64];
            if (pr || s >= PAST) { const v4u* kp = (const v4u*)(KIb + (size_t)(pr ? b * SEQ + s : MP + b * DSEQ + (s - PAST)) * 64);
#pragma unroll
                for (int j = 0; j < 8; ++j) { const v4u w = kp[j]; kv[8 * j] = bflo(w.x); kv[8 * j + 1] = bfhi(w.x); kv[8 * j + 2] = bflo(w.y); kv[8 * j + 3] = bfhi(w.y); kv[8 * j + 4] = bflo(w.z); kv[8 * j + 5] = bfhi(w.z); kv[8 * j + 6] = bflo(w.w); kv[8 * j + 7] = bfhi(w.w); } }
            else { const f32x4* kp = (const f32x4*)(cki + ((size_t)pt[b * NPAGES + s / PAGE] * PAGE + (s % PAGE)) * IDD);
#pragma unroll
                for (int j = 0; j < 16; ++j) { const f32x4 w = kp[j]; kv[4 * j] = w[0]; kv[4 * j + 1] = w[1]; kv[4 * j + 2] = w[2]; kv[4 * j + 3] = w[3]; } }
            float sc = 0.f;
            for (int h = 0; h < NIH; ++h) { float d = 0.f;
#pragma unroll
                for (int j = 0; j < 64; ++j) d += qi[h * 64 + j] * kv[j];
                sc += wi[h] * fmaxf(d, 0.f); }
            out[s] = sc;
        }
    }
}

__device__ __forceinline__ void ph_idx_select(ArgP a_, LAS unsigned char* lds) {
    TID_LOCAL();
    unsigned char* ws = a->ws; LAS float* sc = (LAS float*)lds; int* SEL = (int*)(ws + WS_SEL);
    for (int r = MP + blockIdx.x; r < MR; r += gridDim.x) {
        const bool pr = r < MP; const int t = pr ? r % SEQ : (r - MP) % DSEQ; const int n = pr ? t + 1 : PAST + t + 1;
        const float* src = pr ? (const float*)(ws + WS_SC) + (size_t)r * SEQ : (const float*)(ws + WS_SCS) + (size_t)(r - MP) * SCS_LD;
        if (n <= TOPK) { for (int s = tid; s < n; s += NTHR) SEL[(size_t)r * TOPK + s] = s; continue; }
        __syncthreads();
        for (int s = tid; s < n; s += NTHR) sc[s] = src[s];
        __syncthreads();
        for (int s = tid; s < n; s += NTHR) { const float v = sc[s]; int rank = 0;
            for (int j = 0; j < n; ++j) { const float w = sc[j]; rank += (w > v || (w == v && j < s)) ? 1 : 0; }
            if (rank < TOPK) SEL[(size_t)r * TOPK + rank] = s; }
    }
}


typedef short bf16x8v __attribute__((ext_vector_type(8)));
__device__ __forceinline__ unsigned mono_key(float x) { const unsigned b = __builtin_bit_cast(unsigned, x); return b ^ ((unsigned)((int)b >> 31) | 0x80000000u); }
__device__ __forceinline__ int wave_sum_i(int v) {
#pragma unroll
    for (int o = 1; o < 64; o <<= 1) v += __shfl_xor(v, o);
    return v;
}
__device__ __forceinline__ int lane_prefix(unsigned long long m) { return (int)__builtin_amdgcn_mbcnt_hi((unsigned)(m >> 32), __builtin_amdgcn_mbcnt_lo((unsigned)m, 0u)); }
constexpr size_t KM_WORDS = (size_t)NBATCH * 128 * 64 * 32;

__device__ __forceinline__ void select_wave(const float* sc, int n, int lane, LAS unsigned* ldsk, unsigned long long* km, int* sel) {
    const int nc = (n + 255) >> 8, ne = (n + 63) >> 6;
    for (int i = lane; i < nc * 256; i += 64) ldsk[i] = (i < n) ? mono_key(sc[i]) : 0u;
    LDS_WAIT();
    unsigned T = 0u; int need = TOPK, toteq = 0;
    if (n > TOPK) {
        for (int bit = 31; bit >= 0; --bit) { const unsigned cand = T | (1u << bit); int c = 0;
            for (int ch = 0; ch < nc; ++ch) { const v4u k = *(const LAS v4u*)(ldsk + ch * 256 + lane * 4); c += (k.x >= cand) + (k.y >= cand) + (k.z >= cand) + (k.w >= cand); }
            c = __builtin_amdgcn_readfirstlane(wave_sum_i(c));
            if (c >= TOPK) { T = cand; if (c == TOPK) break; } }
        int cg = 0, ce = 0;
        for (int ch = 0; ch < nc; ++ch) { const v4u k = *(const LAS v4u*)(ldsk + ch * 256 + lane * 4); cg += (k.x > T) + (k.y > T) + (k.z > T) + (k.w > T); ce += (k.x == T) + (k.y == T) + (k.z == T) + (k.w == T); }
        need = TOPK - __builtin_amdgcn_readfirstlane(wave_sum_i(cg));
        toteq = __builtin_amdgcn_readfirstlane(wave_sum_i(ce));
    }
    const bool all_eq = (toteq <= need);
    int base_eq = 0, base_sel = 0;
    for (int e = 0; e < ne; ++e) {
        const int idx = e * 64 + lane; const unsigned k = ldsk[idx]; const bool valid = idx < n; bool s;
        if (n <= TOPK) s = valid;
        else if (all_eq) s = valid && k >= T;
        else { const bool eq = valid && k == T; const unsigned long long em = __ballot(eq); s = valid && (k > T || (eq && base_eq + lane_prefix(em) < need)); base_eq += __popcll(em); }
        const unsigned long long sm = __ballot(s);
        if (lane == 0) km[(size_t)e * 32] = sm;
        if (s) sel[base_sel + lane_prefix(sm)] = idx;
        base_sel += __popcll(sm);
    }
}

__device__ __forceinline__ void ph_idx(ArgP a_, int l, LAS unsigned char* lds) {
    TID_LOCAL();
    unsigned char* ws = a->ws;
    const bf16* QIb = (const bf16*)(ws + WS_QIB); const bf16* KIb = (const bf16*)(ws + WS_KIB); const float* WI = (const float*)(ws + WS_WI);
    float* SC = (float*)(ws + WS_SC); unsigned long long* KM = (unsigned long long*)(ws + WS_KM); int* SEL = (int*)(ws + WS_SEL);
    const int fr = lane & 15, kg = lane >> 4;
    for (int vb = blockIdx.x; vb < 256; vb += gridDim.x) {
        const int b = vb >> 7, x = vb & 127;
        for (int half = 0; half < 2; ++half) {
            const int qt = half ? 255 - x : x; const size_t qrow = (size_t)b * SEQ + qt * 16 + fr;
            bf16x8v Bq[16][2]; float w[16];
#pragma unroll
            for (int h = 0; h < 16; ++h) { Bq[h][0] = *(const bf16x8v*)(QIb + qrow * 1024 + h * 64 + kg * 8); Bq[h][1] = *(const bf16x8v*)(QIb + qrow * 1024 + h * 64 + 32 + kg * 8); w[h] = WI[qrow * 16 + h]; }
            for (int kt = wave; kt <= qt; kt += NWAVES) {
                const bf16* kp = KIb + ((size_t)b * SEQ + kt * 16 + fr) * 64 + kg * 8;
                const bf16x8v A0 = *(const bf16x8v*)kp, A1 = *(const bf16x8v*)(kp + 32);
                f32x4 S = {0.f, 0.f, 0.f, 0.f};
#pragma unroll
                for (int h = 0; h < 16; ++h) { f32x4 acc = {0.f, 0.f, 0.f, 0.f};
                    acc = __builtin_amdgcn_mfma_f32_16x16x32_bf16(A0, Bq[h][0], acc, 0, 0, 0); acc = __builtin_amdgcn_mfma_f32_16x16x32_bf16(A1, Bq[h][1], acc, 0, 0, 0);
#pragma unroll
                    for (int j = 0; j < 4; ++j) S[j] += w[h] * fmaxf(acc[j], 0.f); }
                *(f32x4*)(SC + qrow * SEQ + kt * 16 + kg * 4) = S;
            }
        }
        asm volatile("s_waitcnt vmcnt(0)" ::: "memory"); __syncthreads();
        for (int j = 0; j < 4; ++j) { const int qt = (j & 2) ? 255 - x : x; const int t = qt * 16 + wave * 2 + (j & 1); const size_t row = (size_t)b * SEQ + t;
            select_wave(SC + row * SEQ, t + 1, lane, (LAS unsigned*)(lds + wave * 16384), KM + (((size_t)b * 128 + (t >> 5)) * 64) * 32 + (t & 31), SEL + row * TOPK); }
        __syncthreads();
    }
}

__device__ __forceinline__ void ph_attn_naive(ArgP a_, int l, LAS unsigned char* lds) {
    TID_LOCAL();
    unsigned char* ws = a->ws;
    LAS int* sidx = (LAS int*)lds; LAS float* pl = (LAS float*)(lds + 1024); LAS float* qh = (LAS float*)(lds + 2048); LAS float* red = (LAS float*)(lds + 2560);
    const bf16* Qb = (const bf16*)(ws + WS_QB); const bf16* Kb = (const bf16*)(ws + WS_KB); const bf16* Vb = (const bf16*)(ws + WS_VB); const bf16* Gb = (const bf16*)(ws + WS_GB);
    bf16* AOb = (bf16*)(ws + WS_AOB); const int* SEL = (const int*)(ws + WS_SEL); const int* pt = (const int*)a->in[I_PT]; const float* rb = (const float*)a->in[I_RB];
    const float* ck = (const float*)a->in[I_CK] + (size_t)l * NPOOL * PAGE * 512; const float* cv = (const float*)a->in[I_CV] + (size_t)l * NPOOL * PAGE * 512;
    for (int r = MP + blockIdx.x; r < MR; r += gridDim.x) {
        const bool pr = r < MP; const int b = pr ? r / SEQ : (r - MP) / DSEQ, t = pr ? r % SEQ : (r - MP) % DSEQ; const int tpos = pr ? t : PAST + t; const int n = tpos + 1; const int cnt = n < TOPK ? n : TOPK;
        __syncthreads();
        if (tid < TOPK) sidx[tid] = (tid < cnt) ? SEL[(size_t)r * TOPK + tid] : 0;
        __syncthreads();
        for (int h = 0; h < NH; ++h) { const int g = h / KVG;
            if (tid < HD) qh[tid] = bf2f(Qb[(size_t)r * 2048 + h * HD + tid]);
            __syncthreads();
            float lg = -3.0e38f;
            if (tid < cnt) { const int s = sidx[tid]; float d = 0.f;
                if (pr) { const bf16* kp = Kb + (size_t)(b * SEQ + s) * 512 + g * HD; for (int j = 0; j < HD; ++j) d += qh[j] * bf2f(kp[j]); }
                else if (s < PAST) { const float* kp = ck + ((size_t)pt[b * NPAGES + s / PAGE] * PAGE + (s % PAGE)) * 512 + g * HD; for (int j = 0; j < HD; ++j) d += qh[j] * kp[j]; }
                else { const bf16* kp = Kb + (size_t)(MP + b * DSEQ + (s - PAST)) * 512 + g * HD; for (int j = 0; j < HD; ++j) d += qh[j] * bf2f(kp[j]); }
                lg = d + rb[t5_bucket(tpos - s) * NH + h] * LOG2E; }
            float m = lg;
#pragma unroll
            for (int o = 1; o < 64; o <<= 1) m = fmaxf(m, __shfl_xor(m, o));
            if (lane == 0) red[wave] = m;
            __syncthreads();
            m = fmaxf(fmaxf(fmaxf(red[0], red[1]), fmaxf(red[2], red[3])), fmaxf(fmaxf(red[4], red[5]), fmaxf(red[6], red[7])));
            const float p = (tid < cnt) ? exp2f(lg - m) : 0.f;
            if (tid < TOPK) pl[tid] = p;
            float sm = wave_sum(p);
            if (lane == 0) red[8 + wave] = sm;
            __syncthreads();
            sm = ((red[8] + red[9]) + (red[10] + red[11])) + ((red[12] + red[13]) + (red[14] + red[15]));
            if (tid < HD) { float o = 0.f;
                for (int k = 0; k < cnt; ++k) { const int s = sidx[k]; float vv;
                    if (pr) vv = bf2f(Vb[(size_t)(b * SEQ + s) * 512 + g * HD + tid]);
                    else if (s < PAST) vv = cv[((size_t)pt[b * NPAGES + s / PAGE] * PAGE + (s % PAGE)) * 512 + g * HD + tid];
                    else vv = bf2f(Vb[(size_t)(MP + b * DSEQ + (s - PAST)) * 512 + g * HD + tid]);
                    o += pl[k] * vv; }
                const size_t oi = (size_t)r * 2048 + h * HD + tid;
                AOb[oi] = (bf16)f2bf(o / sm * bf2f(Gb[oi])); }
            __syncthreads();
        }
    }
}


namespace att {
using bf16x8 = __attribute__((ext_vector_type(8))) short;
using s16x4  = __attribute__((ext_vector_type(4))) short;
using f32x16 = __attribute__((ext_vector_type(16))) float;
constexpr int KVBLK = 64;
constexpr int SHM_V = KVBLK * 128 * 2, SHM_K = KVBLK * 128 * 2;
constexpr float THR2 = 8.0f;
#define ATT_SDEPTH 1
#define ATT_KSWZ(row, colB) ((row) * 256 + ((colB) ^ (((row) & 7) << 4)))
#define ATT_SBAR() __builtin_amdgcn_sched_barrier(0)
__device__ __forceinline__ int crow(int r, int hi) { return (r & 3) + 8 * (r >> 2) + 4 * hi; }
__device__ __forceinline__ unsigned cvtpk(float lo, float hi) { unsigned r; asm volatile("v_cvt_pk_bf16_f32 %0, %1, %2" : "=v"(r) : "v"(lo), "v"(hi)); return r; }
__device__ __forceinline__ int v_st(int k, int c) { const int kk = (k & ~0xC) | ((k & 4) << 1) | ((k & 8) >> 1); return ((kk >> 3) * 4 + (c >> 5)) * 512 + ((kk & 7) * 32 + (c & 31)) * 2; }
__device__ __forceinline__ int v_rd_base(int lane) { return ((lane & 3) << 3) | (((lane >> 2) & 3) << 6) | (((lane >> 4) & 1) << 5) | (((lane >> 5) & 1) << 8); }
constexpr int v_rd_off(int d0, int ks, int half) { return d0 * 512 + ks * 4096 + half * 2048; }
template <int OFF> __device__ __forceinline__ s16x4 tr_read(int vb) { s16x4 r; asm volatile("ds_read_b64_tr_b16 %0, %1 offset:%2" : "=&v"(r) : "v"(vb), "i"(OFF) : "memory"); return r; }

__device__ __forceinline__ void partialSM(f32x16& p0, f32x16& p1, float& m_reg, float& mn, float& alpha) {
    float pmax = p0[0];
#pragma unroll
    for (int r = 1; r < 16; ++r) pmax = fmaxf(pmax, p0[r]);
#pragma unroll
    for (int r = 0; r < 16; ++r) pmax = fmaxf(pmax, p1[r]);
    { auto rr = __builtin_amdgcn_permlane32_swap(__builtin_bit_cast(unsigned, pmax), __builtin_bit_cast(unsigned, pmax), false, false);
      const unsigned u0 = rr[0], u1 = rr[1]; pmax = fmaxf(__builtin_bit_cast(float, u0), __builtin_bit_cast(float, u1)); }
    if (__builtin_expect(__all(pmax - m_reg <= THR2), 1)) { mn = m_reg; alpha = 1.f; }
    else { mn = fmaxf(m_reg, pmax); alpha = __builtin_amdgcn_exp2f(m_reg - mn); m_reg = mn; }
#pragma unroll
    for (int r = 0; r < 16; ++r) p0[r] = __builtin_amdgcn_exp2f(p0[r] - mn);
#pragma unroll
    for (int r = 0; r < 16; ++r) p1[r] = p1[r] - mn;
}
__device__ __forceinline__ void finishSM(f32x16& p0, f32x16& p1, float alpha, float& l_reg, unsigned long long mk, int hi, bf16x8& pa0, bf16x8& pa1, bf16x8& pa2, bf16x8& pa3) {
#pragma unroll
    for (int r = 0; r < 16; ++r) p1[r] = __builtin_amdgcn_exp2f(p1[r]);
    const unsigned w0 = (unsigned)mk >> (4 * hi), w1 = (unsigned)(mk >> 32) >> (4 * hi);
#pragma unroll
    for (int r = 0; r < 16; ++r) { const int pos = (r & 3) + 8 * (r >> 2);
        const float a0 = p0[r], a1 = p1[r];
        p0[r] = __builtin_bit_cast(float, __builtin_bit_cast(unsigned, a0) & (unsigned)__builtin_amdgcn_sbfe((int)w0, pos, 1));
        p1[r] = __builtin_bit_cast(float, __builtin_bit_cast(unsigned, a1) & (unsigned)__builtin_amdgcn_sbfe((int)w1, pos, 1)); }
    float ps = 0;
#pragma unroll
    for (int r = 0; r < 16; ++r) ps += p0[r];
#pragma unroll
    for (int r = 0; r < 16; ++r) ps += p1[r];
    { auto rr = __builtin_amdgcn_permlane32_swap(__builtin_bit_cast(unsigned, ps), __builtin_bit_cast(unsigned, ps), false, false);
      const unsigned u0 = rr[0], u1 = rr[1]; ps = __builtin_bit_cast(float, u0) + __builtin_bit_cast(float, u1); }
    l_reg = l_reg * alpha + ps;
#define ATT_PK4(P, BASE, OUT) do { unsigned a0 = cvtpk(P[BASE + 0], P[BASE + 1]), a1 = cvtpk(P[BASE + 2], P[BASE + 3]);   \
    unsigned b0 = cvtpk(P[BASE + 4], P[BASE + 5]), b1 = cvtpk(P[BASE + 6], P[BASE + 7]);                              \
    auto r0 = __builtin_amdgcn_permlane32_swap(a0, b0, false, false); auto r1 = __builtin_amdgcn_permlane32_swap(a1, b1, false, false); \
    v4u w = {r0[0], r1[0], r0[1], r1[1]}; OUT = __builtin_bit_cast(bf16x8, w); } while (0)
    ATT_PK4(p0, 0, pa0); ATT_PK4(p0, 8, pa1); ATT_PK4(p1, 0, pa2); ATT_PK4(p1, 8, pa3);
#undef ATT_PK4
}
__device__ __forceinline__ void qkt(f32x16& p0, f32x16& p1, LAS const char* Ks, const bf16x8* qr, int r32, int hi) {
    p0 = f32x16{}; p1 = f32x16{};
#pragma unroll
    for (int d0 = 0; d0 < 8; ++d0) { const int cb = (d0 * 16 + hi * 8) * 2;
        const bf16x8 b0 = *(LAS const bf16x8*)(Ks + ATT_KSWZ(r32, cb));
        const bf16x8 b1 = *(LAS const bf16x8*)(Ks + ATT_KSWZ(32 + r32, cb));
        p0 = __builtin_amdgcn_mfma_f32_32x32x16_bf16(b0, qr[d0], p0, 0, 0, 0);
        p1 = __builtin_amdgcn_mfma_f32_32x32x16_bf16(b1, qr[d0], p1, 0, 0, 0); }
}
template <int D0> __device__ __forceinline__ void pv_one(f32x16& od, int vb, bf16x8 pa0, bf16x8 pa1, bf16x8 pa2, bf16x8 pa3) {
    const s16x4 l0 = tr_read<v_rd_off(D0, 0, 0)>(vb), h0 = tr_read<v_rd_off(D0, 0, 1)>(vb), l1 = tr_read<v_rd_off(D0, 1, 0)>(vb), h1 = tr_read<v_rd_off(D0, 1, 1)>(vb);
    const s16x4 l2 = tr_read<v_rd_off(D0, 2, 0)>(vb), h2 = tr_read<v_rd_off(D0, 2, 1)>(vb), l3 = tr_read<v_rd_off(D0, 3, 0)>(vb), h3 = tr_read<v_rd_off(D0, 3, 1)>(vb);
    asm volatile("s_waitcnt lgkmcnt(0)" ::: "memory"); ATT_SBAR();
#define ATT_PK(L, H) (bf16x8){L[0], L[1], L[2], L[3], H[0], H[1], H[2], H[3]}
    od = __builtin_amdgcn_mfma_f32_32x32x16_bf16(pa0, ATT_PK(l0, h0), od, 0, 0, 0);
    od = __builtin_amdgcn_mfma_f32_32x32x16_bf16(pa1, ATT_PK(l1, h1), od, 0, 0, 0);
    od = __builtin_amdgcn_mfma_f32_32x32x16_bf16(pa2, ATT_PK(l2, h2), od, 0, 0, 0);
    od = __builtin_amdgcn_mfma_f32_32x32x16_bf16(pa3, ATT_PK(l3, h3), od, 0, 0, 0);
#undef ATT_PK
}
__device__ __forceinline__ void pv_d0(f32x16* o, int vb, bf16x8 pa0, bf16x8 pa1, bf16x8 pa2, bf16x8 pa3) {
    pv_one<0>(o[0], vb, pa0, pa1, pa2, pa3); pv_one<1>(o[1], vb, pa0, pa1, pa2, pa3); pv_one<2>(o[2], vb, pa0, pa1, pa2, pa3); pv_one<3>(o[3], vb, pa0, pa1, pa2, pa3);
}
__device__ __forceinline__ void add_bias(f32x16& p0, f32x16& p1, LAS const float* bt2, int dq) {
    LAS const float* p = bt2 + (255 - dq);
#pragma unroll
    for (int r = 0; r < 16; ++r) { const int c = (r & 3) + 8 * (r >> 2); p0[r] += p[c]; p1[r] += p[c + 32]; }
}
}

__device__ __forceinline__ void ph_attn(ArgP a_, LAS unsigned char* ldsb) {
    using namespace att;
    TID_LOCAL();
    unsigned char* ws = a->ws;
    const bf16* Qb = (const bf16*)(ws + WS_QB); const bf16* Kb = (const bf16*)(ws + WS_KB); const bf16* Vb = (const bf16*)(ws + WS_VB); const bf16* Gb = (const bf16*)(ws + WS_GB);
    bf16* AOb = (bf16*)(ws + WS_AOB); const unsigned long long* KM = (const unsigned long long*)(ws + WS_KM); const float* rb = (const float*)a->in[I_RB];
    LAS char* lds = (LAS char*)ldsb; LAS char* V_lds = lds; LAS char* K_lds = lds + 2 * SHM_V;
    LAS float* wsf = (LAS float*)(lds + 65536) + wave * 64; LAS float* li_l = wsf; LAS float* al_l = wsf + 32;
    LAS float* btab = (LAS float*)(lds + 65536 + 2048);
    const int r32 = lane & 31, hi = lane >> 5, rh = wave & 3, qs = wave >> 2;
    const int sr = tid >> 4, sc = (tid & 15) * 8, vst0 = v_st(sr, sc), vst1 = v_st(32 + sr, sc);
    const int vb0 = (int)(unsigned)(size_t)V_lds + v_rd_base(lane);
    constexpr int LDK = 512;
    for (int vbk = blockIdx.x; vbk < 256; vbk += gridDim.x) {
        const int b = vbk >> 7, g = (vbk >> 5) & 3, x = vbk & 31, h = g * 4 + rh;
        __syncthreads();
        for (int i = tid; i < 4 * 384; i += NTHR) { const int rr = i / 384, d = 255 - (i % 384), hh = g * 4 + rr; btab[i] = (d >= 0 && d < 113) ? (rb[t5_bucket(d) * NH + hh] - rb[31 * NH + hh]) * LOG2E : 0.f; }
        const bf16* Kh = Kb + (size_t)b * SEQ * LDK + g * HD; const bf16* Vh = Vb + (size_t)b * SEQ * LDK + g * HD;
        for (int half = 0; half < 2; ++half) {
            const int jb = half ? 63 - x : x; const int q0w = jb * 64 + qs * 32; const size_t qrow = (size_t)b * SEQ + q0w + r32;
            const int NT = jb + 1, NTp = (NT + 1) & ~1;
            const char* kmu = (const char*)(KM + (((size_t)b * 128 + 2 * jb + qs) * 64) * 32);
            LAS const float* bt = btab + rh * 384; const int qpos = q0w + r32 - 4 * hi;
            float m_reg = -1e30f, l_reg = 0; f32x16 o[4] = {}; bf16x8 qr[8];
            int lq = lane; asm volatile("" : "+v"(lq));
            const bf16* Qw = Qb + ((size_t)b * SEQ + q0w + (lq & 31)) * 2048 + h * HD + (lq >> 5) * 8;
#pragma unroll
            for (int d0 = 0; d0 < 8; ++d0) qr[d0] = *(const bf16x8*)(Qw + d0 * 16);
            struct { bf16x8 vs0, vs1, ks0, ks1; } sr_[ATT_SDEPTH];
            const unsigned toff = (unsigned)(sr * LDK + sc) * 2u;
#define ATT_SLOAD(i, k0) do { const char* vt_ = (const char*)Vh + (size_t)(k0) * (LDK * 2); const char* kt_ = (const char*)Kh + (size_t)(k0) * (LDK * 2); \
    sr_[i].vs0 = *(const bf16x8*)(vt_ + toff); sr_[i].vs1 = *(const bf16x8*)(vt_ + 32 * LDK * 2 + toff); sr_[i].ks0 = *(const bf16x8*)(kt_ + toff); sr_[i].ks1 = *(const bf16x8*)(kt_ + 32 * LDK * 2 + toff); } while (0)
#define ATT_SWRITE(bb, i) do { *(LAS bf16x8*)(V_lds + (bb) * SHM_V + vst0) = sr_[i].vs0; *(LAS bf16x8*)(V_lds + (bb) * SHM_V + vst1) = sr_[i].vs1; const int kc = sc * 2; \
    *(LAS bf16x8*)(K_lds + (bb) * SHM_K + ATT_KSWZ(sr, kc)) = sr_[i].ks0; *(LAS bf16x8*)(K_lds + (bb) * SHM_K + ATT_KSWZ(32 + sr, kc)) = sr_[i].ks1; } while (0)
#define ATT_SWAIT() do { if (ATT_SDEPTH == 2) asm volatile("s_waitcnt vmcnt(4)" ::: "memory"); else asm volatile("s_waitcnt vmcnt(0)" ::: "memory"); } while (0)
#define ATT_RESC(al) do { if (__any((al) < 1.f)) { if (hi == 0) al_l[r32] = (al); asm volatile("s_waitcnt lgkmcnt(0)" ::: "memory"); \
    _Pragma("unroll") for (int d = 0; d < 4; ++d) _Pragma("unroll") for (int r = 0; r < 16; ++r) o[d][r] *= al_l[crow(r, hi)]; } } while (0)
#define ATT_MASK(kt) (((kt) <= jb) ? *(const unsigned long long*)(kmu + (size_t)(kt) * 256 + (unsigned)(r32 * 8)) : 0ull)
#define ATT_BIAS(P0, P1, kt) do { if (64 * (kt) + 176 > q0w) add_bias(P0, P1, bt, qpos - 64 * (kt)); } while (0)
            f32x16 pA0, pA1, pB0, pB1; float mnA, mnB, alA, alB; bf16x8 pa0, pa1, pa2, pa3;
            constexpr int SE = 0, SO = ATT_SDEPTH - 1;
            __syncthreads();
            ATT_SLOAD(SE, 0); asm volatile("s_waitcnt vmcnt(0)" ::: "memory"); ATT_SWRITE(0, SE); __syncthreads();
            qkt(pA0, pA1, K_lds, qr, r32, hi); ATT_BIAS(pA0, pA1, 0); partialSM(pA0, pA1, m_reg, mnA, alA);
            ATT_SLOAD(SO, KVBLK); if (ATT_SDEPTH == 2 && 2 < NTp) ATT_SLOAD(SE, 2 * KVBLK);
            ATT_SWAIT(); ATT_SWRITE(1, SO); __syncthreads();
            for (int j = 1; j + 1 < NTp; j += 2) {
                ATT_SBAR(); qkt(pB0, pB1, K_lds + SHM_K, qr, r32, hi); ATT_BIAS(pB0, pB1, j);
                finishSM(pA0, pA1, alA, l_reg, ATT_MASK(j - 1), hi, pa0, pa1, pa2, pa3); ATT_SBAR();
                ATT_SLOAD(SO, (j + ATT_SDEPTH) * KVBLK); ATT_SBAR();
                pv_d0(o, vb0, pa0, pa1, pa2, pa3); partialSM(pB0, pB1, m_reg, mnB, alB);
                __syncthreads(); ATT_SWAIT(); ATT_SWRITE(0, SE);
                ATT_RESC(alB); __syncthreads();
                ATT_SBAR(); qkt(pA0, pA1, K_lds, qr, r32, hi); ATT_BIAS(pA0, pA1, j + 1);
                finishSM(pB0, pB1, alB, l_reg, ATT_MASK(j), hi, pa0, pa1, pa2, pa3); ATT_SBAR();
                if (ATT_SDEPTH == 1 || j + 3 < NTp) ATT_SLOAD(SE, (j + 1 + ATT_SDEPTH) * KVBLK); ATT_SBAR();
                pv_d0(o, vb0 + SHM_V, pa0, pa1, pa2, pa3); partialSM(pA0, pA1, m_reg, mnA, alA);
                __syncthreads(); ATT_SWAIT(); ATT_SWRITE(1, SO);
                ATT_RESC(alA); __syncthreads();
            }
            ATT_SBAR(); qkt(pB0, pB1, K_lds + SHM_K, qr, r32, hi); ATT_BIAS(pB0, pB1, NTp - 1);
            finishSM(pA0, pA1, alA, l_reg, ATT_MASK(NTp - 2), hi, pa0, pa1, pa2, pa3); ATT_SBAR();
            pv_d0(o, vb0, pa0, pa1, pa2, pa3); partialSM(pB0, pB1, m_reg, mnB, alB);
            __syncthreads(); ATT_RESC(alB);
            finishSM(pB0, pB1, alB, l_reg, ATT_MASK(NTp - 1), hi, pa0, pa1, pa2, pa3); ATT_SBAR();
            pv_d0(o, vb0 + SHM_V, pa0, pa1, pa2, pa3);
            if (hi == 0) li_l[r32] = l_reg; asm volatile("s_waitcnt lgkmcnt(0)" ::: "memory");
            int lane_e = lane; asm volatile("" : "+v"(lane_e)); const int r32e = lane_e & 31, hie = lane_e >> 5;
#pragma unroll
            for (int r = 0; r < 16; ++r) { const int orow = crow(r, hie); const float rli = __builtin_amdgcn_rcpf(li_l[orow]);
                const size_t ob = ((size_t)b * SEQ + q0w + orow) * 2048 + h * HD + r32e;
#pragma unroll
                for (int d0 = 0; d0 < 4; ++d0) AOb[ob + d0 * 32] = (bf16)f2bf(o[d0][r] * rli * bf2f(Gb[ob + d0 * 32]));
                asm volatile("" ::: "memory"); ATT_SBAR(); }
#undef ATT_SLOAD
#undef ATT_SWRITE
#undef ATT_SWAIT
#undef ATT_RESC
#undef ATT_MASK
#undef ATT_BIAS
        }
    }
}

__device__ __forceinline__ void ph_epi_resid(ArgP a_) {
    TID_LOCAL(); GTID_LOCAL();
    unsigned char* ws = a->ws; const float* C = (const float*)(ws + WS_C); float* H = (float*)(ws + WS_H); bf16* Hb = (bf16*)(ws + WS_HBB);
    for (size_t e = gtid; e < (size_t)MR * (DM / 4); e += GT) { const size_t o = e * 4; const f32x4 v = *(const f32x4*)(H + o) + *(const f32x4*)(C + o);
        *(f32x4*)(H + o) = v; v2u w; w.x = pk2(v[0], v[1]); w.y = pk2(v[2], v[3]); *(v2u*)(Hb + o) = w; }
}
__device__ __forceinline__ void ph_epi_ple(ArgP a_) {
    TID_LOCAL(); GTID_LOCAL();
    unsigned char* ws = a->ws; const float* C = (const float*)(ws + WS_C); const float* C2 = (const float*)(ws + WS_C2); const float* rstd = (const float*)(ws + WS_RSTD);
    float* H = (float*)(ws + WS_H); bf16* Hb = (bf16*)(ws + WS_HBA);
    for (size_t e = gtid; e < (size_t)MR * (DM / 4); e += GT) { const size_t o = e * 4; const int r = (int)(e / (DM / 4)); const float rs = rstd[r];
        const f32x4 c = *(const f32x4*)(C + o), p = *(const f32x4*)(C2 + o); f32x4 v = *(const f32x4*)(H + o);
#pragma unroll
        for (int j = 0; j < 4; ++j) v[j] += sigmoidf_(c[j] * rs) * p[j];
        *(f32x4*)(H + o) = v; v2u w; w.x = pk2(v[0], v[1]); w.y = pk2(v[2], v[3]); *(v2u*)(Hb + o) = w; }
}
__device__ __forceinline__ void ph_epi_ssm_in(ArgP a_) {
    TID_LOCAL(); GTID_LOCAL();
    unsigned char* ws = a->ws; const float* C = (const float*)(ws + WS_C); const float* rstd = (const float*)(ws + WS_RSTD);
    for (size_t e = gtid; e < (size_t)MR * 1024; e += GT) { const int r = (int)(e / 1024), c = (int)(e % 1024) * 4;
        f32x4 v = *(const f32x4*)(C + (size_t)r * 4096 + c); v = v * rstd[r];
        if (c < 2048) { v2u o; o.x = pk2(v[0], v[1]); o.y = pk2(v[2], v[3]);
            if (r < MP) { const int b = r / SEQ, t = r % SEQ, g = c / 16, j = c % 16; *(v2u*)((bf16*)(ws + WS_UG) + (((size_t)(b * NGRP + g) * SEQ + t) * 16 + j)) = o; }
            else *(v2u*)((bf16*)(ws + WS_US) + (size_t)(r - MP) * 2048 + c) = o; }
        else { v2u o; o.x = pk2(siluf_(v[0]), siluf_(v[1])); o.y = pk2(siluf_(v[2]), siluf_(v[3])); *(v2u*)((bf16*)(ws + WS_GB) + (size_t)r * 2048 + (c - 2048)) = o; }
    }
}
__device__ __forceinline__ void scan_item(ArgP a, int l, bool pr, int item, int lane) {
    unsigned char* ws = a->ws;
    const int b = item / NGRP, g = item % NGRP, n = lane;
    const size_t gn = ((size_t)l * NGRP + g) * SST + n;
    const float lre = fminf(((const float*)a->in[I_LRE])[gn], -1e-4f), lim = ((const float*)a->in[I_LIM])[gn];
    const float dt = expf(((const float*)a->in[I_LDT])[l * NGRP + g]);
    const float mag = expf(lre * dt), ang = lim * dt; const float are = mag * cosf(ang), aim = mag * sinf(ang);
    const float den = lre * lre + lim * lim; const float cre = ((are - 1.0f) * lre + aim * lim) / den, cim = (aim * lre - (are - 1.0f) * lim) / den;
    float bbr[16], bbi[16], ccr[16], cci[16];
#pragma unroll
    for (int j = 0; j < 16; ++j) { const float br = ((const float*)a->in[I_BRE])[gn * 16 + j], bi = ((const float*)a->in[I_BIM])[gn * 16 + j];
        bbr[j] = cre * br - cim * bi; bbi[j] = cre * bi + cim * br;
        const size_t ci = (((size_t)l * NGRP + g) * 16 + j) * SST + n; ccr[j] = ((const float*)a->in[I_CRE])[ci]; cci[j] = ((const float*)a->in[I_CIM])[ci]; }
    const float dj = ((const float*)a->in[I_SD])[(size_t)l * DM + g * 16 + (lane & 15)];
    float xr = 0.f, xi = 0.f;
    if (!pr) { const size_t si = (((size_t)l * DBATCH + b) * NGRP + g) * SST + n; xr = ((const float*)a->in[I_SRE])[si]; xi = ((const float*)a->in[I_SIM])[si]; }
    const int T = pr ? SEQ : DSEQ;
    const bf16* up = pr ? (const bf16*)(ws + WS_UG) + (size_t)(b * NGRP + g) * SEQ * 16 : (const bf16*)(ws + WS_US) + (size_t)(b * DSEQ) * 2048 + g * 16;
    const int ustride = pr ? 16 : 2048;
    bf16* Yb = (bf16*)(ws + WS_YB);
    for (int t = 0; t < T; ++t) {
        const v4u u0 = *(const v4u*)(up + (size_t)t * ustride), u1 = *(const v4u*)(up + (size_t)t * ustride + 8);
        const float u[16] = {bflo(u0.x), bfhi(u0.x), bflo(u0.y), bfhi(u0.y), bflo(u0.z), bfhi(u0.z), bflo(u0.w), bfhi(u0.w), bflo(u1.x), bfhi(u1.x), bflo(u1.y), bfhi(u1.y), bflo(u1.z), bfhi(u1.z), bflo(u1.w), bfhi(u1.w)};
        float br = 0.f, bi = 0.f;
#pragma unroll
        for (int j = 0; j < 16; ++j) { br += bbr[j] * u[j]; bi += bbi[j] * u[j]; }
        const float nr = are * xr - aim * xi + br, ni = are * xi + aim * xr + bi; xr = nr; xi = ni;
        float yj = 0.f, uj = 0.f;
#pragma unroll
        for (int j = 0; j < 16; ++j) { const float s = wave_sum(ccr[j] * xr - cci[j] * xi); if ((lane & 15) == j) { yj = s; uj = u[j]; } }
        if (lane < 16) { const float y = yj + dj * uj; const int row = pr ? b * SEQ + t : MP + b * DSEQ + t; Yb[(size_t)row * 2048 + g * 16 + lane] = (bf16)f2bf(gelu_tanh(y)); }
    }
    float* osr = a->out + (pr ? O_SRP + (((size_t)l * NBATCH + b) * NGRP + g) * SST : O_SRS + (((size_t)l * DBATCH + b) * NGRP + g) * SST);
    float* osi = a->out + (pr ? O_SIP + (((size_t)l * NBATCH + b) * NGRP + g) * SST : O_SIS + (((size_t)l * DBATCH + b) * NGRP + g) * SST);
    osr[n] = xr; osi[n] = xi;
}
__device__ __forceinline__ void ph_scan_naive(ArgP a_, int l) {
    TID_LOCAL();
    for (int vb = blockIdx.x; vb < 256; vb += gridDim.x) {
        if (wave == 0) scan_item(a, l, true, vb, lane);
        else { const int item = vb * 7 + (wave - 1); if (item < DBATCH * NGRP) scan_item(a, l, false, item, lane); }
    }
}
__device__ __forceinline__ void ph_epi_glu(ArgP a_, int l) {
    TID_LOCAL(); GTID_LOCAL();
    unsigned char* ws = a->ws; const float* C = (const float*)(ws + WS_C); const float* bg = (const float*)a->in[I_BGLU] + (size_t)l * DM;
    const bf16* Yb = (const bf16*)(ws + WS_YB); const bf16* Gb = (const bf16*)(ws + WS_GB); bf16* AOb = (bf16*)(ws + WS_AOB);
    for (size_t e = gtid; e < (size_t)MR * (DM / 4); e += GT) { const size_t o = e * 4; const int c = (int)(o % DM);
        const f32x4 cv = *(const f32x4*)(C + o), bv = *(const f32x4*)(bg + c); const v2u yw = *(const v2u*)(Yb + o), gw2 = *(const v2u*)(Gb + o);
        const float y[4] = {bflo(yw.x), bfhi(yw.x), bflo(yw.y), bfhi(yw.y)}, gg[4] = {bflo(gw2.x), bfhi(gw2.x), bflo(gw2.y), bfhi(gw2.y)};
        float r[4];
#pragma unroll
        for (int j = 0; j < 4; ++j) r[j] = y[j] * sigmoidf_(cv[j] + bv[j]) * gg[j];
        v2u w; w.x = pk2(r[0], r[1]); w.y = pk2(r[2], r[3]); *(v2u*)(AOb + o) = w; }
}
__device__ __forceinline__ void ph_final(ArgP a_) {
    TID_LOCAL(); GTID_LOCAL();
    unsigned char* ws = a->ws; const float* H = (const float*)(ws + WS_H); const float* rstd = (const float*)(ws + WS_RSTD); const float* fw = (const float*)a->in[I_FNW];
    for (size_t e = gtid; e < (size_t)MR * (DM / 4); e += GT) { const size_t o = e * 4; const int r = (int)(e / (DM / 4)), c = (int)(o % DM);
        const f32x4 v = *(const f32x4*)(H + o) * rstd[r] * *(const f32x4*)(fw + c);
        *(f32x4*)(a->out + (r < MP ? O_YP + o : O_YS + (o - (size_t)MP * DM))) = v; }
}

__global__ void __launch_bounds__(NTHR, 2) fwd_kernel(Args args) {
    extern __shared__ __attribute__((aligned(16))) unsigned char lds_raw[];
    LAS unsigned char* lds = (LAS unsigned char*)lds_raw;
    volatile LAS unsigned* MISC = (volatile LAS unsigned*)(lds + MISC_OFF);
    for (int u = threadIdx.x; u < (LDS_BYTES - 131072) / 4; u += NTHR) ((LAS unsigned*)(lds + 131072))[u] = 0u;
    __syncthreads();
    ArgP kap = (ArgP)__builtin_amdgcn_kernarg_segment_ptr();
    XcdBarrier bar = xcd_barrier_post((unsigned*)(kap->ws + WS_CTL) + CW_BAR, MISC + 8);
    int lp = 0;
#define PH_BEGIN { int l = lp; asm volatile("" : "+s"(l)); const int ia = 2 * l, is = 2 * l + 1; (void)ia; (void)is; ArgP args = kap; asm volatile("" : "+s"(args)); unsigned char* ws = args->ws; (void)ws;
#define PH_END   { XcdBarrier b2_ = bar; asm volatile("" : "+s"(b2_.bar), "+s"(b2_.x)); xcd_barrier(b2_); } }
#define PH_LAST  }
#define GEMM_F32(Aptr, Bptr, Npad, Kdim, Cptr) do { pg8::Gemm g_{(const pg8::bf16_t*)(Aptr), (const pg8::bf16_t*)(Bptr), MPAD, (Npad), (Kdim)}; pg8::StaticOrder S_; S_.init(MPAD, (Npad), (int)gridDim.x, (int)blockIdx.x); \
        pg8::EpiF32 E_{(float*)(Cptr), (Npad)}; pg8::gemm_phase<pg8::EpiF32, pg8::StaticOrder, true, true>(lds, g_, S_, E_); } while (0)

    PH_BEGIN ph_prologue(args, lds); PH_END

    for (lp = 0; lp < 2; ++lp) {
        PH_BEGIN ph_rowstat(args); PH_END
        PH_BEGIN GEMM_F32(ws + WS_HBA, (bf16*)(ws + WS_WAIN) + (size_t)l * ACOLS_PAD * DM, ACOLS_PAD, DM, ws + WS_C); PH_END
        PH_BEGIN ph_epi_attn_in(args, l); PH_END
        PH_BEGIN ph_idx(args, l, lds); ph_idx_scores(args, l, lds); PH_END
        PH_BEGIN ph_idx_select(args, lds); PH_END
        PH_BEGIN ph_attn(args, lds); ph_attn_naive(args, l, lds); PH_END
        PH_BEGIN GEMM_F32(ws + WS_AOB, (bf16*)(ws + WS_WAOUT) + (size_t)l * DM * DM, DM, DM, ws + WS_C); PH_END
        PH_BEGIN ph_epi_resid(args); PH_END
        PH_BEGIN ph_rowstat(args); PH_END
        PH_BEGIN GEMM_F32(ws + WS_HBB, (bf16*)(ws + WS_WPG) + (size_t)ia * DM * DM, DM, DM, ws + WS_C); PH_END
        PH_BEGIN GEMM_F32(ws + WS_PB + (size_t)ia * PB_STRIDE, (bf16*)(ws + WS_WPP) + (size_t)ia * DM * PLE, DM, PLE, ws + WS_C2); PH_END
        PH_BEGIN ph_epi_ple(args); PH_END
        PH_BEGIN ph_rowstat(args); PH_END
        PH_BEGIN GEMM_F32(ws + WS_HBA, (bf16*)(ws + WS_WSIN) + (size_t)l * 4096 * DM, 4096, DM, ws + WS_C); PH_END
        PH_BEGIN ph_epi_ssm_in(args); PH_END
        PH_BEGIN ph_scan_naive(args, l); PH_END
        PH_BEGIN GEMM_F32(ws + WS_YB, (bf16*)(ws + WS_WGLU) + (size_t)l * DM * DM, DM, DM, ws + WS_C); PH_END
        PH_BEGIN ph_epi_glu(args, l); PH_END
        PH_BEGIN GEMM_F32(ws + WS_AOB, (bf16*)(ws + WS_WSOUT) + (size_t)l * DM * DM, DM, DM, ws + WS_C); PH_END
        PH_BEGIN ph_epi_resid(args); PH_END
        PH_BEGIN ph_rowstat(args); PH_END
        PH_BEGIN GEMM_F32(ws + WS_HBB, (bf16*)(ws + WS_WPG) + (size_t)is * DM * DM, DM, DM, ws + WS_C); PH_END
        PH_BEGIN GEMM_F32(ws + WS_PB + (size_t)is * PB_STRIDE, (bf16*)(ws + WS_WPP) + (size_t)is * DM * PLE, DM, PLE, ws + WS_C2); PH_END
        PH_BEGIN ph_epi_ple(args); PH_END
    }
    PH_BEGIN ph_rowstat(args); PH_END
    PH_BEGIN ph_final(args); PH_LAST
}
constexpr int N_PHASES = 1 + 2 * 24 + 2;

#ifndef MK_PER_PHASE
#define MK_PER_PHASE 0
#endif
extern "C" void kernel_launch(void* const* d_in, const int* in_sizes, int n_in, void* d_out, int out_size, void* d_ws, size_t ws_size, hipStream_t stream) {
    static int grid = 0;
    if (grid == 0) {
        if (n_in != N_IN || out_size != (int)O_END || ws_size < WS_END) { fprintf(stderr, "kernel_launch: unexpected shapes: n_in %d out %d ws %zu (need %zu)\n", n_in, out_size, ws_size, (size_t)WS_END); grid = -1; return; }
        int dev = 0, cus = 0, per_cu = 0;
        if (hipGetDevice(&dev) != hipSuccess || hipDeviceGetAttribute(&cus, hipDeviceAttributeMultiprocessorCount, dev) != hipSuccess) { grid = -1; return; }
        if (hipFuncSetAttribute((const void*)fwd_kernel, hipFuncAttributeMaxDynamicSharedMemorySize, LDS_BYTES) != hipSuccess) { fprintf(stderr, "kernel_launch: hipFuncSetAttribute failed\n"); grid = -1; return; }
        if (hipOccupancyMaxActiveBlocksPerMultiprocessor(&per_cu, (const void*)fwd_kernel, NTHR, LDS_BYTES) != hipSuccess || per_cu < 1) fprintf(stderr, "kernel_launch: occupancy query reports %d\n", per_cu);
        (void)hipGetLastError();
        grid = cus;
    }
    if (grid < 0) return;
    if (hipMemsetAsync((char*)d_ws + WS_CTL, 0, CTL_ZERO_BYTES, stream) != hipSuccess) return;
    Args a{};
    for (int i = 0; i < N_IN; ++i) a.in[i] = d_in[i];
    a.out = (float*)d_out; a.ws = (unsigned char*)d_ws;
    a.ph_lo = 0; a.ph_hi = N_PHASES;
    hipLaunchKernelGGL(fwd_kernel, dim3(grid), dim3(NTHR), LDS_BYTES, stream, a);
    const hipError_t le = hipPeekAtLastError();
    if (le != hipSuccess) fprintf(stderr, "kernel_launch: launch failed: %s\n", hipGetErrorName(le));
}
```

```cpp
#include <hip/hip_runtime.h>
#include <cstdio>
#include <cstdint>

namespace pg8 {
#define PG8_LAS __attribute__((address_space(3)))
typedef unsigned short bf16_t;
typedef short bf16x8 __attribute__((ext_vector_type(8)));
typedef float f32x4 __attribute__((ext_vector_type(4)));
typedef unsigned u32x4 __attribute__((ext_vector_type(4)));
constexpr int BM = 256, BK = 64, HALF = 128, HTB = HALF * BK * 2, STAGE_BYTES = 8 * HTB, NXCD = 8, WGM = 8;

__host__ __device__ __forceinline__ int lds_byte(int r, int c) { const int st = (r >> 4) * 2 + (c >> 5), rr = r & 15, cc = c & 31, ob = rr * 64 + cc * 2; return st * 1024 + (ob ^ (((ob >> 9) & 1) << 5)); }
__host__ __device__ __forceinline__ void stage_rc(int b, int& R, int& C) { const int st = b / 1024, sb = b % 1024, swz = sb ^ (((sb >> 9) & 1) << 5); R = (st >> 1) * 16 + swz / 64; C = (st & 1) * 32 + (swz % 64) / 2; }

struct Unit { int pm, pn; };
struct Gemm { const bf16_t* A; const bf16_t* Bt; int M, N, K; };

struct StaticOrder {
    int nM, nN, nwg, G, c;
    __host__ __device__ void init(int M, int N, int G_, int c_) { nM = M / BM; nN = N / BM; nwg = nM * nN; G = G_; c = c_; }
    __host__ __device__ bool next(int i, Unit& u) const {
        const long L = (long)i * G + c; if (L >= nwg) return false;
        int wgid = (int)L; { const int q = nwg / NXCD, r = nwg % NXCD, xcd = wgid % NXCD, off = wgid / NXCD; wgid = (xcd < r ? xcd * (q + 1) : r * (q + 1) + (xcd - r) * q) + off; }
        const int nig = WGM * nN, gid = wgid / nig, fm = gid * WGM, gsz = (nM - fm) < WGM ? (nM - fm) : WGM;
        u.pm = fm + ((wgid % nig) % gsz); u.pn = (wgid % nig) / gsz; return true;
    }
    __device__ __forceinline__ void a_ready(const Unit&) const {}
    __device__ __forceinline__ void done(const Unit&) const {}
};

struct EpiF32 {
    float* C; int ldc;
    __device__ __forceinline__ void operator()(const f32x4 (&acc)[2][2][4][2], const Unit& u, int wr, int wc, int fr, int fq) const {
        const int row0 = u.pm * BM + wr * 64 + fr, col0 = u.pn * BM + wc * 32 + 4 * fq;
#pragma unroll
        for (int ai = 0; ai < 2; ++ai)
#pragma unroll
            for (int m = 0; m < 4; ++m) { float* rowp = C + (size_t)(row0 + ai * HALF + m * 16) * ldc + col0;
#pragma unroll
                for (int bj = 0; bj < 2; ++bj)
#pragma unroll
                    for (int n = 0; n < 2; ++n) *(f32x4*)(rowp + bj * HALF + n * 16) = acc[ai][bj][m][n]; }
    }
};

template <class Epi, class Sched, bool ALIGN_EPI = false, bool SP2 = false>
__device__ __forceinline__ void gemm_phase(PG8_LAS unsigned char* lds, const Gemm g, const Sched& S, const Epi& E) {
    int tid = threadIdx.x; asm volatile("" : "+v"(tid));
    const int wid = __builtin_amdgcn_readfirstlane(tid >> 6), lane = tid & 63, wr = wid >> 2, wc = wid & 3, fr = lane & 15, fq = lane >> 4;
    const int K = g.K, nt = K / BK;
    unsigned voffA[2], voffB[2];
#pragma unroll
    for (int i = 0; i < 2; ++i) { int R, C; stage_rc(tid * 16 + i * 8192, R, C); const int Rb = R;
        voffA[i] = (unsigned)(R * K + C) * 2u; voffB[i] = (unsigned)(Rb * K + C) * 2u; }
    const size_t kstep = (size_t)(BK * 2);
    const size_t hstep = (size_t)HALF * K * 2;
    const size_t tstep = 2 * hstep;
    const unsigned ldsw = (unsigned)wid * 1024u;
    const int aoff = lds_byte(wr * 64 + fr, fq * 8), boff = lds_byte(wc * 32 + fr, fq * 8);
#define PG8_SA(b, h) (((b) * 2 + (h)) * HTB)
#define PG8_SB(b, h) ((4 + (b) * 2 + (h)) * HTB)
#define PG8_STAGE(bufoff, gbase, voff) do { _Pragma("unroll") for (int _i = 0; _i < 2; ++_i) \
        __builtin_amdgcn_global_load_lds((const unsigned*)((const char*)(gbase) + (voff)[_i]), (PG8_LAS unsigned*)(lds + (bufoff) + ldsw + _i * 8192), 16, 0, 0); } while (0)
#define PG8_LDA(dst, b, h) do { _Pragma("unroll") for (int m = 0; m < 4; ++m) _Pragma("unroll") for (int k = 0; k < 2; ++k) dst[m][k] = *(const PG8_LAS bf16x8*)(lds + PG8_SA(b, h) + aoff + m * 2048 + k * 1024); } while (0)
#define PG8_LDB(dst, b, h) do { _Pragma("unroll") for (int n = 0; n < 2; ++n) _Pragma("unroll") for (int k = 0; k < 2; ++k) dst[n][k] = *(const PG8_LAS bf16x8*)(lds + PG8_SB(b, h) + boff + n * 2048 + k * 1024); } while (0)
#define PG8_MMA(ai, bj, At, Bt) do { __builtin_amdgcn_s_setprio(1); _Pragma("unroll") for (int m = 0; m < 4; ++m) _Pragma("unroll") for (int n = 0; n < 2; ++n) _Pragma("unroll") for (int k = 0; k < 2; ++k) \
        acc[ai][bj][m][n] = __builtin_amdgcn_mfma_f32_16x16x32_bf16(Bt[n][k], At[m][k], acc[ai][bj][m][n], 0, 0, 0); __builtin_amdgcn_s_setprio(0); } while (0)
#define PG8_WAIT_V(n) asm volatile("s_waitcnt vmcnt(" #n ")" ::: "memory")
#define PG8_WAIT_L(n) asm volatile("s_waitcnt lgkmcnt(" #n ")" ::: "memory")
#define PG8_BAR __builtin_amdgcn_s_barrier()
#define PG8_SCHED __builtin_amdgcn_sched_barrier(0)
    Unit cur, nxt; int ui = 0;
    if (!S.next(0, cur)) return;
    f32x4 acc[2][2][4][2];
#pragma unroll
    for (int a = 0; a < 2; ++a)
#pragma unroll
        for (int b = 0; b < 2; ++b)
#pragma unroll
            for (int m = 0; m < 4; ++m)
#pragma unroll
                for (int n = 0; n < 2; ++n) acc[a][b][m][n] = (f32x4){0.f, 0.f, 0.f, 0.f};
    bf16x8 At[4][2], B0[2][2], B1[2][2];
    const char* cA = (const char*)g.A + (size_t)cur.pm * tstep; const char* cB = (const char*)g.Bt + (size_t)cur.pn * tstep;
    S.a_ready(cur);
    if constexpr (SP2) {
        PG8_STAGE(PG8_SB(0, 0), cB, voffB); PG8_STAGE(PG8_SB(0, 1), cB + hstep, voffB); PG8_STAGE(PG8_SA(0, 0), cA, voffA); PG8_STAGE(PG8_SA(0, 1), cA + hstep, voffA);
        if (wr == 1) PG8_BAR;
        PG8_WAIT_V(2); PG8_BAR;
        PG8_STAGE(PG8_SB(1, 0), cB + kstep, voffB); PG8_STAGE(PG8_SA(1, 0), cA + kstep, voffA); PG8_STAGE(PG8_SB(1, 1), cB + hstep + kstep, voffB);
        PG8_WAIT_V(6); PG8_BAR;
    } else {
        PG8_STAGE(PG8_SB(0, 0), cB, voffB); PG8_STAGE(PG8_SA(0, 0), cA, voffA); PG8_STAGE(PG8_SB(0, 1), cB + hstep, voffB); PG8_STAGE(PG8_SA(0, 1), cA + hstep, voffA);
        if (wr == 1) PG8_BAR;
        PG8_WAIT_V(4); PG8_BAR;
        PG8_STAGE(PG8_SB(1, 0), cB + kstep, voffB); PG8_STAGE(PG8_SA(1, 0), cA + kstep, voffA); PG8_STAGE(PG8_SB(1, 1), cB + hstep + kstep, voffB);
        PG8_WAIT_V(6); PG8_BAR;
    }
    for (;;) {
        const bool has_next = S.next(ui + 1, nxt);
        const char* nA = has_next ? (const char*)g.A + (size_t)nxt.pm * tstep : cA; const char* nB = has_next ? (const char*)g.Bt + (size_t)nxt.pn * tstep : cB;
        for (int t = 0; t < nt; t += 2) {
            const bool last = (t == nt - 2);
            const char* a1 = cA + (size_t)(t + 1) * kstep;
            const char* a2 = last ? nA : cA + (size_t)(t + 2) * kstep; const char* b2 = last ? nB : cB + (size_t)(t + 2) * kstep;
            const char* a3 = a2 + kstep; const char* b3 = b2 + kstep;
            if (last && has_next) S.a_ready(nxt);
            if constexpr (SP2) {
            PG8_LDB(B0, 0, 0); PG8_LDB(B1, 0, 1); PG8_SCHED; PG8_LDA(At, 0, 0); PG8_STAGE(PG8_SA(1, 1), a1 + hstep, voffA);
            PG8_WAIT_V(8); PG8_WAIT_L(0); PG8_BAR; PG8_MMA(0, 0, At, B0); PG8_MMA(0, 1, At, B1); PG8_BAR; PG8_SCHED;
            PG8_LDA(At, 0, 1); PG8_STAGE(PG8_SB(0, 0), b2, voffB); PG8_STAGE(PG8_SB(0, 1), b2 + hstep, voffB); PG8_STAGE(PG8_SA(0, 0), a2, voffA);
            PG8_WAIT_V(8); PG8_WAIT_L(0); PG8_BAR; PG8_MMA(1, 0, At, B0); PG8_MMA(1, 1, At, B1); PG8_BAR; PG8_SCHED;
            PG8_LDB(B0, 1, 0); PG8_LDB(B1, 1, 1); PG8_SCHED; PG8_LDA(At, 1, 0); PG8_STAGE(PG8_SA(0, 1), a2 + hstep, voffA);
            PG8_WAIT_V(8); PG8_WAIT_L(0); PG8_BAR; PG8_MMA(0, 0, At, B0); PG8_MMA(0, 1, At, B1); PG8_BAR; PG8_SCHED;
            PG8_LDA(At, 1, 1); PG8_STAGE(PG8_SB(1, 0), b3, voffB); PG8_STAGE(PG8_SB(1, 1), b3 + hstep, voffB); PG8_STAGE(PG8_SA(1, 0), a3, voffA);
            PG8_WAIT_V(8); PG8_WAIT_L(0); PG8_BAR; PG8_MMA(1, 0, At, B0); PG8_MMA(1, 1, At, B1); PG8_BAR; PG8_SCHED;
            } else {
            PG8_LDB(B0, 0, 0); PG8_SCHED; PG8_LDA(At, 0, 0); PG8_STAGE(PG8_SA(1, 1), a1 + hstep, voffA);
            PG8_WAIT_L(8); PG8_BAR; PG8_WAIT_L(0); PG8_MMA(0, 0, At, B0); PG8_BAR; PG8_SCHED;
            PG8_LDB(B1, 0, 1); PG8_STAGE(PG8_SB(0, 0), b2, voffB);
            PG8_BAR; PG8_WAIT_L(0); PG8_MMA(0, 1, At, B1); PG8_BAR;
            PG8_LDA(At, 0, 1); PG8_STAGE(PG8_SA(0, 0), a2, voffA);
            PG8_BAR; PG8_WAIT_L(0); PG8_MMA(1, 0, At, B0); PG8_BAR; PG8_SCHED;
            PG8_STAGE(PG8_SB(0, 1), b2 + hstep, voffB);
            PG8_WAIT_V(6); PG8_BAR; PG8_MMA(1, 1, At, B1); PG8_BAR;
            PG8_LDB(B0, 1, 0); PG8_SCHED; PG8_LDA(At, 1, 0); PG8_STAGE(PG8_SA(0, 1), a2 + hstep, voffA);
            PG8_WAIT_L(8); PG8_BAR; PG8_WAIT_L(0); PG8_MMA(0, 0, At, B0); PG8_BAR; PG8_SCHED;
            PG8_LDB(B1, 1, 1); PG8_STAGE(PG8_SB(1, 0), b3, voffB);
            PG8_BAR; PG8_WAIT_L(0); PG8_MMA(0, 1, At, B1); PG8_BAR;
            PG8_LDA(At, 1, 1); PG8_STAGE(PG8_SA(1, 0), a3, voffA);
            PG8_BAR; PG8_WAIT_L(0); PG8_MMA(1, 0, At, B0); PG8_BAR; PG8_SCHED;
            PG8_STAGE(PG8_SB(1, 1), b3 + hstep, voffB);
            PG8_WAIT_V(6); PG8_BAR; PG8_MMA(1, 1, At, B1); PG8_BAR;
            }
        }
        if constexpr (ALIGN_EPI) { if (wr == 0) PG8_BAR; }
        E(acc, cur, wr, wc, fr, fq); S.done(cur);
        if (!has_next) break;
#pragma unroll
        for (int a = 0; a < 2; ++a)
#pragma unroll
            for (int b = 0; b < 2; ++b)
#pragma unroll
                for (int m = 0; m < 4; ++m)
#pragma unroll
                    for (int n = 0; n < 2; ++n) acc[a][b][m][n] = (f32x4){0.f, 0.f, 0.f, 0.f};
        cur = nxt; cA = nA; cB = nB; ++ui;
        if constexpr (ALIGN_EPI) { if (wr == 1) PG8_BAR; }
    }
    PG8_WAIT_V(0);
    if constexpr (!ALIGN_EPI) { if (wr == 0) PG8_BAR; }
    PG8_BAR;
#undef PG8_SA
#undef PG8_SB
#undef PG8_STAGE
#undef PG8_LDA
#undef PG8_LDB
#undef PG8_MMA
#undef PG8_WAIT_V
#undef PG8_WAIT_L
#undef PG8_BAR
#undef PG8_SCHED
}
}

constexpr int NWAVES = 8, NTHR = NWAVES * 64;
constexpr int DM = 2048, NBATCH = 2, SEQ = 4096, DEPTH = 4, DBATCH = 8, DSEQ = 4, PAST = 16384, PAGE = 128;
constexpr int NPAGES = PAST / PAGE, NPOOL = 1280, NAL = 2, NSL = 2;
constexpr int NH = 16, NKV = 4, HD = 128, KVG = 4, NIH = 16, IDD = 64, TOPK = 256;
constexpr int ACOLS = 6224, ACOLS_PAD = 6400;
constexpr int C_Q = 0, C_K = 2048, C_V = 2560, C_G = 3072, C_QI = 5120, C_KI = 6144, C_WI = 6208;
constexpr int SGRP = 16, NGRP = 128, SST = 64, PLE = 256;
constexpr int MP = NBATCH * SEQ, MS = DBATCH * DSEQ, MR = MP + MS, MPAD = 8448;
constexpr float RMS_EPS = 1e-6f;
constexpr float LOG2E = 1.4426950408889634f;
constexpr float QSCALE = 0.088388347648318440f * LOG2E;
constexpr float WISCALE = 0.25f * 0.125f;
enum { I_XP = 0, I_XS, I_CK, I_CV, I_CKI, I_SRE, I_SIM, I_PT, I_PP, I_PS, I_NW, I_FNW, I_RB, I_AWI, I_AWO, I_SWI, I_LRE, I_LIM, I_LDT, I_BRE, I_BIM, I_CRE, I_CIM, I_SD, I_WGLU, I_BGLU, I_SWO, I_PNW, I_PWG, I_PWP, N_IN };
constexpr size_t O_YP = 0, O_YS = O_YP + (size_t)MP * DM, O_KP = O_YS + (size_t)MS * DM, O_VP = O_KP + (size_t)NAL * MP * 512, O_KIP = O_VP + (size_t)NAL * MP * 512,
    O_SRP = O_KIP + (size_t)NAL * MP * 64, O_SIP = O_SRP + (size_t)NSL * NBATCH * NGRP * SST, O_KS = O_SIP + (size_t)NSL * NBATCH * NGRP * SST, O_VS = O_KS + (size_t)NAL * MS * 512,
    O_KIS = O_VS + (size_t)NAL * MS * 512, O_SRS = O_KIS + (size_t)NAL * MS * 64, O_SIS = O_SRS + (size_t)NSL * DBATCH * NGRP * SST, O_END = O_SIS + (size_t)NSL * DBATCH * NGRP * SST;
static_assert(O_END == 35065856, "output size");

constexpr size_t MiB = 1u << 20;
constexpr size_t WS_CTL = 0, CTL_ZERO_BYTES = 1 * MiB;
constexpr size_t WS_WAIN = 2 * MiB;
constexpr size_t WS_WAOUT = WS_WAIN + 50 * MiB;
constexpr size_t WS_WSIN = WS_WAOUT + 16 * MiB;
constexpr size_t WS_WGLU = WS_WSIN + 32 * MiB;
constexpr size_t WS_WSOUT = WS_WGLU + 16 * MiB;
constexpr size_t WS_WPG = WS_WSOUT + 16 * MiB;
constexpr size_t WS_WPP = WS_WPG + 32 * MiB;
constexpr size_t WS_H = WS_WPP + 4 * MiB;
constexpr size_t WS_HBA = WS_H + 66 * MiB, WS_HBB = WS_HBA + 33 * MiB;
constexpr size_t WS_PB = WS_HBB + 33 * MiB;
constexpr size_t PB_STRIDE = (size_t)MPAD * PLE * 2;
constexpr size_t WS_QB = WS_PB + 17 * MiB;
constexpr size_t WS_KB = WS_QB + 33 * MiB, WS_VB = WS_KB + 9 * MiB;
constexpr size_t WS_GB = WS_VB + 9 * MiB;
constexpr size_t WS_QIB = WS_GB + 33 * MiB;
constexpr size_t WS_KIB = WS_QIB + 17 * MiB;
constexpr size_t WS_WI = WS_KIB + 2 * MiB;
constexpr size_t WS_AOB = WS_WI + 1 * MiB;
constexpr size_t WS_UG = WS_AOB + 33 * MiB;
constexpr size_t WS_US = WS_UG + 32 * MiB;
constexpr size_t WS_YB = WS_US + 1 * MiB;
constexpr size_t WS_RSTD = WS_YB + 33 * MiB;
constexpr size_t WS_C = WS_RSTD + 1 * MiB;
constexpr size_t WS_C2 = WS_C + 207 * MiB;
constexpr size_t WS_SC = WS_C2 + 66 * MiB;
constexpr size_t WS_SCS = WS_SC + 128 * MiB;
constexpr int SCS_LD = 16400;
constexpr size_t WS_SEL = WS_SCS + 3 * MiB;
constexpr size_t WS_KM = WS_SEL + 9 * MiB;
constexpr size_t WS_END = WS_KM + 4 * MiB;
constexpr int CW_BAR = 4096;

constexpr int LDS_BYTES = 147456;
constexpr int MISC_OFF = 131072 + 320;

#define GAS __attribute__((address_space(1)))
#define LAS __attribute__((address_space(3)))
typedef unsigned short bf16;
typedef unsigned v4u __attribute__((ext_vector_type(4)));
typedef unsigned v2u __attribute__((ext_vector_type(2)));
typedef float f32x4 __attribute__((ext_vector_type(4)));
#define LDS_WAIT() asm volatile("s_waitcnt lgkmcnt(0)" ::: "memory")
__device__ __forceinline__ unsigned f2bf(float f) { unsigned u = __builtin_bit_cast(unsigned, f); return (u + 0x7fffu + ((u >> 16) & 1u)) >> 16; }
__device__ __forceinline__ unsigned pk2(float lo, float hi) { return f2bf(lo) | (f2bf(hi) << 16); }
__device__ __forceinline__ float bf2f(unsigned short b) { return __builtin_bit_cast(float, ((unsigned)b) << 16); }
__device__ __forceinline__ float bflo(unsigned w) { return __builtin_bit_cast(float, w << 16); }
__device__ __forceinline__ float bfhi(unsigned w) { return __builtin_bit_cast(float, w & 0xffff0000u); }
__device__ __forceinline__ float sigmoidf_(float x) { return 1.0f / (1.0f + __expf(-x)); }
__device__ __forceinline__ float siluf_(float x) { return x * sigmoidf_(x); }
__device__ __forceinline__ float gelu_tanh(float x) { const float u = 0.7978845608028654f * (x + 0.044715f * x * x * x); return x * sigmoidf_(2.0f * u); }
__device__ __forceinline__ float wave_sum(float v) {
#pragma unroll
    for (int o = 1; o < 64; o <<= 1) v += __shfl_xor(v, o);
    return v;
}
__device__ __forceinline__ int t5_bucket(int n) {
    if (n < 16) return n;
    int b = 16;
    b += (n >= 19) + (n >= 21) + (n >= 24) + (n >= 27) + (n >= 31) + (n >= 35) + (n >= 40) + (n >= 46) + (n >= 52) + (n >= 59) + (n >= 67) + (n >= 77) + (n >= 87) + (n >= 99) + (n >= 113);
    return b;
}

#define XB_TMO      128
#define XB_XCNT(j)  (256  + 64 * (j))
#define XB_XSUB(j)  (1280 + 64 * (j))
#define XB_XGEN(j)  (2304 + 64 * (j))
#define XB_TOP      3328
#define XB_TOPGEN   3392
#define XCD_BAR_WORDS 3456
#define XB_SPIN_CAP (1u << 22)
__device__ __forceinline__ unsigned xb_ld(unsigned* p)              { return __hip_atomic_load(p, __ATOMIC_RELAXED, __HIP_MEMORY_SCOPE_AGENT); }
__device__ __forceinline__ unsigned xb_add(unsigned* p, unsigned v) { return __hip_atomic_fetch_add(p, v, __ATOMIC_RELAXED, __HIP_MEMORY_SCOPE_AGENT); }
__device__ __forceinline__ unsigned xb_xcc_id() { return (unsigned)__builtin_amdgcn_s_getreg((3 << 11) | 20) & 0xFu; }
#define XB_SPIN(cond, bar) do { unsigned _sp = 0; while (cond) { __builtin_amdgcn_s_sleep(1); \
    if ((++_sp & 255u) == 0u) { if (xb_ld(&(bar)[XB_TMO])) break; if (_sp > XB_SPIN_CAP) { atomicAdd(&(bar)[XB_TMO], 1u); break; } } } } while (0)
struct XcdBarrier { unsigned* bar; unsigned x; volatile LAS unsigned* st; };
__device__ __forceinline__ XcdBarrier xcd_barrier_post(unsigned* bar, volatile LAS unsigned* st) {
    XcdBarrier b; b.bar = bar; b.x = xb_xcc_id(); b.st = st;
    if (threadIdx.x == 0) (void)xb_add(&bar[XB_XCNT(b.x)], 1u);
    return b;
}
__device__ __forceinline__ void xcd_barrier_complete(unsigned* bar, unsigned x, unsigned& nloc, unsigned& nx) {
    const unsigned G = gridDim.x * gridDim.y * gridDim.z;
    unsigned sum, cnt, mine, sp = 0u;
    for (;;) {
        sum = 0u; cnt = 0u; mine = 0u;
#pragma unroll
        for (unsigned j = 0; j < 16; ++j) { const unsigned c = xb_ld(&bar[XB_XCNT(j)]); sum += c; cnt += (c > 0u) ? 1u : 0u; mine = (j == x) ? c : mine; }
        if (sum == G) break;
        __builtin_amdgcn_s_sleep(1);
        if ((++sp & 255u) == 0u) { if (xb_ld(&bar[XB_TMO])) break; if (sp > XB_SPIN_CAP) { atomicAdd(&bar[XB_TMO], 1u); break; } }
    }
    nloc = mine > 0u ? mine : 1u; nx = cnt > 0u ? cnt : 1u;
}
__device__ __forceinline__ void xcd_barrier(const XcdBarrier& b) {
    asm volatile("s_waitcnt vmcnt(0)" ::: "memory");
    __syncthreads();
    if (threadIdx.x == 0) {
        unsigned* bar = b.bar;
        __builtin_amdgcn_s_waitcnt(0);
        unsigned nloc = b.st[0], nx = b.st[1];
        if (nloc == 0u) { xcd_barrier_complete(bar, b.x, nloc, nx); b.st[0] = nloc; b.st[1] = nx; }
        const unsigned old = xb_add(&bar[XB_XSUB(b.x)], 1u);
        const unsigned gen = old / nloc;
        if (old + 1u == (gen + 1u) * nloc) {
            __builtin_amdgcn_fence(__ATOMIC_RELEASE, "agent");
            asm volatile("s_waitcnt vmcnt(0)" ::: "memory");
            const unsigned og = xb_add(&bar[XB_TOP], 1u);
            const unsigned tg = og / nx;
            if (og + 1u == (tg + 1u) * nx) xb_add(&bar[XB_TOPGEN], 1u);
            else XB_SPIN(xb_ld(&bar[XB_TOPGEN]) == tg, bar);
            __builtin_amdgcn_fence(__ATOMIC_ACQUIRE, "agent");
            xb_add(&bar[XB_XGEN(b.x)], 1u);
            asm volatile("s_waitcnt vmcnt(0)" ::: "memory");
        } else {
            XB_SPIN(xb_ld(&bar[XB_XGEN(b.x)]) == gen, bar);
            __builtin_amdgcn_fence(__ATOMIC_ACQUIRE, "agent");
            asm volatile("s_waitcnt vmcnt(0)" ::: "memory");
        }
    }
    __syncthreads();
}

struct Args { const void* in[N_IN]; float* out; unsigned char* ws; int ph_lo, ph_hi; };
typedef const __attribute__((address_space(4))) Args* ArgP;
#define TID_LOCAL() ArgP a = a_; asm volatile("" : "+s"(a)); int tid = threadIdx.x; asm volatile("" : "+v"(tid)); const int lane = tid & 63, wave = __builtin_amdgcn_readfirstlane(tid >> 6); const int gw = blockIdx.x * NWAVES + wave, NGW = gridDim.x * NWAVES; (void)lane; (void)wave; (void)gw; (void)NGW
#define GTID_LOCAL() const size_t gtid = (size_t)blockIdx.x * NTHR + tid, GT = (size_t)gridDim.x * NTHR

__device__ __forceinline__ void transpose_item(const float* W, int K, int N, const float* scale, bf16* WT, LAS float* scr, int item, int lane) {
    const int nblk = (N + 31) / 32, kb = item / nblk, nb = item % nblk, k0 = 64 * kb, n0 = 32 * nb;
#pragma unroll 8
    for (int i = 0; i < 32; ++i) { const int kk = 2 * i + (lane >> 5); const int n = n0 + (lane & 31);
        float v = (n < N) ? W[(size_t)(k0 + kk) * N + n] : 0.f; if (scale) v *= scale[k0 + kk];
        scr[kk * 33 + (lane & 31)] = v; }
    LDS_WAIT(); asm volatile("" ::: "memory");
    const int c = lane & 7;
#pragma unroll
    for (int j = 0; j < 4; ++j) { const int n = (lane >> 3) + 8 * j; const LAS float* s = scr + (8 * c) * 33 + n;
        v4u o; o.x = pk2(s[0 * 33], s[1 * 33]); o.y = pk2(s[2 * 33], s[3 * 33]); o.z = pk2(s[4 * 33], s[5 * 33]); o.w = pk2(s[6 * 33], s[7 * 33]);
        *(v4u*)(WT + (size_t)(n0 + n) * K + k0 + 8 * c) = o; }
    LDS_WAIT(); asm volatile("" ::: "memory");
}

__device__ __forceinline__ void ph_prologue(ArgP a_, LAS unsigned char* lds) {
    TID_LOCAL();
    LAS float* scr = (LAS float*)(lds + wave * 16384);
    unsigned char* ws = a->ws;
    for (int m = 0; m < 18; ++m) {
        const float* W; int K = DM, N = DM; const float* sc = nullptr; bf16* WT;
        if (m < 2)       { W = (const float*)a->in[I_AWI] + (size_t)m * DM * ACOLS; N = ACOLS; sc = (const float*)a->in[I_NW] + (size_t)(2 * m) * DM; WT = (bf16*)(ws + WS_WAIN) + (size_t)m * ACOLS_PAD * DM; }
        else if (m < 4)  { const int l = m - 2; W = (const float*)a->in[I_AWO] + (size_t)l * DM * DM; WT = (bf16*)(ws + WS_WAOUT) + (size_t)l * DM * DM; }
        else if (m < 6)  { const int l = m - 4; W = (const float*)a->in[I_SWI] + (size_t)l * DM * 4096; N = 4096; sc = (const float*)a->in[I_NW] + (size_t)(2 * l + 1) * DM; WT = (bf16*)(ws + WS_WSIN) + (size_t)l * 4096 * DM; }
        else if (m < 8)  { const int l = m - 6; W = (const float*)a->in[I_WGLU] + (size_t)l * DM * DM; WT = (bf16*)(ws + WS_WGLU) + (size_t)l * DM * DM; }
        else if (m < 10) { const int l = m - 8; W = (const float*)a->in[I_SWO] + (size_t)l * DM * DM; WT = (bf16*)(ws + WS_WSOUT) + (size_t)l * DM * DM; }
        else if (m < 14) { const int i = m - 10; W = (const float*)a->in[I_PWG] + (size_t)i * DM * DM; sc = (const float*)a->in[I_PNW] + (size_t)i * DM; WT = (bf16*)(ws + WS_WPG) + (size_t)i * DM * DM; }
        else             { const int i = m - 14; W = (const float*)a->in[I_PWP] + (size_t)i * PLE * DM; K = PLE; WT = (bf16*)(ws + WS_WPP) + (size_t)i * DM * PLE; }
        const int nitems = (K / 64) * ((N + 31) / 32);
        for (int it = gw; it < nitems; it += NGW) transpose_item(W, K, N, sc, WT, scr, it, lane);
    }
    float* H = (float*)(ws + WS_H); bf16* Hb = (bf16*)(ws + WS_HBA);
    for (int r = gw; r < MR; r += NGW) {
        const float* src = (r < MP) ? (const float*)a->in[I_XP] + (size_t)r * DM : (const float*)a->in[I_XS] + (size_t)(r - MP) * DM;
#pragma unroll
        for (int j = 0; j < 8; ++j) { const int c = (j * 64 + lane) * 4; const f32x4 v = *(const f32x4*)(src + c);
            *(f32x4*)(H + (size_t)r * DM + c) = v; v2u o; o.x = pk2(v[0], v[1]); o.y = pk2(v[2], v[3]); *(v2u*)(Hb + (size_t)r * DM + c) = o; }
    }
    for (int q = gw; q < DEPTH * MR; q += NGW) { const int i = q / MR, r = q % MR;
        const float* src = (r < MP) ? (const float*)a->in[I_PP] + ((size_t)i * MP + r) * PLE : (const float*)a->in[I_PS] + ((size_t)i * MS + (r - MP)) * PLE;
        const f32x4 v = *(const f32x4*)(src + lane * 4); v2u o; o.x = pk2(v[0], v[1]); o.y = pk2(v[2], v[3]);
        *(v2u*)((bf16*)(ws + WS_PB + (size_t)i * PB_STRIDE) + (size_t)r * PLE + lane * 4) = o; }
}

__device__ __forceinline__ void ph_rowstat(ArgP a_) {
    TID_LOCAL();
    const float* H = (const float*)(a->ws + WS_H); float* rstd = (float*)(a->ws + WS_RSTD);
    for (int r = gw; r < MR; r += NGW) { float s = 0.f;
#pragma unroll
        for (int j = 0; j < 8; ++j) { const f32x4 v = *(const f32x4*)(H + (size_t)r * DM + (j * 64 + lane) * 4); s += v[0] * v[0] + v[1] * v[1] + v[2] * v[2] + v[3] * v[3]; }
        s = wave_sum(s); if (lane == 0) rstd[r] = 1.0f / sqrtf(s * (1.0f / DM) + RMS_EPS); }
}

__device__ __forceinline__ void ph_epi_attn_in(ArgP a_, int l) {
    TID_LOCAL(); GTID_LOCAL();
    unsigned char* ws = a->ws; const float* C = (const float*)(ws + WS_C); const float* rstd = (const float*)(ws + WS_RSTD);
    constexpr int NG4 = ACOLS / 4;
    for (size_t e = gtid; e < (size_t)MR * NG4; e += GT) { const int r = (int)(e / NG4), c = (int)(e % NG4) * 4;
        f32x4 v = *(const f32x4*)(C + (size_t)r * ACOLS_PAD + c); const float rs = rstd[r]; v = v * rs;
        if (c < C_K) { v = v * QSCALE; v2u o; o.x = pk2(v[0], v[1]); o.y = pk2(v[2], v[3]); *(v2u*)((bf16*)(ws + WS_QB) + (size_t)r * 2048 + c) = o; }
        else if (c < C_G) { const bool isv = c >= C_V; const int cc = c - (isv ? C_V : C_K);
            float* o32 = a->out + (r < MP ? (isv ? O_VP : O_KP) + ((size_t)l * MP + r) * 512 : (isv ? O_VS : O_KS) + ((size_t)l * MS + (r - MP)) * 512) + cc;
            *(f32x4*)o32 = v; v2u o; o.x = pk2(v[0], v[1]); o.y = pk2(v[2], v[3]); *(v2u*)((bf16*)(ws + (isv ? WS_VB : WS_KB)) + (size_t)r * 512 + cc) = o; }
        else if (c < C_QI) { v2u o; o.x = pk2(siluf_(v[0]), siluf_(v[1])); o.y = pk2(siluf_(v[2]), siluf_(v[3])); *(v2u*)((bf16*)(ws + WS_GB) + (size_t)r * 2048 + (c - C_G)) = o; }
        else if (c < C_KI) { v2u o; o.x = pk2(v[0], v[1]); o.y = pk2(v[2], v[3]); *(v2u*)((bf16*)(ws + WS_QIB) + (size_t)r * 1024 + (c - C_QI)) = o; }
        else if (c < C_WI) { const int cc = c - C_KI; float* o32 = a->out + (r < MP ? O_KIP + ((size_t)l * MP + r) * 64 : O_KIS + ((size_t)l * MS + (r - MP)) * 64) + cc;
            *(f32x4*)o32 = v; v2u o; o.x = pk2(v[0], v[1]); o.y = pk2(v[2], v[3]); *(v2u*)((bf16*)(ws + WS_KIB) + (size_t)r * 64 + cc) = o; }
        else { *(f32x4*)((float*)(ws + WS_WI) + (size_t)r * 16 + (c - C_WI)) = v * WISCALE; }
    }
}


typedef short bf16x8v __attribute__((ext_vector_type(8)));
__device__ __forceinline__ unsigned mono_key(float x) { const unsigned b = __builtin_bit_cast(unsigned, x); return b ^ ((unsigned)((int)b >> 31) | 0x80000000u); }
__device__ __forceinline__ int wave_sum_i(int v) {
#pragma unroll
    for (int o = 1; o < 64; o <<= 1) v += __shfl_xor(v, o);
    return v;
}
__device__ __forceinline__ int lane_prefix(unsigned long long m) { return (int)__builtin_amdgcn_mbcnt_hi((unsigned)(m >> 32), __builtin_amdgcn_mbcnt_lo((unsigned)m, 0u)); }
constexpr size_t KM_WORDS = (size_t)NBATCH * 128 * 64 * 32;

__device__ __forceinline__ void select_wave(const float* sc, int n, int lane, LAS unsigned* ldsk, unsigned long long* km, int* sel) {
    const int nc = (n + 255) >> 8, ne = (n + 63) >> 6;
    for (int i = lane; i < nc * 256; i += 64) ldsk[i] = (i < n) ? mono_key(sc[i]) : 0u;
    LDS_WAIT();
    unsigned T = 0u; int need = TOPK, toteq = 0;
    if (n > TOPK) {
        for (int bit = 31; bit >= 0; --bit) { const unsigned cand = T | (1u << bit); int c = 0;
            for (int ch = 0; ch < nc; ++ch) { const v4u k = *(const LAS v4u*)(ldsk + ch * 256 + lane * 4); c += (k.x >= cand) + (k.y >= cand) + (k.z >= cand) + (k.w >= cand); }
            c = __builtin_amdgcn_readfirstlane(wave_sum_i(c));
            if (c >= TOPK) { T = cand; if (c == TOPK) break; } }
        int cg = 0, ce = 0;
        for (int ch = 0; ch < nc; ++ch) { const v4u k = *(const LAS v4u*)(ldsk + ch * 256 + lane * 4); cg += (k.x > T) + (k.y > T) + (k.z > T) + (k.w > T); ce += (k.x == T) + (k.y == T) + (k.z == T) + (k.w == T); }
        need = TOPK - __builtin_amdgcn_readfirstlane(wave_sum_i(cg));
        toteq = __builtin_amdgcn_readfirstlane(wave_sum_i(ce));
    }
    const bool all_eq = (toteq <= need);
    int base_eq = 0, base_sel = 0;
    for (int e = 0; e < ne; ++e) {
        const int idx = e * 64 + lane; const unsigned k = ldsk[idx]; const bool valid = idx < n; bool s;
        if (n <= TOPK) s = valid;
        else if (all_eq) s = valid && k >= T;
        else { const bool eq = valid && k == T; const unsigned long long em = __ballot(eq); s = valid && (k > T || (eq && base_eq + lane_prefix(em) < need)); base_eq += __popcll(em); }
        const unsigned long long sm = __ballot(s);
        if (lane == 0) km[(size_t)e * 32] = sm;
        if (s) sel[base_sel + lane_prefix(sm)] = idx;
        base_sel += __popcll(sm);
    }
}

__device__ __forceinline__ void ph_idx(ArgP a_, int l, LAS unsigned char* lds) {
    TID_LOCAL();
    unsigned char* ws = a->ws;
    const bf16* QIb = (const bf16*)(ws + WS_QIB); const bf16* KIb = (const bf16*)(ws + WS_KIB); const float* WI = (const float*)(ws + WS_WI);
    float* SC = (float*)(ws + WS_SC); unsigned long long* KM = (unsigned long long*)(ws + WS_KM); int* SEL = (int*)(ws + WS_SEL);
    const int fr = lane & 15, kg = lane >> 4;
    for (int vb = blockIdx.x; vb < 256; vb += gridDim.x) {
        const int b = vb >> 7, x = vb & 127;
        for (int half = 0; half < 2; ++half) {
            const int qt = half ? 255 - x : x; const size_t qrow = (size_t)b * SEQ + qt * 16 + fr;
            bf16x8v Bq[16][2]; float w[16];
#pragma unroll
            for (int h = 0; h < 16; ++h) { Bq[h][0] = *(const bf16x8v*)(QIb + qrow * 1024 + h * 64 + kg * 8); Bq[h][1] = *(const bf16x8v*)(QIb + qrow * 1024 + h * 64 + 32 + kg * 8); w[h] = WI[qrow * 16 + h]; }
            for (int kt = wave; kt <= qt; kt += NWAVES) {
                const bf16* kp = KIb + ((size_t)b * SEQ + kt * 16 + fr) * 64 + kg * 8;
                const bf16x8v A0 = *(const bf16x8v*)kp, A1 = *(const bf16x8v*)(kp + 32);
                f32x4 S = {0.f, 0.f, 0.f, 0.f};
#pragma unroll
                for (int h = 0; h < 16; ++h) { f32x4 acc = {0.f, 0.f, 0.f, 0.f};
                    acc = __builtin_amdgcn_mfma_f32_16x16x32_bf16(A0, Bq[h][0], acc, 0, 0, 0); acc = __builtin_amdgcn_mfma_f32_16x16x32_bf16(A1, Bq[h][1], acc, 0, 0, 0);
#pragma unroll
                    for (int j = 0; j < 4; ++j) S[j] += w[h] * fmaxf(acc[j], 0.f); }
                *(f32x4*)(SC + qrow * SEQ + kt * 16 + kg * 4) = S;
            }
        }
        asm volatile("s_waitcnt vmcnt(0)" ::: "memory"); __syncthreads();
        for (int j = 0; j < 4; ++j) { const int qt = (j & 2) ? 255 - x : x; const int t = qt * 16 + wave * 2 + (j & 1); const size_t row = (size_t)b * SEQ + t;
            select_wave(SC + row * SEQ, t + 1, lane, (LAS unsigned*)(lds + wave * 16384), KM + (((size_t)b * 128 + (t >> 5)) * 64) * 32 + (t & 31), SEL + row * TOPK); }
        __syncthreads();
    }
}


namespace att {
using bf16x8 = __attribute__((ext_vector_type(8))) short;
using s16x4  = __attribute__((ext_vector_type(4))) short;
using f32x16 = __attribute__((ext_vector_type(16))) float;
constexpr int KVBLK = 64;
constexpr int SHM_V = KVBLK * 128 * 2, SHM_K = KVBLK * 128 * 2;
constexpr float THR2 = 8.0f;
#define ATT_SDEPTH 1
#define ATT_KSWZ(row, colB) ((row) * 256 + ((colB) ^ (((row) & 7) << 4)))
#define ATT_SBAR() __builtin_amdgcn_sched_barrier(0)
__device__ __forceinline__ int crow(int r, int hi) { return (r & 3) + 8 * (r >> 2) + 4 * hi; }
__device__ __forceinline__ unsigned cvtpk(float lo, float hi) { unsigned r; asm volatile("v_cvt_pk_bf16_f32 %0, %1, %2" : "=v"(r) : "v"(lo), "v"(hi)); return r; }
__device__ __forceinline__ int v_st(int k, int c) { const int kk = (k & ~0xC) | ((k & 4) << 1) | ((k & 8) >> 1); return ((kk >> 3) * 4 + (c >> 5)) * 512 + ((kk & 7) * 32 + (c & 31)) * 2; }
__device__ __forceinline__ int v_rd_base(int lane) { return ((lane & 3) << 3) | (((lane >> 2) & 3) << 6) | (((lane >> 4) & 1) << 5) | (((lane >> 5) & 1) << 8); }
constexpr int v_rd_off(int d0, int ks, int half) { return d0 * 512 + ks * 4096 + half * 2048; }
template <int OFF> __device__ __forceinline__ s16x4 tr_read(int vb) { s16x4 r; asm volatile("ds_read_b64_tr_b16 %0, %1 offset:%2" : "=&v"(r) : "v"(vb), "i"(OFF) : "memory"); return r; }

__device__ __forceinline__ void partialSM(f32x16& p0, f32x16& p1, float& m_reg, float& mn, float& alpha) {
    float pmax = p0[0];
#pragma unroll
    for (int r = 1; r < 16; ++r) pmax = fmaxf(pmax, p0[r]);
#pragma unroll
    for (int r = 0; r < 16; ++r) pmax = fmaxf(pmax, p1[r]);
    { auto rr = __builtin_amdgcn_permlane32_swap(__builtin_bit_cast(unsigned, pmax), __builtin_bit_cast(unsigned, pmax), false, false);
      const unsigned u0 = rr[0], u1 = rr[1]; pmax = fmaxf(__builtin_bit_cast(float, u0), __builtin_bit_cast(float, u1)); }
    if (__builtin_expect(__all(pmax - m_reg <= THR2), 1)) { mn = m_reg; alpha = 1.f; }
    else { mn = fmaxf(m_reg, pmax); alpha = __builtin_amdgcn_exp2f(m_reg - mn); m_reg = mn; }
#pragma unroll
    for (int r = 0; r < 16; ++r) p0[r] = __builtin_amdgcn_exp2f(p0[r] - mn);
#pragma unroll
    for (int r = 0; r < 16; ++r) p1[r] = p1[r] - mn;
}
__device__ __forceinline__ void finishSM(f32x16& p0, f32x16& p1, float alpha, float& l_reg, unsigned long long mk, int hi, bf16x8& pa0, bf16x8& pa1, bf16x8& pa2, bf16x8& pa3) {
#pragma unroll
    for (int r = 0; r < 16; ++r) p1[r] = __builtin_amdgcn_exp2f(p1[r]);
    const unsigned w0 = (unsigned)mk >> (4 * hi), w1 = (unsigned)(mk >> 32) >> (4 * hi);
#pragma unroll
    for (int r = 0; r < 16; ++r) { const int pos = (r & 3) + 8 * (r >> 2);
        const float a0 = p0[r], a1 = p1[r];
        p0[r] = __builtin_bit_cast(float, __builtin_bit_cast(unsigned, a0) & (unsigned)__builtin_amdgcn_sbfe((int)w0, pos, 1));
        p1[r] = __builtin_bit_cast(float, __builtin_bit_cast(unsigned, a1) & (unsigned)__builtin_amdgcn_sbfe((int)w1, pos, 1)); }
    float ps = 0;
#pragma unroll
    for (int r = 0; r < 16; ++r) ps += p0[r];
#pragma unroll
    for (int r = 0; r < 16; ++r) ps += p1[r];
    { auto rr = __builtin_amdgcn_permlane32_swap(__builtin_bit_cast(unsigned, ps), __builtin_bit_cast(unsigned, ps), false, false);
      const unsigned u0 = rr[0], u1 = rr[1]; ps = __builtin_bit_cast(float, u0) + __builtin_bit_cast(float, u1); }
    l_reg = l_reg * alpha + ps;
#define ATT_PK4(P, BASE, OUT) do { unsigned a0 = cvtpk(P[BASE + 0], P[BASE + 1]), a1 = cvtpk(P[BASE + 2], P[BASE + 3]);   \
    unsigned b0 = cvtpk(P[BASE + 4], P[BASE + 5]), b1 = cvtpk(P[BASE + 6], P[BASE + 7]);                              \
    auto r0 = __builtin_amdgcn_permlane32_swap(a0, b0, false, false); auto r1 = __builtin_amdgcn_permlane32_swap(a1, b1, false, false); \
    v4u w = {r0[0], r1[0], r0[1], r1[1]}; OUT = __builtin_bit_cast(bf16x8, w); } while (0)
    ATT_PK4(p0, 0, pa0); ATT_PK4(p0, 8, pa1); ATT_PK4(p1, 0, pa2); ATT_PK4(p1, 8, pa3);
#undef ATT_PK4
}
__device__ __forceinline__ void qkt(f32x16& p0, f32x16& p1, LAS const char* Ks, const bf16x8* qr, int r32, int hi) {
    p0 = f32x16{}; p1 = f32x16{};
    asm volatile("" : "+v"(r32), "+v"(hi));
#pragma unroll
    for (int d0 = 0; d0 < 8; ++d0) { const int cb = (d0 * 16 + hi * 8) * 2;
        const bf16x8 b0 = *(LAS const bf16x8*)(Ks + ATT_KSWZ(r32, cb));
        const bf16x8 b1 = *(LAS const bf16x8*)(Ks + ATT_KSWZ(32 + r32, cb));
        p0 = __builtin_amdgcn_mfma_f32_32x32x16_bf16(b0, qr[d0], p0, 0, 0, 0);
        p1 = __builtin_amdgcn_mfma_f32_32x32x16_bf16(b1, qr[d0], p1, 0, 0, 0); }
}
template <int D0> __device__ __forceinline__ void pv_one(f32x16& od, int vb, bf16x8 pa0, bf16x8 pa1, bf16x8 pa2, bf16x8 pa3) {
    const s16x4 l0 = tr_read<v_rd_off(D0, 0, 0)>(vb), h0 = tr_read<v_rd_off(D0, 0, 1)>(vb), l1 = tr_read<v_rd_off(D0, 1, 0)>(vb), h1 = tr_read<v_rd_off(D0, 1, 1)>(vb);
    const s16x4 l2 = tr_read<v_rd_off(D0, 2, 0)>(vb), h2 = tr_read<v_rd_off(D0, 2, 1)>(vb), l3 = tr_read<v_rd_off(D0, 3, 0)>(vb), h3 = tr_read<v_rd_off(D0, 3, 1)>(vb);
    asm volatile("s_waitcnt lgkmcnt(0)" ::: "memory"); ATT_SBAR();
#define ATT_PK(L, H) (bf16x8){L[0], L[1], L[2], L[3], H[0], H[1], H[2], H[3]}
    od = __builtin_amdgcn_mfma_f32_32x32x16_bf16(pa0, ATT_PK(l0, h0), od, 0, 0, 0);
    od = __builtin_amdgcn_mfma_f32_32x32x16_bf16(pa1, ATT_PK(l1, h1), od, 0, 0, 0);
    od = __builtin_amdgcn_mfma_f32_32x32x16_bf16(pa2, ATT_PK(l2, h2), od, 0, 0, 0);
    od = __builtin_amdgcn_mfma_f32_32x32x16_bf16(pa3, ATT_PK(l3, h3), od, 0, 0, 0);
#undef ATT_PK
}
__device__ __forceinline__ void pv_d0(f32x16* o, int vb, bf16x8 pa0, bf16x8 pa1, bf16x8 pa2, bf16x8 pa3) {
    pv_one<0>(o[0], vb, pa0, pa1, pa2, pa3); pv_one<1>(o[1], vb, pa0, pa1, pa2, pa3); pv_one<2>(o[2], vb, pa0, pa1, pa2, pa3); pv_one<3>(o[3], vb, pa0, pa1, pa2, pa3);
}
__device__ __forceinline__ void add_bias(f32x16& p0, f32x16& p1, LAS const float* bt2, int dq) {
    LAS const float* p = bt2 + (255 - dq);
#pragma unroll
    for (int r = 0; r < 16; ++r) { const int c = (r & 3) + 8 * (r >> 2); p0[r] += p[c]; p1[r] += p[c + 32]; }
}
}

__device__ __forceinline__ void ph_attn(ArgP a_, LAS unsigned char* ldsb) {
    using namespace att;
    TID_LOCAL();
    unsigned char* ws = a->ws;
    const bf16* Qb = (const bf16*)(ws + WS_QB); const bf16* Kb = (const bf16*)(ws + WS_KB); const bf16* Vb = (const bf16*)(ws + WS_VB); const bf16* Gb = (const bf16*)(ws + WS_GB);
    bf16* AOb = (bf16*)(ws + WS_AOB); const unsigned long long* KM = (const unsigned long long*)(ws + WS_KM); const float* rb = (const float*)a->in[I_RB];
    LAS char* lds = (LAS char*)ldsb; LAS char* V_lds = lds; LAS char* K_lds = lds + 2 * SHM_V;
    LAS float* wsf = (LAS float*)(lds + 65536) + wave * 64; LAS float* li_l = wsf; LAS float* al_l = wsf + 32;
    LAS float* btab = (LAS float*)(lds + 65536 + 2048);
    const int r32 = lane & 31, hi = lane >> 5, rh = wave & 3, qs = wave >> 2;
    const int sr = tid >> 4, sc = (tid & 15) * 8, vst0 = v_st(sr, sc), vst1 = v_st(32 + sr, sc);
    const int vb0 = (int)(unsigned)(size_t)V_lds + v_rd_base(lane);
    constexpr int LDK = 512;
    for (int vbk = blockIdx.x; vbk < 256; vbk += gridDim.x) {
        const int b = vbk >> 7, g = (vbk >> 5) & 3, x = vbk & 31, h = g * 4 + rh;
        __syncthreads();
        for (int i = tid; i < 4 * 384; i += NTHR) { const int rr = i / 384, d = 255 - (i % 384), hh = g * 4 + rr; btab[i] = (d >= 0 && d < 113) ? (rb[t5_bucket(d) * NH + hh] - rb[31 * NH + hh]) * LOG2E : 0.f; }
        const bf16* Kh = Kb + (size_t)b * SEQ * LDK + g * HD; const bf16* Vh = Vb + (size_t)b * SEQ * LDK + g * HD;
        for (int half = 0; half < 2; ++half) {
            const int jb = half ? 63 - x : x; const int q0w = jb * 64 + qs * 32; const size_t qrow = (size_t)b * SEQ + q0w + r32;
            const int NT = jb + 1, NTp = (NT + 1) & ~1;
            const char* kmu = (const char*)(KM + (((size_t)b * 128 + 2 * jb + qs) * 64) * 32);
            LAS const float* bt = btab + rh * 384; const int qpos = q0w + r32 - 4 * hi;
            float m_reg = -1e30f, l_reg = 0; f32x16 o[4] = {}; bf16x8 qr[8];
            int lq = lane; asm volatile("" : "+v"(lq));
            const bf16* Qw = Qb + ((size_t)b * SEQ + q0w + (lq & 31)) * 2048 + h * HD + (lq >> 5) * 8;
#pragma unroll
            for (int d0 = 0; d0 < 8; ++d0) qr[d0] = *(const bf16x8*)(Qw + d0 * 16);
            struct { bf16x8 vs0, vs1, ks0, ks1; } sr_[ATT_SDEPTH];
            const unsigned toff = (unsigned)(sr * LDK + sc) * 2u;
#define ATT_SLOAD(i, k0) do { const char* vt_ = (const char*)Vh + (size_t)(k0) * (LDK * 2); const char* kt_ = (const char*)Kh + (size_t)(k0) * (LDK * 2); \
    sr_[i].vs0 = *(const bf16x8*)(vt_ + toff); sr_[i].vs1 = *(const bf16x8*)(vt_ + 32 * LDK * 2 + toff); sr_[i].ks0 = *(const bf16x8*)(kt_ + toff); sr_[i].ks1 = *(const bf16x8*)(kt_ + 32 * LDK * 2 + toff); } while (0)
#define ATT_SWRITE(bb, i) do { *(LAS bf16x8*)(V_lds + (bb) * SHM_V + vst0) = sr_[i].vs0; *(LAS bf16x8*)(V_lds + (bb) * SHM_V + vst1) = sr_[i].vs1; const int kc = sc * 2; \
    *(LAS bf16x8*)(K_lds + (bb) * SHM_K + ATT_KSWZ(sr, kc)) = sr_[i].ks0; *(LAS bf16x8*)(K_lds + (bb) * SHM_K + ATT_KSWZ(32 + sr, kc)) = sr_[i].ks1; } while (0)
#define ATT_SWAIT() do { if (ATT_SDEPTH == 2) asm volatile("s_waitcnt vmcnt(4)" ::: "memory"); else asm volatile("s_waitcnt vmcnt(0)" ::: "memory"); } while (0)
#define ATT_RESC(al) do { if (__any((al) < 1.f)) { if (hi == 0) al_l[r32] = (al); asm volatile("s_waitcnt lgkmcnt(0)" ::: "memory"); \
    _Pragma("unroll") for (int d = 0; d < 4; ++d) _Pragma("unroll") for (int r = 0; r < 16; ++r) o[d][r] *= al_l[crow(r, hi)]; } } while (0)
#define ATT_MASK(kt) (((kt) <= jb) ? *(const unsigned long long*)(kmu + (size_t)(kt) * 256 + (unsigned)(r32 * 8)) : 0ull)
#define ATT_BIAS(P0, P1, kt) do { if (64 * (kt) + 176 > q0w) add_bias(P0, P1, bt, qpos - 64 * (kt)); } while (0)
            f32x16 pA0, pA1, pB0, pB1; float mnA, mnB, alA, alB; bf16x8 pa0, pa1, pa2, pa3;
            constexpr int SE = 0, SO = ATT_SDEPTH - 1;
            __syncthreads();
            ATT_SLOAD(SE, 0); asm volatile("s_waitcnt vmcnt(0)" ::: "memory"); ATT_SWRITE(0, SE); __syncthreads();
            qkt(pA0, pA1, K_lds, qr, r32, hi); ATT_BIAS(pA0, pA1, 0); partialSM(pA0, pA1, m_reg, mnA, alA);
            ATT_SLOAD(SO, KVBLK); if (ATT_SDEPTH == 2 && 2 < NTp) ATT_SLOAD(SE, 2 * KVBLK);
            ATT_SWAIT(); ATT_SWRITE(1, SO); __syncthreads();
            for (int j = 1; j + 1 < NTp; j += 2) {
                ATT_SBAR(); qkt(pB0, pB1, K_lds + SHM_K, qr, r32, hi); ATT_BIAS(pB0, pB1, j);
                finishSM(pA0, pA1, alA, l_reg, ATT_MASK(j - 1), hi, pa0, pa1, pa2, pa3); ATT_SBAR();
                ATT_SLOAD(SO, (j + ATT_SDEPTH) * KVBLK); ATT_SBAR();
                pv_d0(o, vb0, pa0, pa1, pa2, pa3); partialSM(pB0, pB1, m_reg, mnB, alB);
                __syncthreads(); ATT_SWAIT(); ATT_SWRITE(0, SE);
                ATT_RESC(alB); __syncthreads();
                ATT_SBAR(); qkt(pA0, pA1, K_lds, qr, r32, hi); ATT_BIAS(pA0, pA1, j + 1);
                finishSM(pB0, pB1, alB, l_reg, ATT_MASK(j), hi, pa0, pa1, pa2, pa3); ATT_SBAR();
                if (ATT_SDEPTH == 1 || j + 3 < NTp) ATT_SLOAD(SE, (j + 1 + ATT_SDEPTH) * KVBLK); ATT_SBAR();
                pv_d0(o, vb0 + SHM_V, pa0, pa1, pa2, pa3); partialSM(pA0, pA1, m_reg, mnA, alA);
                __syncthreads(); ATT_SWAIT(); ATT_SWRITE(1, SO);
                ATT_RESC(alA); __syncthreads();
            }
            ATT_SBAR(); qkt(pB0, pB1, K_lds + SHM_K, qr, r32, hi); ATT_BIAS(pB0, pB1, NTp - 1);
            finishSM(pA0, pA1, alA, l_reg, ATT_MASK(NTp - 2), hi, pa0, pa1, pa2, pa3); ATT_SBAR();
            pv_d0(o, vb0, pa0, pa1, pa2, pa3); partialSM(pB0, pB1, m_reg, mnB, alB);
            __syncthreads(); ATT_RESC(alB);
            finishSM(pB0, pB1, alB, l_reg, ATT_MASK(NTp - 1), hi, pa0, pa1, pa2, pa3); ATT_SBAR();
            pv_d0(o, vb0 + SHM_V, pa0, pa1, pa2, pa3);
            if (hi == 0) li_l[r32] = l_reg; asm volatile("s_waitcnt lgkmcnt(0)" ::: "memory");
            int lane_e = lane; asm volatile("" : "+v"(lane_e)); const int r32e = lane_e & 31, hie = lane_e >> 5;
#pragma unroll
            for (int r = 0; r < 16; ++r) { const int orow = crow(r, hie); const float rli = __builtin_amdgcn_rcpf(li_l[orow]);
                const size_t ob = ((size_t)b * SEQ + q0w + orow) * 2048 + h * HD + r32e;
#pragma unroll
                for (int d0 = 0; d0 < 4; ++d0) AOb[ob + d0 * 32] = (bf16)f2bf(o[d0][r] * rli * bf2f(Gb[ob + d0 * 32]));
                asm volatile("" ::: "memory"); ATT_SBAR(); }
#undef ATT_SLOAD
#undef ATT_SWRITE
#undef ATT_SWAIT
#undef ATT_RESC
#undef ATT_MASK
#undef ATT_BIAS
        }
    }
}


__device__ __forceinline__ void ph_idx_sample(ArgP a_, int l) {
    TID_LOCAL();
    unsigned char* ws = a->ws;
    const bf16* QIb = (const bf16*)(ws + WS_QIB); const bf16* KIb = (const bf16*)(ws + WS_KIB); const float* WI = (const float*)(ws + WS_WI); float* SCS = (float*)(ws + WS_SCS);
    const int* pt = (const int*)a->in[I_PT]; const float* cki = (const float*)a->in[I_CKI] + (size_t)l * NPOOL * PAGE * IDD;
    const int fr = lane & 15, kg = lane >> 4; constexpr int TPB = PAST / 16 + 1, NT = DBATCH * TPB, TPW = 5;
    for (int c0 = gw * TPW; c0 < NT; c0 += NGW * TPW) {
        int curb = -1; bf16x8v Bq[16][2]; float w[16];
        for (int gt = c0; gt < c0 + TPW && gt < NT; ++gt) { const int b = gt / TPB, kt = gt % TPB;
            if (b != curb) { curb = b; const size_t qrow = (size_t)MP + b * DSEQ + (fr < DSEQ ? fr : DSEQ - 1);
#pragma unroll
                for (int h = 0; h < 16; ++h) { Bq[h][0] = *(const bf16x8v*)(QIb + qrow * 1024 + h * 64 + kg * 8); Bq[h][1] = *(const bf16x8v*)(QIb + qrow * 1024 + h * 64 + 32 + kg * 8); w[h] = WI[qrow * 16 + h]; } }
            bf16x8v A0, A1;
            if (kt < PAST / 16) { const int key = kt * 16 + fr; const float* kp = cki + ((size_t)pt[b * NPAGES + (key >> 7)] * PAGE + (key & 127)) * IDD + kg * 8;
                const f32x4 x0 = *(const f32x4*)kp, x1 = *(const f32x4*)(kp + 4), y0 = *(const f32x4*)(kp + 32), y1 = *(const f32x4*)(kp + 36);
                v4u u0, u1; u0.x = pk2(x0[0], x0[1]); u0.y = pk2(x0[2], x0[3]); u0.z = pk2(x1[0], x1[1]); u0.w = pk2(x1[2], x1[3]); u1.x = pk2(y0[0], y0[1]); u1.y = pk2(y0[2], y0[3]); u1.z = pk2(y1[0], y1[1]); u1.w = pk2(y1[2], y1[3]);
                A0 = __builtin_bit_cast(bf16x8v, u0); A1 = __builtin_bit_cast(bf16x8v, u1); }
            else { const bf16* kp = KIb + ((size_t)MP + b * DSEQ + (fr < DSEQ ? fr : DSEQ - 1)) * 64 + kg * 8; A0 = *(const bf16x8v*)kp; A1 = *(const bf16x8v*)(kp + 32); }
            f32x4 S = {0.f, 0.f, 0.f, 0.f};
#pragma unroll
            for (int h = 0; h < 16; ++h) { f32x4 acc = {0.f, 0.f, 0.f, 0.f};
                acc = __builtin_amdgcn_mfma_f32_16x16x32_bf16(A0, Bq[h][0], acc, 0, 0, 0); acc = __builtin_amdgcn_mfma_f32_16x16x32_bf16(A1, Bq[h][1], acc, 0, 0, 0);
#pragma unroll
                for (int j = 0; j < 4; ++j) S[j] += w[h] * fmaxf(acc[j], 0.f); }
            if (fr < DSEQ) *(f32x4*)(SCS + (size_t)(b * DSEQ + fr) * SCS_LD + kt * 16 + kg * 4) = S;
        }
    }
}
__device__ __forceinline__ void select_block(const float* sc, int n, LAS unsigned* ldsk, LAS int* ldsw, int* sel, int tid, int lane, int wave) {
    const int nc = (n + 2047) >> 11;
    __syncthreads();
    for (int i = tid; i < nc * 2048; i += NTHR) ldsk[i] = (i < n) ? mono_key(sc[i]) : 0u;
    if (tid == 0) ldsw[32] = 0;
    __syncthreads();
    unsigned T = 0u;
    for (int bit = 31; bit >= 0; --bit) { const unsigned cand = T | (1u << bit); int c = 0;
        for (int ch = 0; ch < nc; ++ch) { const v4u k = *(const LAS v4u*)(ldsk + ch * 2048 + tid * 4); c += (k.x >= cand) + (k.y >= cand) + (k.z >= cand) + (k.w >= cand); }
        c = wave_sum_i(c); LAS int* red = ldsw + (bit & 1) * 8; if (lane == 0) red[wave] = c;
        __syncthreads();
        const int tot = ((red[0] + red[1]) + (red[2] + red[3])) + ((red[4] + red[5]) + (red[6] + red[7]));
        if (tot >= TOPK) { T = cand; if (tot == TOPK) break; } }
    int cg = 0, ce = 0;
    for (int ch = 0; ch < nc; ++ch) { const v4u k = *(const LAS v4u*)(ldsk + ch * 2048 + tid * 4); cg += (k.x > T) + (k.y > T) + (k.z > T) + (k.w > T); ce += (k.x == T) + (k.y == T) + (k.z == T) + (k.w == T); }
    cg = wave_sum_i(cg); ce = wave_sum_i(ce);
    __syncthreads();
    if (lane == 0) { ldsw[16 + wave] = cg; ldsw[24 + wave] = ce; }
    __syncthreads();
    int tg = 0, te = 0;
#pragma unroll
    for (int i = 0; i < 8; ++i) { tg += ldsw[16 + i]; te += ldsw[24 + i]; }
    const int need = TOPK - tg; const bool all_eq = te <= need;
    for (int ch = 0; ch < nc; ++ch) { const v4u k4 = *(const LAS v4u*)(ldsk + ch * 2048 + tid * 4); const unsigned kk[4] = {k4.x, k4.y, k4.z, k4.w};
#pragma unroll
        for (int j = 0; j < 4; ++j) { const int idx = ch * 2048 + tid * 4 + j; const unsigned k = kk[j]; bool s = (idx < n) && k > T;
            if ((idx < n) && k == T) { if (all_eq) s = true; else { int rank = 0; for (int q = 0; q < idx; ++q) rank += (ldsk[q] == T) ? 1 : 0; s = rank < need; } }
            if (s) { const int pos = __hip_atomic_fetch_add(ldsw + 32, 1, __ATOMIC_RELAXED, __HIP_MEMORY_SCOPE_WORKGROUP); if (pos < TOPK) sel[pos] = idx; } } }
    __syncthreads();
}
__device__ __forceinline__ void ph_attn_sample(ArgP a_, int l, LAS unsigned char* ldsb) {
    TID_LOCAL();
    unsigned char* ws = a->ws;
    const bf16* Qb = (const bf16*)(ws + WS_QB); const bf16* Kb = (const bf16*)(ws + WS_KB); const bf16* Vb = (const bf16*)(ws + WS_VB); const bf16* Gb = (const bf16*)(ws + WS_GB);
    bf16* AOb = (bf16*)(ws + WS_AOB); int* SEL = (int*)(ws + WS_SEL); const int* pt = (const int*)a->in[I_PT]; const float* rb = (const float*)a->in[I_RB];
    const float* ck = (const float*)a->in[I_CK] + (size_t)l * NPOOL * PAGE * 512; const float* cv = (const float*)a->in[I_CV] + (size_t)l * NPOOL * PAGE * 512;
    LAS unsigned* ldsk = (LAS unsigned*)ldsb;
    LAS int* ldsw = (LAS int*)(ldsb + 81920);
    LAS int* sidx = (LAS int*)ldsb; LAS float* qh = (LAS float*)(ldsb + 1024); LAS float* lg = (LAS float*)(ldsb + 1024 + 2048); LAS float* rs = (LAS float*)(ldsb + 1024 + 2048 + 4096);
    for (int rr = blockIdx.x; rr < MS; rr += gridDim.x) {
        const int r = MP + rr, b = rr / DSEQ, t = rr % DSEQ, tpos = PAST + t;
        select_block((const float*)(ws + WS_SCS) + (size_t)rr * SCS_LD, tpos + 1, ldsk, ldsw, SEL + (size_t)r * TOPK, tid, lane, wave);
        asm volatile("s_waitcnt vmcnt(0)" ::: "memory"); __syncthreads();
        if (tid < TOPK) sidx[tid] = SEL[(size_t)r * TOPK + tid];
        for (int g = 0; g < NKV; ++g) {
            __syncthreads();
            qh[tid] = bf2f(Qb[(size_t)r * 2048 + g * 512 + tid]);
            __syncthreads();
            { const int kk = tid & 255, hp = tid >> 8; const int s = sidx[kk]; float d0 = 0.f, d1 = 0.f; LAS const float* q0 = qh + (2 * hp) * HD; LAS const float* q1 = q0 + HD;
              if (s < PAST) { const float* kp = ck + ((size_t)pt[b * NPAGES + (s >> 7)] * PAGE + (s & 127)) * 512 + g * HD;
#pragma unroll 8
                  for (int c = 0; c < 32; ++c) { const f32x4 kv = *(const f32x4*)(kp + 4 * c); const f32x4 a0 = *(LAS const f32x4*)(q0 + 4 * c), a1 = *(LAS const f32x4*)(q1 + 4 * c);
                      d0 += kv[0] * a0[0] + kv[1] * a0[1] + kv[2] * a0[2] + kv[3] * a0[3]; d1 += kv[0] * a1[0] + kv[1] * a1[1] + kv[2] * a1[2] + kv[3] * a1[3]; } }
              else { const bf16* kp = Kb + ((size_t)MP + b * DSEQ + (s - PAST)) * 512 + g * HD; for (int j = 0; j < HD; ++j) { const float kv = bf2f(kp[j]); d0 += kv * q0[j]; d1 += kv * q1[j]; } }
              const int bk = t5_bucket(tpos - s); const int h0 = g * KVG + 2 * hp;
              lg[(2 * hp) * TOPK + kk] = d0 + rb[bk * NH + h0] * LOG2E; lg[(2 * hp + 1) * TOPK + kk] = d1 + rb[bk * NH + h0 + 1] * LOG2E; }
            __syncthreads();
            if (wave < KVG) { LAS float* row = lg + wave * TOPK; float v[4]; float m = -3.0e38f;
#pragma unroll
                for (int j = 0; j < 4; ++j) { v[j] = row[lane + 64 * j]; m = fmaxf(m, v[j]); }
#pragma unroll
                for (int o = 1; o < 64; o <<= 1) m = fmaxf(m, __shfl_xor(m, o));
                float sm = 0.f;
#pragma unroll
                for (int j = 0; j < 4; ++j) { v[j] = exp2f(v[j] - m); sm += v[j]; row[lane + 64 * j] = v[j]; }
                sm = wave_sum(sm); if (lane == 0) rs[wave] = 1.0f / sm; }
            __syncthreads();
            { const int hh = tid >> 7, d = tid & 127; LAS const float* prow = lg + hh * TOPK; float o = 0.f;
              for (int k = 0; k < TOPK; ++k) { const int s = sidx[k]; float vv;
                  if (s < PAST) vv = cv[((size_t)pt[b * NPAGES + (s >> 7)] * PAGE + (s & 127)) * 512 + g * HD + d];
                  else vv = bf2f(Vb[((size_t)MP + b * DSEQ + (s - PAST)) * 512 + g * HD + d]);
                  o += prow[k] * vv; }
              const size_t oi = (size_t)r * 2048 + g * 512 + tid;
              AOb[oi] = (bf16)f2bf(o * rs[hh] * bf2f(Gb[oi])); }
        }
        __syncthreads();
    }
}

__device__ __forceinline__ void ph_epi_resid(ArgP a_) {
    TID_LOCAL(); GTID_LOCAL();
    unsigned char* ws = a->ws; const float* C = (const float*)(ws + WS_C); float* H = (float*)(ws + WS_H); bf16* Hb = (bf16*)(ws + WS_HBB);
    for (size_t e = gtid; e < (size_t)MR * (DM / 4); e += GT) { const size_t o = e * 4; const f32x4 v = *(const f32x4*)(H + o) + *(const f32x4*)(C + o);
        *(f32x4*)(H + o) = v; v2u w; w.x = pk2(v[0], v[1]); w.y = pk2(v[2], v[3]); *(v2u*)(Hb + o) = w; }
}
__device__ __forceinline__ void ph_epi_ple(ArgP a_) {
    TID_LOCAL(); GTID_LOCAL();
    unsigned char* ws = a->ws; const float* C = (const float*)(ws + WS_C); const float* C2 = (const float*)(ws + WS_C2); const float* rstd = (const float*)(ws + WS_RSTD);
    float* H = (float*)(ws + WS_H); bf16* Hb = (bf16*)(ws + WS_HBA);
    for (size_t e = gtid; e < (size_t)MR * (DM / 4); e += GT) { const size_t o = e * 4; const int r = (int)(e / (DM / 4)); const float rs = rstd[r];
        const f32x4 c = *(const f32x4*)(C + o), p = *(const f32x4*)(C2 + o); f32x4 v = *(const f32x4*)(H + o);
#pragma unroll
        for (int j = 0; j < 4; ++j) v[j] += sigmoidf_(c[j] * rs) * p[j];
        *(f32x4*)(H + o) = v; v2u w; w.x = pk2(v[0], v[1]); w.y = pk2(v[2], v[3]); *(v2u*)(Hb + o) = w; }
}
__device__ __forceinline__ void ph_epi_ssm_in(ArgP a_) {
    TID_LOCAL(); GTID_LOCAL();
    unsigned char* ws = a->ws; const float* C = (const float*)(ws + WS_C); const float* rstd = (const float*)(ws + WS_RSTD);
    for (size_t e = gtid; e < (size_t)MR * 1024; e += GT) { const int r = (int)(e / 1024), c = (int)(e % 1024) * 4;
        f32x4 v = *(const f32x4*)(C + (size_t)r * 4096 + c); v = v * rstd[r];
        if (c < 2048) { v2u o; o.x = pk2(v[0], v[1]); o.y = pk2(v[2], v[3]);
            if (r < MP) { const int b = r / SEQ, t = r % SEQ, g = c / 16, j = c % 16; *(v2u*)((bf16*)(ws + WS_UG) + (((size_t)(b * NGRP + g) * SEQ + t) * 16 + j)) = o; }
            else *(v2u*)((bf16*)(ws + WS_US) + (size_t)(r - MP) * 2048 + c) = o; }
        else { v2u o; o.x = pk2(siluf_(v[0]), siluf_(v[1])); o.y = pk2(siluf_(v[2]), siluf_(v[3])); *(v2u*)((bf16*)(ws + WS_GB) + (size_t)r * 2048 + (c - 2048)) = o; }
    }
}
__device__ __forceinline__ void scan_item(ArgP a, int l, bool pr, int item, int lane) {
    unsigned char* ws = a->ws;
    const int b = item / NGRP, g = item % NGRP, n = lane;
    const size_t gn = ((size_t)l * NGRP + g) * SST + n;
    const float lre = fminf(((const float*)a->in[I_LRE])[gn], -1e-4f), lim = ((const float*)a->in[I_LIM])[gn];
    const float dt = expf(((const float*)a->in[I_LDT])[l * NGRP + g]);
    const float mag = expf(lre * dt), ang = lim * dt; const float are = mag * cosf(ang), aim = mag * sinf(ang);
    const float den = lre * lre + lim * lim; const float cre = ((are - 1.0f) * lre + aim * lim) / den, cim = (aim * lre - (are - 1.0f) * lim) / den;
    float bbr[16], bbi[16], ccr[16], cci[16];
#pragma unroll
    for (int j = 0; j < 16; ++j) { const float br = ((const float*)a->in[I_BRE])[gn * 16 + j], bi = ((const float*)a->in[I_BIM])[gn * 16 + j];
        bbr[j] = cre * br - cim * bi; bbi[j] = cre * bi + cim * br;
        const size_t ci = (((size_t)l * NGRP + g) * 16 + j) * SST + n; ccr[j] = ((const float*)a->in[I_CRE])[ci]; cci[j] = ((const float*)a->in[I_CIM])[ci]; }
    const float dj = ((const float*)a->in[I_SD])[(size_t)l * DM + g * 16 + (lane & 15)];
    float xr = 0.f, xi = 0.f;
    if (!pr) { const size_t si = (((size_t)l * DBATCH + b) * NGRP + g) * SST + n; xr = ((const float*)a->in[I_SRE])[si]; xi = ((const float*)a->in[I_SIM])[si]; }
    const int T = pr ? SEQ : DSEQ;
    const bf16* up = pr ? (const bf16*)(ws + WS_UG) + (size_t)(b * NGRP + g) * SEQ * 16 : (const bf16*)(ws + WS_US) + (size_t)(b * DSEQ) * 2048 + g * 16;
    const int ustride = pr ? 16 : 2048;
    bf16* Yb = (bf16*)(ws + WS_YB);
    for (int t = 0; t < T; ++t) {
        const v4u u0 = *(const v4u*)(up + (size_t)t * ustride), u1 = *(const v4u*)(up + (size_t)t * ustride + 8);
        const float u[16] = {bflo(u0.x), bfhi(u0.x), bflo(u0.y), bfhi(u0.y), bflo(u0.z), bfhi(u0.z), bflo(u0.w), bfhi(u0.w), bflo(u1.x), bfhi(u1.x), bflo(u1.y), bfhi(u1.y), bflo(u1.z), bfhi(u1.z), bflo(u1.w), bfhi(u1.w)};
        float br = 0.f, bi = 0.f;
#pragma unroll
        for (int j = 0; j < 16; ++j) { br += bbr[j] * u[j]; bi += bbi[j] * u[j]; }
        const float nr = are * xr - aim * xi + br, ni = are * xi + aim * xr + bi; xr = nr; xi = ni;
        float yj = 0.f, uj = 0.f;
#pragma unroll
        for (int j = 0; j < 16; ++j) { const float s = wave_sum(ccr[j] * xr - cci[j] * xi); if ((lane & 15) == j) { yj = s; uj = u[j]; } }
        if (lane < 16) { const float y = yj + dj * uj; const int row = pr ? b * SEQ + t : MP + b * DSEQ + t; Yb[(size_t)row * 2048 + g * 16 + lane] = (bf16)f2bf(gelu_tanh(y)); }
    }
    float* osr = a->out + (pr ? O_SRP + (((size_t)l * NBATCH + b) * NGRP + g) * SST : O_SRS + (((size_t)l * DBATCH + b) * NGRP + g) * SST);
    float* osi = a->out + (pr ? O_SIP + (((size_t)l * NBATCH + b) * NGRP + g) * SST : O_SIS + (((size_t)l * DBATCH + b) * NGRP + g) * SST);
    osr[n] = xr; osi[n] = xi;
}
__device__ __forceinline__ void ph_scan_naive(ArgP a_, int l) {
    TID_LOCAL();
    for (int vb = blockIdx.x; vb < 256; vb += gridDim.x) {
        if (wave == 0) scan_item(a, l, true, vb, lane);
        else { const int item = vb * 7 + (wave - 1); if (item < DBATCH * NGRP) scan_item(a, l, false, item, lane); }
    }
}

namespace s5 {
using bf16x8 = __attribute__((ext_vector_type(8))) short;
using s16x4  = __attribute__((ext_vector_type(4))) short;
using f32x16 = __attribute__((ext_vector_type(16))) float;
constexpr int XSTR = 80;
constexpr int XT_BYTES = 128 * XSTR;
constexpr int E_OFF = 8 * XT_BYTES, H_OFF = E_OFF + 16 * 64 * 8;
__device__ __forceinline__ s16x4 tr_read(int addr) { s16x4 r; asm volatile("ds_read_b64_tr_b16 %0, %1" : "=&v"(r) : "v"(addr) : "memory"); return r; }
}
__device__ __forceinline__ void ph_scan(ArgP a_, int l, LAS unsigned char* ldsb) {
    using namespace s5;
    TID_LOCAL();
    unsigned char* ws = a->ws;
    LAS char* lds = (LAS char*)ldsb;
    bf16* Yb = (bf16*)(ws + WS_YB);
    const int n0 = lane & 31, h2 = lane >> 5, fj = lane & 15, kg = lane >> 4;
    for (int vb = blockIdx.x; vb < NBATCH * NGRP; vb += gridDim.x) {
        const int b = vb >> 7, g = vb & 127;
        const size_t gbase = (size_t)l * NGRP + g;
        float ar[2], ai[2]; bf16x8 Bfr[2][2];
        const float dt = expf(((const float*)a->in[I_LDT])[gbase]);
#pragma unroll
        for (int nt = 0; nt < 2; ++nt) { const size_t gn = gbase * SST + n0 + 32 * nt;
            const float lre = fminf(((const float*)a->in[I_LRE])[gn], -1e-4f), lim = ((const float*)a->in[I_LIM])[gn];
            const float mag = expf(lre * dt), ang = lim * dt; const float are = mag * cosf(ang), aim = mag * sinf(ang);
            const float den = lre * lre + lim * lim; const float cre = ((are - 1.0f) * lre + aim * lim) / den, cim = (aim * lre - (are - 1.0f) * lim) / den;
            ar[nt] = are; ai[nt] = aim;
            const f32x4 br0 = *(const f32x4*)((const float*)a->in[I_BRE] + gn * 16 + 8 * h2), br1 = *(const f32x4*)((const float*)a->in[I_BRE] + gn * 16 + 8 * h2 + 4);
            const f32x4 bi0 = *(const f32x4*)((const float*)a->in[I_BIM] + gn * 16 + 8 * h2), bi1 = *(const f32x4*)((const float*)a->in[I_BIM] + gn * 16 + 8 * h2 + 4);
            v4u wr_, wi_;
            wr_.x = pk2(cre * br0[0] - cim * bi0[0], cre * br0[1] - cim * bi0[1]); wr_.y = pk2(cre * br0[2] - cim * bi0[2], cre * br0[3] - cim * bi0[3]);
            wr_.z = pk2(cre * br1[0] - cim * bi1[0], cre * br1[1] - cim * bi1[1]); wr_.w = pk2(cre * br1[2] - cim * bi1[2], cre * br1[3] - cim * bi1[3]);
            wi_.x = pk2(cre * bi0[0] + cim * br0[0], cre * bi0[1] + cim * br0[1]); wi_.y = pk2(cre * bi0[2] + cim * br0[2], cre * bi0[3] + cim * br0[3]);
            wi_.z = pk2(cre * bi1[0] + cim * br1[0], cre * bi1[1] + cim * br1[1]); wi_.w = pk2(cre * bi1[2] + cim * br1[2], cre * bi1[3] + cim * br1[3]);
            Bfr[nt][0] = __builtin_bit_cast(bf16x8, wr_); Bfr[nt][1] = __builtin_bit_cast(bf16x8, wi_); }
        bf16x8 Cf[4];
#pragma unroll
        for (int ks = 0; ks < 4; ++ks) { const float* srcp = (const float*)a->in[(ks >> 1) ? I_CIM : I_CRE] + (gbase * 16 + fj) * SST + (ks & 1) * 32 + kg * 8; const float sg = (ks >> 1) ? -1.0f : 1.0f;
            const f32x4 c0 = *(const f32x4*)srcp, c1 = *(const f32x4*)(srcp + 4);
            v4u w; w.x = pk2(sg * c0[0], sg * c0[1]); w.y = pk2(sg * c0[2], sg * c0[3]); w.z = pk2(sg * c1[0], sg * c1[1]); w.w = pk2(sg * c1[2], sg * c1[3]); Cf[ks] = __builtin_bit_cast(bf16x8, w); }
        const f32x4 dv = *(const f32x4*)((const float*)a->in[I_SD] + (size_t)l * DM + g * 16 + 4 * kg);
        const bf16* up = (const bf16*)(ws + WS_UG) + (size_t)(b * NGRP + g) * SEQ * 16;
        const int a_time0 = 256 * (2 * wave + ((n0 >> 2) & 1)) + (n0 & 3) + 4 * (n0 >> 3);
        const bf16* ap = up + (size_t)a_time0 * 16 + 8 * h2;
        LAS float* E = (LAS float*)(lds + E_OFF); LAS float* Hs = (LAS float*)(lds + H_OFF);
        const int seg = 2 * wave + h2;
        { float xr[2] = {0.f, 0.f}, xi[2] = {0.f, 0.f};
          for (int tile = 0; tile < 16; ++tile) { const bf16x8 A = *(const bf16x8*)(ap + (size_t)tile * 256);
#pragma unroll
              for (int nt = 0; nt < 2; ++nt) { f32x16 cr = {}, ci = {};
                  cr = __builtin_amdgcn_mfma_f32_32x32x16_bf16(A, Bfr[nt][0], cr, 0, 0, 0); ci = __builtin_amdgcn_mfma_f32_32x32x16_bf16(A, Bfr[nt][1], ci, 0, 0, 0);
#pragma unroll
                  for (int i = 0; i < 16; ++i) { const float nr = ar[nt] * xr[nt] - ai[nt] * xi[nt] + cr[i], ni = ar[nt] * xi[nt] + ai[nt] * xr[nt] + ci[i]; xr[nt] = nr; xi[nt] = ni; } } }
#pragma unroll
          for (int nt = 0; nt < 2; ++nt) { E[(seg * 64 + n0 + 32 * nt) * 2] = xr[nt]; E[(seg * 64 + n0 + 32 * nt) * 2 + 1] = xi[nt]; } }
        __syncthreads();
        if (wave == 0) { const size_t gn = gbase * SST + lane;
            const float lre = fminf(((const float*)a->in[I_LRE])[gn], -1e-4f), lim = ((const float*)a->in[I_LIM])[gn];
            const float mag = expf(lre * dt), ang = lim * dt; float pr_ = mag * cosf(ang), pi_ = mag * sinf(ang);
#pragma unroll
            for (int q = 0; q < 8; ++q) { const float t0 = pr_ * pr_ - pi_ * pi_, t1 = 2.0f * pr_ * pi_; pr_ = t0; pi_ = t1; }
            float hr = 0.f, hi_ = 0.f; Hs[lane * 2] = 0.f; Hs[lane * 2 + 1] = 0.f;
            for (int s = 0; s < 16; ++s) { const float er = E[(s * 64 + lane) * 2], ei = E[(s * 64 + lane) * 2 + 1];
                const float nr = pr_ * hr - pi_ * hi_ + er, ni = pr_ * hi_ + pi_ * hr + ei; hr = nr; hi_ = ni; Hs[((s + 1) * 64 + lane) * 2] = hr; Hs[((s + 1) * 64 + lane) * 2 + 1] = hi_; }
            a->out[O_SRP + (((size_t)l * NBATCH + b) * NGRP + g) * SST + lane] = hr; a->out[O_SIP + (((size_t)l * NBATCH + b) * NGRP + g) * SST + lane] = hi_; }
        __syncthreads();
        { float xr[2], xi[2];
#pragma unroll
          for (int nt = 0; nt < 2; ++nt) { xr[nt] = Hs[(seg * 64 + n0 + 32 * nt) * 2]; xi[nt] = Hs[(seg * 64 + n0 + 32 * nt) * 2 + 1]; }
          LAS char* Xt = lds + wave * XT_BYTES; const int xt_addr = (int)(unsigned)(size_t)Xt;
          for (int tile = 0; tile < 16; ++tile) { const bf16x8 A = *(const bf16x8*)(ap + (size_t)tile * 256);
#pragma unroll
              for (int nt = 0; nt < 2; ++nt) { f32x16 cr = {}, ci = {};
                  cr = __builtin_amdgcn_mfma_f32_32x32x16_bf16(A, Bfr[nt][0], cr, 0, 0, 0); ci = __builtin_amdgcn_mfma_f32_32x32x16_bf16(A, Bfr[nt][1], ci, 0, 0, 0);
                  unsigned pr[8], pi[8];
#pragma unroll
                  for (int i = 0; i < 16; i += 2) { float r0, i0, r1, i1;
                      r0 = ar[nt] * xr[nt] - ai[nt] * xi[nt] + cr[i]; i0 = ar[nt] * xi[nt] + ai[nt] * xr[nt] + ci[i];
                      r1 = ar[nt] * r0 - ai[nt] * i0 + cr[i + 1]; i1 = ar[nt] * i0 + ai[nt] * r0 + ci[i + 1]; xr[nt] = r1; xi[nt] = i1;
                      pr[i >> 1] = pk2(r0, r1); pi[i >> 1] = pk2(i0, i1); }
                  LAS char* rowr = Xt + (nt * 32 + n0) * XSTR + h2 * 32; LAS char* rowi = rowr + 64 * XSTR;
                  *(LAS v4u*)rowr = (v4u){pr[0], pr[1], pr[2], pr[3]}; *(LAS v4u*)(rowr + 16) = (v4u){pr[4], pr[5], pr[6], pr[7]};
                  *(LAS v4u*)rowi = (v4u){pi[0], pi[1], pi[2], pi[3]}; *(LAS v4u*)(rowi + 16) = (v4u){pi[4], pi[5], pi[6], pi[7]}; }
              asm volatile("s_waitcnt lgkmcnt(0)" ::: "memory");
#pragma unroll
              for (int tt = 0; tt < 2; ++tt) { f32x4 acc = {0.f, 0.f, 0.f, 0.f};
                  s16x4 lo[4], hi4[4];
#pragma unroll
                  for (int ks = 0; ks < 4; ++ks) { const int rowk = 32 * ks + 8 * kg + (fj >> 2); const int ad = xt_addr + rowk * XSTR + (16 * tt + 4 * (fj & 3)) * 2;
                      lo[ks] = tr_read(ad); hi4[ks] = tr_read(ad + 4 * XSTR); }
                  asm volatile("s_waitcnt lgkmcnt(0)" ::: "memory"); __builtin_amdgcn_sched_barrier(0);
#pragma unroll
                  for (int ks = 0; ks < 4; ++ks) { const bf16x8 Bx = (bf16x8){lo[ks][0], lo[ks][1], lo[ks][2], lo[ks][3], hi4[ks][0], hi4[ks][1], hi4[ks][2], hi4[ks][3]};
                      acc = __builtin_amdgcn_mfma_f32_16x16x32_bf16(Cf[ks], Bx, acc, 0, 0, 0); }
                  const int time = 256 * (2 * wave + tt) + 16 * tile + fj;
                  const v2u uw = *(const v2u*)(up + (size_t)time * 16 + 4 * kg);
                  const float y0 = acc[0] + dv[0] * bflo(uw.x), y1 = acc[1] + dv[1] * bfhi(uw.x), y2 = acc[2] + dv[2] * bflo(uw.y), y3 = acc[3] + dv[3] * bfhi(uw.y);
                  v2u o; o.x = pk2(gelu_tanh(y0), gelu_tanh(y1)); o.y = pk2(gelu_tanh(y2), gelu_tanh(y3));
                  *(v2u*)(Yb + ((size_t)b * SEQ + time) * 2048 + g * 16 + 4 * kg) = o; }
          } }
        __syncthreads();
    }
    for (int it = gw; it < DBATCH * NGRP; it += NGW) scan_item(a, l, false, it, lane);
}

__device__ __forceinline__ void ph_epi_glu(ArgP a_, int l) {
    TID_LOCAL(); GTID_LOCAL();
    unsigned char* ws = a->ws; const float* C = (const float*)(ws + WS_C); const float* bg = (const float*)a->in[I_BGLU] + (size_t)l * DM;
    const bf16* Yb = (const bf16*)(ws + WS_YB); const bf16* Gb = (const bf16*)(ws + WS_GB); bf16* AOb = (bf16*)(ws + WS_AOB);
    for (size_t e = gtid; e < (size_t)MR * (DM / 4); e += GT) { const size_t o = e * 4; const int c = (int)(o % DM);
        const f32x4 cv = *(const f32x4*)(C + o), bv = *(const f32x4*)(bg + c); const v2u yw = *(const v2u*)(Yb + o), gw2 = *(const v2u*)(Gb + o);
        const float y[4] = {bflo(yw.x), bfhi(yw.x), bflo(yw.y), bfhi(yw.y)}, gg[4] = {bflo(gw2.x), bfhi(gw2.x), bflo(gw2.y), bfhi(gw2.y)};
        float r[4];
#pragma unroll
        for (int j = 0; j < 4; ++j) r[j] = y[j] * sigmoidf_(cv[j] + bv[j]) * gg[j];
        v2u w; w.x = pk2(r[0], r[1]); w.y = pk2(r[2], r[3]); *(v2u*)(AOb + o) = w; }
}
__device__ __forceinline__ void ph_final(ArgP a_) {
    TID_LOCAL(); GTID_LOCAL();
    unsigned char* ws = a->ws; const float* H = (const float*)(ws + WS_H); const float* rstd = (const float*)(ws + WS_RSTD); const float* fw = (const float*)a->in[I_FNW];
    for (size_t e = gtid; e < (size_t)MR * (DM / 4); e += GT) { const size_t o = e * 4; const int r = (int)(e / (DM / 4)), c = (int)(o % DM);
        const f32x4 v = *(const f32x4*)(H + o) * rstd[r] * *(const f32x4*)(fw + c);
        *(f32x4*)(a->out + (r < MP ? O_YP + o : O_YS + (o - (size_t)MP * DM))) = v; }
}

__global__ void __launch_bounds__(NTHR, 2) fwd_kernel(Args args) {
    extern __shared__ __attribute__((aligned(16))) unsigned char lds_raw[];
    LAS unsigned char* lds = (LAS unsigned char*)lds_raw;
    volatile LAS unsigned* MISC = (volatile LAS unsigned*)(lds + MISC_OFF);
    for (int u = threadIdx.x; u < (LDS_BYTES - 131072) / 4; u += NTHR) ((LAS unsigned*)(lds + 131072))[u] = 0u;
    __syncthreads();
    ArgP kap = (ArgP)__builtin_amdgcn_kernarg_segment_ptr();
    XcdBarrier bar = xcd_barrier_post((unsigned*)(kap->ws + WS_CTL) + CW_BAR, MISC + 8);
    int lp = 0;
#define PH_BEGIN { int l = lp; asm volatile("" : "+s"(l)); const int ia = 2 * l, is = 2 * l + 1; (void)ia; (void)is; ArgP args = kap; asm volatile("" : "+s"(args)); unsigned char* ws = args->ws; (void)ws;
#define PH_END   { XcdBarrier b2_ = bar; asm volatile("" : "+s"(b2_.bar), "+s"(b2_.x)); xcd_barrier(b2_); } }
#define PH_LAST  }
#define GEMM_F32(Aptr, Bptr, Npad, Kdim, Cptr) do { pg8::Gemm g_{(const pg8::bf16_t*)(Aptr), (const pg8::bf16_t*)(Bptr), MPAD, (Npad), (Kdim)}; pg8::StaticOrder S_; S_.init(MPAD, (Npad), (int)gridDim.x, (int)blockIdx.x); \
        pg8::EpiF32 E_{(float*)(Cptr), (Npad)}; pg8::gemm_phase<pg8::EpiF32, pg8::StaticOrder, true, true>(lds, g_, S_, E_); } while (0)

    PH_BEGIN ph_prologue(args, lds); PH_END

    for (lp = 0; lp < 2; ++lp) {
        PH_BEGIN ph_rowstat(args); PH_END
        PH_BEGIN GEMM_F32(ws + WS_HBA, (bf16*)(ws + WS_WAIN) + (size_t)l * ACOLS_PAD * DM, ACOLS_PAD, DM, ws + WS_C); PH_END
        PH_BEGIN ph_epi_attn_in(args, l); PH_END
        PH_BEGIN ph_idx(args, l, lds); ph_idx_sample(args, l); PH_END
        PH_BEGIN ph_attn(args, lds); ph_attn_sample(args, l, lds); PH_END
        PH_BEGIN GEMM_F32(ws + WS_AOB, (bf16*)(ws + WS_WAOUT) + (size_t)l * DM * DM, DM, DM, ws + WS_C); PH_END
        PH_BEGIN ph_epi_resid(args); PH_END
        PH_BEGIN ph_rowstat(args); PH_END
        PH_BEGIN GEMM_F32(ws + WS_HBB, (bf16*)(ws + WS_WPG) + (size_t)ia * DM * DM, DM, DM, ws + WS_C); PH_END
        PH_BEGIN GEMM_F32(ws + WS_PB + (size_t)ia * PB_STRIDE, (bf16*)(ws + WS_WPP) + (size_t)ia * DM * PLE, DM, PLE, ws + WS_C2); PH_END
        PH_BEGIN ph_epi_ple(args); PH_END
        PH_BEGIN ph_rowstat(args); PH_END
        PH_BEGIN GEMM_F32(ws + WS_HBA, (bf16*)(ws + WS_WSIN) + (size_t)l * 4096 * DM, 4096, DM, ws + WS_C); PH_END
        PH_BEGIN ph_epi_ssm_in(args); PH_END
        PH_BEGIN ph_scan(args, l, lds); PH_END
        PH_BEGIN GEMM_F32(ws + WS_YB, (bf16*)(ws + WS_WGLU) + (size_t)l * DM * DM, DM, DM, ws + WS_C); PH_END
        PH_BEGIN ph_epi_glu(args, l); PH_END
        PH_BEGIN GEMM_F32(ws + WS_AOB, (bf16*)(ws + WS_WSOUT) + (size_t)l * DM * DM, DM, DM, ws + WS_C); PH_END
        PH_BEGIN ph_epi_resid(args); PH_END
        PH_BEGIN ph_rowstat(args); PH_END
        PH_BEGIN GEMM_F32(ws + WS_HBB, (bf16*)(ws + WS_WPG) + (size_t)is * DM * DM, DM, DM, ws + WS_C); PH_END
        PH_BEGIN GEMM_F32(ws + WS_PB + (size_t)is * PB_STRIDE, (bf16*)(ws + WS_WPP) + (size_t)is * DM * PLE, DM, PLE, ws + WS_C2); PH_END
        PH_BEGIN ph_epi_ple(args); PH_END
    }
    PH_BEGIN ph_rowstat(args); PH_END
    PH_BEGIN ph_final(args); PH_LAST
}
constexpr int N_PHASES = 1 + 2 * 24 + 2;

#ifndef MK_PER_PHASE
#define MK_PER_PHASE 0
#endif
extern "C" void kernel_launch(void* const* d_in, const int* in_sizes, int n_in, void* d_out, int out_size, void* d_ws, size_t ws_size, hipStream_t stream) {
    static int grid = 0;
    if (grid == 0) {
        if (n_in != N_IN || out_size != (int)O_END || ws_size < WS_END) { fprintf(stderr, "kernel_launch: unexpected shapes: n_in %d out %d ws %zu (need %zu)\n", n_in, out_size, ws_size, (size_t)WS_END); grid = -1; return; }
        int dev = 0, cus = 0, per_cu = 0;
        if (hipGetDevice(&dev) != hipSuccess || hipDeviceGetAttribute(&cus, hipDeviceAttributeMultiprocessorCount, dev) != hipSuccess) { grid = -1; return; }
        if (hipFuncSetAttribute((const void*)fwd_kernel, hipFuncAttributeMaxDynamicSharedMemorySize, LDS_BYTES) != hipSuccess) { fprintf(stderr, "kernel_launch: hipFuncSetAttribute failed\n"); grid = -1; return; }
        if (hipOccupancyMaxActiveBlocksPerMultiprocessor(&per_cu, (const void*)fwd_kernel, NTHR, LDS_BYTES) != hipSuccess || per_cu < 1) fprintf(stderr, "kernel_launch: occupancy query reports %d\n", per_cu);
        (void)hipGetLastError();
        grid = cus;
    }
    if (grid < 0) return;
    if (hipMemsetAsync((char*)d_ws + WS_CTL, 0, CTL_ZERO_BYTES, stream) != hipSuccess) return;
    Args a{};
    for (int i = 0; i < N_IN; ++i) a.in[i] = d_in[i];
    a.out = (float*)d_out; a.ws = (unsigned char*)d_ws;
    a.ph_lo = 0; a.ph_hi = N_PHASES;
    hipLaunchKernelGGL(fwd_kernel, dim3(grid), dim3(NTHR), LDS_BYTES, stream, a);
    const hipError_t le = hipPeekAtLastError();
    if (le != hipSuccess) fprintf(stderr, "kernel_launch: launch failed: %s\n", hipGetErrorName(le));
}
```

```cpp
#include <hip/hip_runtime.h>
#include <cstdio>
#include <cstdint>
#ifndef PROF
#define PROF 0
#endif
#define PROF_UNIT_US 8u
#define PROF_MATCH_A(id) (false)
#define PROF_MATCH_B(id) (false)

__device__ __forceinline__ int lane_id_fresh();
namespace pg8 {
#define PG8_LAS __attribute__((address_space(3)))
typedef unsigned short bf16_t;
typedef short bf16x8 __attribute__((ext_vector_type(8)));
typedef float f32x4 __attribute__((ext_vector_type(4)));
typedef unsigned u32x4 __attribute__((ext_vector_type(4)));
constexpr int BM = 256, BK = 64, HALF = 128, HTB = HALF * BK * 2, STAGE_BYTES = 8 * HTB, NXCD = 8, WGM = 8;

__host__ __device__ __forceinline__ int lds_byte(int r, int c) { const int st = (r >> 4) * 2 + (c >> 5), rr = r & 15, cc = c & 31, ob = rr * 64 + cc * 2; return st * 1024 + (ob ^ (((ob >> 9) & 1) << 5)); }
__host__ __device__ __forceinline__ void stage_rc(int b, int& R, int& C) { const int st = b / 1024, sb = b % 1024, swz = sb ^ (((sb >> 9) & 1) << 5); R = (st >> 1) * 16 + swz / 64; C = (st & 1) * 32 + (swz % 64) / 2; }

struct Unit { int pm, pn; };
struct Gemm { const bf16_t* A; const bf16_t* Bt; int M, N, K; };

struct StaticOrder {
    int nM, nN, nwg, G, c;
    __host__ __device__ void init(int M, int N, int G_, int c_) { nM = M / BM; nN = N / BM; nwg = nM * nN; G = G_; c = c_; }
    __host__ __device__ bool next(int i, Unit& u) const {
        const long L = (long)i * G + c; if (L >= nwg) return false;
        int wgid = (int)L; { const int q = nwg / NXCD, r = nwg % NXCD, xcd = wgid % NXCD, off = wgid / NXCD; wgid = (xcd < r ? xcd * (q + 1) : r * (q + 1) + (xcd - r) * q) + off; }
        const int nig = WGM * nN, gid = wgid / nig, fm = gid * WGM, gsz = (nM - fm) < WGM ? (nM - fm) : WGM;
        u.pm = fm + ((wgid % nig) % gsz); u.pn = (wgid % nig) / gsz; return true;
    }
    __device__ __forceinline__ void a_ready(const Unit&) const {}
    __device__ __forceinline__ void done(const Unit&) const {}
};

struct EpiF32 {
    float* C; int ldc;
    __device__ __forceinline__ void operator()(const f32x4 (&acc)[2][2][4][2], const Unit& u, int wr, int wc, int fr, int fq) const {
        const int row0 = u.pm * BM + wr * 64 + fr, col0 = u.pn * BM + wc * 32 + 4 * fq;
#pragma unroll
        for (int ai = 0; ai < 2; ++ai)
#pragma unroll
            for (int m = 0; m < 4; ++m) { float* rowp = C + (size_t)(row0 + ai * HALF + m * 16) * ldc + col0;
#pragma unroll
                for (int bj = 0; bj < 2; ++bj)
#pragma unroll
                    for (int n = 0; n < 2; ++n) *(f32x4*)(rowp + bj * HALF + n * 16) = acc[ai][bj][m][n]; }
    }
};

template <class Epi, class Sched, bool ALIGN_EPI = false, bool SP2 = false>
__device__ __forceinline__ void gemm_phase(PG8_LAS unsigned char* lds, const Gemm g, const Sched& S, const Epi& E, int wv) {
    int tid = threadIdx.x; (void)wv; asm volatile("" : "+v"(tid)); __builtin_assume(tid >= 0); __builtin_assume(tid < 512);
    int tidg = tid;
    const int wid = __builtin_amdgcn_readfirstlane(tid >> 6), lane = tid & 63, wr = wid >> 2, wc = wid & 3, fr = lane & 15, fq = lane >> 4;
    const int K = g.K, nt = K / BK;
    unsigned voffA[2], voffB[2];
#pragma unroll
    for (int i = 0; i < 2; ++i) { int R, C; stage_rc(tidg * 16 + i * 8192, R, C); const int Rb = R;
        voffA[i] = (unsigned)(R * K + C) * 2u; voffB[i] = (unsigned)(Rb * K + C) * 2u; }
    const size_t kstep = (size_t)(BK * 2);
    const size_t hstep = (size_t)HALF * K * 2;
    const size_t tstep = 2 * hstep;
    const unsigned ldsw = (unsigned)wid * 1024u;
    const int aoff = lds_byte(wr * 64 + fr, fq * 8), boff = lds_byte(wc * 32 + fr, fq * 8);
#define PG8_SA(b, h) (((b) * 2 + (h)) * HTB)
#define PG8_SB(b, h) ((4 + (b) * 2 + (h)) * HTB)
#define PG8_STAGE(bufoff, gbase, voff) do { _Pragma("unroll") for (int _i = 0; _i < 2; ++_i) \
        __builtin_amdgcn_global_load_lds((const unsigned*)((const char*)(gbase) + (voff)[_i]), (PG8_LAS unsigned*)(lds + (bufoff) + ldsw + _i * 8192), 16, 0, 0); } while (0)
#define PG8_LDA(dst, b, h) do { _Pragma("unroll") for (int m = 0; m < 4; ++m) _Pragma("unroll") for (int k = 0; k < 2; ++k) dst[m][k] = *(const PG8_LAS bf16x8*)(lds + PG8_SA(b, h) + aoff + m * 2048 + k * 1024); } while (0)
#define PG8_LDB(dst, b, h) do { _Pragma("unroll") for (int n = 0; n < 2; ++n) _Pragma("unroll") for (int k = 0; k < 2; ++k) dst[n][k] = *(const PG8_LAS bf16x8*)(lds + PG8_SB(b, h) + boff + n * 2048 + k * 1024); } while (0)
#define PG8_MMA(ai, bj, At, Bt) do { __builtin_amdgcn_s_setprio(1); _Pragma("unroll") for (int m = 0; m < 4; ++m) _Pragma("unroll") for (int n = 0; n < 2; ++n) _Pragma("unroll") for (int k = 0; k < 2; ++k) \
        acc[ai][bj][m][n] = __builtin_amdgcn_mfma_f32_16x16x32_bf16(Bt[n][k], At[m][k], acc[ai][bj][m][n], 0, 0, 0); __builtin_amdgcn_s_setprio(0); } while (0)
#define PG8_WAIT_V(n) asm volatile("s_waitcnt vmcnt(" #n ")" ::: "memory")
#define PG8_WAIT_L(n) asm volatile("s_waitcnt lgkmcnt(" #n ")" ::: "memory")
#define PG8_BAR __builtin_amdgcn_s_barrier()
#define PG8_SCHED __builtin_amdgcn_sched_barrier(0)
    Unit cur, nxt; int ui = 0;
    if (!S.next(0, cur)) return;
    f32x4 acc[2][2][4][2];
#pragma unroll
    for (int a = 0; a < 2; ++a)
#pragma unroll
        for (int b = 0; b < 2; ++b)
#pragma unroll
            for (int m = 0; m < 4; ++m)
#pragma unroll
                for (int n = 0; n < 2; ++n) acc[a][b][m][n] = (f32x4){0.f, 0.f, 0.f, 0.f};
    bf16x8 At[4][2], B0[2][2], B1[2][2];
    const char* cA = (const char*)g.A + (size_t)cur.pm * tstep; const char* cB = (const char*)g.Bt + (size_t)cur.pn * tstep;
    S.a_ready(cur);
    if constexpr (SP2) {
        PG8_STAGE(PG8_SB(0, 0), cB, voffB); PG8_STAGE(PG8_SB(0, 1), cB + hstep, voffB); PG8_STAGE(PG8_SA(0, 0), cA, voffA); PG8_STAGE(PG8_SA(0, 1), cA + hstep, voffA);
        if (wr == 1) PG8_BAR;
        PG8_WAIT_V(2); PG8_BAR;
        PG8_STAGE(PG8_SB(1, 0), cB + kstep, voffB); PG8_STAGE(PG8_SA(1, 0), cA + kstep, voffA); PG8_STAGE(PG8_SB(1, 1), cB + hstep + kstep, voffB);
        PG8_WAIT_V(6); PG8_BAR;
    } else {
        PG8_STAGE(PG8_SB(0, 0), cB, voffB); PG8_STAGE(PG8_SA(0, 0), cA, voffA); PG8_STAGE(PG8_SB(0, 1), cB + hstep, voffB); PG8_STAGE(PG8_SA(0, 1), cA + hstep, voffA);
        if (wr == 1) PG8_BAR;
        PG8_WAIT_V(4); PG8_BAR;
        PG8_STAGE(PG8_SB(1, 0), cB + kstep, voffB); PG8_STAGE(PG8_SA(1, 0), cA + kstep, voffA); PG8_STAGE(PG8_SB(1, 1), cB + hstep + kstep, voffB);
        PG8_WAIT_V(6); PG8_BAR;
    }
    for (;;) {
        const bool has_next = S.next(ui + 1, nxt);
        const char* nA = has_next ? (const char*)g.A + (size_t)nxt.pm * tstep : cA; const char* nB = has_next ? (const char*)g.Bt + (size_t)nxt.pn * tstep : cB;
        for (int t = 0; t < nt; t += 2) {
            const bool last = (t == nt - 2);
            const char* a1 = cA + (size_t)(t + 1) * kstep;
            const char* a2 = last ? nA : cA + (size_t)(t + 2) * kstep; const char* b2 = last ? nB : cB + (size_t)(t + 2) * kstep;
            const char* a3 = a2 + kstep; const char* b3 = b2 + kstep;
            if (last && has_next) S.a_ready(nxt);
            if constexpr (SP2) {
            PG8_LDB(B0, 0, 0); PG8_LDB(B1, 0, 1); PG8_SCHED; PG8_LDA(At, 0, 0); PG8_STAGE(PG8_SA(1, 1), a1 + hstep, voffA);
            PG8_WAIT_V(8); PG8_WAIT_L(0); PG8_BAR; PG8_MMA(0, 0, At, B0); PG8_MMA(0, 1, At, B1); PG8_BAR; PG8_SCHED;
            PG8_LDA(At, 0, 1); PG8_STAGE(PG8_SB(0, 0), b2, voffB); PG8_STAGE(PG8_SB(0, 1), b2 + hstep, voffB); PG8_STAGE(PG8_SA(0, 0), a2, voffA);
            PG8_WAIT_V(8); PG8_WAIT_L(0); PG8_BAR; PG8_MMA(1, 0, At, B0); PG8_MMA(1, 1, At, B1); PG8_BAR; PG8_SCHED;
            PG8_LDB(B0, 1, 0); PG8_LDB(B1, 1, 1); PG8_SCHED; PG8_LDA(At, 1, 0); PG8_STAGE(PG8_SA(0, 1), a2 + hstep, voffA);
            PG8_WAIT_V(8); PG8_WAIT_L(0); PG8_BAR; PG8_MMA(0, 0, At, B0); PG8_MMA(0, 1, At, B1); PG8_BAR; PG8_SCHED;
            PG8_LDA(At, 1, 1); PG8_STAGE(PG8_SB(1, 0), b3, voffB); PG8_STAGE(PG8_SB(1, 1), b3 + hstep, voffB); PG8_STAGE(PG8_SA(1, 0), a3, voffA);
            PG8_WAIT_V(8); PG8_WAIT_L(0); PG8_BAR; PG8_MMA(1, 0, At, B0); PG8_MMA(1, 1, At, B1); PG8_BAR; PG8_SCHED;
            } else {
            PG8_LDB(B0, 0, 0); PG8_SCHED; PG8_LDA(At, 0, 0); PG8_STAGE(PG8_SA(1, 1), a1 + hstep, voffA);
            PG8_WAIT_L(8); PG8_BAR; PG8_WAIT_L(0); PG8_MMA(0, 0, At, B0); PG8_BAR; PG8_SCHED;
            PG8_LDB(B1, 0, 1); PG8_STAGE(PG8_SB(0, 0), b2, voffB);
            PG8_BAR; PG8_WAIT_L(0); PG8_MMA(0, 1, At, B1); PG8_BAR;
            PG8_LDA(At, 0, 1); PG8_STAGE(PG8_SA(0, 0), a2, voffA);
            PG8_BAR; PG8_WAIT_L(0); PG8_MMA(1, 0, At, B0); PG8_BAR; PG8_SCHED;
            PG8_STAGE(PG8_SB(0, 1), b2 + hstep, voffB);
            PG8_WAIT_V(6); PG8_BAR; PG8_MMA(1, 1, At, B1); PG8_BAR;
            PG8_LDB(B0, 1, 0); PG8_SCHED; PG8_LDA(At, 1, 0); PG8_STAGE(PG8_SA(0, 1), a2 + hstep, voffA);
            PG8_WAIT_L(8); PG8_BAR; PG8_WAIT_L(0); PG8_MMA(0, 0, At, B0); PG8_BAR; PG8_SCHED;
            PG8_LDB(B1, 1, 1); PG8_STAGE(PG8_SB(1, 0), b3, voffB);
            PG8_BAR; PG8_WAIT_L(0); PG8_MMA(0, 1, At, B1); PG8_BAR;
            PG8_LDA(At, 1, 1); PG8_STAGE(PG8_SA(1, 0), a3, voffA);
            PG8_BAR; PG8_WAIT_L(0); PG8_MMA(1, 0, At, B0); PG8_BAR; PG8_SCHED;
            PG8_STAGE(PG8_SB(1, 1), b3 + hstep, voffB);
            PG8_WAIT_V(6); PG8_BAR; PG8_MMA(1, 1, At, B1); PG8_BAR;
            }
        }
        if constexpr (ALIGN_EPI) { if (wr == 0) PG8_BAR; }
        E(acc, cur, wr, wc, tidg & 15, (tidg >> 4) & 3); S.done(cur);
        if (!has_next) break;
#pragma unroll
        for (int a = 0; a < 2; ++a)
#pragma unroll
            for (int b = 0; b < 2; ++b)
#pragma unroll
                for (int m = 0; m < 4; ++m)
#pragma unroll
                    for (int n = 0; n < 2; ++n) acc[a][b][m][n] = (f32x4){0.f, 0.f, 0.f, 0.f};
        cur = nxt; cA = nA; cB = nB; ++ui;
        if constexpr (ALIGN_EPI) { if (wr == 1) PG8_BAR; }
    }
    PG8_WAIT_V(0);
    if constexpr (!ALIGN_EPI) { if (wr == 0) PG8_BAR; }
    PG8_BAR;
#undef PG8_SA
#undef PG8_SB
#undef PG8_STAGE
#undef PG8_LDA
#undef PG8_LDB
#undef PG8_MMA
#undef PG8_WAIT_V
#undef PG8_WAIT_L
#undef PG8_BAR
#undef PG8_SCHED
}
}

constexpr int NWAVES = 8, NTHR = NWAVES * 64;
constexpr int DM = 2048, NBATCH = 2, SEQ = 4096, DEPTH = 4, DBATCH = 8, DSEQ = 4, PAST = 16384, PAGE = 128;
constexpr int NPAGES = PAST / PAGE, NPOOL = 1280, NAL = 2, NSL = 2;
constexpr int NH = 16, NKV = 4, HD = 128, KVG = 4, NIH = 16, IDD = 64, TOPK = 256;
constexpr int ACOLS = 6224, ACOLS_PAD = 6400;
constexpr int C_Q = 0, C_K = 2048, C_V = 2560, C_G = 3072, C_QI = 5120, C_KI = 6144, C_WI = 6208;
constexpr int SGRP = 16, NGRP = 128, SST = 64, PLE = 256;
constexpr int MP = NBATCH * SEQ, MS = DBATCH * DSEQ, MR = MP + MS, MPAD = 8448;
constexpr float RMS_EPS = 1e-6f;
constexpr float LOG2E = 1.4426950408889634f;
constexpr float QSCALE = 0.088388347648318440f * LOG2E;
constexpr float WISCALE = 0.25f * 0.125f;
enum { I_XP = 0, I_XS, I_CK, I_CV, I_CKI, I_SRE, I_SIM, I_PT, I_PP, I_PS, I_NW, I_FNW, I_RB, I_AWI, I_AWO, I_SWI, I_LRE, I_LIM, I_LDT, I_BRE, I_BIM, I_CRE, I_CIM, I_SD, I_WGLU, I_BGLU, I_SWO, I_PNW, I_PWG, I_PWP, N_IN };
constexpr size_t O_YP = 0, O_YS = O_YP + (size_t)MP * DM, O_KP = O_YS + (size_t)MS * DM, O_VP = O_KP + (size_t)NAL * MP * 512, O_KIP = O_VP + (size_t)NAL * MP * 512,
    O_SRP = O_KIP + (size_t)NAL * MP * 64, O_SIP = O_SRP + (size_t)NSL * NBATCH * NGRP * SST, O_KS = O_SIP + (size_t)NSL * NBATCH * NGRP * SST, O_VS = O_KS + (size_t)NAL * MS * 512,
    O_KIS = O_VS + (size_t)NAL * MS * 512, O_SRS = O_KIS + (size_t)NAL * MS * 64, O_SIS = O_SRS + (size_t)NSL * DBATCH * NGRP * SST, O_END = O_SIS + (size_t)NSL * DBATCH * NGRP * SST;
static_assert(O_END == 35065856, "output size");

constexpr size_t MiB = 1u << 20;
constexpr size_t WS_CTL = 0, CTL_ZERO_BYTES = 64 * 1024;
constexpr size_t WS_WAIN = 2 * MiB;
constexpr size_t WS_WAOUT = WS_WAIN + 50 * MiB;
constexpr size_t WS_WSIN = WS_WAOUT + 16 * MiB;
constexpr size_t WS_WGLU = WS_WSIN + 32 * MiB;
constexpr size_t WS_WSOUT = WS_WGLU + 16 * MiB;
constexpr size_t WS_WPG = WS_WSOUT + 16 * MiB;
constexpr size_t WS_WPP = WS_WPG + 32 * MiB;
constexpr size_t WS_H = WS_WPP + 4 * MiB;
constexpr size_t WS_HBA = WS_H + 66 * MiB, WS_HBB = WS_HBA + 33 * MiB;
constexpr size_t WS_PB = WS_HBB + 33 * MiB;
constexpr size_t PB_STRIDE = (size_t)MPAD * PLE * 2;
constexpr size_t WS_QB = WS_PB + 17 * MiB;
constexpr size_t WS_KB = WS_QB + 33 * MiB, WS_VB = WS_KB + 9 * MiB;
constexpr size_t WS_GB = WS_VB + 9 * MiB;
constexpr size_t WS_QIB = WS_GB + 33 * MiB;
constexpr size_t WS_KIB = WS_QIB + 17 * MiB;
constexpr size_t WS_WI = WS_KIB + 2 * MiB;
constexpr size_t WS_AOB = WS_WI + 1 * MiB;
constexpr size_t WS_UG = WS_AOB + 33 * MiB;
constexpr size_t WS_US = WS_UG + 32 * MiB;
constexpr size_t WS_YB = WS_US + 1 * MiB;
constexpr size_t WS_RSTD = WS_YB + 33 * MiB;
constexpr size_t WS_C = WS_RSTD + 1 * MiB;
constexpr size_t WS_C2 = WS_C + 207 * MiB;
constexpr size_t WS_SC = WS_C2 + 66 * MiB;
constexpr int SC_LD = SEQ + 64;
constexpr size_t WS_SCS = WS_SC + 130 * MiB;
constexpr int SCS_LD = 16400;
constexpr size_t WS_SEL = WS_SCS + 3 * MiB;
constexpr size_t WS_KM = WS_SEL + 9 * MiB;
constexpr size_t WS_END = WS_KM + 4 * MiB;
constexpr int CW_BAR = 4096;

constexpr int LDS_BYTES = 147456;
constexpr int MISC_OFF = 131072 + 320;

#define GAS __attribute__((address_space(1)))
#define LAS __attribute__((address_space(3)))
typedef unsigned short bf16;
typedef unsigned v4u __attribute__((ext_vector_type(4)));
typedef unsigned v2u __attribute__((ext_vector_type(2)));
typedef float f32x4 __attribute__((ext_vector_type(4)));
#define LDS_WAIT() asm volatile("s_waitcnt lgkmcnt(0)" ::: "memory")
__device__ __forceinline__ int lane_id_fresh() { unsigned ones = ~0u; asm volatile("" : "+s"(ones)); return (int)__builtin_amdgcn_mbcnt_hi(ones, __builtin_amdgcn_mbcnt_lo(ones, 0u)); }
__device__ __forceinline__ unsigned f2bf(float f) { unsigned u = __builtin_bit_cast(unsigned, f); return (u + 0x7fffu + ((u >> 16) & 1u)) >> 16; }
__device__ __forceinline__ unsigned pk2(float lo, float hi) { return f2bf(lo) | (f2bf(hi) << 16); }
__device__ __forceinline__ float bf2f(unsigned short b) { return __builtin_bit_cast(float, ((unsigned)b) << 16); }
__device__ __forceinline__ float bflo(unsigned w) { return __builtin_bit_cast(float, w << 16); }
__device__ __forceinline__ float bfhi(unsigned w) { return __builtin_bit_cast(float, w & 0xffff0000u); }
__device__ __forceinline__ float sigmoidf_(float x) { return 1.0f / (1.0f + __expf(-x)); }
__device__ __forceinline__ float siluf_(float x) { return x * sigmoidf_(x); }
__device__ __forceinline__ float gelu_tanh(float x) { const float u = 0.7978845608028654f * (x + 0.044715f * x * x * x); return x * sigmoidf_(2.0f * u); }
__device__ __forceinline__ float wave_sum(float v) {
#pragma unroll
    for (int o = 1; o < 64; o <<= 1) v += __shfl_xor(v, o);
    return v;
}
__device__ __forceinline__ float* ss_buf(unsigned char* ws, int k);
__device__ __forceinline__ float ss2rstd(float ss);
__device__ __forceinline__ float ss_row_rstd(const float* ssp, int r);
__device__ __forceinline__ int t5_bucket(int n) {
    if (n < 16) return n;
    int b = 16;
    b += (n >= 19) + (n >= 21) + (n >= 24) + (n >= 27) + (n >= 31) + (n >= 35) + (n >= 40) + (n >= 46) + (n >= 52) + (n >= 59) + (n >= 67) + (n >= 77) + (n >= 87) + (n >= 99) + (n >= 113);
    return b;
}

#define XB_TMO      128
#define XB_XCNT(j)  (256  + 64 * (j))
#define XB_XSUB(j)  (1280 + 64 * (j))
#define XB_XGEN(j)  (2304 + 64 * (j))
#define XB_TOP      3328
#define XB_TOPGEN   3392
#define XCD_BAR_WORDS 3456
#define XB_SPIN_CAP (1u << 22)
__device__ __forceinline__ unsigned xb_ld(unsigned* p)              { return __hip_atomic_load(p, __ATOMIC_RELAXED, __HIP_MEMORY_SCOPE_AGENT); }
__device__ __forceinline__ unsigned xb_add(unsigned* p, unsigned v) { return __hip_atomic_fetch_add(p, v, __ATOMIC_RELAXED, __HIP_MEMORY_SCOPE_AGENT); }
__device__ __forceinline__ unsigned xb_xcc_id() { return (unsigned)__builtin_amdgcn_s_getreg((3 << 11) | 20) & 0xFu; }
#define XB_SPIN(cond, bar) do { unsigned _sp = 0; while (cond) { __builtin_amdgcn_s_sleep(1); \
    if ((++_sp & 255u) == 0u) { if (xb_ld(&(bar)[XB_TMO])) break; if (_sp > XB_SPIN_CAP) { atomicAdd(&(bar)[XB_TMO], 1u); break; } } } } while (0)
struct XcdBarrier { unsigned* bar; unsigned x; volatile LAS unsigned* st; };
__device__ __forceinline__ XcdBarrier xcd_barrier_post(unsigned* bar, volatile LAS unsigned* st, int wv) {
    XcdBarrier b; b.bar = bar; b.x = xb_xcc_id(); b.st = st;
    if (wv == 0 && lane_id_fresh() == 0) (void)xb_add(&bar[XB_XCNT(b.x)], 1u);
    return b;
}
__device__ __forceinline__ void xcd_barrier_complete(unsigned* bar, unsigned x, unsigned& nloc, unsigned& nx) {
    const unsigned G = gridDim.x * gridDim.y * gridDim.z;
    unsigned sum, cnt, mine, sp = 0u;
    for (;;) {
        sum = 0u; cnt = 0u; mine = 0u;
#pragma unroll
        for (unsigned j = 0; j < 16; ++j) { const unsigned c = xb_ld(&bar[XB_XCNT(j)]); sum += c; cnt += (c > 0u) ? 1u : 0u; mine = (j == x) ? c : mine; }
        if (sum == G) break;
        __builtin_amdgcn_s_sleep(1);
        if ((++sp & 255u) == 0u) { if (xb_ld(&bar[XB_TMO])) break; if (sp > XB_SPIN_CAP) { atomicAdd(&bar[XB_TMO], 1u); break; } }
    }
    nloc = mine > 0u ? mine : 1u; nx = cnt > 0u ? cnt : 1u;
}
__device__ __forceinline__ void xcd_barrier(const XcdBarrier& b, int wv) {
    asm volatile("s_waitcnt vmcnt(0)" ::: "memory");
    __syncthreads();
    if (wv == 0 && lane_id_fresh() == 0) {
        unsigned* bar = b.bar;
        __builtin_amdgcn_s_waitcnt(0);
        unsigned nloc = b.st[0], nx = b.st[1];
        if (nloc == 0u) { xcd_barrier_complete(bar, b.x, nloc, nx); b.st[0] = nloc; b.st[1] = nx; }
        const unsigned old = xb_add(&bar[XB_XSUB(b.x)], 1u);
        const unsigned gen = old / nloc;
        if (old + 1u == (gen + 1u) * nloc) {
            __builtin_amdgcn_fence(__ATOMIC_RELEASE, "agent");
            asm volatile("s_waitcnt vmcnt(0)" ::: "memory");
            const unsigned og = xb_add(&bar[XB_TOP], 1u);
            const unsigned tg = og / nx;
            if (og + 1u == (tg + 1u) * nx) xb_add(&bar[XB_TOPGEN], 1u);
            else XB_SPIN(xb_ld(&bar[XB_TOPGEN]) == tg, bar);
            __builtin_amdgcn_fence(__ATOMIC_ACQUIRE, "agent");
            xb_add(&bar[XB_XGEN(b.x)], 1u);
            asm volatile("s_waitcnt vmcnt(0)" ::: "memory");
        } else {
            XB_SPIN(xb_ld(&bar[XB_XGEN(b.x)]) == gen, bar);
            __builtin_amdgcn_fence(__ATOMIC_ACQUIRE, "agent");
            asm volatile("s_waitcnt vmcnt(0)" ::: "memory");
        }
    }
    __syncthreads();
}

#if PROF
__device__ __forceinline__ void prof_mark(int id, int wave) {
    extern __shared__ __attribute__((aligned(16))) unsigned char lds_raw[];
    if (blockIdx.x == 0 && wave == 0) { volatile LAS unsigned* M = (volatile LAS unsigned*)((LAS unsigned char*)lds_raw + MISC_OFF);
        const unsigned long long tn = __builtin_amdgcn_s_memrealtime(); const unsigned long long tp = ((unsigned long long)M[17] << 32) | M[16]; const unsigned d = (unsigned)(tn - tp);
        if (PROF_MATCH_A(id)) M[18] = M[18] + d; if (PROF_MATCH_B(id)) M[19] = M[19] + d; M[16] = (unsigned)tn; M[17] = (unsigned)(tn >> 32); }
}
#define PMARK(id, wave) prof_mark(id, wave)
#else
#define PMARK(id, wave) do {} while (0)
#endif
struct Args { const void* in[N_IN]; float* out; unsigned char* ws; int ph_lo, ph_hi; };
typedef const __attribute__((address_space(4))) Args* ArgP;
#define TID_LOCAL() ArgP a = a_; asm volatile("" : "+s"(a)); const int wave = wv_; const int lane = lane_id_fresh(); int tid = wave * 64 + lane; asm volatile("" : "+v"(tid)); const int gw = blockIdx.x * NWAVES + wave, NGW = gridDim.x * NWAVES; (void)lane; (void)wave; (void)gw; (void)NGW
#define GTID_LOCAL() const size_t gtid = (size_t)blockIdx.x * NTHR + tid, GT = (size_t)gridDim.x * NTHR

__device__ __forceinline__ void transpose_item(const float* W, int K, int N, const float* scale, bf16* WT, LAS float* scr, int item, int lane) {
    const int nblk = (N + 31) / 32, kb = item / nblk, nb = item % nblk, k0 = 64 * kb, n0 = 32 * nb;
    const int n = n0 + (lane & 31); const float* wp = W + (size_t)(k0 + (lane >> 5)) * N + n;
    float v[32];
#pragma unroll
    for (int i = 0; i < 32; ++i) v[i] = (n < N) ? wp[(size_t)(2 * i) * N] : 0.f;
#pragma unroll
    for (int i = 0; i < 32; ++i) scr[(2 * i + (lane >> 5)) * 33 + (lane & 31)] = v[i];
    LDS_WAIT(); asm volatile("" ::: "memory");
    const int c = lane & 7;
    f32x4 s0 = {1.f, 1.f, 1.f, 1.f}, s1 = {1.f, 1.f, 1.f, 1.f};
    if (scale) { s0 = *(const f32x4*)(scale + k0 + 8 * c); s1 = *(const f32x4*)(scale + k0 + 8 * c + 4); }
#pragma unroll
    for (int j = 0; j < 4; ++j) { const int nn = (lane >> 3) + 8 * j; const LAS float* s = scr + (8 * c) * 33 + nn;
        v4u o; o.x = pk2(s[0 * 33] * s0[0], s[1 * 33] * s0[1]); o.y = pk2(s[2 * 33] * s0[2], s[3 * 33] * s0[3]); o.z = pk2(s[4 * 33] * s1[0], s[5 * 33] * s1[1]); o.w = pk2(s[6 * 33] * s1[2], s[7 * 33] * s1[3]);
        *(v4u*)(WT + (size_t)(n0 + nn) * K + k0 + 8 * c) = o; }
    LDS_WAIT(); asm volatile("" ::: "memory");
}

__device__ __forceinline__ void ph_prologue(ArgP a_, LAS unsigned char* lds, int wv_) {
    TID_LOCAL();
    LAS float* scr = (LAS float*)(lds + wave * 16384);
    unsigned char* ws = a->ws;
    for (int m = 0; m < 18; ++m) {
        const float* W; int K = DM, N = DM; const float* sc = nullptr; bf16* WT;
        if (m < 2)       { W = (const float*)a->in[I_AWI] + (size_t)m * DM * ACOLS; N = ACOLS; sc = (const float*)a->in[I_NW] + (size_t)(2 * m) * DM; WT = (bf16*)(ws + WS_WAIN) + (size_t)m * ACOLS_PAD * DM; }
        else if (m < 4)  { const int l = m - 2; W = (const float*)a->in[I_AWO] + (size_t)l * DM * DM; WT = (bf16*)(ws + WS_WAOUT) + (size_t)l * DM * DM; }
        else if (m < 6)  { const int l = m - 4; W = (const float*)a->in[I_SWI] + (size_t)l * DM * 4096; N = 4096; sc = (const float*)a->in[I_NW] + (size_t)(2 * l + 1) * DM; WT = (bf16*)(ws + WS_WSIN) + (size_t)l * 4096 * DM; }
        else if (m < 8)  { const int l = m - 6; W = (const float*)a->in[I_WGLU] + (size_t)l * DM * DM; WT = (bf16*)(ws + WS_WGLU) + (size_t)l * DM * DM; }
        else if (m < 10) { const int l = m - 8; W = (const float*)a->in[I_SWO] + (size_t)l * DM * DM; WT = (bf16*)(ws + WS_WSOUT) + (size_t)l * DM * DM; }
        else if (m < 14) { const int i = m - 10; W = (const float*)a->in[I_PWG] + (size_t)i * DM * DM; sc = (const float*)a->in[I_PNW] + (size_t)i * DM; WT = (bf16*)(ws + WS_WPG) + (size_t)i * DM * DM; }
        else             { const int i = m - 14; W = (const float*)a->in[I_PWP] + (size_t)i * PLE * DM; K = PLE; WT = (bf16*)(ws + WS_WPP) + (size_t)i * DM * PLE; }
        const int nitems = (K / 64) * ((N + 31) / 32);
        for (int it = gw; it < nitems; it += NGW) transpose_item(W, K, N, sc, WT, scr, it, lane);
    }
    bf16* Hb = (bf16*)(ws + WS_HBA);
    for (int r = gw; r < MR; r += NGW) {
        const float* src = (r < MP) ? (const float*)a->in[I_XP] + (size_t)r * DM : (const float*)a->in[I_XS] + (size_t)(r - MP) * DM;
        float ssq = 0.f;
#pragma unroll
        for (int j = 0; j < 8; ++j) { const int c = (j * 64 + lane) * 4; const f32x4 v = *(const f32x4*)(src + c); ssq += v[0] * v[0] + v[1] * v[1] + v[2] * v[2] + v[3] * v[3];
            v2u o; o.x = pk2(v[0], v[1]); o.y = pk2(v[2], v[3]); *(v2u*)(Hb + (size_t)r * DM + c) = o; }
        ssq = wave_sum(ssq);
        if (r < MP) { if (lane < 32) ss_buf(ws, 0)[(size_t)r * 32 + lane] = (lane == 0) ? ssq : 0.f; }
        else { float* sp = ss_buf(ws, 0) + (size_t)MPAD * 32 + (size_t)(r - MP) * 128; sp[lane] = (lane == 0) ? ssq : 0.f; sp[64 + lane] = 0.f; }
    }
    for (int q = gw; q < DEPTH * MR; q += NGW) { const int i = q / MR, r = q % MR;
        const float* src = (r < MP) ? (const float*)a->in[I_PP] + ((size_t)i * MP + r) * PLE : (const float*)a->in[I_PS] + ((size_t)i * MS + (r - MP)) * PLE;
        const f32x4 v = *(const f32x4*)(src + lane * 4); v2u o; o.x = pk2(v[0], v[1]); o.y = pk2(v[2], v[3]);
        *(v2u*)((bf16*)(ws + WS_PB + (size_t)i * PB_STRIDE) + (size_t)r * PLE + lane * 4) = o; }
}

__device__ __forceinline__ void ph_rowstat(ArgP a_, int wv_) {
    TID_LOCAL();
    const float* H = (const float*)(a->ws + WS_H); float* rstd = (float*)(a->ws + WS_RSTD);
    for (int r = gw; r < MR; r += NGW) { float s = 0.f;
#pragma unroll
        for (int j = 0; j < 8; ++j) { const f32x4 v = *(const f32x4*)(H + (size_t)r * DM + (j * 64 + lane) * 4); s += v[0] * v[0] + v[1] * v[1] + v[2] * v[2] + v[3] * v[3]; }
        s = wave_sum(s); if (lane == 0) rstd[r] = 1.0f / sqrtf(s * (1.0f / DM) + RMS_EPS); }
}

__device__ __forceinline__ void ph_epi_attn_in(ArgP a_, int l, int wv_) {
    TID_LOCAL(); GTID_LOCAL();
    unsigned char* ws = a->ws; const float* C = (const float*)(ws + WS_C); const float* rstd = (const float*)(ws + WS_RSTD);
    constexpr int NG4 = ACOLS / 4;
    for (size_t e = gtid; e < (size_t)MR * NG4; e += GT) { const int r = (int)(e / NG4), c = (int)(e % NG4) * 4;
        f32x4 v = *(const f32x4*)(C + (size_t)r * ACOLS_PAD + c); const float rs = rstd[r]; v = v * rs;
        if (c < C_K) { v = v * QSCALE; v2u o; o.x = pk2(v[0], v[1]); o.y = pk2(v[2], v[3]); *(v2u*)((bf16*)(ws + WS_QB) + (size_t)r * 2048 + c) = o; }
        else if (c < C_G) { const bool isv = c >= C_V; const int cc = c - (isv ? C_V : C_K);
            float* o32 = a->out + (r < MP ? (isv ? O_VP : O_KP) + ((size_t)l * MP + r) * 512 : (isv ? O_VS : O_KS) + ((size_t)l * MS + (r - MP)) * 512) + cc;
            *(f32x4*)o32 = v; v2u o; o.x = pk2(v[0], v[1]); o.y = pk2(v[2], v[3]); *(v2u*)((bf16*)(ws + (isv ? WS_VB : WS_KB)) + (size_t)r * 512 + cc) = o; }
        else if (c < C_QI) { v2u o; o.x = pk2(siluf_(v[0]), siluf_(v[1])); o.y = pk2(siluf_(v[2]), siluf_(v[3])); *(v2u*)((bf16*)(ws + WS_GB) + (size_t)r * 2048 + (c - C_G)) = o; }
        else if (c < C_KI) { v2u o; o.x = pk2(v[0], v[1]); o.y = pk2(v[2], v[3]); *(v2u*)((bf16*)(ws + WS_QIB) + (size_t)r * 1024 + (c - C_QI)) = o; }
        else if (c < C_WI) { const int cc = c - C_KI; float* o32 = a->out + (r < MP ? O_KIP + ((size_t)l * MP + r) * 64 : O_KIS + ((size_t)l * MS + (r - MP)) * 64) + cc;
            *(f32x4*)o32 = v; v2u o; o.x = pk2(v[0], v[1]); o.y = pk2(v[2], v[3]); *(v2u*)((bf16*)(ws + WS_KIB) + (size_t)r * 64 + cc) = o; }
        else { *(f32x4*)((float*)(ws + WS_WI) + (size_t)r * 16 + (c - C_WI)) = v * WISCALE; }
    }
}


typedef short bf16x8v __attribute__((ext_vector_type(8)));
__device__ __forceinline__ unsigned mono_key(float x) { const unsigned b = __builtin_bit_cast(unsigned, x); return b ^ ((unsigned)((int)b >> 31) | 0x80000000u); }
__device__ __forceinline__ int wave_sum_i(int v) {
#pragma unroll
    for (int o = 1; o < 64; o <<= 1) v += __shfl_xor(v, o);
    return v;
}
__device__ __forceinline__ int lane_prefix(unsigned long long m) { return (int)__builtin_amdgcn_mbcnt_hi((unsigned)(m >> 32), __builtin_amdgcn_mbcnt_lo((unsigned)m, 0u)); }
constexpr size_t KM_WORDS = (size_t)NBATCH * 128 * 64 * 32;

__device__ __forceinline__ int cnt_ge4(const v4u k, unsigned cand) { return __popcll(__ballot(k.x >= cand)) + __popcll(__ballot(k.y >= cand)) + __popcll(__ballot(k.z >= cand)) + __popcll(__ballot(k.w >= cand)); }
__device__ __forceinline__ void sel_load(const float* sc, int n, int lane, f32x4 (&v)[16]) {
#pragma unroll
    for (int ch = 0; ch < 16; ++ch) { const int i0 = ch * 256 + 4 * lane; f32x4 t = {0.f, 0.f, 0.f, 0.f}; if (ch * 256 < n) t = *(const f32x4*)(sc + i0); v[ch] = t; }
}
__device__ __forceinline__ void sel_store(const f32x4 (&v)[16], int n, int lane, LAS unsigned* ldsk) {
#pragma unroll
    for (int ch = 0; ch < 16; ++ch) { const int i0 = ch * 256 + 4 * lane;
        v4u k; k.x = (i0 < n) ? mono_key(v[ch][0]) : 0u; k.y = (i0 + 1 < n) ? mono_key(v[ch][1]) : 0u; k.z = (i0 + 2 < n) ? mono_key(v[ch][2]) : 0u; k.w = (i0 + 3 < n) ? mono_key(v[ch][3]) : 0u;
        *(LAS v4u*)(ldsk + i0) = k; }
}
__device__ __forceinline__ void select_core(int n, int lane, LAS unsigned* ldsk, LAS unsigned long long* mrow) {
    const int nc = (n + 255) >> 8, ne = (n + 63) >> 6, ng = (nc + 3) >> 2;
    unsigned T = 0u; int need = TOPK, toteq = 0;
    if (n > TOPK) {
        for (int bit = 31; bit >= 0; --bit) { const unsigned cand = T | (1u << bit); int c = 0;
            for (int g4 = 0; g4 < ng; ++g4) { const LAS v4u* p = (const LAS v4u*)(ldsk + g4 * 1024 + lane * 4); const v4u k0 = p[0], k1 = p[64], k2 = p[128], k3 = p[192];
                c += cnt_ge4(k0, cand) + cnt_ge4(k1, cand) + cnt_ge4(k2, cand) + cnt_ge4(k3, cand); }
            if (c >= TOPK) { T = cand; if (c == TOPK) break; } }
        int cg = 0, ce = 0;
        for (int ch = 0; ch < nc; ++ch) { const v4u k = *(const LAS v4u*)(ldsk + ch * 256 + lane * 4);
            cg += __popcll(__ballot(k.x > T)) + __popcll(__ballot(k.y > T)) + __popcll(__ballot(k.z > T)) + __popcll(__ballot(k.w > T));
            ce += __popcll(__ballot(k.x == T)) + __popcll(__ballot(k.y == T)) + __popcll(__ballot(k.z == T)) + __popcll(__ballot(k.w == T)); }
        need = TOPK - cg;
        toteq = ce;
    }
    const bool all_eq = (toteq <= need);
    int base_eq = 0;
    for (int e0 = 0; e0 < ne; e0 += 4) {
        unsigned kk[4];
#pragma unroll
        for (int u = 0; u < 4; ++u) kk[u] = ldsk[(e0 + u) * 64 + lane];
#pragma unroll
        for (int u = 0; u < 4; ++u) { const int e = e0 + u; const int idx = e * 64 + lane; const unsigned k = kk[u]; const bool valid = idx < n; bool s;
            if (n <= TOPK) s = valid;
            else if (all_eq) s = valid && k >= T;
            else { const bool eq = valid && k == T; const unsigned long long em = __ballot(eq); s = valid && (k > T || (eq && base_eq + lane_prefix(em) < need)); base_eq += __popcll(em); }
            const unsigned long long sm = __ballot(s);
            if (lane == 0 && e < ne) mrow[e * 16] = sm; }
    }
}

__device__ __forceinline__ void ph_idx(ArgP a_, int l, LAS unsigned char* lds, int wv_) {
    TID_LOCAL();
    unsigned char* ws = a->ws;
    const bf16* QIb = (const bf16*)(ws + WS_QIB); const bf16* KIb = (const bf16*)(ws + WS_KIB); const float* WI = (const float*)(ws + WS_WI);
    unsigned long long* KM = (unsigned long long*)(ws + WS_KM);
    for (int vb = blockIdx.x; vb < 256; vb += gridDim.x) {
        const int b = vb >> 7, x = vb & 127;
        int ln = lane; asm volatile("" : "+v"(ln)); const int fr = ln & 15, kg = ln >> 4, qi = fr & 7, hh = fr >> 3;
        LAS unsigned long long* msk = (LAS unsigned long long*)(lds + 132096);
        LAS unsigned* ldsk = (LAS unsigned*)(lds + wave * 16384);
        for (int rnd = 0; rnd < 4; ++rnd) {
            const int qt = (rnd & 2) ? 255 - x : x, qbase = qt * 16 + (rnd & 1) * 8;
            const int nrow = qbase + wave + 1;
            { const int ngk = ((((nrow + 255) >> 8) + 3) >> 2) * 1024; for (int i = (qt + 1) * 16 + lane * 4; i < ngk; i += 256) *(LAS v4u*)(ldsk + i) = (v4u){0u, 0u, 0u, 0u}; }
            const int tq = qbase + qi; const size_t qrow = (size_t)b * SEQ + tq;
            bf16x8v Bq[8][2]; float w[8];
#pragma unroll
            for (int it = 0; it < 8; ++it) { const int h = hh * 8 + it; Bq[it][0] = *(const bf16x8v*)(QIb + qrow * 1024 + h * 64 + kg * 8); Bq[it][1] = *(const bf16x8v*)(QIb + qrow * 1024 + h * 64 + 32 + kg * 8); w[it] = WI[qrow * 16 + h]; }
            const bf16* kbase = KIb + ((size_t)b * SEQ + fr) * 64 + kg * 8;
            bf16x8v A0 = {0, 0, 0, 0, 0, 0, 0, 0}, A1 = A0, N0 = A0, N1 = A0;
            if (wave <= qt) { A0 = *(const bf16x8v*)(kbase + (size_t)wave * 1024); A1 = *(const bf16x8v*)(kbase + (size_t)wave * 1024 + 32); }
            if (wave + NWAVES <= qt) { N0 = *(const bf16x8v*)(kbase + (size_t)(wave + NWAVES) * 1024); N1 = *(const bf16x8v*)(kbase + (size_t)(wave + NWAVES) * 1024 + 32); }
            LAS unsigned* rowp = (LAS unsigned*)(lds + qi * 16384) + kg * 4;
            for (int kt = wave; kt <= qt; kt += NWAVES) {
                bf16x8v M0 = N0, M1 = N1;
                if (kt + 2 * NWAVES <= qt) { M0 = *(const bf16x8v*)(kbase + (size_t)(kt + 2 * NWAVES) * 1024); M1 = *(const bf16x8v*)(kbase + (size_t)(kt + 2 * NWAVES) * 1024 + 32); }
                f32x4 S = {0.f, 0.f, 0.f, 0.f};
#pragma unroll
                for (int it = 0; it < 8; ++it) { f32x4 acc = {0.f, 0.f, 0.f, 0.f};
                    acc = __builtin_amdgcn_mfma_f32_16x16x32_bf16(A0, Bq[it][0], acc, 0, 0, 0); acc = __builtin_amdgcn_mfma_f32_16x16x32_bf16(A1, Bq[it][1], acc, 0, 0, 0);
#pragma unroll
                    for (int j = 0; j < 4; ++j) S[j] += w[it] * fmaxf(acc[j], 0.f); }
                v4u kk;
#pragma unroll
                for (int j = 0; j < 4; ++j) { const float o_ = S[j]; const float s_ = o_ + __builtin_bit_cast(float, __builtin_amdgcn_update_dpp(0, __builtin_bit_cast(int, o_), 0x108, 0xF, 0xF, true));
                    const unsigned key_ = (kt * 16 + kg * 4 + j <= tq) ? mono_key(s_) : 0u; if (j == 0) kk.x = key_; else if (j == 1) kk.y = key_; else if (j == 2) kk.z = key_; else kk.w = key_; }
                if (hh == 0) *(LAS v4u*)(rowp + kt * 16) = kk;
                A0 = N0; A1 = N1; N0 = M0; N1 = M1;
            }
            LDS_WAIT(); __syncthreads();
            select_core(nrow, lane, ldsk, msk + ((rnd & 2) ? ((x >> 2) + 1) * 16 : 0) + (rnd & 1) * 8 + wave);
            __syncthreads();
        }
        { const int ne0 = (x >> 2) + 1, ne1 = ((255 - x) >> 2) + 1;
          for (int i = tid; i < (ne0 + ne1) * 16; i += NTHR) { const int h2 = i >= ne0 * 16, ii = i - (h2 ? ne0 * 16 : 0), e = ii >> 4, tr = ii & 15; const int qt = h2 ? 255 - x : x;
              KM[(((size_t)b * 128 + (qt >> 1)) * 64 + e) * 32 + (qt & 1) * 16 + tr] = msk[i]; } }
        __syncthreads(); PMARK(4, wave);
    }
}


namespace att {
using bf16x8 = __attribute__((ext_vector_type(8))) short;
using s16x4  = __attribute__((ext_vector_type(4))) short;
using f32x16 = __attribute__((ext_vector_type(16))) float;
constexpr int KVBLK = 64;
constexpr int SHM_V = KVBLK * 128 * 2, SHM_K = KVBLK * 128 * 2;
constexpr float THR2 = 8.0f;
#define ATT_SDEPTH 1
#define ATT_KSWZ(row, colB) ((row) * 256 + ((colB) ^ (((row) & 7) << 4)))
#define ATT_SBAR() __builtin_amdgcn_sched_barrier(0)
__device__ __forceinline__ int crow(int r, int hi) { return (r & 3) + 8 * (r >> 2) + 4 * hi; }
__device__ __forceinline__ unsigned cvtpk(float lo, float hi) { unsigned r; asm volatile("v_cvt_pk_bf16_f32 %0, %1, %2" : "=v"(r) : "v"(lo), "v"(hi)); return r; }
__device__ __forceinline__ int v_st(int k, int c) { const int kk = (k & ~0xC) | ((k & 4) << 1) | ((k & 8) >> 1); return ((kk >> 3) * 4 + (c >> 5)) * 512 + ((kk & 7) * 32 + (c & 31)) * 2; }
__device__ __forceinline__ int v_rd_base(int lane) { return ((lane & 3) << 3) | (((lane >> 2) & 3) << 6) | (((lane >> 4) & 1) << 5) | (((lane >> 5) & 1) << 8); }
constexpr int v_rd_off(int d0, int ks, int half) { return d0 * 512 + ks * 4096 + half * 2048; }
template <int OFF> __device__ __forceinline__ s16x4 tr_read(int vb) { s16x4 r; asm volatile("ds_read_b64_tr_b16 %0, %1 offset:%2" : "=&v"(r) : "v"(vb), "i"(OFF) : "memory"); return r; }

__device__ __forceinline__ void partialSM(f32x16& p0, f32x16& p1, float& m_reg, float& mn, float& alpha) {
    float pmax = p0[0];
#pragma unroll
    for (int r = 1; r < 16; ++r) pmax = fmaxf(pmax, p0[r]);
#pragma unroll
    for (int r = 0; r < 16; ++r) pmax = fmaxf(pmax, p1[r]);
    { auto rr = __builtin_amdgcn_permlane32_swap(__builtin_bit_cast(unsigned, pmax), __builtin_bit_cast(unsigned, pmax), false, false);
      const unsigned u0 = rr[0], u1 = rr[1]; pmax = fmaxf(__builtin_bit_cast(float, u0), __builtin_bit_cast(float, u1)); }
    if (__builtin_expect(__all(pmax - m_reg <= THR2), 1)) { mn = m_reg; alpha = 1.f; }
    else { mn = fmaxf(m_reg, pmax); alpha = __builtin_amdgcn_exp2f(m_reg - mn); m_reg = mn; }
#pragma unroll
    for (int r = 0; r < 16; ++r) p0[r] = __builtin_amdgcn_exp2f(p0[r] - mn);
#pragma unroll
    for (int r = 0; r < 16; ++r) p1[r] = p1[r] - mn;
}
__device__ __forceinline__ void finishSM(f32x16& p0, f32x16& p1, float alpha, float& l_reg, unsigned long long mk, int hi, bf16x8& pa0, bf16x8& pa1, bf16x8& pa2, bf16x8& pa3) {
#pragma unroll
    for (int r = 0; r < 16; ++r) p1[r] = __builtin_amdgcn_exp2f(p1[r]);
    const unsigned w0 = (unsigned)mk >> (4 * hi), w1 = (unsigned)(mk >> 32) >> (4 * hi);
#pragma unroll
    for (int r = 0; r < 16; ++r) { const int pos = (r & 3) + 8 * (r >> 2);
        const float a0 = p0[r], a1 = p1[r];
        p0[r] = __builtin_bit_cast(float, __builtin_bit_cast(unsigned, a0) & (unsigned)__builtin_amdgcn_sbfe((int)w0, pos, 1));
        p1[r] = __builtin_bit_cast(float, __builtin_bit_cast(unsigned, a1) & (unsigned)__builtin_amdgcn_sbfe((int)w1, pos, 1)); }
    float ps = 0;
#pragma unroll
    for (int r = 0; r < 16; ++r) ps += p0[r];
#pragma unroll
    for (int r = 0; r < 16; ++r) ps += p1[r];
    { auto rr = __builtin_amdgcn_permlane32_swap(__builtin_bit_cast(unsigned, ps), __builtin_bit_cast(unsigned, ps), false, false);
      const unsigned u0 = rr[0], u1 = rr[1]; ps = __builtin_bit_cast(float, u0) + __builtin_bit_cast(float, u1); }
    l_reg = l_reg * alpha + ps;
#define ATT_PK4(P, BASE, OUT) do { unsigned a0 = cvtpk(P[BASE + 0], P[BASE + 1]), a1 = cvtpk(P[BASE + 2], P[BASE + 3]);   \
    unsigned b0 = cvtpk(P[BASE + 4], P[BASE + 5]), b1 = cvtpk(P[BASE + 6], P[BASE + 7]);                              \
    auto r0 = __builtin_amdgcn_permlane32_swap(a0, b0, false, false); auto r1 = __builtin_amdgcn_permlane32_swap(a1, b1, false, false); \
    v4u w = {r0[0], r1[0], r0[1], r1[1]}; OUT = __builtin_bit_cast(bf16x8, w); } while (0)
    ATT_PK4(p0, 0, pa0); ATT_PK4(p0, 8, pa1); ATT_PK4(p1, 0, pa2); ATT_PK4(p1, 8, pa3);
#undef ATT_PK4
}
__device__ __forceinline__ void qkt(f32x16& p0, f32x16& p1, LAS const char* Ks, const bf16x8* qr, int r32, int hi) {
    p0 = f32x16{}; p1 = f32x16{};
    asm volatile("" : "+v"(r32), "+v"(hi));
#pragma unroll
    for (int d0 = 0; d0 < 8; ++d0) { const int cb = (d0 * 16 + hi * 8) * 2;
        const bf16x8 b0 = *(LAS const bf16x8*)(Ks + ATT_KSWZ(r32, cb));
        const bf16x8 b1 = *(LAS const bf16x8*)(Ks + ATT_KSWZ(32 + r32, cb));
        p0 = __builtin_amdgcn_mfma_f32_32x32x16_bf16(b0, qr[d0], p0, 0, 0, 0);
        p1 = __builtin_amdgcn_mfma_f32_32x32x16_bf16(b1, qr[d0], p1, 0, 0, 0); }
}
template <int D0> __device__ __forceinline__ void pv_one(f32x16& od, int vb, bf16x8 pa0, bf16x8 pa1, bf16x8 pa2, bf16x8 pa3) {
    const s16x4 l0 = tr_read<v_rd_off(D0, 0, 0)>(vb), h0 = tr_read<v_rd_off(D0, 0, 1)>(vb), l1 = tr_read<v_rd_off(D0, 1, 0)>(vb), h1 = tr_read<v_rd_off(D0, 1, 1)>(vb);
    const s16x4 l2 = tr_read<v_rd_off(D0, 2, 0)>(vb), h2 = tr_read<v_rd_off(D0, 2, 1)>(vb), l3 = tr_read<v_rd_off(D0, 3, 0)>(vb), h3 = tr_read<v_rd_off(D0, 3, 1)>(vb);
    asm volatile("s_waitcnt lgkmcnt(0)" ::: "memory"); ATT_SBAR();
#define ATT_PK(L, H) (bf16x8){L[0], L[1], L[2], L[3], H[0], H[1], H[2], H[3]}
    od = __builtin_amdgcn_mfma_f32_32x32x16_bf16(pa0, ATT_PK(l0, h0), od, 0, 0, 0);
    od = __builtin_amdgcn_mfma_f32_32x32x16_bf16(pa1, ATT_PK(l1, h1), od, 0, 0, 0);
    od = __builtin_amdgcn_mfma_f32_32x32x16_bf16(pa2, ATT_PK(l2, h2), od, 0, 0, 0);
    od = __builtin_amdgcn_mfma_f32_32x32x16_bf16(pa3, ATT_PK(l3, h3), od, 0, 0, 0);
#undef ATT_PK
}
__device__ __forceinline__ void pv_d0(f32x16* o, int vb, bf16x8 pa0, bf16x8 pa1, bf16x8 pa2, bf16x8 pa3) {
    pv_one<0>(o[0], vb, pa0, pa1, pa2, pa3); pv_one<1>(o[1], vb, pa0, pa1, pa2, pa3); pv_one<2>(o[2], vb, pa0, pa1, pa2, pa3); pv_one<3>(o[3], vb, pa0, pa1, pa2, pa3);
}
__device__ __forceinline__ void add_bias(f32x16& p0, f32x16& p1, LAS const float* bt2, int dq) {
    LAS const float* p = bt2 + (255 - dq);
#pragma unroll
    for (int r = 0; r < 16; ++r) { const int c = (r & 3) + 8 * (r >> 2); p0[r] += p[c]; p1[r] += p[c + 32]; }
}
}

__device__ __forceinline__ void ph_attn(ArgP a_, LAS unsigned char* ldsb, int wv_) {
    using namespace att;
    TID_LOCAL();
    unsigned char* ws = a->ws;
    const bf16* Qb = (const bf16*)(ws + WS_QB); const bf16* Kb = (const bf16*)(ws + WS_KB); const bf16* Vb = (const bf16*)(ws + WS_VB); const bf16* Gb = (const bf16*)(ws + WS_GB);
    bf16* AOb = (bf16*)(ws + WS_AOB); const unsigned long long* KM = (const unsigned long long*)(ws + WS_KM); const float* rb = (const float*)a->in[I_RB];
    LAS char* lds = (LAS char*)ldsb; LAS char* V_lds = lds; LAS char* K_lds = lds + 2 * SHM_V;
    LAS float* wsf = (LAS float*)(lds + 65536) + wave * 64; LAS float* li_l = wsf; LAS float* al_l = wsf + 32;
    LAS float* btab = (LAS float*)(lds + 65536 + 2048);
    const int r32 = lane & 31, hi = lane >> 5, rh = wave & 3, qs = wave >> 2;
    const int sr = tid >> 4, sc = (tid & 15) * 8, vst0 = v_st(sr, sc), kst0 = ATT_KSWZ(sr, sc * 2);
    const int vb0 = (int)(unsigned)(size_t)V_lds + v_rd_base(lane);
    constexpr int LDK = 512;
    for (int vbk = blockIdx.x; vbk < 256; vbk += gridDim.x) {
        const int b = vbk >> 7, g = (vbk >> 5) & 3, x = vbk & 31, h = g * 4 + rh;
        __syncthreads();
        for (int i = tid; i < 4 * 384; i += NTHR) { const int rr = i / 384, d = 255 - (i % 384), hh = g * 4 + rr; btab[i] = (d >= 0 && d < 113) ? (rb[t5_bucket(d) * NH + hh] - rb[31 * NH + hh]) * LOG2E : 0.f; }
        const bf16* Kh = Kb + (size_t)b * SEQ * LDK + g * HD; const bf16* Vh = Vb + (size_t)b * SEQ * LDK + g * HD;
        for (int half = 0; half < 2; ++half) {
            const int jb = half ? 63 - x : x; const int q0w = jb * 64 + qs * 32; const size_t qrow = (size_t)b * SEQ + q0w + r32;
            const int NT = jb + 1, NTp = (NT + 1) & ~1;
            LAS const float* bt = btab + rh * 384;
            float m_reg = -1e30f, l_reg = 0; f32x16 o[4] = {}; bf16x8 qr[8];
            int lq = lane; asm volatile("" : "+v"(lq));
            const bf16* Qw = Qb + ((size_t)b * SEQ + q0w + (lq & 31)) * 2048 + h * HD + (lq >> 5) * 8;
#pragma unroll
            for (int d0 = 0; d0 < 8; ++d0) qr[d0] = *(const bf16x8*)(Qw + d0 * 16);
            struct { bf16x8 vs0, vs1, ks0, ks1; } sr_[ATT_SDEPTH];
            const unsigned toff = (unsigned)(sr * LDK + sc) * 2u;
#define ATT_SLOAD(i, k0) do { const char* vt_ = (const char*)Vh + (size_t)(k0) * (LDK * 2); const char* kt_ = (const char*)Kh + (size_t)(k0) * (LDK * 2); \
    sr_[i].vs0 = *(const bf16x8*)(vt_ + toff); sr_[i].vs1 = *(const bf16x8*)(vt_ + 32 * LDK * 2 + toff); sr_[i].ks0 = *(const bf16x8*)(kt_ + toff); sr_[i].ks1 = *(const bf16x8*)(kt_ + 32 * LDK * 2 + toff); } while (0)
#define ATT_SWRITE(bb, i) do { *(LAS bf16x8*)(V_lds + (bb) * SHM_V + vst0) = sr_[i].vs0; *(LAS bf16x8*)(V_lds + (bb) * SHM_V + vst0 + 8192) = sr_[i].vs1; \
    *(LAS bf16x8*)(K_lds + (bb) * SHM_K + kst0) = sr_[i].ks0; *(LAS bf16x8*)(K_lds + (bb) * SHM_K + kst0 + 8192) = sr_[i].ks1; } while (0)
#define ATT_SWAIT() do { if (ATT_SDEPTH == 2) asm volatile("s_waitcnt vmcnt(4)" ::: "memory"); else asm volatile("s_waitcnt vmcnt(0)" ::: "memory"); } while (0)
#define ATT_RESC(al) do { if (__any((al) < 1.f)) { if (hi == 0) al_l[r32] = (al); asm volatile("s_waitcnt lgkmcnt(0)" ::: "memory"); \
    _Pragma("unroll") for (int d = 0; d < 4; ++d) _Pragma("unroll") for (int r = 0; r < 16; ++r) o[d][r] *= al_l[crow(r, hi)]; } } while (0)
#define ATT_MASK(kt) (((kt) <= jb) ? ((LAS const unsigned long long*)(lds + 73728))[(qs * 64 + (kt)) * 32 + (lane_id_fresh() & 31)] : 0ull)
#define ATT_BIAS(P0, P1, kt) do { if (64 * (kt) + 176 > q0w) { const int le_ = lane_id_fresh(); add_bias(P0, P1, bt, q0w + (le_ & 31) - 4 * (le_ >> 5) - 64 * (kt)); } } while (0)
            f32x16 pA0, pA1, pB0, pB1; float mnA, mnB, alA, alB; bf16x8 pa0, pa1, pa2, pa3;
            constexpr int SE = 0, SO = ATT_SDEPTH - 1;
            __syncthreads();
            { LAS unsigned long long* mks = (LAS unsigned long long*)(lds + 73728);
              const unsigned long long* kg0 = KM + (((size_t)b * 128 + 2 * jb) * 64) * 32; const int nw = (jb + 1) * 32;
              for (int i = wave * 64 + lane_id_fresh(); i < 2 * nw; i += NTHR) { const int q2 = (i >= nw) ? 1 : 0, j2 = i - q2 * nw; mks[q2 * 2048 + j2] = kg0[(size_t)q2 * 2048 + j2]; } }
            ATT_SLOAD(SE, 0); asm volatile("s_waitcnt vmcnt(0)" ::: "memory"); ATT_SWRITE(0, SE); __syncthreads();
            qkt(pA0, pA1, K_lds, qr, r32, hi); ATT_BIAS(pA0, pA1, 0); partialSM(pA0, pA1, m_reg, mnA, alA);
            ATT_SLOAD(SO, KVBLK); if (ATT_SDEPTH == 2 && 2 < NTp) ATT_SLOAD(SE, 2 * KVBLK);
            ATT_SWAIT(); ATT_SWRITE(1, SO); __syncthreads();
            for (int j = 1; j + 1 < NTp; j += 2) {
                ATT_SBAR(); qkt(pB0, pB1, K_lds + SHM_K, qr, r32, hi); ATT_BIAS(pB0, pB1, j);
                finishSM(pA0, pA1, alA, l_reg, ATT_MASK(j - 1), hi, pa0, pa1, pa2, pa3); ATT_SBAR();
                ATT_SLOAD(SO, (j + ATT_SDEPTH) * KVBLK); ATT_SBAR();
                pv_d0(o, vb0, pa0, pa1, pa2, pa3); partialSM(pB0, pB1, m_reg, mnB, alB);
                __syncthreads(); ATT_SWAIT(); ATT_SWRITE(0, SE);
                ATT_RESC(alB); __syncthreads();
                ATT_SBAR(); qkt(pA0, pA1, K_lds, qr, r32, hi); ATT_BIAS(pA0, pA1, j + 1);
                finishSM(pB0, pB1, alB, l_reg, ATT_MASK(j), hi, pa0, pa1, pa2, pa3); ATT_SBAR();
                if (ATT_SDEPTH == 1 || j + 3 < NTp) ATT_SLOAD(SE, (j + 1 + ATT_SDEPTH) * KVBLK); ATT_SBAR();
                pv_d0(o, vb0 + SHM_V, pa0, pa1, pa2, pa3); partialSM(pA0, pA1, m_reg, mnA, alA);
                __syncthreads(); ATT_SWAIT(); ATT_SWRITE(1, SO);
                ATT_RESC(alA); __syncthreads();
            }
            ATT_SBAR(); qkt(pB0, pB1, K_lds + SHM_K, qr, r32, hi); ATT_BIAS(pB0, pB1, NTp - 1);
            finishSM(pA0, pA1, alA, l_reg, ATT_MASK(NTp - 2), hi, pa0, pa1, pa2, pa3); ATT_SBAR();
            pv_d0(o, vb0, pa0, pa1, pa2, pa3); partialSM(pB0, pB1, m_reg, mnB, alB);
            __syncthreads(); ATT_RESC(alB);
            finishSM(pB0, pB1, alB, l_reg, ATT_MASK(NTp - 1), hi, pa0, pa1, pa2, pa3); ATT_SBAR();
            pv_d0(o, vb0 + SHM_V, pa0, pa1, pa2, pa3);
            if (hi == 0) li_l[r32] = l_reg; asm volatile("s_waitcnt lgkmcnt(0)" ::: "memory");
            int lane_e = lane; asm volatile("" : "+v"(lane_e)); const int r32e = lane_e & 31, hie = lane_e >> 5;
#pragma unroll
            for (int r = 0; r < 16; ++r) { const int orow = crow(r, hie); const float rli = __builtin_amdgcn_rcpf(li_l[orow]);
                const size_t ob = ((size_t)b * SEQ + q0w + orow) * 2048 + h * HD + r32e;
#pragma unroll
                for (int d0 = 0; d0 < 4; ++d0) AOb[ob + d0 * 32] = (bf16)f2bf(o[d0][r] * rli * bf2f(Gb[ob + d0 * 32]));
                asm volatile("" ::: "memory"); ATT_SBAR(); }
#undef ATT_SLOAD
#undef ATT_SWRITE
#undef ATT_SWAIT
#undef ATT_RESC
#undef ATT_MASK
#undef ATT_BIAS
        }
    }
}


__device__ __forceinline__ void ph_idx_sample(ArgP a_, int l, int wv_) {
    TID_LOCAL();
    unsigned char* ws = a->ws;
    const bf16* QIb = (const bf16*)(ws + WS_QIB); const bf16* KIb = (const bf16*)(ws + WS_KIB); const float* WI = (const float*)(ws + WS_WI); float* SCS = (float*)(ws + WS_SCS);
    const int* pt = (const int*)a->in[I_PT]; const float* cki = (const float*)a->in[I_CKI] + (size_t)l * NPOOL * PAGE * IDD;
    const int fr = lane & 15, kg = lane >> 4; constexpr int TPB = PAST / 16 + 1, NT = DBATCH * TPB, TPW = 5;
    for (int c0 = gw * TPW; c0 < NT; c0 += NGW * TPW) {
        int curb = -1; bf16x8v Bq[16][2]; float w[16];
        const int cend = (c0 + TPW < NT) ? c0 + TPW : NT;
        f32x4 x0, x1, y0, y1;
        int pg[TPW];
#pragma unroll
        for (int j = 0; j < TPW; ++j) { const int g_ = c0 + j; const int b_ = g_ / TPB, kt_ = g_ % TPB; pg[j] = (g_ < NT && kt_ < PAST / 16) ? pt[b_ * NPAGES + ((kt_ * 16 + fr) >> 7)] : 0; }
#define IDXS_FETCH(gt_) do { const int kt_ = (gt_) % TPB; if (kt_ < PAST / 16) { const int key_ = kt_ * 16 + fr; const int jj_ = (gt_) - c0; \
            const int pgv_ = (jj_ == 0) ? pg[0] : (jj_ == 1) ? pg[1] : (jj_ == 2) ? pg[2] : (jj_ == 3) ? pg[3] : pg[4]; \
            const float* kp_ = cki + ((size_t)pgv_ * PAGE + (key_ & 127)) * IDD + kg * 8; x0 = *(const f32x4*)kp_; x1 = *(const f32x4*)(kp_ + 4); y0 = *(const f32x4*)(kp_ + 32); y1 = *(const f32x4*)(kp_ + 36); } } while (0)
        IDXS_FETCH(c0);
        for (int gt = c0; gt < cend; ++gt) { const int b = gt / TPB, kt = gt % TPB;
            if (b != curb) { curb = b; const size_t qrow = (size_t)MP + b * DSEQ + (fr < DSEQ ? fr : DSEQ - 1);
#pragma unroll
                for (int h = 0; h < 16; ++h) { Bq[h][0] = *(const bf16x8v*)(QIb + qrow * 1024 + h * 64 + kg * 8); Bq[h][1] = *(const bf16x8v*)(QIb + qrow * 1024 + h * 64 + 32 + kg * 8); w[h] = WI[qrow * 16 + h]; } }
            bf16x8v A0, A1;
            if (kt < PAST / 16) { v4u u0, u1; u0.x = pk2(x0[0], x0[1]); u0.y = pk2(x0[2], x0[3]); u0.z = pk2(x1[0], x1[1]); u0.w = pk2(x1[2], x1[3]); u1.x = pk2(y0[0], y0[1]); u1.y = pk2(y0[2], y0[3]); u1.z = pk2(y1[0], y1[1]); u1.w = pk2(y1[2], y1[3]);
                A0 = __builtin_bit_cast(bf16x8v, u0); A1 = __builtin_bit_cast(bf16x8v, u1); }
            else { const bf16* kp = KIb + ((size_t)MP + b * DSEQ + (fr < DSEQ ? fr : DSEQ - 1)) * 64 + kg * 8; A0 = *(const bf16x8v*)kp; A1 = *(const bf16x8v*)(kp + 32); }
            if (gt + 1 < cend) IDXS_FETCH(gt + 1);
            f32x4 S = {0.f, 0.f, 0.f, 0.f};
#pragma unroll
            for (int h = 0; h < 16; ++h) { f32x4 acc = {0.f, 0.f, 0.f, 0.f};
                acc = __builtin_amdgcn_mfma_f32_16x16x32_bf16(A0, Bq[h][0], acc, 0, 0, 0); acc = __builtin_amdgcn_mfma_f32_16x16x32_bf16(A1, Bq[h][1], acc, 0, 0, 0);
#pragma unroll
                for (int j = 0; j < 4; ++j) S[j] += w[h] * fmaxf(acc[j], 0.f); }
            if (fr < DSEQ) *(f32x4*)(SCS + (size_t)(b * DSEQ + fr) * SCS_LD + kt * 16 + kg * 4) = S;
        }
#undef IDXS_FETCH
    }
}
__device__ __forceinline__ void select_block(const float* sc, int n, LAS unsigned* ldsk, LAS int* ldsw, LAS int* sel, int tid, int lane, int wave) {
    const int nc = (n + 2047) >> 11;
    __syncthreads();
    for (int i = tid; i < nc * 2048; i += NTHR) ldsk[i] = (i < n) ? mono_key(sc[i]) : 0u;
    if (tid == 0) ldsw[32] = 0;
    __syncthreads();
    unsigned T = 0u;
    for (int bit = 31; bit >= 0; --bit) { const unsigned cand = T | (1u << bit); int c = 0;
        for (int ch = 0; ch < nc; ++ch) { const v4u k = *(const LAS v4u*)(ldsk + ch * 2048 + tid * 4); c += (k.x >= cand) + (k.y >= cand) + (k.z >= cand) + (k.w >= cand); }
        c = wave_sum_i(c); LAS int* red = ldsw + (bit & 1) * 8; if (lane == 0) red[wave] = c;
        __syncthreads();
        const int tot = ((red[0] + red[1]) + (red[2] + red[3])) + ((red[4] + red[5]) + (red[6] + red[7]));
        if (tot >= TOPK) { T = cand; if (tot == TOPK) break; } }
    int cg = 0, ce = 0;
    for (int ch = 0; ch < nc; ++ch) { const v4u k = *(const LAS v4u*)(ldsk + ch * 2048 + tid * 4); cg += (k.x > T) + (k.y > T) + (k.z > T) + (k.w > T); ce += (k.x == T) + (k.y == T) + (k.z == T) + (k.w == T); }
    cg = wave_sum_i(cg); ce = wave_sum_i(ce);
    __syncthreads();
    if (lane == 0) { ldsw[16 + wave] = cg; ldsw[24 + wave] = ce; }
    __syncthreads();
    int tg = 0, te = 0;
#pragma unroll
    for (int i = 0; i < 8; ++i) { tg += ldsw[16 + i]; te += ldsw[24 + i]; }
    const int need = TOPK - tg; const bool all_eq = te <= need;
    for (int ch = 0; ch < nc; ++ch) { const v4u k4 = *(const LAS v4u*)(ldsk + ch * 2048 + tid * 4); const unsigned kk[4] = {k4.x, k4.y, k4.z, k4.w};
#pragma unroll
        for (int j = 0; j < 4; ++j) { const int idx = ch * 2048 + tid * 4 + j; const unsigned k = kk[j]; bool s = (idx < n) && k > T;
            if ((idx < n) && k == T) { if (all_eq) s = true; else { int rank = 0; for (int q = 0; q < idx; ++q) rank += (ldsk[q] == T) ? 1 : 0; s = rank < need; } }
            if (s) { const int pos = __hip_atomic_fetch_add(ldsw + 32, 1, __ATOMIC_RELAXED, __HIP_MEMORY_SCOPE_WORKGROUP); if (pos < TOPK) sel[pos] = idx; } } }
    __syncthreads();
}
__device__ __forceinline__ f32x4 ld_kvrow(const float* cache, const bf16* fresh, int off, int c) {
    if (off >= 0) return *(const f32x4*)(cache + (size_t)off + 4 * c);
    const v2u w = *(const v2u*)(fresh + (size_t)(-off - 1) + 4 * c); return (f32x4){bflo(w.x), bfhi(w.x), bflo(w.y), bfhi(w.y)};
}
__device__ __forceinline__ void ph_attn_sample(ArgP a_, int l, LAS unsigned char* ldsb, int wv_) {
    TID_LOCAL();
    unsigned char* ws = a->ws;
    const bf16* Qb = (const bf16*)(ws + WS_QB); const bf16* Kb = (const bf16*)(ws + WS_KB); const bf16* Vb = (const bf16*)(ws + WS_VB); const bf16* Gb = (const bf16*)(ws + WS_GB);
    bf16* AOb = (bf16*)(ws + WS_AOB); const int* pt = (const int*)a->in[I_PT]; const float* rb = (const float*)a->in[I_RB];
    const float* ck = (const float*)a->in[I_CK] + (size_t)l * NPOOL * PAGE * 512; const float* cv = (const float*)a->in[I_CV] + (size_t)l * NPOOL * PAGE * 512;
    LAS unsigned* ldsk = (LAS unsigned*)ldsb;
    LAS int* ldsw = (LAS int*)(ldsb + 81920); LAS int* sidx = (LAS int*)(ldsb + 81920 + 256); LAS int* koff = sidx + TOPK; LAS int* kbk = koff + TOPK;
    LAS float* qh = (LAS float*)ldsb; LAS float* lg = (LAS float*)(ldsb + 2048); LAS float* rs = (LAS float*)(ldsb + 2048 + 4096); LAS float* red = (LAS float*)(ldsb + 8192);
    const int par = lane >> 5, c = lane & 31;
    for (int it = blockIdx.x; it < MS * NKV; it += gridDim.x) {
        const int rr = it >> 2, g = it & 3; const int r = MP + rr, b = rr / DSEQ, t = rr % DSEQ, tpos = PAST + t;
        select_block((const float*)(ws + WS_SCS) + (size_t)rr * SCS_LD, tpos + 1, ldsk, ldsw, sidx, tid, lane, wave);
        if (tid < TOPK) { const int s = sidx[tid]; kbk[tid] = t5_bucket(tpos - s);
            koff[tid] = (s < PAST) ? (int)(((unsigned)pt[b * NPAGES + (s >> 7)] * PAGE + (s & 127)) * 512u + g * HD) : -(1 + (int)(((unsigned)MP + b * DSEQ + (s - PAST)) * 512u + g * HD)); }
        qh[tid] = bf2f(Qb[(size_t)r * 2048 + g * 512 + tid]);
        __syncthreads();
        { f32x4 q4[4];
#pragma unroll
          for (int h = 0; h < 4; ++h) q4[h] = *(LAS const f32x4*)(qh + h * HD + 4 * c);
          f32x4 kv[16];
#pragma unroll
          for (int i = 0; i < 16; ++i) kv[i] = ld_kvrow(ck, Kb, koff[wave * 32 + 2 * i + par], c);
#pragma unroll
          for (int i = 0; i < 16; ++i) { float d[4];
#pragma unroll
              for (int h = 0; h < 4; ++h) d[h] = kv[i][0] * q4[h][0] + kv[i][1] * q4[h][1] + kv[i][2] * q4[h][2] + kv[i][3] * q4[h][3];
#pragma unroll
              for (int o = 1; o < 32; o <<= 1) {
#pragma unroll
                  for (int h = 0; h < 4; ++h) d[h] += __shfl_xor(d[h], o); }
              const int k = wave * 32 + 2 * i + par;
              if (c < 4) { const float dd = (c == 0) ? d[0] : (c == 1) ? d[1] : (c == 2) ? d[2] : d[3]; lg[c * TOPK + k] = dd + rb[kbk[k] * NH + g * KVG + c] * LOG2E; } } }
        __syncthreads();
        if (wave < KVG) { LAS float* row = lg + wave * TOPK; float v[4]; float m = -3.0e38f;
#pragma unroll
            for (int j = 0; j < 4; ++j) { v[j] = row[lane + 64 * j]; m = fmaxf(m, v[j]); }
#pragma unroll
            for (int o = 1; o < 64; o <<= 1) m = fmaxf(m, __shfl_xor(m, o));
            float sm = 0.f;
#pragma unroll
            for (int j = 0; j < 4; ++j) { v[j] = exp2f(v[j] - m); sm += v[j]; row[lane + 64 * j] = v[j]; }
            sm = wave_sum(sm); if (lane == 0) rs[wave] = 1.0f / sm; }
        __syncthreads();
        { f32x4 vv[16];
#pragma unroll
          for (int i = 0; i < 16; ++i) vv[i] = ld_kvrow(cv, Vb, koff[wave * 32 + 2 * i + par], c);
          f32x4 o4[4] = {{0.f, 0.f, 0.f, 0.f}, {0.f, 0.f, 0.f, 0.f}, {0.f, 0.f, 0.f, 0.f}, {0.f, 0.f, 0.f, 0.f}};
#pragma unroll
          for (int i = 0; i < 16; ++i) { const int k = wave * 32 + 2 * i + par;
#pragma unroll
              for (int h = 0; h < 4; ++h) o4[h] += vv[i] * lg[h * TOPK + k]; }
#pragma unroll
          for (int h = 0; h < 4; ++h) *(LAS f32x4*)(red + ((wave * 2 + par) * 4 + h) * HD + 4 * c) = o4[h]; }
        __syncthreads();
        { float o = 0.f;
#pragma unroll
          for (int p = 0; p < 16; ++p) o += red[p * 4 * HD + tid];
          const size_t oi = (size_t)r * 2048 + g * 512 + tid;
          AOb[oi] = (bf16)f2bf(o * rs[tid >> 7] * bf2f(Gb[oi])); }
        __syncthreads();
    }
}

__device__ __forceinline__ void ph_epi_resid(ArgP a_, int wv_) {
    TID_LOCAL(); GTID_LOCAL();
    unsigned char* ws = a->ws; const float* C = (const float*)(ws + WS_C); float* H = (float*)(ws + WS_H); bf16* Hb = (bf16*)(ws + WS_HBB);
    for (size_t e = gtid; e < (size_t)MR * (DM / 4); e += GT) { const size_t o = e * 4; const f32x4 v = *(const f32x4*)(H + o) + *(const f32x4*)(C + o);
        *(f32x4*)(H + o) = v; v2u w; w.x = pk2(v[0], v[1]); w.y = pk2(v[2], v[3]); *(v2u*)(Hb + o) = w; }
}
__device__ __forceinline__ void ph_epi_ple(ArgP a_, int wv_) {
    TID_LOCAL(); GTID_LOCAL();
    unsigned char* ws = a->ws; const float* C = (const float*)(ws + WS_C); const float* C2 = (const float*)(ws + WS_C2); const float* rstd = (const float*)(ws + WS_RSTD);
    float* H = (float*)(ws + WS_H); bf16* Hb = (bf16*)(ws + WS_HBA);
    for (size_t e = gtid; e < (size_t)MR * (DM / 4); e += GT) { const size_t o = e * 4; const int r = (int)(e / (DM / 4)); const float rs = rstd[r];
        const f32x4 c = *(const f32x4*)(C + o), p = *(const f32x4*)(C2 + o); f32x4 v = *(const f32x4*)(H + o);
#pragma unroll
        for (int j = 0; j < 4; ++j) v[j] += sigmoidf_(c[j] * rs) * p[j];
        *(f32x4*)(H + o) = v; v2u w; w.x = pk2(v[0], v[1]); w.y = pk2(v[2], v[3]); *(v2u*)(Hb + o) = w; }
}
__device__ __forceinline__ void ph_epi_ssm_in(ArgP a_, int wv_) {
    TID_LOCAL(); GTID_LOCAL();
    unsigned char* ws = a->ws; const float* C = (const float*)(ws + WS_C); const float* rstd = (const float*)(ws + WS_RSTD);
    for (size_t e = gtid; e < (size_t)MR * 1024; e += GT) { const int r = (int)(e / 1024), c = (int)(e % 1024) * 4;
        f32x4 v = *(const f32x4*)(C + (size_t)r * 4096 + c); v = v * rstd[r];
        if (c < 2048) { v2u o; o.x = pk2(v[0], v[1]); o.y = pk2(v[2], v[3]);
            if (r < MP) { const int b = r / SEQ, t = r % SEQ, g = c / 16, j = c % 16; *(v2u*)((bf16*)(ws + WS_UG) + (((size_t)(b * NGRP + g) * SEQ + t) * 16 + j)) = o; }
            else *(v2u*)((bf16*)(ws + WS_US) + (size_t)(r - MP) * 2048 + c) = o; }
        else { v2u o; o.x = pk2(siluf_(v[0]), siluf_(v[1])); o.y = pk2(siluf_(v[2]), siluf_(v[3])); *(v2u*)((bf16*)(ws + WS_GB) + (size_t)r * 2048 + (c - 2048)) = o; }
    }
}
__device__ __forceinline__ void scan_item(ArgP a, int l, bool pr, int item, int lane) {
    unsigned char* ws = a->ws;
    const int b = item / NGRP, g = item % NGRP, n = lane;
    const size_t gn = ((size_t)l * NGRP + g) * SST + n;
    const float lre = fminf(((const float*)a->in[I_LRE])[gn], -1e-4f), lim = ((const float*)a->in[I_LIM])[gn];
    const float dt = expf(((const float*)a->in[I_LDT])[l * NGRP + g]);
    const float mag = expf(lre * dt), ang = lim * dt; const float are = mag * cosf(ang), aim = mag * sinf(ang);
    const float den = lre * lre + lim * lim; const float cre = ((are - 1.0f) * lre + aim * lim) / den, cim = (aim * lre - (are - 1.0f) * lim) / den;
    float bbr[16], bbi[16], ccr[16], cci[16];
#pragma unroll
    for (int j = 0; j < 16; ++j) { const float br = ((const float*)a->in[I_BRE])[gn * 16 + j], bi = ((const float*)a->in[I_BIM])[gn * 16 + j];
        bbr[j] = cre * br - cim * bi; bbi[j] = cre * bi + cim * br;
        const size_t ci = (((size_t)l * NGRP + g) * 16 + j) * SST + n; ccr[j] = ((const float*)a->in[I_CRE])[ci]; cci[j] = ((const float*)a->in[I_CIM])[ci]; }
    const float dj = ((const float*)a->in[I_SD])[(size_t)l * DM + g * 16 + (lane & 15)];
    float xr = 0.f, xi = 0.f;
    if (!pr) { const size_t si = (((size_t)l * DBATCH + b) * NGRP + g) * SST + n; xr = ((const float*)a->in[I_SRE])[si]; xi = ((const float*)a->in[I_SIM])[si]; }
    const int T = pr ? SEQ : DSEQ;
    const bf16* up = pr ? (const bf16*)(ws + WS_UG) + (size_t)(b * NGRP + g) * SEQ * 16 : (const bf16*)(ws + WS_US) + (size_t)(b * DSEQ) * 2048 + g * 16;
    const int ustride = pr ? 16 : 2048;
    bf16* Yb = (bf16*)(ws + WS_YB);
    for (int t = 0; t < T; ++t) {
        const v4u u0 = *(const v4u*)(up + (size_t)t * ustride), u1 = *(const v4u*)(up + (size_t)t * ustride + 8);
        const float u[16] = {bflo(u0.x), bfhi(u0.x), bflo(u0.y), bfhi(u0.y), bflo(u0.z), bfhi(u0.z), bflo(u0.w), bfhi(u0.w), bflo(u1.x), bfhi(u1.x), bflo(u1.y), bfhi(u1.y), bflo(u1.z), bfhi(u1.z), bflo(u1.w), bfhi(u1.w)};
        float br = 0.f, bi = 0.f;
#pragma unroll
        for (int j = 0; j < 16; ++j) { br += bbr[j] * u[j]; bi += bbi[j] * u[j]; }
        const float nr = are * xr - aim * xi + br, ni = are * xi + aim * xr + bi; xr = nr; xi = ni;
        float yj = 0.f, uj = 0.f;
#pragma unroll
        for (int j = 0; j < 16; ++j) { const float s = wave_sum(ccr[j] * xr - cci[j] * xi); if ((lane & 15) == j) { yj = s; uj = u[j]; } }
        if (lane < 16) { const float y = yj + dj * uj; const int row = pr ? b * SEQ + t : MP + b * DSEQ + t; Yb[(size_t)row * 2048 + g * 16 + lane] = (bf16)f2bf(gelu_tanh(y)); }
    }
    float* osr = a->out + (pr ? O_SRP + (((size_t)l * NBATCH + b) * NGRP + g) * SST : O_SRS + (((size_t)l * DBATCH + b) * NGRP + g) * SST);
    float* osi = a->out + (pr ? O_SIP + (((size_t)l * NBATCH + b) * NGRP + g) * SST : O_SIS + (((size_t)l * DBATCH + b) * NGRP + g) * SST);
    osr[n] = xr; osi[n] = xi;
}
__device__ __forceinline__ void ph_scan_naive(ArgP a_, int l, int wv_) {
    TID_LOCAL();
    for (int vb = blockIdx.x; vb < 256; vb += gridDim.x) {
        if (wave == 0) scan_item(a, l, true, vb, lane);
        else { const int item = vb * 7 + (wave - 1); if (item < DBATCH * NGRP) scan_item(a, l, false, item, lane); }
    }
}

namespace s5 {
using bf16x8 = __attribute__((ext_vector_type(8))) short;
using s16x4  = __attribute__((ext_vector_type(4))) short;
using f32x16 = __attribute__((ext_vector_type(16))) float;
constexpr int XSTR = 80;
constexpr int XT_BYTES = 128 * XSTR;
constexpr int E_OFF = 8 * XT_BYTES, H_OFF = E_OFF + 16 * 64 * 8;
__device__ __forceinline__ s16x4 tr_read(int addr) { s16x4 r; asm volatile("ds_read_b64_tr_b16 %0, %1" : "=&v"(r) : "v"(addr) : "memory"); return r; }
}
__device__ __forceinline__ void ph_scan(ArgP a_, int l, LAS unsigned char* ldsb, int wv_) {
    using namespace s5;
    TID_LOCAL();
    unsigned char* ws = a->ws;
    LAS char* lds = (LAS char*)ldsb;
    bf16* Yb = (bf16*)(ws + WS_YB);
    const int n0 = lane & 31, h2 = lane >> 5, fj = lane & 15, kg = lane >> 4;
    for (int vb = blockIdx.x; vb < NBATCH * NGRP; vb += gridDim.x) {
        const int b = vb >> 7, g = vb & 127;
        const size_t gbase = (size_t)l * NGRP + g;
        float ar[2], ai[2]; bf16x8 Bfr[2][2];
        const float dt = expf(((const float*)a->in[I_LDT])[gbase]);
#pragma unroll
        for (int nt = 0; nt < 2; ++nt) { const size_t gn = gbase * SST + n0 + 32 * nt;
            const float lre = fminf(((const float*)a->in[I_LRE])[gn], -1e-4f), lim = ((const float*)a->in[I_LIM])[gn];
            const float mag = expf(lre * dt), ang = lim * dt; const float are = mag * cosf(ang), aim = mag * sinf(ang);
            const float den = lre * lre + lim * lim; const float cre = ((are - 1.0f) * lre + aim * lim) / den, cim = (aim * lre - (are - 1.0f) * lim) / den;
            ar[nt] = are; ai[nt] = aim;
            const f32x4 br0 = *(const f32x4*)((const float*)a->in[I_BRE] + gn * 16 + 8 * h2), br1 = *(const f32x4*)((const float*)a->in[I_BRE] + gn * 16 + 8 * h2 + 4);
            const f32x4 bi0 = *(const f32x4*)((const float*)a->in[I_BIM] + gn * 16 + 8 * h2), bi1 = *(const f32x4*)((const float*)a->in[I_BIM] + gn * 16 + 8 * h2 + 4);
            v4u wr_, wi_;
            wr_.x = pk2(cre * br0[0] - cim * bi0[0], cre * br0[1] - cim * bi0[1]); wr_.y = pk2(cre * br0[2] - cim * bi0[2], cre * br0[3] - cim * bi0[3]);
            wr_.z = pk2(cre * br1[0] - cim * bi1[0], cre * br1[1] - cim * bi1[1]); wr_.w = pk2(cre * br1[2] - cim * bi1[2], cre * br1[3] - cim * bi1[3]);
            wi_.x = pk2(cre * bi0[0] + cim * br0[0], cre * bi0[1] + cim * br0[1]); wi_.y = pk2(cre * bi0[2] + cim * br0[2], cre * bi0[3] + cim * br0[3]);
            wi_.z = pk2(cre * bi1[0] + cim * br1[0], cre * bi1[1] + cim * br1[1]); wi_.w = pk2(cre * bi1[2] + cim * br1[2], cre * bi1[3] + cim * br1[3]);
            Bfr[nt][0] = __builtin_bit_cast(bf16x8, wr_); Bfr[nt][1] = __builtin_bit_cast(bf16x8, wi_); }
        bf16x8 Cf[4];
#pragma unroll
        for (int ks = 0; ks < 4; ++ks) { const float* srcp = (const float*)a->in[(ks >> 1) ? I_CIM : I_CRE] + (gbase * 16 + fj) * SST + (ks & 1) * 32 + kg * 8; const float sg = (ks >> 1) ? -1.0f : 1.0f;
            const f32x4 c0 = *(const f32x4*)srcp, c1 = *(const f32x4*)(srcp + 4);
            v4u w; w.x = pk2(sg * c0[0], sg * c0[1]); w.y = pk2(sg * c0[2], sg * c0[3]); w.z = pk2(sg * c1[0], sg * c1[1]); w.w = pk2(sg * c1[2], sg * c1[3]); Cf[ks] = __builtin_bit_cast(bf16x8, w); }
        const f32x4 dv = *(const f32x4*)((const float*)a->in[I_SD] + (size_t)l * DM + g * 16 + 4 * kg);
        const bf16* up = (const bf16*)(ws + WS_UG) + (size_t)(b * NGRP + g) * SEQ * 16;
        const int a_time0 = 256 * (2 * wave + ((n0 >> 2) & 1)) + (n0 & 3) + 4 * (n0 >> 3);
        const bf16* ap = up + (size_t)a_time0 * 16 + 8 * h2;
        LAS float* E = (LAS float*)(lds + E_OFF); LAS float* Hs = (LAS float*)(lds + H_OFF);
        const int seg = 2 * wave + h2;
        { float xr[2] = {0.f, 0.f}, xi[2] = {0.f, 0.f};
          bf16x8 An = *(const bf16x8*)ap;
          for (int tile = 0; tile < 16; ++tile) { const bf16x8 A = An; if (tile < 15) An = *(const bf16x8*)(ap + (size_t)(tile + 1) * 256);
#pragma unroll
              for (int nt = 0; nt < 2; ++nt) { f32x16 cr = {}, ci = {};
                  cr = __builtin_amdgcn_mfma_f32_32x32x16_bf16(A, Bfr[nt][0], cr, 0, 0, 0); ci = __builtin_amdgcn_mfma_f32_32x32x16_bf16(A, Bfr[nt][1], ci, 0, 0, 0);
#pragma unroll
                  for (int i = 0; i < 16; ++i) { const float nr = ar[nt] * xr[nt] - ai[nt] * xi[nt] + cr[i], ni = ar[nt] * xi[nt] + ai[nt] * xr[nt] + ci[i]; xr[nt] = nr; xi[nt] = ni; } } }
#pragma unroll
          for (int nt = 0; nt < 2; ++nt) { E[(seg * 64 + n0 + 32 * nt) * 2] = xr[nt]; E[(seg * 64 + n0 + 32 * nt) * 2 + 1] = xi[nt]; } }
        __syncthreads();
        if (wave == 0) { const size_t gn = gbase * SST + lane;
            const float lre = fminf(((const float*)a->in[I_LRE])[gn], -1e-4f), lim = ((const float*)a->in[I_LIM])[gn];
            const float mag = expf(lre * dt), ang = lim * dt; float pr_ = mag * cosf(ang), pi_ = mag * sinf(ang);
#pragma unroll
            for (int q = 0; q < 8; ++q) { const float t0 = pr_ * pr_ - pi_ * pi_, t1 = 2.0f * pr_ * pi_; pr_ = t0; pi_ = t1; }
            float hr = 0.f, hi_ = 0.f; Hs[lane * 2] = 0.f; Hs[lane * 2 + 1] = 0.f;
            for (int s = 0; s < 16; ++s) { const float er = E[(s * 64 + lane) * 2], ei = E[(s * 64 + lane) * 2 + 1];
                const float nr = pr_ * hr - pi_ * hi_ + er, ni = pr_ * hi_ + pi_ * hr + ei; hr = nr; hi_ = ni; Hs[((s + 1) * 64 + lane) * 2] = hr; Hs[((s + 1) * 64 + lane) * 2 + 1] = hi_; }
            a->out[O_SRP + (((size_t)l * NBATCH + b) * NGRP + g) * SST + lane] = hr; a->out[O_SIP + (((size_t)l * NBATCH + b) * NGRP + g) * SST + lane] = hi_; }
        __syncthreads();
        { float xr[2], xi[2];
#pragma unroll
          for (int nt = 0; nt < 2; ++nt) { xr[nt] = Hs[(seg * 64 + n0 + 32 * nt) * 2]; xi[nt] = Hs[(seg * 64 + n0 + 32 * nt) * 2 + 1]; }
          LAS char* Xt = lds + wave * XT_BYTES; const int xt_addr = (int)(unsigned)(size_t)Xt;
          bf16x8 An = *(const bf16x8*)ap;
          for (int tile = 0; tile < 16; ++tile) { const bf16x8 A = An; if (tile < 15) An = *(const bf16x8*)(ap + (size_t)(tile + 1) * 256);
#pragma unroll
              for (int nt = 0; nt < 2; ++nt) { f32x16 cr = {}, ci = {};
                  cr = __builtin_amdgcn_mfma_f32_32x32x16_bf16(A, Bfr[nt][0], cr, 0, 0, 0); ci = __builtin_amdgcn_mfma_f32_32x32x16_bf16(A, Bfr[nt][1], ci, 0, 0, 0);
                  unsigned pr[8], pi[8];
#pragma unroll
                  for (int i = 0; i < 16; i += 2) { float r0, i0, r1, i1;
                      r0 = ar[nt] * xr[nt] - ai[nt] * xi[nt] + cr[i]; i0 = ar[nt] * xi[nt] + ai[nt] * xr[nt] + ci[i];
                      r1 = ar[nt] * r0 - ai[nt] * i0 + cr[i + 1]; i1 = ar[nt] * i0 + ai[nt] * r0 + ci[i + 1]; xr[nt] = r1; xi[nt] = i1;
                      pr[i >> 1] = pk2(r0, r1); pi[i >> 1] = pk2(i0, i1); }
                  LAS char* rowr = Xt + (nt * 32 + n0) * XSTR + h2 * 32; LAS char* rowi = rowr + 64 * XSTR;
                  *(LAS v4u*)rowr = (v4u){pr[0], pr[1], pr[2], pr[3]}; *(LAS v4u*)(rowr + 16) = (v4u){pr[4], pr[5], pr[6], pr[7]};
                  *(LAS v4u*)rowi = (v4u){pi[0], pi[1], pi[2], pi[3]}; *(LAS v4u*)(rowi + 16) = (v4u){pi[4], pi[5], pi[6], pi[7]}; }
              asm volatile("s_waitcnt lgkmcnt(0)" ::: "memory");
#pragma unroll
              for (int tt = 0; tt < 2; ++tt) { f32x4 acc = {0.f, 0.f, 0.f, 0.f};
                  s16x4 lo[4], hi4[4];
#pragma unroll
                  for (int ks = 0; ks < 4; ++ks) { const int rowk = 32 * ks + 8 * kg + (fj >> 2); const int ad = xt_addr + rowk * XSTR + (16 * tt + 4 * (fj & 3)) * 2;
                      lo[ks] = tr_read(ad); hi4[ks] = tr_read(ad + 4 * XSTR); }
                  asm volatile("s_waitcnt lgkmcnt(0)" ::: "memory"); __builtin_amdgcn_sched_barrier(0);
#pragma unroll
                  for (int ks = 0; ks < 4; ++ks) { const bf16x8 Bx = (bf16x8){lo[ks][0], lo[ks][1], lo[ks][2], lo[ks][3], hi4[ks][0], hi4[ks][1], hi4[ks][2], hi4[ks][3]};
                      acc = __builtin_amdgcn_mfma_f32_16x16x32_bf16(Cf[ks], Bx, acc, 0, 0, 0); }
                  const int time = 256 * (2 * wave + tt) + 16 * tile + fj;
                  const v2u uw = *(const v2u*)(up + (size_t)time * 16 + 4 * kg);
                  const float y0 = acc[0] + dv[0] * bflo(uw.x), y1 = acc[1] + dv[1] * bfhi(uw.x), y2 = acc[2] + dv[2] * bflo(uw.y), y3 = acc[3] + dv[3] * bfhi(uw.y);
                  v2u o; o.x = pk2(gelu_tanh(y0), gelu_tanh(y1)); o.y = pk2(gelu_tanh(y2), gelu_tanh(y3));
                  *(v2u*)(Yb + ((size_t)b * SEQ + time) * 2048 + g * 16 + 4 * kg) = o; }
          } }
        __syncthreads();
    }
    for (int it = gw; it < DBATCH * NGRP; it += NGW) scan_item(a, l, false, it, lane);
}

__device__ __forceinline__ void ph_epi_glu(ArgP a_, int l, int wv_) {
    TID_LOCAL(); GTID_LOCAL();
    unsigned char* ws = a->ws; const float* C = (const float*)(ws + WS_C); const float* bg = (const float*)a->in[I_BGLU] + (size_t)l * DM;
    const bf16* Yb = (const bf16*)(ws + WS_YB); const bf16* Gb = (const bf16*)(ws + WS_GB); bf16* AOb = (bf16*)(ws + WS_AOB);
    for (size_t e = gtid; e < (size_t)MR * (DM / 4); e += GT) { const size_t o = e * 4; const int c = (int)(o % DM);
        const f32x4 cv = *(const f32x4*)(C + o), bv = *(const f32x4*)(bg + c); const v2u yw = *(const v2u*)(Yb + o), gw2 = *(const v2u*)(Gb + o);
        const float y[4] = {bflo(yw.x), bfhi(yw.x), bflo(yw.y), bfhi(yw.y)}, gg[4] = {bflo(gw2.x), bfhi(gw2.x), bflo(gw2.y), bfhi(gw2.y)};
        float r[4];
#pragma unroll
        for (int j = 0; j < 4; ++j) r[j] = y[j] * sigmoidf_(cv[j] + bv[j]) * gg[j];
        v2u w; w.x = pk2(r[0], r[1]); w.y = pk2(r[2], r[3]); *(v2u*)(AOb + o) = w; }
}
__device__ __forceinline__ void ph_final(ArgP a_, int wv_) {
    TID_LOCAL();
    unsigned char* ws = a->ws; const bf16* Hb = (const bf16*)(ws + WS_HBA); const float* ssq = ss_buf(ws, 8); const float* fw = (const float*)a->in[I_FNW];
    for (int r = gw; r < MR; r += NGW) {
        float s;
        if (r < MP) s = (lane < 32) ? ssq[(size_t)r * 32 + lane] : 0.f;
        else s = ssq[(size_t)MPAD * 32 + (size_t)(r - MP) * 128 + lane] + ssq[(size_t)MPAD * 32 + (size_t)(r - MP) * 128 + 64 + lane];
        const float rs = ss2rstd(wave_sum(s));
        float* out = a->out + (r < MP ? O_YP + (size_t)r * DM : O_YS + (size_t)(r - MP) * DM);
#pragma unroll
        for (int j = 0; j < 8; ++j) { const int c = (j * 64 + lane) * 4; const v2u hw = *(const v2u*)(Hb + (size_t)r * DM + c);
            *(f32x4*)(out + c) = (f32x4){bflo(hw.x), bfhi(hw.x), bflo(hw.y), bfhi(hw.y)} * rs * *(const f32x4*)(fw + c); } }
}

constexpr size_t WS_PRJ = WS_C;
constexpr size_t PRJ_STRIDE = (size_t)MPAD * DM * 2;
constexpr size_t WS_SSP = WS_C2;
constexpr size_t SSP_STRIDE = (size_t)MPAD * 32 + (size_t)MS * 128;
__device__ __forceinline__ float* ss_buf(unsigned char* ws, int k) { return (float*)(ws + WS_SSP) + (size_t)k * SSP_STRIDE; }
__device__ __forceinline__ float ss2rstd(float ss) { return 1.0f / sqrtf(ss * (1.0f / DM) + RMS_EPS); }
struct AuxNone {};
__device__ __forceinline__ float ss_row_part(const float* ssp, int r, int q) {
    const f32x4* p = (const f32x4*)(ssp + (size_t)r * 32 + 8 * q); const f32x4 s = p[0] + p[1]; return (s[0] + s[1]) + (s[2] + s[3]); }
__device__ __forceinline__ float ss_srow_part(const float* ssp, int r, int q) {
    const f32x4* p = (const f32x4*)(ssp + (size_t)MPAD * 32 + (size_t)(r - MP) * 128 + 32 * q); f32x4 s = p[0];
#pragma unroll
    for (int i = 1; i < 8; ++i) s += p[i];
    return (s[0] + s[1]) + (s[2] + s[3]); }
__device__ __forceinline__ float ss_row_rstd(const float* ssp, int r) {
    if (r < MP) { const f32x4* p = (const f32x4*)(ssp + (size_t)r * 32); f32x4 s = p[0];
#pragma unroll
        for (int i = 1; i < 8; ++i) s += p[i];
        return ss2rstd((s[0] + s[1]) + (s[2] + s[3])); }
    const f32x4* p = (const f32x4*)(ssp + (size_t)MPAD * 32 + (size_t)(r - MP) * 128); f32x4 s = p[0];
    for (int i = 1; i < 32; ++i) s += p[i];
    return ss2rstd((s[0] + s[1]) + (s[2] + s[3])); }
__device__ __forceinline__ v2u pk4(const f32x4 v) { v2u o; o.x = pk2(v[0], v[1]); o.y = pk2(v[2], v[3]); return o; }
struct FAttnIn { unsigned char* ws; float* out; const float* ssin; int l; static constexpr bool SUMSQ = false, RSTD = true; float* ssout; typedef AuxNone Aux;
    __device__ __forceinline__ void prefetch(int, int, Aux&) const {}
    __device__ __forceinline__ float store4(int r, int c, f32x4 v, float rs, const Aux&) const {
        if (c >= ACOLS) return 0.f;
        v = v * rs;
        if (c < C_K) { v = v * QSCALE; *(v2u*)((bf16*)(ws + WS_QB) + (size_t)r * 2048 + c) = pk4(v); }
        else if (c < C_G) { const bool isv = c >= C_V; const int cc = c - (isv ? C_V : C_K);
            float* o32 = out + (r < MP ? (isv ? O_VP : O_KP) + ((size_t)l * MP + r) * 512 : (isv ? O_VS : O_KS) + ((size_t)l * MS + (r - MP)) * 512) + cc;
            *(f32x4*)o32 = v; *(v2u*)((bf16*)(ws + (isv ? WS_VB : WS_KB)) + (size_t)r * 512 + cc) = pk4(v); }
        else if (c < C_QI) { v2u o; o.x = pk2(siluf_(v[0]), siluf_(v[1])); o.y = pk2(siluf_(v[2]), siluf_(v[3])); *(v2u*)((bf16*)(ws + WS_GB) + (size_t)r * 2048 + (c - C_G)) = o; }
        else if (c < C_KI) { *(v2u*)((bf16*)(ws + WS_QIB) + (size_t)r * 1024 + (c - C_QI)) = pk4(v); }
        else if (c < C_WI) { const int cc = c - C_KI; float* o32 = out + (r < MP ? O_KIP + ((size_t)l * MP + r) * 64 : O_KIS + ((size_t)l * MS + (r - MP)) * 64) + cc;
            *(f32x4*)o32 = v; *(v2u*)((bf16*)(ws + WS_KIB) + (size_t)r * 64 + cc) = pk4(v); }
        else { *(f32x4*)((float*)(ws + WS_WI) + (size_t)r * 16 + (c - C_WI)) = v * WISCALE; }
        return 0.f; } };
struct FResid { unsigned char* ws; float* ssout; const float* ssin; static constexpr bool SUMSQ = true, RSTD = false;
    struct Aux { v2u h; };
    __device__ __forceinline__ void prefetch(int r, int c, Aux& x) const { x.h = *(const v2u*)((const bf16*)(ws + WS_HBA) + (size_t)r * DM + c); }
    __device__ __forceinline__ float store4(int r, int c, f32x4 v, float, const Aux& x) const { const size_t o = (size_t)r * DM + c; const f32x4 h = (f32x4){bflo(x.h.x), bfhi(x.h.x), bflo(x.h.y), bfhi(x.h.y)} + v;
        *(v2u*)((bf16*)(ws + WS_HBB) + o) = pk4(h); return h[0] * h[0] + h[1] * h[1] + h[2] * h[2] + h[3] * h[3]; } };
struct FPleProj { unsigned char* ws; float* ssout; const float* ssin; bf16* prj; static constexpr bool SUMSQ = false, RSTD = false; typedef AuxNone Aux;
    __device__ __forceinline__ void prefetch(int, int, Aux&) const {}
    __device__ __forceinline__ float store4(int r, int c, f32x4 v, float, const Aux&) const { *(v2u*)(prj + (size_t)r * DM + c) = pk4(v); return 0.f; } };
struct FPle { unsigned char* ws; const float* ssin; float* ssout; const bf16* prj; static constexpr bool SUMSQ = true, RSTD = true;
    struct Aux { v2u h; v2u p; };
    __device__ __forceinline__ void prefetch(int r, int c, Aux& x) const { const size_t o = (size_t)r * DM + c; x.h = *(const v2u*)((const bf16*)(ws + WS_HBB) + o); x.p = *(const v2u*)(prj + o); }
    __device__ __forceinline__ float store4(int r, int c, f32x4 v, float rs, const Aux& x) const { const size_t o = (size_t)r * DM + c; f32x4 h = (f32x4){bflo(x.h.x), bfhi(x.h.x), bflo(x.h.y), bfhi(x.h.y)};
        const v2u pw = x.p; const float p[4] = {bflo(pw.x), bfhi(pw.x), bflo(pw.y), bfhi(pw.y)};
#pragma unroll
        for (int j = 0; j < 4; ++j) h[j] += sigmoidf_(v[j] * rs) * p[j];
        *(v2u*)((bf16*)(ws + WS_HBA) + o) = pk4(h); return h[0] * h[0] + h[1] * h[1] + h[2] * h[2] + h[3] * h[3]; } };
struct FSsmIn { unsigned char* ws; const float* ssin; float* ssout; static constexpr bool SUMSQ = false, RSTD = true; typedef AuxNone Aux;
    __device__ __forceinline__ void prefetch(int, int, Aux&) const {}
    __device__ __forceinline__ float store4(int r, int c, f32x4 v, float rs, const Aux&) const { v = v * rs;
        if (c < 2048) { if (r < MP) { const int b = r / SEQ, t = r % SEQ, g = c / 16, j = c % 16; *(v2u*)((bf16*)(ws + WS_UG) + (((size_t)(b * NGRP + g) * SEQ + t) * 16 + j)) = pk4(v); }
                        else *(v2u*)((bf16*)(ws + WS_US) + (size_t)(r - MP) * 2048 + c) = pk4(v); }
        else { v2u o; o.x = pk2(siluf_(v[0]), siluf_(v[1])); o.y = pk2(siluf_(v[2]), siluf_(v[3])); *(v2u*)((bf16*)(ws + WS_GB) + (size_t)r * 2048 + (c - 2048)) = o; }
        return 0.f; } };
struct FGlu { unsigned char* ws; const float* bg; float* ssout; const float* ssin; static constexpr bool SUMSQ = false, RSTD = false;
    struct Aux { f32x4 bv; v2u y, g; };
    __device__ __forceinline__ void prefetch(int r, int c, Aux& x) const { const size_t o = (size_t)r * DM + c; x.bv = *(const f32x4*)(bg + c); x.y = *(const v2u*)((const bf16*)(ws + WS_YB) + o); x.g = *(const v2u*)((const bf16*)(ws + WS_GB) + o); }
    __device__ __forceinline__ float store4(int r, int c, f32x4 v, float, const Aux& x) const { const size_t o = (size_t)r * DM + c; const f32x4 bv = x.bv;
        const v2u yw = x.y, gw2 = x.g;
        const float y[4] = {bflo(yw.x), bfhi(yw.x), bflo(yw.y), bfhi(yw.y)}, gg[4] = {bflo(gw2.x), bfhi(gw2.x), bflo(gw2.y), bfhi(gw2.y)}; f32x4 rr;
#pragma unroll
        for (int j = 0; j < 4; ++j) rr[j] = y[j] * sigmoidf_(v[j] + bv[j]) * gg[j];
        *(v2u*)((bf16*)(ws + WS_AOB) + o) = pk4(rr); return 0.f; } };
template <class F> struct EpiFused { F f;
    __device__ __forceinline__ void operator()(const f32x4 (&acc)[2][2][4][2], const pg8::Unit& u, int wr, int wc, int fr, int fq) const {
        const int row0 = u.pm * 256 + wr * 64 + fr, col0 = u.pn * 256 + wc * 32 + 4 * fq;
#pragma unroll
        for (int ai = 0; ai < 2; ++ai) {
            float rs[4];
            if (F::RSTD) {
#pragma unroll
                for (int m = 0; m < 4; ++m) rs[m] = ss_row_part(f.ssin, row0 + ai * 128 + m * 16, fq);
#pragma unroll
                for (int m = 0; m < 4; ++m) { float s = rs[m]; s += __shfl_xor(s, 16); s += __shfl_xor(s, 32); rs[m] = ss2rstd(s); } }
            else {
#pragma unroll
                for (int m = 0; m < 4; ++m) rs[m] = 0.f; }
            constexpr int RB = (sizeof(typename F::Aux) <= 24) ? 2 : 1;
#pragma unroll
            for (int m0 = 0; m0 < 4; m0 += RB) {
                typename F::Aux cur[RB][4];
#pragma unroll
                for (int j = 0; j < RB; ++j)
#pragma unroll
                    for (int g = 0; g < 4; ++g) f.prefetch(row0 + ai * 128 + (m0 + j) * 16, col0 + (g >> 1) * 128 + (g & 1) * 16, cur[j][g]);
#pragma unroll
                for (int j = 0; j < RB; ++j) { const int m = m0 + j; const int row = row0 + ai * 128 + m * 16; float ss = 0.f;
#pragma unroll
                    for (int g = 0; g < 4; ++g) ss += f.store4(row, col0 + (g >> 1) * 128 + (g & 1) * 16, acc[ai][g >> 1][m][g & 1], rs[m], cur[j][g]);
                    if (F::SUMSQ) { ss += __shfl_xor(ss, 16); ss += __shfl_xor(ss, 32); if (fq == 0) f.ssout[(size_t)row * 32 + u.pn * 4 + wc] = ss; } } } }
    } };
template <int NC, class F>
__device__ __forceinline__ void thin_tile(LAS unsigned char* lds, const bf16* A, const bf16* Bt, int K, int grow0, int gcol0, const F& f, int tid, int lane, int wave) {
    constexpr int NTL = NC / 16, RS = NC + 4, RT = NC / 4;
    const int fr = lane & 15, kg = lane >> 4; const int kw = K >> 3;
    f32x4 acc[2][NTL];
#pragma unroll
    for (int i = 0; i < 2; ++i)
#pragma unroll
        for (int j = 0; j < NTL; ++j) acc[i][j] = (f32x4){0.f, 0.f, 0.f, 0.f};
    const bf16* ap = A + (size_t)fr * K + wave * kw + kg * 8; const bf16* bp = Bt + (size_t)fr * K + wave * kw + kg * 8;
    for (int ks0 = 0; ks0 < kw / 32; ks0 += 2) {
        bf16x8v a0[2], a1[2], bw[2][NTL];
#pragma unroll
        for (int j = 0; j < 2; ++j) { a0[j] = *(const bf16x8v*)(ap + (ks0 + j) * 32); a1[j] = *(const bf16x8v*)(ap + (size_t)16 * K + (ks0 + j) * 32);
#pragma unroll
            for (int nt = 0; nt < NTL; ++nt) bw[j][nt] = *(const bf16x8v*)(bp + (size_t)nt * 16 * K + (ks0 + j) * 32); }
#pragma unroll
        for (int j = 0; j < 2; ++j)
#pragma unroll
            for (int nt = 0; nt < NTL; ++nt) { acc[0][nt] = __builtin_amdgcn_mfma_f32_16x16x32_bf16(bw[j][nt], a0[j], acc[0][nt], 0, 0, 0); acc[1][nt] = __builtin_amdgcn_mfma_f32_16x16x32_bf16(bw[j][nt], a1[j], acc[1][nt], 0, 0, 0); } }
    LAS float* red = (LAS float*)lds;
    __syncthreads();
#pragma unroll
    for (int mt = 0; mt < 2; ++mt)
#pragma unroll
        for (int nt = 0; nt < NTL; ++nt) *(LAS f32x4*)(red + ((wave * 32 + mt * 16 + fr) * RS + nt * 16 + 4 * kg)) = acc[mt][nt];
    __syncthreads();
    for (int it = tid; it < 32 * RT; it += NTHR) { const int m = it / RT, c4 = it % RT; f32x4 v = {0.f, 0.f, 0.f, 0.f};
#pragma unroll
        for (int w = 0; w < 8; ++w) v += *(LAS const f32x4*)(red + ((w * 32 + m) * RS + 4 * c4));
        const float rs = F::RSTD ? ss_row_rstd(f.ssin, grow0 + m) : 0.f; typename F::Aux x; f.prefetch(grow0 + m, gcol0 + 4 * c4, x); f.store4(grow0 + m, gcol0 + 4 * c4, v, rs, x); }
    __syncthreads();
}
template <int KS, class F>
__device__ __forceinline__ void thin_tile16(LAS unsigned char* lds, const bf16* A, const bf16* Bt, int grow0, int gcol0, int slot, const F& f, int tid, int lane, int wave) {
    constexpr int K = KS * 256, RS = 20;
    const int fr = lane & 15, kg = lane >> 4;
    const bf16* ap = A + (size_t)fr * K + wave * (KS * 32) + kg * 8; const bf16* bp = Bt + (size_t)fr * K + wave * (KS * 32) + kg * 8;
    bf16x8v a0[KS], a1[KS], bw[KS];
#pragma unroll
    for (int ks = 0; ks < KS; ++ks) { a0[ks] = *(const bf16x8v*)(ap + ks * 32); a1[ks] = *(const bf16x8v*)(ap + (size_t)16 * K + ks * 32); bw[ks] = *(const bf16x8v*)(bp + ks * 32); }
    f32x4 acc0 = {0.f, 0.f, 0.f, 0.f}, acc1 = {0.f, 0.f, 0.f, 0.f};
#pragma unroll
    for (int ks = 0; ks < KS; ++ks) { acc0 = __builtin_amdgcn_mfma_f32_16x16x32_bf16(bw[ks], a0[ks], acc0, 0, 0, 0); acc1 = __builtin_amdgcn_mfma_f32_16x16x32_bf16(bw[ks], a1[ks], acc1, 0, 0, 0); }
    LAS float* red = (LAS float*)lds;
    __syncthreads();
    *(LAS f32x4*)(red + ((wave * 32 + fr) * RS + 4 * kg)) = acc0; *(LAS f32x4*)(red + ((wave * 32 + 16 + fr) * RS + 4 * kg)) = acc1;
    __syncthreads();
    if (tid < 128) { const int m = tid >> 2, c4 = tid & 3; f32x4 v = {0.f, 0.f, 0.f, 0.f};
#pragma unroll
        for (int w = 0; w < 8; ++w) v += *(LAS const f32x4*)(red + ((w * 32 + m) * RS + 4 * c4));
        typename F::Aux x; f.prefetch(grow0 + m, gcol0 + 4 * c4, x);
        float rs = 0.f; if (F::RSTD) { rs = ss_srow_part(f.ssin, grow0 + m, c4); rs += __shfl_xor(rs, 1); rs += __shfl_xor(rs, 2); rs = ss2rstd(rs); }
        float ss = f.store4(grow0 + m, gcol0 + 4 * c4, v, rs, x);
        if (F::SUMSQ) { ss += __shfl_xor(ss, 1); ss += __shfl_xor(ss, 2); if (c4 == 0) f.ssout[(size_t)MPAD * 32 + (size_t)(grow0 + m - MP) * 128 + slot] = ss; } }
    __syncthreads();
}
template <int KS, class F> __device__ __forceinline__ void thin_sample(LAS unsigned char* lds, const bf16* A, const bf16* Bt, int N, const F& f, int wv_, int wg0 = 0, int nwg = 0) {
    const int wave = wv_, lane = lane_id_fresh(); int tid = wave * 64 + lane; asm volatile("" : "+v"(tid));
    constexpr int K = KS * 256;
    if (nwg == 0) nwg = gridDim.x;
    for (int t = (int)blockIdx.x - wg0; t < (N + 15) / 16; t += nwg) thin_tile16<KS, F>(lds, A + (size_t)MP * K, Bt + (size_t)t * 16 * K, MP, t * 16, t, f, tid, lane, wave);
}

__global__ void __launch_bounds__(NTHR, 2) fwd_kernel(Args args) {
    extern __shared__ __attribute__((aligned(16))) unsigned char lds_raw[];
    LAS unsigned char* lds = (LAS unsigned char*)lds_raw;
    volatile LAS unsigned* MISC = (volatile LAS unsigned*)(lds + MISC_OFF);
    const int wave_u = __builtin_amdgcn_readfirstlane((int)threadIdx.x >> 6);
    for (int u = wave_u * 64 + lane_id_fresh(); u < (LDS_BYTES - 131072) / 4; u += NTHR) ((LAS unsigned*)(lds + 131072))[u] = 0u;
    __syncthreads();
    ArgP kap = (ArgP)__builtin_amdgcn_kernarg_segment_ptr();
    XcdBarrier bar = xcd_barrier_post((unsigned*)(kap->ws + WS_CTL) + CW_BAR, MISC + 8, wave_u);
    int lp = 0;
#if PROF
    unsigned ph = 0; if (blockIdx.x == 0 && wave_u == 0) { const unsigned long long t0_ = __builtin_amdgcn_s_memrealtime(); MISC[16] = (unsigned)t0_; MISC[17] = (unsigned)(t0_ >> 32); }
#endif
#define PH_BEGIN { int l = lp; asm volatile("" : "+s"(l)); const int ia = 2 * l, is = 2 * l + 1; (void)ia; (void)is; ArgP args = kap; asm volatile("" : "+s"(args)); unsigned char* ws = args->ws; (void)ws;
#if PROF
#define PROF_ARRIVE() do { prof_mark(100 + (int)ph, wave_u); } while (0)
#define PROF_EXIT()   do { prof_mark(200 + (int)ph, wave_u); ++ph; } while (0)
#else
#define PROF_ARRIVE() do {} while (0)
#define PROF_EXIT()   do {} while (0)
#endif
#define PH_END   { PROF_ARRIVE(); XcdBarrier b2_ = bar; asm volatile("" : "+s"(b2_.bar), "+s"(b2_.x)); xcd_barrier(b2_, wave_u); PROF_EXIT(); } }
#define PH_LAST  PROF_ARRIVE(); }
#define GEMM_FUSED(FT, fobj, Aptr, Bptr, Ncols, Kdim) do { pg8::Gemm g_{(const pg8::bf16_t*)(Aptr), (const pg8::bf16_t*)(Bptr), MP, (Ncols), (Kdim)}; pg8::StaticOrder S_; S_.init(MP, (Ncols), (int)gridDim.x, (int)blockIdx.x); \
        EpiFused<FT> E_{fobj}; pg8::gemm_phase<EpiFused<FT>, pg8::StaticOrder, true, true>(lds, g_, S_, E_, wave_u); } while (0)

#define GEMM_FUSED_SUB(FT, fobj, Aptr, Bptr, Ncols, Kdim, wg0_, nwg_) do { pg8::Gemm g_{(const pg8::bf16_t*)(Aptr), (const pg8::bf16_t*)(Bptr), MP, (Ncols), (Kdim)}; pg8::StaticOrder S_; S_.init(MP, (Ncols), (nwg_), (int)blockIdx.x - (wg0_)); \
        EpiFused<FT> E_{fobj}; pg8::gemm_phase<EpiFused<FT>, pg8::StaticOrder, true, true>(lds, g_, S_, E_, wave_u); } while (0)

    PH_BEGIN ph_prologue(args, lds, wave_u); PH_END

    lp = 0;
        PH_BEGIN { const bf16* Aa = (const bf16*)(ws + WS_HBA); const bf16* Bw = (const bf16*)(ws + WS_WAIN) + (size_t)l * ACOLS_PAD * DM; FAttnIn f{ws, args->out, ss_buf(ws, 2 * ia), l, nullptr};
                   GEMM_FUSED(FAttnIn, f, Aa, Bw, 6144, DM);
                   { const int wave = wave_u, lane = lane_id_fresh(); int tid = wave * 64 + lane; asm volatile("" : "+v"(tid));
                     for (int rb = blockIdx.x; rb < MP / 32; rb += gridDim.x) thin_tile<96, FAttnIn>(lds, Aa + (size_t)rb * 32 * DM, Bw + (size_t)6144 * DM, DM, rb * 32, 6144, f, tid, lane, wave); }
                   thin_sample<8, FAttnIn>(lds, Aa, Bw, ACOLS, f, wave_u); } PH_END
        PH_BEGIN ph_idx(args, l, lds, wave_u); ph_idx_sample(args, l, wave_u); PMARK(5, wave_u); PH_END
        PH_BEGIN ph_attn(args, lds, wave_u);
                   if ((int)blockIdx.x < MS * NKV || (int)gridDim.x < 2 * MS * NKV) ph_attn_sample(args, l, lds, wave_u);
                   if ((int)blockIdx.x >= MS * NKV || (int)gridDim.x < 2 * MS * NKV) {
                       const int wg0 = ((int)gridDim.x < 2 * MS * NKV) ? 0 : MS * NKV, nwg = (int)gridDim.x - wg0;
                       __syncthreads();
                       for (int q = 0; q < 2; ++q) { const int li = 2 * l + q; const bf16* Ap = (const bf16*)(ws + WS_PB + (size_t)li * PB_STRIDE); const bf16* Bp = (const bf16*)(ws + WS_WPP) + (size_t)li * DM * PLE;
                           FPleProj fp{ws, nullptr, nullptr, (bf16*)(ws + WS_PRJ + (size_t)q * PRJ_STRIDE)};
                           GEMM_FUSED_SUB(FPleProj, fp, Ap, Bp, DM, PLE, wg0, nwg); thin_sample<1, FPleProj>(lds, Ap, Bp, DM, fp, wave_u, wg0, nwg); } } PH_END
        PH_BEGIN { const bf16* Aa = (const bf16*)(ws + WS_AOB); const bf16* Bw = (const bf16*)(ws + WS_WAOUT) + (size_t)l * DM * DM; FResid f{ws, ss_buf(ws, 1 + 2 * ia), nullptr};
                   GEMM_FUSED(FResid, f, Aa, Bw, DM, DM); thin_sample<8, FResid>(lds, Aa, Bw, DM, f, wave_u);
                   } PH_END
        PH_BEGIN { const bf16* Aa = (const bf16*)(ws + WS_HBB); const bf16* Bw = (const bf16*)(ws + WS_WPG) + (size_t)ia * DM * DM; FPle f{ws, ss_buf(ws, 1 + 2 * ia), ss_buf(ws, 2 + 2 * ia), (const bf16*)(ws + WS_PRJ)};
                   GEMM_FUSED(FPle, f, Aa, Bw, DM, DM); PMARK(1, wave_u); thin_sample<8, FPle>(lds, Aa, Bw, DM, f, wave_u); PMARK(2, wave_u); } PH_END
        PH_BEGIN { const bf16* Aa = (const bf16*)(ws + WS_HBA); const bf16* Bw = (const bf16*)(ws + WS_WSIN) + (size_t)l * 4096 * DM; FSsmIn f{ws, ss_buf(ws, 2 * is), nullptr};
                   GEMM_FUSED(FSsmIn, f, Aa, Bw, 4096, DM); thin_sample<8, FSsmIn>(lds, Aa, Bw, 4096, f, wave_u); } PH_END
        PH_BEGIN ph_scan(args, l, lds, wave_u); PH_END
        PH_BEGIN { const bf16* Aa = (const bf16*)(ws + WS_YB); const bf16* Bw = (const bf16*)(ws + WS_WGLU) + (size_t)l * DM * DM; FGlu f{ws, (const float*)args->in[I_BGLU] + (size_t)l * DM, nullptr, nullptr};
                   GEMM_FUSED(FGlu, f, Aa, Bw, DM, DM); thin_sample<8, FGlu>(lds, Aa, Bw, DM, f, wave_u); } PH_END
        PH_BEGIN { const bf16* Aa = (const bf16*)(ws + WS_AOB); const bf16* Bw = (const bf16*)(ws + WS_WSOUT) + (size_t)l * DM * DM; FResid f{ws, ss_buf(ws, 1 + 2 * is), nullptr};
                   GEMM_FUSED(FResid, f, Aa, Bw, DM, DM); thin_sample<8, FResid>(lds, Aa, Bw, DM, f, wave_u);
                   } PH_END
        PH_BEGIN { const bf16* Aa = (const bf16*)(ws + WS_HBB); const bf16* Bw = (const bf16*)(ws + WS_WPG) + (size_t)is * DM * DM; FPle f{ws, ss_buf(ws, 1 + 2 * is), ss_buf(ws, 2 + 2 * is), (const bf16*)(ws + WS_PRJ + PRJ_STRIDE)};
                   GEMM_FUSED(FPle, f, Aa, Bw, DM, DM); PMARK(1, wave_u); thin_sample<8, FPle>(lds, Aa, Bw, DM, f, wave_u); PMARK(2, wave_u); } PH_END
    lp = 1;
        PH_BEGIN { const bf16* Aa = (const bf16*)(ws + WS_HBA); const bf16* Bw = (const bf16*)(ws + WS_WAIN) + (size_t)l * ACOLS_PAD * DM; FAttnIn f{ws, args->out, ss_buf(ws, 2 * ia), l, nullptr};
                   GEMM_FUSED(FAttnIn, f, Aa, Bw, 6144, DM);
                   { const int wave = wave_u, lane = lane_id_fresh(); int tid = wave * 64 + lane; asm volatile("" : "+v"(tid));
                     for (int rb = blockIdx.x; rb < MP / 32; rb += gridDim.x) thin_tile<96, FAttnIn>(lds, Aa + (size_t)rb * 32 * DM, Bw + (size_t)6144 * DM, DM, rb * 32, 6144, f, tid, lane, wave); }
                   thin_sample<8, FAttnIn>(lds, Aa, Bw, ACOLS, f, wave_u); } PH_END
        PH_BEGIN ph_idx(args, l, lds, wave_u); ph_idx_sample(args, l, wave_u); PMARK(5, wave_u); PH_END
        PH_BEGIN ph_attn(args, lds, wave_u);
                   if ((int)blockIdx.x < MS * NKV || (int)gridDim.x < 2 * MS * NKV) ph_attn_sample(args, l, lds, wave_u);
                   if ((int)blockIdx.x >= MS * NKV || (int)gridDim.x < 2 * MS * NKV) {
                       const int wg0 = ((int)gridDim.x < 2 * MS * NKV) ? 0 : MS * NKV, nwg = (int)gridDim.x - wg0;
                       __syncthreads();
                       for (int q = 0; q < 2; ++q) { const int li = 2 * l + q; const bf16* Ap = (const bf16*)(ws + WS_PB + (size_t)li * PB_STRIDE); const bf16* Bp = (const bf16*)(ws + WS_WPP) + (size_t)li * DM * PLE;
                           FPleProj fp{ws, nullptr, nullptr, (bf16*)(ws + WS_PRJ + (size_t)q * PRJ_STRIDE)};
                           GEMM_FUSED_SUB(FPleProj, fp, Ap, Bp, DM, PLE, wg0, nwg); thin_sample<1, FPleProj>(lds, Ap, Bp, DM, fp, wave_u, wg0, nwg); } } PH_END
        PH_BEGIN { const bf16* Aa = (const bf16*)(ws + WS_AOB); const bf16* Bw = (const bf16*)(ws + WS_WAOUT) + (size_t)l * DM * DM; FResid f{ws, ss_buf(ws, 1 + 2 * ia), nullptr};
                   GEMM_FUSED(FResid, f, Aa, Bw, DM, DM); thin_sample<8, FResid>(lds, Aa, Bw, DM, f, wave_u);
                   } PH_END
        PH_BEGIN { const bf16* Aa = (const bf16*)(ws + WS_HBB); const bf16* Bw = (const bf16*)(ws + WS_WPG) + (size_t)ia * DM * DM; FPle f{ws, ss_buf(ws, 1 + 2 * ia), ss_buf(ws, 2 + 2 * ia), (const bf16*)(ws + WS_PRJ)};
                   GEMM_FUSED(FPle, f, Aa, Bw, DM, DM); PMARK(1, wave_u); thin_sample<8, FPle>(lds, Aa, Bw, DM, f, wave_u); PMARK(2, wave_u); } PH_END
        PH_BEGIN { const bf16* Aa = (const bf16*)(ws + WS_HBA); const bf16* Bw = (const bf16*)(ws + WS_WSIN) + (size_t)l * 4096 * DM; FSsmIn f{ws, ss_buf(ws, 2 * is), nullptr};
                   GEMM_FUSED(FSsmIn, f, Aa, Bw, 4096, DM); thin_sample<8, FSsmIn>(lds, Aa, Bw, 4096, f, wave_u); } PH_END
        PH_BEGIN ph_scan(args, l, lds, wave_u); PH_END
        PH_BEGIN { const bf16* Aa = (const bf16*)(ws + WS_YB); const bf16* Bw = (const bf16*)(ws + WS_WGLU) + (size_t)l * DM * DM; FGlu f{ws, (const float*)args->in[I_BGLU] + (size_t)l * DM, nullptr, nullptr};
                   GEMM_FUSED(FGlu, f, Aa, Bw, DM, DM); thin_sample<8, FGlu>(lds, Aa, Bw, DM, f, wave_u); } PH_END
        PH_BEGIN { const bf16* Aa = (const bf16*)(ws + WS_AOB); const bf16* Bw = (const bf16*)(ws + WS_WSOUT) + (size_t)l * DM * DM; FResid f{ws, ss_buf(ws, 1 + 2 * is), nullptr};
                   GEMM_FUSED(FResid, f, Aa, Bw, DM, DM); thin_sample<8, FResid>(lds, Aa, Bw, DM, f, wave_u);
                   } PH_END
        PH_BEGIN { const bf16* Aa = (const bf16*)(ws + WS_HBB); const bf16* Bw = (const bf16*)(ws + WS_WPG) + (size_t)is * DM * DM; FPle f{ws, ss_buf(ws, 1 + 2 * is), ss_buf(ws, 2 + 2 * is), (const bf16*)(ws + WS_PRJ + PRJ_STRIDE)};
                   GEMM_FUSED(FPle, f, Aa, Bw, DM, DM); PMARK(1, wave_u); thin_sample<8, FPle>(lds, Aa, Bw, DM, f, wave_u); PMARK(2, wave_u); } PH_END
    PH_BEGIN ph_final(args, wave_u); PH_LAST
#if PROF
    if (blockIdx.x == 0 && wave_u == 0) { const unsigned accA = MISC[18], accB = MISC[19]; const unsigned qa = min(99u, accA / (100u * PROF_UNIT_US)), qb = min(99u, accB / (100u * PROF_UNIT_US));
        const unsigned long long t_end = __builtin_amdgcn_s_memrealtime() + (unsigned long long)(qa * 20u + qb * 2000u) * 100ull;
        while (__builtin_amdgcn_s_memrealtime() < t_end) __builtin_amdgcn_s_sleep(32); }
#endif
}
constexpr int N_PHASES = 1 + 2 * 24 + 2;

#ifndef MK_PER_PHASE
#define MK_PER_PHASE 0
#endif
extern "C" void kernel_launch(void* const* d_in, const int* in_sizes, int n_in, void* d_out, int out_size, void* d_ws, size_t ws_size, hipStream_t stream) {
    static int grid = 0;
    if (grid == 0) {
        if (n_in != N_IN || out_size != (int)O_END || ws_size < WS_END) { fprintf(stderr, "kernel_launch: unexpected shapes: n_in %d out %d ws %zu (need %zu)\n", n_in, out_size, ws_size, (size_t)WS_END); grid = -1; return; }
        int dev = 0, cus = 0, per_cu = 0;
        if (hipGetDevice(&dev) != hipSuccess || hipDeviceGetAttribute(&cus, hipDeviceAttributeMultiprocessorCount, dev) != hipSuccess) { grid = -1; return; }
        if (hipFuncSetAttribute((const void*)fwd_kernel, hipFuncAttributeMaxDynamicSharedMemorySize, LDS_BYTES) != hipSuccess) { fprintf(stderr, "kernel_launch: hipFuncSetAttribute failed\n"); grid = -1; return; }
        if (hipOccupancyMaxActiveBlocksPerMultiprocessor(&per_cu, (const void*)fwd_kernel, NTHR, LDS_BYTES) != hipSuccess || per_cu < 1) fprintf(stderr, "kernel_launch: occupancy query reports %d\n", per_cu);
        (void)hipGetLastError();
        grid = cus;
    }
    if (grid < 0) return;
    if (hipMemsetAsync((char*)d_ws + WS_CTL, 0, CTL_ZERO_BYTES, stream) != hipSuccess) return;
    Args a{};
    for (int i = 0; i < N_IN; ++i) a.in[i] = d_in[i];
    a.out = (float*)d_out; a.ws = (unsigned char*)d_ws;
    a.ph_lo = 0; a.ph_hi = N_PHASES;
    hipLaunchKernelGGL(fwd_kernel, dim3(grid), dim3(NTHR), LDS_BYTES, stream, a);
    const hipError_t le = hipPeekAtLastError();
    if (le != hipSuccess) fprintf(stderr, "kernel_launch: launch failed: %s\n", hipGetErrorName(le));
}
```

```cpp
#include <hip/hip_runtime.h>
#include <cstdio>
#include <cstdint>
#ifndef PROF
#define PROF 0
#endif
#define PROF_UNIT_US 8u
#define PROF_MATCH_A(id) (false)
#define PROF_MATCH_B(id) (false)

__device__ __forceinline__ int lane_id_fresh();
namespace pg8 {
#define PG8_LAS __attribute__((address_space(3)))
typedef unsigned short bf16_t;
typedef short bf16x8 __attribute__((ext_vector_type(8)));
typedef float f32x4 __attribute__((ext_vector_type(4)));
typedef unsigned u32x4 __attribute__((ext_vector_type(4)));
constexpr int BM = 256, BK = 64, HALF = 128, HTB = HALF * BK * 2, STAGE_BYTES = 8 * HTB, NXCD = 8, WGM = 8;

__host__ __device__ __forceinline__ int lds_byte(int r, int c) { const int st = (r >> 4) * 2 + (c >> 5), rr = r & 15, cc = c & 31, ob = rr * 64 + cc * 2; return st * 1024 + (ob ^ (((ob >> 9) & 1) << 5)); }
__host__ __device__ __forceinline__ void stage_rc(int b, int& R, int& C) { const int st = b / 1024, sb = b % 1024, swz = sb ^ (((sb >> 9) & 1) << 5); R = (st >> 1) * 16 + swz / 64; C = (st & 1) * 32 + (swz % 64) / 2; }

struct Unit { int pm, pn; };
struct Gemm { const bf16_t* A; const bf16_t* Bt; int M, N, K; };

struct StaticOrder {
    int nM, nN, nwg, G, c;
    __host__ __device__ void init(int M, int N, int G_, int c_) { nM = M / BM; nN = N / BM; nwg = nM * nN; G = G_; c = c_; }
    __host__ __device__ bool next(int i, Unit& u) const {
        const long L = (long)i * G + c; if (L >= nwg) return false;
        int wgid = (int)L; { const int q = nwg / NXCD, r = nwg % NXCD, xcd = wgid % NXCD, off = wgid / NXCD; wgid = (xcd < r ? xcd * (q + 1) : r * (q + 1) + (xcd - r) * q) + off; }
        const int nig = WGM * nN, gid = wgid / nig, fm = gid * WGM, gsz = (nM - fm) < WGM ? (nM - fm) : WGM;
        u.pm = fm + ((wgid % nig) % gsz); u.pn = (wgid % nig) / gsz; return true;
    }
    __device__ __forceinline__ void a_ready(const Unit&) const {}
    __device__ __forceinline__ void done(const Unit&) const {}
};

struct EpiF32 {
    float* C; int ldc;
    __device__ __forceinline__ void operator()(const f32x4 (&acc)[2][2][4][2], const Unit& u, int wr, int wc, int fr, int fq) const {
        const int row0 = u.pm * BM + wr * 64 + fr, col0 = u.pn * BM + wc * 32 + 4 * fq;
#pragma unroll
        for (int ai = 0; ai < 2; ++ai)
#pragma unroll
            for (int m = 0; m < 4; ++m) { float* rowp = C + (size_t)(row0 + ai * HALF + m * 16) * ldc + col0;
#pragma unroll
                for (int bj = 0; bj < 2; ++bj)
#pragma unroll
                    for (int n = 0; n < 2; ++n) *(f32x4*)(rowp + bj * HALF + n * 16) = acc[ai][bj][m][n]; }
    }
};

template <class Epi, class Sched, bool ALIGN_EPI = false, bool SP2 = false>
__device__ __forceinline__ void gemm_phase(PG8_LAS unsigned char* lds, const Gemm g, const Sched& S, const Epi& E, int wv) {
    int tid = threadIdx.x; (void)wv; asm volatile("" : "+v"(tid)); __builtin_assume(tid >= 0); __builtin_assume(tid < 512);
    int tidg = tid;
    const int wid = __builtin_amdgcn_readfirstlane(tid >> 6), lane = tid & 63, wr = wid >> 2, wc = wid & 3, fr = lane & 15, fq = lane >> 4;
    const int K = g.K, nt = K / BK;
    unsigned voffA[2], voffB[2];
#pragma unroll
    for (int i = 0; i < 2; ++i) { int R, C; stage_rc(tidg * 16 + i * 8192, R, C); const int Rb = R;
        voffA[i] = (unsigned)(R * K + C) * 2u; voffB[i] = (unsigned)(Rb * K + C) * 2u; }
    const size_t kstep = (size_t)(BK * 2);
    const size_t hstep = (size_t)HALF * K * 2;
    const size_t tstep = 2 * hstep;
    const unsigned ldsw = (unsigned)wid * 1024u;
    const int aoff = lds_byte(wr * 64 + fr, fq * 8), boff = lds_byte(wc * 32 + fr, fq * 8);
#define PG8_SA(b, h) (((b) * 2 + (h)) * HTB)
#define PG8_SB(b, h) ((4 + (b) * 2 + (h)) * HTB)
#define PG8_STAGE(bufoff, gbase, voff) do { _Pragma("unroll") for (int _i = 0; _i < 2; ++_i) \
        __builtin_amdgcn_global_load_lds((const unsigned*)((const char*)(gbase) + (voff)[_i]), (PG8_LAS unsigned*)(lds + (bufoff) + ldsw + _i * 8192), 16, 0, 0); } while (0)
#define PG8_LDA(dst, b, h) do { _Pragma("unroll") for (int m = 0; m < 4; ++m) _Pragma("unroll") for (int k = 0; k < 2; ++k) dst[m][k] = *(const PG8_LAS bf16x8*)(lds + PG8_SA(b, h) + aoff + m * 2048 + k * 1024); } while (0)
#define PG8_LDB(dst, b, h) do { _Pragma("unroll") for (int n = 0; n < 2; ++n) _Pragma("unroll") for (int k = 0; k < 2; ++k) dst[n][k] = *(const PG8_LAS bf16x8*)(lds + PG8_SB(b, h) + boff + n * 2048 + k * 1024); } while (0)
#define PG8_MMA(ai, bj, At, Bt) do { __builtin_amdgcn_s_setprio(1); _Pragma("unroll") for (int m = 0; m < 4; ++m) _Pragma("unroll") for (int n = 0; n < 2; ++n) _Pragma("unroll") for (int k = 0; k < 2; ++k) \
        acc[ai][bj][m][n] = __builtin_amdgcn_mfma_f32_16x16x32_bf16(Bt[n][k], At[m][k], acc[ai][bj][m][n], 0, 0, 0); __builtin_amdgcn_s_setprio(0); } while (0)
#define PG8_WAIT_V(n) asm volatile("s_waitcnt vmcnt(" #n ")" ::: "memory")
#define PG8_WAIT_L(n) asm volatile("s_waitcnt lgkmcnt(" #n ")" ::: "memory")
#define PG8_BAR __builtin_amdgcn_s_barrier()
#define PG8_SCHED __builtin_amdgcn_sched_barrier(0)
    Unit cur, nxt; int ui = 0;
    if (!S.next(0, cur)) return;
    f32x4 acc[2][2][4][2];
#pragma unroll
    for (int a = 0; a < 2; ++a)
#pragma unroll
        for (int b = 0; b < 2; ++b)
#pragma unroll
            for (int m = 0; m < 4; ++m)
#pragma unroll
                for (int n = 0; n < 2; ++n) acc[a][b][m][n] = (f32x4){0.f, 0.f, 0.f, 0.f};
    bf16x8 At[4][2], B0[2][2], B1[2][2];
    const char* cA = (const char*)g.A + (size_t)cur.pm * tstep; const char* cB = (const char*)g.Bt + (size_t)cur.pn * tstep;
    S.a_ready(cur);
    if constexpr (SP2) {
        PG8_STAGE(PG8_SB(0, 0), cB, voffB); PG8_STAGE(PG8_SB(0, 1), cB + hstep, voffB); PG8_STAGE(PG8_SA(0, 0), cA, voffA); PG8_STAGE(PG8_SA(0, 1), cA + hstep, voffA);
        if (wr == 1) PG8_BAR;
        PG8_WAIT_V(2); PG8_BAR;
        PG8_STAGE(PG8_SB(1, 0), cB + kstep, voffB); PG8_STAGE(PG8_SA(1, 0), cA + kstep, voffA); PG8_STAGE(PG8_SB(1, 1), cB + hstep + kstep, voffB);
        PG8_WAIT_V(6); PG8_BAR;
    } else {
        PG8_STAGE(PG8_SB(0, 0), cB, voffB); PG8_STAGE(PG8_SA(0, 0), cA, voffA); PG8_STAGE(PG8_SB(0, 1), cB + hstep, voffB); PG8_STAGE(PG8_SA(0, 1), cA + hstep, voffA);
        if (wr == 1) PG8_BAR;
        PG8_WAIT_V(4); PG8_BAR;
        PG8_STAGE(PG8_SB(1, 0), cB + kstep, voffB); PG8_STAGE(PG8_SA(1, 0), cA + kstep, voffA); PG8_STAGE(PG8_SB(1, 1), cB + hstep + kstep, voffB);
        PG8_WAIT_V(6); PG8_BAR;
    }
    for (;;) {
        const bool has_next = S.next(ui + 1, nxt);
        const char* nA = has_next ? (const char*)g.A + (size_t)nxt.pm * tstep : cA; const char* nB = has_next ? (const char*)g.Bt + (size_t)nxt.pn * tstep : cB;
        for (int t = 0; t < nt; t += 2) {
            const bool last = (t == nt - 2);
            const char* a1 = cA + (size_t)(t + 1) * kstep;
            const char* a2 = last ? nA : cA + (size_t)(t + 2) * kstep; const char* b2 = last ? nB : cB + (size_t)(t + 2) * kstep;
            const char* a3 = a2 + kstep; const char* b3 = b2 + kstep;
            if (last && has_next) S.a_ready(nxt);
            if constexpr (SP2) {
            PG8_LDB(B0, 0, 0); PG8_LDB(B1, 0, 1); PG8_SCHED; PG8_LDA(At, 0, 0); PG8_STAGE(PG8_SA(1, 1), a1 + hstep, voffA);
            PG8_WAIT_V(8); PG8_WAIT_L(0); PG8_BAR; PG8_MMA(0, 0, At, B0); PG8_MMA(0, 1, At, B1); PG8_BAR; PG8_SCHED;
            PG8_LDA(At, 0, 1); PG8_STAGE(PG8_SB(0, 0), b2, voffB); PG8_STAGE(PG8_SB(0, 1), b2 + hstep, voffB); PG8_STAGE(PG8_SA(0, 0), a2, voffA);
            PG8_WAIT_V(8); PG8_WAIT_L(0); PG8_BAR; PG8_MMA(1, 0, At, B0); PG8_MMA(1, 1, At, B1); PG8_BAR; PG8_SCHED;
            PG8_LDB(B0, 1, 0); PG8_LDB(B1, 1, 1); PG8_SCHED; PG8_LDA(At, 1, 0); PG8_STAGE(PG8_SA(0, 1), a2 + hstep, voffA);
            PG8_WAIT_V(8); PG8_WAIT_L(0); PG8_BAR; PG8_MMA(0, 0, At, B0); PG8_MMA(0, 1, At, B1); PG8_BAR; PG8_SCHED;
            PG8_LDA(At, 1, 1); PG8_STAGE(PG8_SB(1, 0), b3, voffB); PG8_STAGE(PG8_SB(1, 1), b3 + hstep, voffB); PG8_STAGE(PG8_SA(1, 0), a3, voffA);
            PG8_WAIT_V(8); PG8_WAIT_L(0); PG8_BAR; PG8_MMA(1, 0, At, B0); PG8_MMA(1, 1, At, B1); PG8_BAR; PG8_SCHED;
            } else {
            PG8_LDB(B0, 0, 0); PG8_SCHED; PG8_LDA(At, 0, 0); PG8_STAGE(PG8_SA(1, 1), a1 + hstep, voffA);
            PG8_WAIT_L(8); PG8_BAR; PG8_WAIT_L(0); PG8_MMA(0, 0, At, B0); PG8_BAR; PG8_SCHED;
            PG8_LDB(B1, 0, 1); PG8_STAGE(PG8_SB(0, 0), b2, voffB);
            PG8_BAR; PG8_WAIT_L(0); PG8_MMA(0, 1, At, B1); PG8_BAR;
            PG8_LDA(At, 0, 1); PG8_STAGE(PG8_SA(0, 0), a2, voffA);
            PG8_BAR; PG8_WAIT_L(0); PG8_MMA(1, 0, At, B0); PG8_BAR; PG8_SCHED;
            PG8_STAGE(PG8_SB(0, 1), b2 + hstep, voffB);
            PG8_WAIT_V(6); PG8_BAR; PG8_MMA(1, 1, At, B1); PG8_BAR;
            PG8_LDB(B0, 1, 0); PG8_SCHED; PG8_LDA(At, 1, 0); PG8_STAGE(PG8_SA(0, 1), a2 + hstep, voffA);
            PG8_WAIT_L(8); PG8_BAR; PG8_WAIT_L(0); PG8_MMA(0, 0, At, B0); PG8_BAR; PG8_SCHED;
            PG8_LDB(B1, 1, 1); PG8_STAGE(PG8_SB(1, 0), b3, voffB);
            PG8_BAR; PG8_WAIT_L(0); PG8_MMA(0, 1, At, B1); PG8_BAR;
            PG8_LDA(At, 1, 1); PG8_STAGE(PG8_SA(1, 0), a3, voffA);
            PG8_BAR; PG8_WAIT_L(0); PG8_MMA(1, 0, At, B0); PG8_BAR; PG8_SCHED;
            PG8_STAGE(PG8_SB(1, 1), b3 + hstep, voffB);
            PG8_WAIT_V(6); PG8_BAR; PG8_MMA(1, 1, At, B1); PG8_BAR;
            }
        }
        if constexpr (ALIGN_EPI) { if (wr == 0) PG8_BAR; }
        E(acc, cur, wr, wc, tidg & 15, (tidg >> 4) & 3); S.done(cur);
        if (!has_next) break;
#pragma unroll
        for (int a = 0; a < 2; ++a)
#pragma unroll
            for (int b = 0; b < 2; ++b)
#pragma unroll
                for (int m = 0; m < 4; ++m)
#pragma unroll
                    for (int n = 0; n < 2; ++n) acc[a][b][m][n] = (f32x4){0.f, 0.f, 0.f, 0.f};
        cur = nxt; cA = nA; cB = nB; ++ui;
        if constexpr (ALIGN_EPI) { if (wr == 1) PG8_BAR; }
    }
    PG8_WAIT_V(0);
    if constexpr (!ALIGN_EPI) { if (wr == 0) PG8_BAR; }
    PG8_BAR;
#undef PG8_SA
#undef PG8_SB
#undef PG8_STAGE
#undef PG8_LDA
#undef PG8_LDB
#undef PG8_MMA
#undef PG8_WAIT_V
#undef PG8_WAIT_L
#undef PG8_BAR
#undef PG8_SCHED
}
}

constexpr int NWAVES = 8, NTHR = NWAVES * 64;
constexpr int DM = 2048, NBATCH = 2, SEQ = 4096, DEPTH = 4, DBATCH = 8, DSEQ = 4, PAST = 16384, PAGE = 128;
constexpr int NPAGES = PAST / PAGE, NPOOL = 1280, NAL = 2, NSL = 2;
constexpr int NH = 16, NKV = 4, HD = 128, KVG = 4, NIH = 16, IDD = 64, TOPK = 256;
constexpr int ACOLS = 6224, ACOLS_PAD = 6400;
constexpr int C_Q = 0, C_K = 2048, C_V = 2560, C_G = 3072, C_QI = 5120, C_KI = 6144, C_WI = 6208;
constexpr int SGRP = 16, NGRP = 128, SST = 64, PLE = 256;
constexpr int MP = NBATCH * SEQ, MS = DBATCH * DSEQ, MR = MP + MS, MPAD = 8448;
constexpr float RMS_EPS = 1e-6f;
constexpr float LOG2E = 1.4426950408889634f;
constexpr float QSCALE = 0.088388347648318440f * LOG2E;
constexpr float WISCALE = 0.25f * 0.125f;
enum { I_XP = 0, I_XS, I_CK, I_CV, I_CKI, I_SRE, I_SIM, I_PT, I_PP, I_PS, I_NW, I_FNW, I_RB, I_AWI, I_AWO, I_SWI, I_LRE, I_LIM, I_LDT, I_BRE, I_BIM, I_CRE, I_CIM, I_SD, I_WGLU, I_BGLU, I_SWO, I_PNW, I_PWG, I_PWP, N_IN };
constexpr size_t O_YP = 0, O_YS = O_YP + (size_t)MP * DM, O_KP = O_YS + (size_t)MS * DM, O_VP = O_KP + (size_t)NAL * MP * 512, O_KIP = O_VP + (size_t)NAL * MP * 512,
    O_SRP = O_KIP + (size_t)NAL * MP * 64, O_SIP = O_SRP + (size_t)NSL * NBATCH * NGRP * SST, O_KS = O_SIP + (size_t)NSL * NBATCH * NGRP * SST, O_VS = O_KS + (size_t)NAL * MS * 512,
    O_KIS = O_VS + (size_t)NAL * MS * 512, O_SRS = O_KIS + (size_t)NAL * MS * 64, O_SIS = O_SRS + (size_t)NSL * DBATCH * NGRP * SST, O_END = O_SIS + (size_t)NSL * DBATCH * NGRP * SST;
static_assert(O_END == 35065856, "output size");

constexpr size_t MiB = 1u << 20;
constexpr size_t WS_CTL = 0, CTL_ZERO_BYTES = 64 * 1024;
constexpr size_t WS_WAIN = 2 * MiB;
constexpr size_t WS_WAOUT = WS_WAIN + 50 * MiB;
constexpr size_t WS_WSIN = WS_WAOUT + 16 * MiB;
constexpr size_t WS_WGLU = WS_WSIN + 32 * MiB;
constexpr size_t WS_WSOUT = WS_WGLU + 16 * MiB;
constexpr size_t WS_WPG = WS_WSOUT + 16 * MiB;
constexpr size_t WS_WPP = WS_WPG + 32 * MiB;
constexpr size_t WS_H = WS_WPP + 4 * MiB;
constexpr size_t WS_HBA = WS_H + 66 * MiB, WS_HBB = WS_HBA + 33 * MiB;
constexpr size_t WS_PB = WS_HBB + 33 * MiB;
constexpr size_t PB_STRIDE = (size_t)MPAD * PLE * 2;
constexpr size_t WS_QB = WS_PB + 17 * MiB;
constexpr size_t WS_KB = WS_QB + 33 * MiB, WS_VB = WS_KB + 9 * MiB;
constexpr size_t WS_GB = WS_VB + 9 * MiB;
constexpr size_t WS_QIB = WS_GB + 33 * MiB;
constexpr size_t WS_KIB = WS_QIB + 17 * MiB;
constexpr size_t WS_WI = WS_KIB + 2 * MiB;
constexpr size_t WS_AOB = WS_WI + 1 * MiB;
constexpr size_t WS_UG = WS_AOB + 33 * MiB;
constexpr size_t WS_US = WS_UG + 32 * MiB;
constexpr size_t WS_YB = WS_US + 1 * MiB;
constexpr size_t WS_RSTD = WS_YB + 33 * MiB;
constexpr size_t WS_C = WS_RSTD + 1 * MiB;
constexpr size_t WS_C2 = WS_C + 207 * MiB;
constexpr size_t WS_SC = WS_C2 + 66 * MiB;
constexpr int SC_LD = SEQ + 64;
constexpr size_t WS_SCS = WS_SC + 130 * MiB;
constexpr int SCS_LD = 16400;
constexpr size_t WS_SEL = WS_SCS + 3 * MiB;
constexpr size_t WS_KM = WS_SEL + 9 * MiB;
constexpr size_t WS_END = WS_KM + 4 * MiB;
constexpr int CW_BAR = 4096;

constexpr int LDS_BYTES = 147456;
constexpr int MISC_OFF = 131072 + 320;

#define GAS __attribute__((address_space(1)))
#define LAS __attribute__((address_space(3)))
typedef unsigned short bf16;
typedef unsigned v4u __attribute__((ext_vector_type(4)));
typedef unsigned v2u __attribute__((ext_vector_type(2)));
typedef float f32x4 __attribute__((ext_vector_type(4)));
#define LDS_WAIT() asm volatile("s_waitcnt lgkmcnt(0)" ::: "memory")
__device__ __forceinline__ int lane_id_fresh() { unsigned ones = ~0u; asm volatile("" : "+s"(ones)); return (int)__builtin_amdgcn_mbcnt_hi(ones, __builtin_amdgcn_mbcnt_lo(ones, 0u)); }
__device__ __forceinline__ unsigned f2bf(float f) { unsigned u = __builtin_bit_cast(unsigned, f); return (u + 0x7fffu + ((u >> 16) & 1u)) >> 16; }
__device__ __forceinline__ unsigned pk2(float lo, float hi) { return f2bf(lo) | (f2bf(hi) << 16); }
__device__ __forceinline__ float bf2f(unsigned short b) { return __builtin_bit_cast(float, ((unsigned)b) << 16); }
__device__ __forceinline__ float bflo(unsigned w) { return __builtin_bit_cast(float, w << 16); }
__device__ __forceinline__ float bfhi(unsigned w) { return __builtin_bit_cast(float, w & 0xffff0000u); }
__device__ __forceinline__ float sigmoidf_(float x) { return 1.0f / (1.0f + __expf(-x)); }
__device__ __forceinline__ float siluf_(float x) { return x * sigmoidf_(x); }
__device__ __forceinline__ float gelu_tanh(float x) { const float u = 0.7978845608028654f * (x + 0.044715f * x * x * x); return x * sigmoidf_(2.0f * u); }
__device__ __forceinline__ float wave_sum(float v) {
#pragma unroll
    for (int o = 1; o < 64; o <<= 1) v += __shfl_xor(v, o);
    return v;
}
__device__ __forceinline__ float* ss_buf(unsigned char* ws, int k);
__device__ __forceinline__ float ss2rstd(float ss);
__device__ __forceinline__ float ss_row_rstd(const float* ssp, int r);
__device__ __forceinline__ int t5_bucket(int n) {
    if (n < 16) return n;
    int b = 16;
    b += (n >= 19) + (n >= 21) + (n >= 24) + (n >= 27) + (n >= 31) + (n >= 35) + (n >= 40) + (n >= 46) + (n >= 52) + (n >= 59) + (n >= 67) + (n >= 77) + (n >= 87) + (n >= 99) + (n >= 113);
    return b;
}

#define XB_TMO      128
#define XB_XCNT(j)  (256  + 64 * (j))
#define XB_XSUB(j)  (1280 + 64 * (j))
#define XB_XGEN(j)  (2304 + 64 * (j))
#define XB_TOP      3328
#define XB_TOPGEN   3392
#define XCD_BAR_WORDS 3456
#define XB_SPIN_CAP (1u << 22)
__device__ __forceinline__ unsigned xb_ld(unsigned* p)              { return __hip_atomic_load(p, __ATOMIC_RELAXED, __HIP_MEMORY_SCOPE_AGENT); }
__device__ __forceinline__ unsigned xb_add(unsigned* p, unsigned v) { return __hip_atomic_fetch_add(p, v, __ATOMIC_RELAXED, __HIP_MEMORY_SCOPE_AGENT); }
__device__ __forceinline__ unsigned xb_xcc_id() { return (unsigned)__builtin_amdgcn_s_getreg((3 << 11) | 20) & 0xFu; }
#define XB_SPIN(cond, bar) do { unsigned _sp = 0; while (cond) { __builtin_amdgcn_s_sleep(1); \
    if ((++_sp & 255u) == 0u) { if (xb_ld(&(bar)[XB_TMO])) break; if (_sp > XB_SPIN_CAP) { atomicAdd(&(bar)[XB_TMO], 1u); break; } } } } while (0)
struct XcdBarrier { unsigned* bar; unsigned x; volatile LAS unsigned* st; };
__device__ __forceinline__ XcdBarrier xcd_barrier_post(unsigned* bar, volatile LAS unsigned* st, int wv) {
    XcdBarrier b; b.bar = bar; b.x = xb_xcc_id(); b.st = st;
    if (wv == 0 && lane_id_fresh() == 0) (void)xb_add(&bar[XB_XCNT(b.x)], 1u);
    return b;
}
__device__ __forceinline__ void xcd_barrier_complete(unsigned* bar, unsigned x, unsigned& nloc, unsigned& nx) {
    const unsigned G = gridDim.x * gridDim.y * gridDim.z;
    unsigned sum, cnt, mine, sp = 0u;
    for (;;) {
        sum = 0u; cnt = 0u; mine = 0u;
#pragma unroll
        for (unsigned j = 0; j < 16; ++j) { const unsigned c = xb_ld(&bar[XB_XCNT(j)]); sum += c; cnt += (c > 0u) ? 1u : 0u; mine = (j == x) ? c : mine; }
        if (sum == G) break;
        __builtin_amdgcn_s_sleep(1);
        if ((++sp & 255u) == 0u) { if (xb_ld(&bar[XB_TMO])) break; if (sp > XB_SPIN_CAP) { atomicAdd(&bar[XB_TMO], 1u); break; } }
    }
    nloc = mine > 0u ? mine : 1u; nx = cnt > 0u ? cnt : 1u;
}
__device__ __forceinline__ void xcd_barrier(const XcdBarrier& b, int wv) {
    asm volatile("s_waitcnt vmcnt(0)" ::: "memory");
    __syncthreads();
    if (wv == 0 && lane_id_fresh() == 0) {
        unsigned* bar = b.bar;
        __builtin_amdgcn_s_waitcnt(0);
        unsigned nloc = b.st[0], nx = b.st[1];
        if (nloc == 0u) { xcd_barrier_complete(bar, b.x, nloc, nx); b.st[0] = nloc; b.st[1] = nx; }
        const unsigned old = xb_add(&bar[XB_XSUB(b.x)], 1u);
        const unsigned gen = old / nloc;
        if (old + 1u == (gen + 1u) * nloc) {
            __builtin_amdgcn_fence(__ATOMIC_RELEASE, "agent");
            asm volatile("s_waitcnt vmcnt(0)" ::: "memory");
            const unsigned og = xb_add(&bar[XB_TOP], 1u);
            const unsigned tg = og / nx;
            if (og + 1u == (tg + 1u) * nx) xb_add(&bar[XB_TOPGEN], 1u);
            else XB_SPIN(xb_ld(&bar[XB_TOPGEN]) == tg, bar);
            __builtin_amdgcn_fence(__ATOMIC_ACQUIRE, "agent");
            xb_add(&bar[XB_XGEN(b.x)], 1u);
            asm volatile("s_waitcnt vmcnt(0)" ::: "memory");
        } else {
            XB_SPIN(xb_ld(&bar[XB_XGEN(b.x)]) == gen, bar);
            __builtin_amdgcn_fence(__ATOMIC_ACQUIRE, "agent");
            asm volatile("s_waitcnt vmcnt(0)" ::: "memory");
        }
    }
    __syncthreads();
}

#if PROF
__device__ __forceinline__ void prof_mark(int id, int wave) {
    extern __shared__ __attribute__((aligned(16))) unsigned char lds_raw[];
    if (blockIdx.x == 0 && wave == 0) { volatile LAS unsigned* M = (volatile LAS unsigned*)((LAS unsigned char*)lds_raw + MISC_OFF);
        const unsigned long long tn = __builtin_amdgcn_s_memrealtime(); const unsigned long long tp = ((unsigned long long)M[17] << 32) | M[16]; const unsigned d = (unsigned)(tn - tp);
        if (PROF_MATCH_A(id)) M[18] = M[18] + d; if (PROF_MATCH_B(id)) M[19] = M[19] + d; M[16] = (unsigned)tn; M[17] = (unsigned)(tn >> 32); }
}
#define PMARK(id, wave) prof_mark(id, wave)
#else
#define PMARK(id, wave) do {} while (0)
#endif
struct Args { const void* in[N_IN]; float* out; unsigned char* ws; int ph_lo, ph_hi; };
typedef const __attribute__((address_space(4))) Args* ArgP;
#define TID_LOCAL() ArgP a = a_; asm volatile("" : "+s"(a)); const int wave = wv_; const int lane = lane_id_fresh(); int tid = wave * 64 + lane; asm volatile("" : "+v"(tid)); const int gw = blockIdx.x * NWAVES + wave, NGW = gridDim.x * NWAVES; (void)lane; (void)wave; (void)gw; (void)NGW
#define GTID_LOCAL() const size_t gtid = (size_t)blockIdx.x * NTHR + tid, GT = (size_t)gridDim.x * NTHR

__device__ __forceinline__ void transpose_item(const float* W, int K, int N, const float* scale, bf16* WT, LAS float* scr, int item, int lane) {
    const int nblk = (N + 31) / 32, kb = item / nblk, nb = item % nblk, k0 = 64 * kb, n0 = 32 * nb;
    const int n = n0 + (lane & 31); const float* wp = W + (size_t)(k0 + (lane >> 5)) * N + n;
    float v[32];
#pragma unroll
    for (int i = 0; i < 32; ++i) v[i] = (n < N) ? wp[(size_t)(2 * i) * N] : 0.f;
#pragma unroll
    for (int i = 0; i < 32; ++i) scr[(2 * i + (lane >> 5)) * 33 + (lane & 31)] = v[i];
    LDS_WAIT(); asm volatile("" ::: "memory");
    const int c = lane & 7;
    f32x4 s0 = {1.f, 1.f, 1.f, 1.f}, s1 = {1.f, 1.f, 1.f, 1.f};
    if (scale) { s0 = *(const f32x4*)(scale + k0 + 8 * c); s1 = *(const f32x4*)(scale + k0 + 8 * c + 4); }
#pragma unroll
    for (int j = 0; j < 4; ++j) { const int nn = (lane >> 3) + 8 * j; const LAS float* s = scr + (8 * c) * 33 + nn;
        v4u o; o.x = pk2(s[0 * 33] * s0[0], s[1 * 33] * s0[1]); o.y = pk2(s[2 * 33] * s0[2], s[3 * 33] * s0[3]); o.z = pk2(s[4 * 33] * s1[0], s[5 * 33] * s1[1]); o.w = pk2(s[6 * 33] * s1[2], s[7 * 33] * s1[3]);
        *(v4u*)(WT + (size_t)(n0 + nn) * K + k0 + 8 * c) = o; }
    LDS_WAIT(); asm volatile("" ::: "memory");
}

__device__ __forceinline__ void ph_prologue(ArgP a_, LAS unsigned char* lds, int wv_) {
    TID_LOCAL();
    LAS float* scr = (LAS float*)(lds + wave * 16384);
    unsigned char* ws = a->ws;
    for (int m = 0; m < 18; ++m) {
        const float* W; int K = DM, N = DM; const float* sc = nullptr; bf16* WT;
        if (m < 2)       { W = (const float*)a->in[I_AWI] + (size_t)m * DM * ACOLS; N = ACOLS; sc = (const float*)a->in[I_NW] + (size_t)(2 * m) * DM; WT = (bf16*)(ws + WS_WAIN) + (size_t)m * ACOLS_PAD * DM; }
        else if (m < 4)  { const int l = m - 2; W = (const float*)a->in[I_AWO] + (size_t)l * DM * DM; WT = (bf16*)(ws + WS_WAOUT) + (size_t)l * DM * DM; }
        else if (m < 6)  { const int l = m - 4; W = (const float*)a->in[I_SWI] + (size_t)l * DM * 4096; N = 4096; sc = (const float*)a->in[I_NW] + (size_t)(2 * l + 1) * DM; WT = (bf16*)(ws + WS_WSIN) + (size_t)l * 4096 * DM; }
        else if (m < 8)  { const int l = m - 6; W = (const float*)a->in[I_WGLU] + (size_t)l * DM * DM; WT = (bf16*)(ws + WS_WGLU) + (size_t)l * DM * DM; }
        else if (m < 10) { const int l = m - 8; W = (const float*)a->in[I_SWO] + (size_t)l * DM * DM; WT = (bf16*)(ws + WS_WSOUT) + (size_t)l * DM * DM; }
        else if (m < 14) { const int i = m - 10; W = (const float*)a->in[I_PWG] + (size_t)i * DM * DM; sc = (const float*)a->in[I_PNW] + (size_t)i * DM; WT = (bf16*)(ws + WS_WPG) + (size_t)i * DM * DM; }
        else             { const int i = m - 14; W = (const float*)a->in[I_PWP] + (size_t)i * PLE * DM; K = PLE; WT = (bf16*)(ws + WS_WPP) + (size_t)i * DM * PLE; }
        const int nitems = (K / 64) * ((N + 31) / 32);
        for (int it = gw; it < nitems; it += NGW) transpose_item(W, K, N, sc, WT, scr, it, lane);
    }
    bf16* Hb = (bf16*)(ws + WS_HBA);
    for (int r = gw; r < MR; r += NGW) {
        const float* src = (r < MP) ? (const float*)a->in[I_XP] + (size_t)r * DM : (const float*)a->in[I_XS] + (size_t)(r - MP) * DM;
        float ssq = 0.f;
#pragma unroll
        for (int j = 0; j < 8; ++j) { const int c = (j * 64 + lane) * 4; const f32x4 v = *(const f32x4*)(src + c); ssq += v[0] * v[0] + v[1] * v[1] + v[2] * v[2] + v[3] * v[3];
            v2u o; o.x = pk2(v[0], v[1]); o.y = pk2(v[2], v[3]); *(v2u*)(Hb + (size_t)r * DM + c) = o; }
        ssq = wave_sum(ssq);
        if (r < MP) { if (lane < 32) ss_buf(ws, 0)[(size_t)r * 32 + lane] = (lane == 0) ? ssq : 0.f; }
        else { float* sp = ss_buf(ws, 0) + (size_t)MPAD * 32 + (size_t)(r - MP) * 128; sp[lane] = (lane == 0) ? ssq : 0.f; sp[64 + lane] = 0.f; }
    }
    for (int q = gw; q < DEPTH * MR; q += NGW) { const int i = q / MR, r = q % MR;
        const float* src = (r < MP) ? (const float*)a->in[I_PP] + ((size_t)i * MP + r) * PLE : (const float*)a->in[I_PS] + ((size_t)i * MS + (r - MP)) * PLE;
        const f32x4 v = *(const f32x4*)(src + lane * 4); v2u o; o.x = pk2(v[0], v[1]); o.y = pk2(v[2], v[3]);
        *(v2u*)((bf16*)(ws + WS_PB + (size_t)i * PB_STRIDE) + (size_t)r * PLE + lane * 4) = o; }
}

__device__ __forceinline__ void ph_rowstat(ArgP a_, int wv_) {
    TID_LOCAL();
    const float* H = (const float*)(a->ws + WS_H); float* rstd = (float*)(a->ws + WS_RSTD);
    for (int r = gw; r < MR; r += NGW) { float s = 0.f;
#pragma unroll
        for (int j = 0; j < 8; ++j) { const f32x4 v = *(const f32x4*)(H + (size_t)r * DM + (j * 64 + lane) * 4); s += v[0] * v[0] + v[1] * v[1] + v[2] * v[2] + v[3] * v[3]; }
        s = wave_sum(s); if (lane == 0) rstd[r] = 1.0f / sqrtf(s * (1.0f / DM) + RMS_EPS); }
}

__device__ __forceinline__ void ph_epi_attn_in(ArgP a_, int l, int wv_) {
    TID_LOCAL(); GTID_LOCAL();
    unsigned char* ws = a->ws; const float* C = (const float*)(ws + WS_C); const float* rstd = (const float*)(ws + WS_RSTD);
    constexpr int NG4 = ACOLS / 4;
    for (size_t e = gtid; e < (size_t)MR * NG4; e += GT) { const int r = (int)(e / NG4), c = (int)(e % NG4) * 4;
        f32x4 v = *(const f32x4*)(C + (size_t)r * ACOLS_PAD + c); const float rs = rstd[r]; v = v * rs;
        if (c < C_K) { v = v * QSCALE; v2u o; o.x = pk2(v[0], v[1]); o.y = pk2(v[2], v[3]); *(v2u*)((bf16*)(ws + WS_QB) + (size_t)r * 2048 + c) = o; }
        else if (c < C_G) { const bool isv = c >= C_V; const int cc = c - (isv ? C_V : C_K);
            float* o32 = a->out + (r < MP ? (isv ? O_VP : O_KP) + ((size_t)l * MP + r) * 512 : (isv ? O_VS : O_KS) + ((size_t)l * MS + (r - MP)) * 512) + cc;
            *(f32x4*)o32 = v; v2u o; o.x = pk2(v[0], v[1]); o.y = pk2(v[2], v[3]); *(v2u*)((bf16*)(ws + (isv ? WS_VB : WS_KB)) + (size_t)r * 512 + cc) = o; }
        else if (c < C_QI) { v2u o; o.x = pk2(siluf_(v[0]), siluf_(v[1])); o.y = pk2(siluf_(v[2]), siluf_(v[3])); *(v2u*)((bf16*)(ws + WS_GB) + (size_t)r * 2048 + (c - C_G)) = o; }
        else if (c < C_KI) { v2u o; o.x = pk2(v[0], v[1]); o.y = pk2(v[2], v[3]); *(v2u*)((bf16*)(ws + WS_QIB) + (size_t)r * 1024 + (c - C_QI)) = o; }
        else if (c < C_WI) { const int cc = c - C_KI; float* o32 = a->out + (r < MP ? O_KIP + ((size_t)l * MP + r) * 64 : O_KIS + ((size_t)l * MS + (r - MP)) * 64) + cc;
            *(f32x4*)o32 = v; v2u o; o.x = pk2(v[0], v[1]); o.y = pk2(v[2], v[3]); *(v2u*)((bf16*)(ws + WS_KIB) + (size_t)r * 64 + cc) = o; }
        else { *(f32x4*)((float*)(ws + WS_WI) + (size_t)r * 16 + (c - C_WI)) = v * WISCALE; }
    }
}


typedef short bf16x8v __attribute__((ext_vector_type(8)));
__device__ __forceinline__ float relu_i(float x) { const int b = __builtin_bit_cast(int, x); return __builtin_bit_cast(float, b > 0 ? b : 0); }
__device__ __forceinline__ unsigned mono_key(float x) { const unsigned b = __builtin_bit_cast(unsigned, x); return b ^ ((unsigned)((int)b >> 31) | 0x80000000u); }
__device__ __forceinline__ int wave_sum_i(int v) {
#pragma unroll
    for (int o = 1; o < 64; o <<= 1) v += __shfl_xor(v, o);
    return v;
}
__device__ __forceinline__ int lane_prefix(unsigned long long m) { return (int)__builtin_amdgcn_mbcnt_hi((unsigned)(m >> 32), __builtin_amdgcn_mbcnt_lo((unsigned)m, 0u)); }
constexpr size_t KM_WORDS = (size_t)NBATCH * 128 * 64 * 32;

__device__ __forceinline__ int cnt_ge4(const v4u k, unsigned cand) { return __popcll(__ballot(k.x >= cand)) + __popcll(__ballot(k.y >= cand)) + __popcll(__ballot(k.z >= cand)) + __popcll(__ballot(k.w >= cand)); }
__device__ __forceinline__ void sel_load(const float* sc, int n, int lane, f32x4 (&v)[16]) {
#pragma unroll
    for (int ch = 0; ch < 16; ++ch) { const int i0 = ch * 256 + 4 * lane; f32x4 t = {0.f, 0.f, 0.f, 0.f}; if (ch * 256 < n) t = *(const f32x4*)(sc + i0); v[ch] = t; }
}
__device__ __forceinline__ void sel_store(const f32x4 (&v)[16], int n, int lane, LAS unsigned* ldsk) {
#pragma unroll
    for (int ch = 0; ch < 16; ++ch) { const int i0 = ch * 256 + 4 * lane;
        v4u k; k.x = (i0 < n) ? mono_key(v[ch][0]) : 0u; k.y = (i0 + 1 < n) ? mono_key(v[ch][1]) : 0u; k.z = (i0 + 2 < n) ? mono_key(v[ch][2]) : 0u; k.w = (i0 + 3 < n) ? mono_key(v[ch][3]) : 0u;
        *(LAS v4u*)(ldsk + i0) = k; }
}
__device__ __forceinline__ void select_core(int n, int lane, LAS unsigned* ldsk, LAS unsigned long long* mrow) {
    const int nc = (n + 255) >> 8, ne = (n + 63) >> 6, ng = (nc + 3) >> 2;
    unsigned T = 0u; int need = TOPK, toteq = 0;
    if (n > TOPK) {
        for (int bit = 31; bit >= 0; --bit) { const unsigned cand = T | (1u << bit); int c = 0;
            for (int g4 = 0; g4 < ng; ++g4) { const LAS v4u* p = (const LAS v4u*)(ldsk + g4 * 1024 + lane * 4); const v4u k0 = p[0], k1 = p[64], k2 = p[128], k3 = p[192];
                c += cnt_ge4(k0, cand) + cnt_ge4(k1, cand) + cnt_ge4(k2, cand) + cnt_ge4(k3, cand); }
            if (c >= TOPK) { T = cand; if (c == TOPK) break; } }
        int cg = 0, ce = 0;
        for (int ch = 0; ch < nc; ++ch) { const v4u k = *(const LAS v4u*)(ldsk + ch * 256 + lane * 4);
            cg += __popcll(__ballot(k.x > T)) + __popcll(__ballot(k.y > T)) + __popcll(__ballot(k.z > T)) + __popcll(__ballot(k.w > T));
            ce += __popcll(__ballot(k.x == T)) + __popcll(__ballot(k.y == T)) + __popcll(__ballot(k.z == T)) + __popcll(__ballot(k.w == T)); }
        need = TOPK - cg;
        toteq = ce;
    }
    const bool all_eq = (toteq <= need);
    int base_eq = 0;
    for (int e0 = 0; e0 < ne; e0 += 4) {
        unsigned kk[4];
#pragma unroll
        for (int u = 0; u < 4; ++u) kk[u] = ldsk[(e0 + u) * 64 + lane];
#pragma unroll
        for (int u = 0; u < 4; ++u) { const int e = e0 + u; const int idx = e * 64 + lane; const unsigned k = kk[u]; const bool valid = idx < n; bool s;
            if (n <= TOPK) s = valid;
            else if (all_eq) s = valid && k >= T;
            else { const bool eq = valid && k == T; const unsigned long long em = __ballot(eq); s = valid && (k > T || (eq && base_eq + lane_prefix(em) < need)); base_eq += __popcll(em); }
            const unsigned long long sm = __ballot(s);
            if (lane == 0 && e < ne) mrow[e * 16] = sm; }
    }
}

__device__ __forceinline__ void ph_idx(ArgP a_, int l, LAS unsigned char* lds, int wv_) {
    TID_LOCAL();
    unsigned char* ws = a->ws;
    const bf16* QIb = (const bf16*)(ws + WS_QIB); const bf16* KIb = (const bf16*)(ws + WS_KIB); const float* WI = (const float*)(ws + WS_WI);
    unsigned long long* KM = (unsigned long long*)(ws + WS_KM);
    for (int vb = blockIdx.x; vb < 256; vb += gridDim.x) {
        const int b = vb >> 7, x = vb & 127;
        int ln = lane; asm volatile("" : "+v"(ln)); const int fr = ln & 15, kg = ln >> 4, qi = fr & 7, hh = fr >> 3;
        LAS unsigned long long* msk = (LAS unsigned long long*)(lds + 132096);
        LAS unsigned* ldsk = (LAS unsigned*)(lds + wave * 16384);
        for (int rnd = 0; rnd < 4; ++rnd) {
            const int qt = (rnd & 2) ? 255 - x : x, qbase = qt * 16 + (rnd & 1) * 8;
            const int nrow = qbase + wave + 1;
            { const int ngk = ((((nrow + 255) >> 8) + 3) >> 2) * 1024; for (int i = (qt + 1) * 16 + lane * 4; i < ngk; i += 256) *(LAS v4u*)(ldsk + i) = (v4u){0u, 0u, 0u, 0u}; }
            const int tq = qbase + qi; const size_t qrow = (size_t)b * SEQ + tq;
            bf16x8v Bq[8][2]; float w[8];
#pragma unroll
            for (int it = 0; it < 8; ++it) { const int h = hh * 8 + it; Bq[it][0] = *(const bf16x8v*)(QIb + qrow * 1024 + h * 64 + kg * 8); Bq[it][1] = *(const bf16x8v*)(QIb + qrow * 1024 + h * 64 + 32 + kg * 8); w[it] = WI[qrow * 16 + h]; }
            const bf16* kbase = KIb + ((size_t)b * SEQ + fr) * 64 + kg * 8;
            bf16x8v A0 = {0, 0, 0, 0, 0, 0, 0, 0}, A1 = A0, N0 = A0, N1 = A0;
            if (wave <= qt) { A0 = *(const bf16x8v*)(kbase + (size_t)wave * 1024); A1 = *(const bf16x8v*)(kbase + (size_t)wave * 1024 + 32); }
            if (wave + NWAVES <= qt) { N0 = *(const bf16x8v*)(kbase + (size_t)(wave + NWAVES) * 1024); N1 = *(const bf16x8v*)(kbase + (size_t)(wave + NWAVES) * 1024 + 32); }
            LAS unsigned* rowp = (LAS unsigned*)(lds + qi * 16384) + kg * 4;
            for (int kt = wave; kt <= qt; kt += NWAVES) {
                bf16x8v M0 = N0, M1 = N1;
                if (kt + 2 * NWAVES <= qt) { M0 = *(const bf16x8v*)(kbase + (size_t)(kt + 2 * NWAVES) * 1024); M1 = *(const bf16x8v*)(kbase + (size_t)(kt + 2 * NWAVES) * 1024 + 32); }
                f32x4 S = {0.f, 0.f, 0.f, 0.f};
#pragma unroll
                for (int it = 0; it < 8; ++it) { f32x4 acc = {0.f, 0.f, 0.f, 0.f};
                    acc = __builtin_amdgcn_mfma_f32_16x16x32_bf16(A0, Bq[it][0], acc, 0, 0, 0); acc = __builtin_amdgcn_mfma_f32_16x16x32_bf16(A1, Bq[it][1], acc, 0, 0, 0);
#pragma unroll
                    for (int j = 0; j < 4; ++j) { const float a_ = acc[j]; S[j] += w[it] * relu_i(a_); } }
                v4u kk;
#pragma unroll
                for (int j = 0; j < 4; ++j) { const float o_ = S[j]; const float s_ = o_ + __builtin_bit_cast(float, __builtin_amdgcn_update_dpp(0, __builtin_bit_cast(int, o_), 0x108, 0xF, 0xF, true));
                    const unsigned key_ = (kt * 16 + kg * 4 + j <= tq) ? mono_key(s_) : 0u; if (j == 0) kk.x = key_; else if (j == 1) kk.y = key_; else if (j == 2) kk.z = key_; else kk.w = key_; }
                if (hh == 0) *(LAS v4u*)(rowp + kt * 16) = kk;
                A0 = N0; A1 = N1; N0 = M0; N1 = M1;
            }
            LDS_WAIT(); __syncthreads();
            select_core(nrow, lane, ldsk, msk + ((rnd & 2) ? ((x >> 2) + 1) * 16 : 0) + (rnd & 1) * 8 + wave);
            __syncthreads();
        }
        { const int ne0 = (x >> 2) + 1, ne1 = ((255 - x) >> 2) + 1;
          for (int i = tid; i < (ne0 + ne1) * 16; i += NTHR) { const int h2 = i >= ne0 * 16, ii = i - (h2 ? ne0 * 16 : 0), e = ii >> 4, tr = ii & 15; const int qt = h2 ? 255 - x : x;
              KM[(((size_t)b * 128 + (qt >> 1)) * 64 + e) * 32 + (qt & 1) * 16 + tr] = msk[i]; } }
        __syncthreads(); PMARK(4, wave);
    }
}


namespace att {
using bf16x8 = __attribute__((ext_vector_type(8))) short;
using s16x4  = __attribute__((ext_vector_type(4))) short;
using f32x16 = __attribute__((ext_vector_type(16))) float;
constexpr int KVBLK = 64;
constexpr int SHM_V = KVBLK * 128 * 2, SHM_K = KVBLK * 128 * 2;
constexpr float THR2 = 8.0f;
#define ATT_SDEPTH 1
#define ATT_KSWZ(row, colB) ((row) * 256 + ((colB) ^ (((row) & 7) << 4)))
#define ATT_SBAR() __builtin_amdgcn_sched_barrier(0)
__device__ __forceinline__ int crow(int r, int hi) { return (r & 3) + 8 * (r >> 2) + 4 * hi; }
__device__ __forceinline__ unsigned cvtpk(float lo, float hi) { unsigned r; asm volatile("v_cvt_pk_bf16_f32 %0, %1, %2" : "=v"(r) : "v"(lo), "v"(hi)); return r; }
__device__ __forceinline__ int v_st(int k, int c) { const int kk = (k & ~0xC) | ((k & 4) << 1) | ((k & 8) >> 1); return ((kk >> 3) * 4 + (c >> 5)) * 512 + ((kk & 7) * 32 + (c & 31)) * 2; }
__device__ __forceinline__ int v_rd_base(int lane) { return ((lane & 3) << 3) | (((lane >> 2) & 3) << 6) | (((lane >> 4) & 1) << 5) | (((lane >> 5) & 1) << 8); }
constexpr int v_rd_off(int d0, int ks, int half) { return d0 * 512 + ks * 4096 + half * 2048; }
template <int OFF> __device__ __forceinline__ s16x4 tr_read(int vb) { s16x4 r; asm volatile("ds_read_b64_tr_b16 %0, %1 offset:%2" : "=&v"(r) : "v"(vb), "i"(OFF) : "memory"); return r; }

__device__ __forceinline__ void partialSM(f32x16& p0, f32x16& p1, float& m_reg, float& mn, float& alpha) {
    float pmax = p0[0];
#pragma unroll
    for (int r = 1; r < 16; ++r) pmax = fmaxf(pmax, p0[r]);
#pragma unroll
    for (int r = 0; r < 16; ++r) pmax = fmaxf(pmax, p1[r]);
    { auto rr = __builtin_amdgcn_permlane32_swap(__builtin_bit_cast(unsigned, pmax), __builtin_bit_cast(unsigned, pmax), false, false);
      const unsigned u0 = rr[0], u1 = rr[1]; pmax = fmaxf(__builtin_bit_cast(float, u0), __builtin_bit_cast(float, u1)); }
    if (__builtin_expect(__all(pmax - m_reg <= THR2), 1)) { mn = m_reg; alpha = 1.f; }
    else { mn = fmaxf(m_reg, pmax); alpha = __builtin_amdgcn_exp2f(m_reg - mn); m_reg = mn; }
#pragma unroll
    for (int r = 0; r < 16; ++r) p0[r] = __builtin_amdgcn_exp2f(p0[r] - mn);
#pragma unroll
    for (int r = 0; r < 16; ++r) p1[r] = p1[r] - mn;
}
__device__ __forceinline__ void finishSM(f32x16& p0, f32x16& p1, float alpha, float& l_reg, unsigned long long mk, int hi, bf16x8& pa0, bf16x8& pa1, bf16x8& pa2, bf16x8& pa3) {
#pragma unroll
    for (int r = 0; r < 16; ++r) p1[r] = __builtin_amdgcn_exp2f(p1[r]);
    const unsigned w0 = (unsigned)mk >> (4 * hi), w1 = (unsigned)(mk >> 32) >> (4 * hi);
#pragma unroll
    for (int r = 0; r < 16; ++r) { const int pos = (r & 3) + 8 * (r >> 2);
        const float a0 = p0[r], a1 = p1[r];
        p0[r] = __builtin_bit_cast(float, __builtin_bit_cast(unsigned, a0) & (unsigned)__builtin_amdgcn_sbfe((int)w0, pos, 1));
        p1[r] = __builtin_bit_cast(float, __builtin_bit_cast(unsigned, a1) & (unsigned)__builtin_amdgcn_sbfe((int)w1, pos, 1)); }
    float ps = 0;
#pragma unroll
    for (int r = 0; r < 16; ++r) ps += p0[r];
#pragma unroll
    for (int r = 0; r < 16; ++r) ps += p1[r];
    { auto rr = __builtin_amdgcn_permlane32_swap(__builtin_bit_cast(unsigned, ps), __builtin_bit_cast(unsigned, ps), false, false);
      const unsigned u0 = rr[0], u1 = rr[1]; ps = __builtin_bit_cast(float, u0) + __builtin_bit_cast(float, u1); }
    l_reg = l_reg * alpha + ps;
#define ATT_PK4(P, BASE, OUT) do { unsigned a0 = cvtpk(P[BASE + 0], P[BASE + 1]), a1 = cvtpk(P[BASE + 2], P[BASE + 3]);   \
    unsigned b0 = cvtpk(P[BASE + 4], P[BASE + 5]), b1 = cvtpk(P[BASE + 6], P[BASE + 7]);                              \
    auto r0 = __builtin_amdgcn_permlane32_swap(a0, b0, false, false); auto r1 = __builtin_amdgcn_permlane32_swap(a1, b1, false, false); \
    v4u w = {r0[0], r1[0], r0[1], r1[1]}; OUT = __builtin_bit_cast(bf16x8, w); } while (0)
    ATT_PK4(p0, 0, pa0); ATT_PK4(p0, 8, pa1); ATT_PK4(p1, 0, pa2); ATT_PK4(p1, 8, pa3);
#undef ATT_PK4
}
__device__ __forceinline__ void qkt(f32x16& p0, f32x16& p1, LAS const char* Ks, const bf16x8* qr, int r32, int hi) {
    p0 = f32x16{}; p1 = f32x16{};
    asm volatile("" : "+v"(r32), "+v"(hi));
#pragma unroll
    for (int d0 = 0; d0 < 8; ++d0) { const int cb = (d0 * 16 + hi * 8) * 2;
        const bf16x8 b0 = *(LAS const bf16x8*)(Ks + ATT_KSWZ(r32, cb));
        const bf16x8 b1 = *(LAS const bf16x8*)(Ks + ATT_KSWZ(32 + r32, cb));
        p0 = __builtin_amdgcn_mfma_f32_32x32x16_bf16(b0, qr[d0], p0, 0, 0, 0);
        p1 = __builtin_amdgcn_mfma_f32_32x32x16_bf16(b1, qr[d0], p1, 0, 0, 0); }
}
template <int D0> __device__ __forceinline__ void pv_one(f32x16& od, int vb, bf16x8 pa0, bf16x8 pa1, bf16x8 pa2, bf16x8 pa3) {
    const s16x4 l0 = tr_read<v_rd_off(D0, 0, 0)>(vb), h0 = tr_read<v_rd_off(D0, 0, 1)>(vb), l1 = tr_read<v_rd_off(D0, 1, 0)>(vb), h1 = tr_read<v_rd_off(D0, 1, 1)>(vb);
    const s16x4 l2 = tr_read<v_rd_off(D0, 2, 0)>(vb), h2 = tr_read<v_rd_off(D0, 2, 1)>(vb), l3 = tr_read<v_rd_off(D0, 3, 0)>(vb), h3 = tr_read<v_rd_off(D0, 3, 1)>(vb);
    asm volatile("s_waitcnt lgkmcnt(0)" ::: "memory"); ATT_SBAR();
#define ATT_PK(L, H) (bf16x8){L[0], L[1], L[2], L[3], H[0], H[1], H[2], H[3]}
    od = __builtin_amdgcn_mfma_f32_32x32x16_bf16(pa0, ATT_PK(l0, h0), od, 0, 0, 0);
    od = __builtin_amdgcn_mfma_f32_32x32x16_bf16(pa1, ATT_PK(l1, h1), od, 0, 0, 0);
    od = __builtin_amdgcn_mfma_f32_32x32x16_bf16(pa2, ATT_PK(l2, h2), od, 0, 0, 0);
    od = __builtin_amdgcn_mfma_f32_32x32x16_bf16(pa3, ATT_PK(l3, h3), od, 0, 0, 0);
#undef ATT_PK
}
__device__ __forceinline__ void pv_d0(f32x16* o, int vb, bf16x8 pa0, bf16x8 pa1, bf16x8 pa2, bf16x8 pa3) {
    pv_one<0>(o[0], vb, pa0, pa1, pa2, pa3); pv_one<1>(o[1], vb, pa0, pa1, pa2, pa3); pv_one<2>(o[2], vb, pa0, pa1, pa2, pa3); pv_one<3>(o[3], vb, pa0, pa1, pa2, pa3);
}
__device__ __forceinline__ void add_bias(f32x16& p0, f32x16& p1, LAS const float* bt2, int dq) {
    LAS const float* p = bt2 + (255 - dq);
#pragma unroll
    for (int r = 0; r < 16; ++r) { const int c = (r & 3) + 8 * (r >> 2); p0[r] += p[c]; p1[r] += p[c + 32]; }
}
}

__device__ __forceinline__ void ph_attn(ArgP a_, LAS unsigned char* ldsb, int wv_) {
    using namespace att;
    TID_LOCAL();
    unsigned char* ws = a->ws;
    const bf16* Qb = (const bf16*)(ws + WS_QB); const bf16* Kb = (const bf16*)(ws + WS_KB); const bf16* Vb = (const bf16*)(ws + WS_VB); const bf16* Gb = (const bf16*)(ws + WS_GB);
    bf16* AOb = (bf16*)(ws + WS_AOB); const unsigned long long* KM = (const unsigned long long*)(ws + WS_KM); const float* rb = (const float*)a->in[I_RB];
    LAS char* lds = (LAS char*)ldsb; LAS char* V_lds = lds; LAS char* K_lds = lds + 2 * SHM_V;
    LAS float* wsf = (LAS float*)(lds + 65536) + wave * 64; LAS float* li_l = wsf; LAS float* al_l = wsf + 32;
    LAS float* btab = (LAS float*)(lds + 65536 + 2048);
    const int r32 = lane & 31, hi = lane >> 5, rh = wave & 3, qs = wave >> 2;
    const int sr = tid >> 4, sc = (tid & 15) * 8, vst0 = v_st(sr, sc), kst0 = ATT_KSWZ(sr, sc * 2);
    const int vb0 = (int)(unsigned)(size_t)V_lds + v_rd_base(lane);
    constexpr int LDK = 512;
    for (int vbk = blockIdx.x; vbk < 256; vbk += gridDim.x) {
        const int b = vbk >> 7, g = (vbk >> 5) & 3, x = vbk & 31, h = g * 4 + rh;
        __syncthreads();
        for (int i = tid; i < 4 * 384; i += NTHR) { const int rr = i / 384, d = 255 - (i % 384), hh = g * 4 + rr; btab[i] = (d >= 0 && d < 113) ? (rb[t5_bucket(d) * NH + hh] - rb[31 * NH + hh]) * LOG2E : 0.f; }
        const bf16* Kh = Kb + (size_t)b * SEQ * LDK + g * HD; const bf16* Vh = Vb + (size_t)b * SEQ * LDK + g * HD;
        for (int half = 0; half < 2; ++half) {
            const int jb = half ? 63 - x : x; const int q0w = jb * 64 + qs * 32; const size_t qrow = (size_t)b * SEQ + q0w + r32;
            const int NT = jb + 1, NTp = (NT + 1) & ~1;
            LAS const float* bt = btab + rh * 384;
            float m_reg = -1e30f, l_reg = 0; f32x16 o[4] = {}; bf16x8 qr[8];
            int lq = lane; asm volatile("" : "+v"(lq));
            const bf16* Qw = Qb + ((size_t)b * SEQ + q0w + (lq & 31)) * 2048 + h * HD + (lq >> 5) * 8;
#pragma unroll
            for (int d0 = 0; d0 < 8; ++d0) qr[d0] = *(const bf16x8*)(Qw + d0 * 16);
            struct { bf16x8 vs0, vs1, ks0, ks1; } sr_[ATT_SDEPTH];
            const unsigned toff = (unsigned)(sr * LDK + sc) * 2u;
#define ATT_SLOAD(i, k0) do { const char* vt_ = (const char*)Vh + (size_t)(k0) * (LDK * 2); const char* kt_ = (const char*)Kh + (size_t)(k0) * (LDK * 2); \
    sr_[i].vs0 = *(const bf16x8*)(vt_ + toff); sr_[i].vs1 = *(const bf16x8*)(vt_ + 32 * LDK * 2 + toff); sr_[i].ks0 = *(const bf16x8*)(kt_ + toff); sr_[i].ks1 = *(const bf16x8*)(kt_ + 32 * LDK * 2 + toff); } while (0)
#define ATT_SWRITE(bb, i) do { *(LAS bf16x8*)(V_lds + (bb) * SHM_V + vst0) = sr_[i].vs0; *(LAS bf16x8*)(V_lds + (bb) * SHM_V + vst0 + 8192) = sr_[i].vs1; \
    *(LAS bf16x8*)(K_lds + (bb) * SHM_K + kst0) = sr_[i].ks0; *(LAS bf16x8*)(K_lds + (bb) * SHM_K + kst0 + 8192) = sr_[i].ks1; } while (0)
#define ATT_SWAIT() do { if (ATT_SDEPTH == 2) asm volatile("s_waitcnt vmcnt(4)" ::: "memory"); else asm volatile("s_waitcnt vmcnt(0)" ::: "memory"); } while (0)
#define ATT_RESC(al) do { if (__any((al) < 1.f)) { if (hi == 0) al_l[r32] = (al); asm volatile("s_waitcnt lgkmcnt(0)" ::: "memory"); \
    _Pragma("unroll") for (int d = 0; d < 4; ++d) _Pragma("unroll") for (int r = 0; r < 16; ++r) o[d][r] *= al_l[crow(r, hi)]; } } while (0)
#define ATT_MASK(kt) (((kt) <= jb) ? ((LAS const unsigned long long*)(lds + 73728))[(qs * 64 + (kt)) * 32 + (lane_id_fresh() & 31)] : 0ull)
#define ATT_BIAS(P0, P1, kt) do { if (64 * (kt) + 176 > q0w) { const int le_ = lane_id_fresh(); add_bias(P0, P1, bt, q0w + (le_ & 31) - 4 * (le_ >> 5) - 64 * (kt)); } } while (0)
            f32x16 pA0, pA1, pB0, pB1; float mnA, mnB, alA, alB; bf16x8 pa0, pa1, pa2, pa3;
            constexpr int SE = 0, SO = ATT_SDEPTH - 1;
            __syncthreads();
            { LAS unsigned long long* mks = (LAS unsigned long long*)(lds + 73728);
              const unsigned long long* kg0 = KM + (((size_t)b * 128 + 2 * jb) * 64) * 32; const int nw = (jb + 1) * 32;
              for (int i = wave * 64 + lane_id_fresh(); i < 2 * nw; i += NTHR) { const int q2 = (i >= nw) ? 1 : 0, j2 = i - q2 * nw; mks[q2 * 2048 + j2] = kg0[(size_t)q2 * 2048 + j2]; } }
            ATT_SLOAD(SE, 0); asm volatile("s_waitcnt vmcnt(0)" ::: "memory"); ATT_SWRITE(0, SE); __syncthreads();
            qkt(pA0, pA1, K_lds, qr, r32, hi); ATT_BIAS(pA0, pA1, 0); partialSM(pA0, pA1, m_reg, mnA, alA);
            ATT_SLOAD(SO, KVBLK); if (ATT_SDEPTH == 2 && 2 < NTp) ATT_SLOAD(SE, 2 * KVBLK);
            ATT_SWAIT(); ATT_SWRITE(1, SO); __syncthreads();
            for (int j = 1; j + 1 < NTp; j += 2) {
                ATT_SBAR(); qkt(pB0, pB1, K_lds + SHM_K, qr, r32, hi); ATT_BIAS(pB0, pB1, j);
                finishSM(pA0, pA1, alA, l_reg, ATT_MASK(j - 1), hi, pa0, pa1, pa2, pa3); ATT_SBAR();
                ATT_SLOAD(SO, (j + ATT_SDEPTH) * KVBLK); ATT_SBAR();
                pv_d0(o, vb0, pa0, pa1, pa2, pa3); partialSM(pB0, pB1, m_reg, mnB, alB);
                __syncthreads(); ATT_SWAIT(); ATT_SWRITE(0, SE);
                ATT_RESC(alB); __syncthreads();
                ATT_SBAR(); qkt(pA0, pA1, K_lds, qr, r32, hi); ATT_BIAS(pA0, pA1, j + 1);
                finishSM(pB0, pB1, alB, l_reg, ATT_MASK(j), hi, pa0, pa1, pa2, pa3); ATT_SBAR();
                if (ATT_SDEPTH == 1 || j + 3 < NTp) ATT_SLOAD(SE, (j + 1 + ATT_SDEPTH) * KVBLK); ATT_SBAR();
                pv_d0(o, vb0 + SHM_V, pa0, pa1, pa2, pa3); partialSM(pA0, pA1, m_reg, mnA, alA);
                __syncthreads(); ATT_SWAIT(); ATT_SWRITE(1, SO);
                ATT_RESC(alA); __syncthreads();
            }
            ATT_SBAR(); qkt(pB0, pB1, K_lds + SHM_K, qr, r32, hi); ATT_BIAS(pB0, pB1, NTp - 1);
            finishSM(pA0, pA1, alA, l_reg, ATT_MASK(NTp - 2), hi, pa0, pa1, pa2, pa3); ATT_SBAR();
            pv_d0(o, vb0, pa0, pa1, pa2, pa3); partialSM(pB0, pB1, m_reg, mnB, alB);
            __syncthreads(); ATT_RESC(alB);
            finishSM(pB0, pB1, alB, l_reg, ATT_MASK(NTp - 1), hi, pa0, pa1, pa2, pa3); ATT_SBAR();
            pv_d0(o, vb0 + SHM_V, pa0, pa1, pa2, pa3);
            if (hi == 0) li_l[r32] = l_reg; asm volatile("s_waitcnt lgkmcnt(0)" ::: "memory");
            int lane_e = lane; asm volatile("" : "+v"(lane_e)); const int r32e = lane_e & 31, hie = lane_e >> 5;
#pragma unroll
            for (int r = 0; r < 16; ++r) { const int orow = crow(r, hie); const float rli = __builtin_amdgcn_rcpf(li_l[orow]);
                const size_t ob = ((size_t)b * SEQ + q0w + orow) * 2048 + h * HD + r32e;
#pragma unroll
                for (int d0 = 0; d0 < 4; ++d0) AOb[ob + d0 * 32] = (bf16)f2bf(o[d0][r] * rli * bf2f(Gb[ob + d0 * 32]));
                asm volatile("" ::: "memory"); ATT_SBAR(); }
#undef ATT_SLOAD
#undef ATT_SWRITE
#undef ATT_SWAIT
#undef ATT_RESC
#undef ATT_MASK
#undef ATT_BIAS
        }
    }
}


__device__ __forceinline__ void ph_idx_sample(ArgP a_, int l, int wv_) {
    TID_LOCAL();
    unsigned char* ws = a->ws;
    const bf16* QIb = (const bf16*)(ws + WS_QIB); const bf16* KIb = (const bf16*)(ws + WS_KIB); const float* WI = (const float*)(ws + WS_WI); float* SCS = (float*)(ws + WS_SCS);
    const int* pt = (const int*)a->in[I_PT]; const float* cki = (const float*)a->in[I_CKI] + (size_t)l * NPOOL * PAGE * IDD;
    const int fr = lane & 15, kg = lane >> 4; constexpr int TPB = PAST / 16 + 1, NT = DBATCH * TPB, TPW = 5;
    for (int c0 = gw * TPW; c0 < NT; c0 += NGW * TPW) {
        int curb = -1; bf16x8v Bq[16][2]; float w[16];
        const int cend = (c0 + TPW < NT) ? c0 + TPW : NT;
        f32x4 x0, x1, y0, y1;
        int pg[TPW];
#pragma unroll
        for (int j = 0; j < TPW; ++j) { const int g_ = c0 + j; const int b_ = g_ / TPB, kt_ = g_ % TPB; pg[j] = (g_ < NT && kt_ < PAST / 16) ? pt[b_ * NPAGES + ((kt_ * 16 + fr) >> 7)] : 0; }
#define IDXS_FETCH(gt_) do { const int kt_ = (gt_) % TPB; if (kt_ < PAST / 16) { const int key_ = kt_ * 16 + fr; const int jj_ = (gt_) - c0; \
            const int pgv_ = (jj_ == 0) ? pg[0] : (jj_ == 1) ? pg[1] : (jj_ == 2) ? pg[2] : (jj_ == 3) ? pg[3] : pg[4]; \
            const float* kp_ = cki + ((size_t)pgv_ * PAGE + (key_ & 127)) * IDD + kg * 8; x0 = *(const f32x4*)kp_; x1 = *(const f32x4*)(kp_ + 4); y0 = *(const f32x4*)(kp_ + 32); y1 = *(const f32x4*)(kp_ + 36); } } while (0)
        IDXS_FETCH(c0);
        for (int gt = c0; gt < cend; ++gt) { const int b = gt / TPB, kt = gt % TPB;
            if (b != curb) { curb = b; const size_t qrow = (size_t)MP + b * DSEQ + (fr < DSEQ ? fr : DSEQ - 1);
#pragma unroll
                for (int h = 0; h < 16; ++h) { Bq[h][0] = *(const bf16x8v*)(QIb + qrow * 1024 + h * 64 + kg * 8); Bq[h][1] = *(const bf16x8v*)(QIb + qrow * 1024 + h * 64 + 32 + kg * 8); w[h] = WI[qrow * 16 + h]; } }
            bf16x8v A0, A1;
            if (kt < PAST / 16) { v4u u0, u1; u0.x = pk2(x0[0], x0[1]); u0.y = pk2(x0[2], x0[3]); u0.z = pk2(x1[0], x1[1]); u0.w = pk2(x1[2], x1[3]); u1.x = pk2(y0[0], y0[1]); u1.y = pk2(y0[2], y0[3]); u1.z = pk2(y1[0], y1[1]); u1.w = pk2(y1[2], y1[3]);
                A0 = __builtin_bit_cast(bf16x8v, u0); A1 = __builtin_bit_cast(bf16x8v, u1); }
            else { const bf16* kp = KIb + ((size_t)MP + b * DSEQ + (fr < DSEQ ? fr : DSEQ - 1)) * 64 + kg * 8; A0 = *(const bf16x8v*)kp; A1 = *(const bf16x8v*)(kp + 32); }
            if (gt + 1 < cend) IDXS_FETCH(gt + 1);
            f32x4 S = {0.f, 0.f, 0.f, 0.f};
#pragma unroll
            for (int h = 0; h < 16; ++h) { f32x4 acc = {0.f, 0.f, 0.f, 0.f};
                acc = __builtin_amdgcn_mfma_f32_16x16x32_bf16(A0, Bq[h][0], acc, 0, 0, 0); acc = __builtin_amdgcn_mfma_f32_16x16x32_bf16(A1, Bq[h][1], acc, 0, 0, 0);
#pragma unroll
                for (int j = 0; j < 4; ++j) { const float a_ = acc[j]; S[j] += w[h] * relu_i(a_); } }
            if (fr < DSEQ) *(f32x4*)(SCS + (size_t)(b * DSEQ + fr) * SCS_LD + kt * 16 + kg * 4) = S;
        }
#undef IDXS_FETCH
    }
}
__device__ __forceinline__ void select_block(const float* sc, int n, LAS unsigned* ldsk, LAS int* ldsw, LAS int* sel, int tid, int lane, int wave) {
    const int nc = (n + 2047) >> 11;
    __syncthreads();
    for (int i = tid; i < nc * 2048; i += NTHR) ldsk[i] = (i < n) ? mono_key(sc[i]) : 0u;
    if (tid == 0) ldsw[32] = 0;
    __syncthreads();
    unsigned T = 0u;
    for (int bit = 31; bit >= 0; --bit) { const unsigned cand = T | (1u << bit); int c = 0;
        for (int ch = 0; ch < nc; ++ch) { const v4u k = *(const LAS v4u*)(ldsk + ch * 2048 + tid * 4); c += (k.x >= cand) + (k.y >= cand) + (k.z >= cand) + (k.w >= cand); }
        c = wave_sum_i(c); LAS int* red = ldsw + (bit & 1) * 8; if (lane == 0) red[wave] = c;
        __syncthreads();
        const int tot = ((red[0] + red[1]) + (red[2] + red[3])) + ((red[4] + red[5]) + (red[6] + red[7]));
        if (tot >= TOPK) { T = cand; if (tot == TOPK) break; } }
    int cg = 0, ce = 0;
    for (int ch = 0; ch < nc; ++ch) { const v4u k = *(const LAS v4u*)(ldsk + ch * 2048 + tid * 4); cg += (k.x > T) + (k.y > T) + (k.z > T) + (k.w > T); ce += (k.x == T) + (k.y == T) + (k.z == T) + (k.w == T); }
    cg = wave_sum_i(cg); ce = wave_sum_i(ce);
    __syncthreads();
    if (lane == 0) { ldsw[16 + wave] = cg; ldsw[24 + wave] = ce; }
    __syncthreads();
    int tg = 0, te = 0;
#pragma unroll
    for (int i = 0; i < 8; ++i) { tg += ldsw[16 + i]; te += ldsw[24 + i]; }
    const int need = TOPK - tg; const bool all_eq = te <= need;
    for (int ch = 0; ch < nc; ++ch) { const v4u k4 = *(const LAS v4u*)(ldsk + ch * 2048 + tid * 4); const unsigned kk[4] = {k4.x, k4.y, k4.z, k4.w};
#pragma unroll
        for (int j = 0; j < 4; ++j) { const int idx = ch * 2048 + tid * 4 + j; const unsigned k = kk[j]; bool s = (idx < n) && k > T;
            if ((idx < n) && k == T) { if (all_eq) s = true; else { int rank = 0; for (int q = 0; q < idx; ++q) rank += (ldsk[q] == T) ? 1 : 0; s = rank < need; } }
            if (s) { const int pos = __hip_atomic_fetch_add(ldsw + 32, 1, __ATOMIC_RELAXED, __HIP_MEMORY_SCOPE_WORKGROUP); if (pos < TOPK) sel[pos] = idx; } } }
    __syncthreads();
}
__device__ __forceinline__ f32x4 ld_kvrow(const float* cache, const bf16* fresh, int off, int c) {
    if (off >= 0) return *(const f32x4*)(cache + (size_t)off + 4 * c);
    const v2u w = *(const v2u*)(fresh + (size_t)(-off - 1) + 4 * c); return (f32x4){bflo(w.x), bfhi(w.x), bflo(w.y), bfhi(w.y)};
}
__device__ __forceinline__ void ph_attn_sample(ArgP a_, int l, LAS unsigned char* ldsb, int wv_) {
    TID_LOCAL();
    unsigned char* ws = a->ws;
    const bf16* Qb = (const bf16*)(ws + WS_QB); const bf16* Kb = (const bf16*)(ws + WS_KB); const bf16* Vb = (const bf16*)(ws + WS_VB); const bf16* Gb = (const bf16*)(ws + WS_GB);
    bf16* AOb = (bf16*)(ws + WS_AOB); const int* pt = (const int*)a->in[I_PT]; const float* rb = (const float*)a->in[I_RB];
    const float* ck = (const float*)a->in[I_CK] + (size_t)l * NPOOL * PAGE * 512; const float* cv = (const float*)a->in[I_CV] + (size_t)l * NPOOL * PAGE * 512;
    LAS unsigned* ldsk = (LAS unsigned*)ldsb;
    LAS int* ldsw = (LAS int*)(ldsb + 81920); LAS int* sidx = (LAS int*)(ldsb + 81920 + 256); LAS int* koff = sidx + TOPK; LAS int* kbk = koff + TOPK;
    LAS float* qh = (LAS float*)ldsb; LAS float* lg = (LAS float*)(ldsb + 2048); LAS float* rs = (LAS float*)(ldsb + 2048 + 4096); LAS float* red = (LAS float*)(ldsb + 8192);
    const int par = lane >> 5, c = lane & 31;
    for (int it = blockIdx.x; it < MS * NKV; it += gridDim.x) {
        const int rr = it >> 2, g = it & 3; const int r = MP + rr, b = rr / DSEQ, t = rr % DSEQ, tpos = PAST + t;
        select_block((const float*)(ws + WS_SCS) + (size_t)rr * SCS_LD, tpos + 1, ldsk, ldsw, sidx, tid, lane, wave);
        if (tid < TOPK) { const int s = sidx[tid]; kbk[tid] = t5_bucket(tpos - s);
            koff[tid] = (s < PAST) ? (int)(((unsigned)pt[b * NPAGES + (s >> 7)] * PAGE + (s & 127)) * 512u + g * HD) : -(1 + (int)(((unsigned)MP + b * DSEQ + (s - PAST)) * 512u + g * HD)); }
        qh[tid] = bf2f(Qb[(size_t)r * 2048 + g * 512 + tid]);
        __syncthreads();
        { f32x4 q4[4];
#pragma unroll
          for (int h = 0; h < 4; ++h) q4[h] = *(LAS const f32x4*)(qh + h * HD + 4 * c);
          f32x4 kv[16];
#pragma unroll
          for (int i = 0; i < 16; ++i) kv[i] = ld_kvrow(ck, Kb, koff[wave * 32 + 2 * i + par], c);
#pragma unroll
          for (int i = 0; i < 16; ++i) { float d[4];
#pragma unroll
              for (int h = 0; h < 4; ++h) d[h] = kv[i][0] * q4[h][0] + kv[i][1] * q4[h][1] + kv[i][2] * q4[h][2] + kv[i][3] * q4[h][3];
#pragma unroll
              for (int o = 1; o < 32; o <<= 1) {
#pragma unroll
                  for (int h = 0; h < 4; ++h) d[h] += __shfl_xor(d[h], o); }
              const int k = wave * 32 + 2 * i + par;
              if (c < 4) { const float dd = (c == 0) ? d[0] : (c == 1) ? d[1] : (c == 2) ? d[2] : d[3]; lg[c * TOPK + k] = dd + rb[kbk[k] * NH + g * KVG + c] * LOG2E; } } }
        __syncthreads();
        if (wave < KVG) { LAS float* row = lg + wave * TOPK; float v[4]; float m = -3.0e38f;
#pragma unroll
            for (int j = 0; j < 4; ++j) { v[j] = row[lane + 64 * j]; m = fmaxf(m, v[j]); }
#pragma unroll
            for (int o = 1; o < 64; o <<= 1) m = fmaxf(m, __shfl_xor(m, o));
            float sm = 0.f;
#pragma unroll
            for (int j = 0; j < 4; ++j) { v[j] = exp2f(v[j] - m); sm += v[j]; row[lane + 64 * j] = v[j]; }
            sm = wave_sum(sm); if (lane == 0) rs[wave] = 1.0f / sm; }
        __syncthreads();
        { f32x4 vv[16];
#pragma unroll
          for (int i = 0; i < 16; ++i) vv[i] = ld_kvrow(cv, Vb, koff[wave * 32 + 2 * i + par], c);
          f32x4 o4[4] = {{0.f, 0.f, 0.f, 0.f}, {0.f, 0.f, 0.f, 0.f}, {0.f, 0.f, 0.f, 0.f}, {0.f, 0.f, 0.f, 0.f}};
#pragma unroll
          for (int i = 0; i < 16; ++i) { const int k = wave * 32 + 2 * i + par;
#pragma unroll
              for (int h = 0; h < 4; ++h) o4[h] += vv[i] * lg[h * TOPK + k]; }
#pragma unroll
          for (int h = 0; h < 4; ++h) *(LAS f32x4*)(red + ((wave * 2 + par) * 4 + h) * HD + 4 * c) = o4[h]; }
        __syncthreads();
        { float o = 0.f;
#pragma unroll
          for (int p = 0; p < 16; ++p) o += red[p * 4 * HD + tid];
          const size_t oi = (size_t)r * 2048 + g * 512 + tid;
          AOb[oi] = (bf16)f2bf(o * rs[tid >> 7] * bf2f(Gb[oi])); }
        __syncthreads();
    }
}

__device__ __forceinline__ void ph_epi_resid(ArgP a_, int wv_) {
    TID_LOCAL(); GTID_LOCAL();
    unsigned char* ws = a->ws; const float* C = (const float*)(ws + WS_C); float* H = (float*)(ws + WS_H); bf16* Hb = (bf16*)(ws + WS_HBB);
    for (size_t e = gtid; e < (size_t)MR * (DM / 4); e += GT) { const size_t o = e * 4; const f32x4 v = *(const f32x4*)(H + o) + *(const f32x4*)(C + o);
        *(f32x4*)(H + o) = v; v2u w; w.x = pk2(v[0], v[1]); w.y = pk2(v[2], v[3]); *(v2u*)(Hb + o) = w; }
}
__device__ __forceinline__ void ph_epi_ple(ArgP a_, int wv_) {
    TID_LOCAL(); GTID_LOCAL();
    unsigned char* ws = a->ws; const float* C = (const float*)(ws + WS_C); const float* C2 = (const float*)(ws + WS_C2); const float* rstd = (const float*)(ws + WS_RSTD);
    float* H = (float*)(ws + WS_H); bf16* Hb = (bf16*)(ws + WS_HBA);
    for (size_t e = gtid; e < (size_t)MR * (DM / 4); e += GT) { const size_t o = e * 4; const int r = (int)(e / (DM / 4)); const float rs = rstd[r];
        const f32x4 c = *(const f32x4*)(C + o), p = *(const f32x4*)(C2 + o); f32x4 v = *(const f32x4*)(H + o);
#pragma unroll
        for (int j = 0; j < 4; ++j) v[j] += sigmoidf_(c[j] * rs) * p[j];
        *(f32x4*)(H + o) = v; v2u w; w.x = pk2(v[0], v[1]); w.y = pk2(v[2], v[3]); *(v2u*)(Hb + o) = w; }
}
__device__ __forceinline__ void ph_epi_ssm_in(ArgP a_, int wv_) {
    TID_LOCAL(); GTID_LOCAL();
    unsigned char* ws = a->ws; const float* C = (const float*)(ws + WS_C); const float* rstd = (const float*)(ws + WS_RSTD);
    for (size_t e = gtid; e < (size_t)MR * 1024; e += GT) { const int r = (int)(e / 1024), c = (int)(e % 1024) * 4;
        f32x4 v = *(const f32x4*)(C + (size_t)r * 4096 + c); v = v * rstd[r];
        if (c < 2048) { v2u o; o.x = pk2(v[0], v[1]); o.y = pk2(v[2], v[3]);
            if (r < MP) { const int b = r / SEQ, t = r % SEQ, g = c / 16, j = c % 16; *(v2u*)((bf16*)(ws + WS_UG) + (((size_t)(b * NGRP + g) * SEQ + t) * 16 + j)) = o; }
            else *(v2u*)((bf16*)(ws + WS_US) + (size_t)(r - MP) * 2048 + c) = o; }
        else { v2u o; o.x = pk2(siluf_(v[0]), siluf_(v[1])); o.y = pk2(siluf_(v[2]), siluf_(v[3])); *(v2u*)((bf16*)(ws + WS_GB) + (size_t)r * 2048 + (c - 2048)) = o; }
    }
}
__device__ __forceinline__ void scan_item(ArgP a, int l, bool pr, int item, int lane) {
    unsigned char* ws = a->ws;
    const int b = item / NGRP, g = item % NGRP, n = lane;
    const size_t gn = ((size_t)l * NGRP + g) * SST + n;
    const float lre = fminf(((const float*)a->in[I_LRE])[gn], -1e-4f), lim = ((const float*)a->in[I_LIM])[gn];
    const float dt = expf(((const float*)a->in[I_LDT])[l * NGRP + g]);
    const float mag = expf(lre * dt), ang = lim * dt; const float are = mag * cosf(ang), aim = mag * sinf(ang);
    const float den = lre * lre + lim * lim; const float cre = ((are - 1.0f) * lre + aim * lim) / den, cim = (aim * lre - (are - 1.0f) * lim) / den;
    float bbr[16], bbi[16], ccr[16], cci[16];
#pragma unroll
    for (int j = 0; j < 16; ++j) { const float br = ((const float*)a->in[I_BRE])[gn * 16 + j], bi = ((const float*)a->in[I_BIM])[gn * 16 + j];
        bbr[j] = cre * br - cim * bi; bbi[j] = cre * bi + cim * br;
        const size_t ci = (((size_t)l * NGRP + g) * 16 + j) * SST + n; ccr[j] = ((const float*)a->in[I_CRE])[ci]; cci[j] = ((const float*)a->in[I_CIM])[ci]; }
    const float dj = ((const float*)a->in[I_SD])[(size_t)l * DM + g * 16 + (lane & 15)];
    float xr = 0.f, xi = 0.f;
    if (!pr) { const size_t si = (((size_t)l * DBATCH + b) * NGRP + g) * SST + n; xr = ((const float*)a->in[I_SRE])[si]; xi = ((const float*)a->in[I_SIM])[si]; }
    const int T = pr ? SEQ : DSEQ;
    const bf16* up = pr ? (const bf16*)(ws + WS_UG) + (size_t)(b * NGRP + g) * SEQ * 16 : (const bf16*)(ws + WS_US) + (size_t)(b * DSEQ) * 2048 + g * 16;
    const int ustride = pr ? 16 : 2048;
    bf16* Yb = (bf16*)(ws + WS_YB);
    for (int t = 0; t < T; ++t) {
        const v4u u0 = *(const v4u*)(up + (size_t)t * ustride), u1 = *(const v4u*)(up + (size_t)t * ustride + 8);
        const float u[16] = {bflo(u0.x), bfhi(u0.x), bflo(u0.y), bfhi(u0.y), bflo(u0.z), bfhi(u0.z), bflo(u0.w), bfhi(u0.w), bflo(u1.x), bfhi(u1.x), bflo(u1.y), bfhi(u1.y), bflo(u1.z), bfhi(u1.z), bflo(u1.w), bfhi(u1.w)};
        float br = 0.f, bi = 0.f;
#pragma unroll
        for (int j = 0; j < 16; ++j) { br += bbr[j] * u[j]; bi += bbi[j] * u[j]; }
        const float nr = are * xr - aim * xi + br, ni = are * xi + aim * xr + bi; xr = nr; xi = ni;
        float yj = 0.f, uj = 0.f;
#pragma unroll
        for (int j = 0; j < 16; ++j) { const float s = wave_sum(ccr[j] * xr - cci[j] * xi); if ((lane & 15) == j) { yj = s; uj = u[j]; } }
        if (lane < 16) { const float y = yj + dj * uj; const int row = pr ? b * SEQ + t : MP + b * DSEQ + t; Yb[(size_t)row * 2048 + g * 16 + lane] = (bf16)f2bf(gelu_tanh(y)); }
    }
    float* osr = a->out + (pr ? O_SRP + (((size_t)l * NBATCH + b) * NGRP + g) * SST : O_SRS + (((size_t)l * DBATCH + b) * NGRP + g) * SST);
    float* osi = a->out + (pr ? O_SIP + (((size_t)l * NBATCH + b) * NGRP + g) * SST : O_SIS + (((size_t)l * DBATCH + b) * NGRP + g) * SST);
    osr[n] = xr; osi[n] = xi;
}
__device__ __forceinline__ void ph_scan_naive(ArgP a_, int l, int wv_) {
    TID_LOCAL();
    for (int vb = blockIdx.x; vb < 256; vb += gridDim.x) {
        if (wave == 0) scan_item(a, l, true, vb, lane);
        else { const int item = vb * 7 + (wave - 1); if (item < DBATCH * NGRP) scan_item(a, l, false, item, lane); }
    }
}

namespace s5 {
using bf16x8 = __attribute__((ext_vector_type(8))) short;
using s16x4  = __attribute__((ext_vector_type(4))) short;
using f32x16 = __attribute__((ext_vector_type(16))) float;
constexpr int XSTR = 80;
constexpr int XT_BYTES = 128 * XSTR;
constexpr int E_OFF = 8 * XT_BYTES, H_OFF = E_OFF + 16 * 64 * 8;
__device__ __forceinline__ s16x4 tr_read(int addr) { s16x4 r; asm volatile("ds_read_b64_tr_b16 %0, %1" : "=&v"(r) : "v"(addr) : "memory"); return r; }
}
__device__ __forceinline__ void ph_scan(ArgP a_, int l, LAS unsigned char* ldsb, int wv_) {
    using namespace s5;
    TID_LOCAL();
    unsigned char* ws = a->ws;
    LAS char* lds = (LAS char*)ldsb;
    bf16* Yb = (bf16*)(ws + WS_YB);
    const int n0 = lane & 31, h2 = lane >> 5, fj = lane & 15, kg = lane >> 4;
    for (int vb = blockIdx.x; vb < NBATCH * NGRP; vb += gridDim.x) {
        const int b = vb >> 7, g = vb & 127;
        const size_t gbase = (size_t)l * NGRP + g;
        float ar[2], ai[2]; bf16x8 Bfr[2][2];
        const float dt = expf(((const float*)a->in[I_LDT])[gbase]);
#pragma unroll
        for (int nt = 0; nt < 2; ++nt) { const size_t gn = gbase * SST + n0 + 32 * nt;
            const float lre = fminf(((const float*)a->in[I_LRE])[gn], -1e-4f), lim = ((const float*)a->in[I_LIM])[gn];
            const float mag = expf(lre * dt), ang = lim * dt; const float are = mag * cosf(ang), aim = mag * sinf(ang);
            const float den = lre * lre + lim * lim; const float cre = ((are - 1.0f) * lre + aim * lim) / den, cim = (aim * lre - (are - 1.0f) * lim) / den;
            ar[nt] = are; ai[nt] = aim;
            const f32x4 br0 = *(const f32x4*)((const float*)a->in[I_BRE] + gn * 16 + 8 * h2), br1 = *(const f32x4*)((const float*)a->in[I_BRE] + gn * 16 + 8 * h2 + 4);
            const f32x4 bi0 = *(const f32x4*)((const float*)a->in[I_BIM] + gn * 16 + 8 * h2), bi1 = *(const f32x4*)((const float*)a->in[I_BIM] + gn * 16 + 8 * h2 + 4);
            v4u wr_, wi_;
            wr_.x = pk2(cre * br0[0] - cim * bi0[0], cre * br0[1] - cim * bi0[1]); wr_.y = pk2(cre * br0[2] - cim * bi0[2], cre * br0[3] - cim * bi0[3]);
            wr_.z = pk2(cre * br1[0] - cim * bi1[0], cre * br1[1] - cim * bi1[1]); wr_.w = pk2(cre * br1[2] - cim * bi1[2], cre * br1[3] - cim * bi1[3]);
            wi_.x = pk2(cre * bi0[0] + cim * br0[0], cre * bi0[1] + cim * br0[1]); wi_.y = pk2(cre * bi0[2] + cim * br0[2], cre * bi0[3] + cim * br0[3]);
            wi_.z = pk2(cre * bi1[0] + cim * br1[0], cre * bi1[1] + cim * br1[1]); wi_.w = pk2(cre * bi1[2] + cim * br1[2], cre * bi1[3] + cim * br1[3]);
            Bfr[nt][0] = __builtin_bit_cast(bf16x8, wr_); Bfr[nt][1] = __builtin_bit_cast(bf16x8, wi_); }
        bf16x8 Cf[4];
#pragma unroll
        for (int ks = 0; ks < 4; ++ks) { const float* srcp = (const float*)a->in[(ks >> 1) ? I_CIM : I_CRE] + (gbase * 16 + fj) * SST + (ks & 1) * 32 + kg * 8; const float sg = (ks >> 1) ? -1.0f : 1.0f;
            const f32x4 c0 = *(const f32x4*)srcp, c1 = *(const f32x4*)(srcp + 4);
            v4u w; w.x = pk2(sg * c0[0], sg * c0[1]); w.y = pk2(sg * c0[2], sg * c0[3]); w.z = pk2(sg * c1[0], sg * c1[1]); w.w = pk2(sg * c1[2], sg * c1[3]); Cf[ks] = __builtin_bit_cast(bf16x8, w); }
        const f32x4 dv = *(const f32x4*)((const float*)a->in[I_SD] + (size_t)l * DM + g * 16 + 4 * kg);
        const bf16* up = (const bf16*)(ws + WS_UG) + (size_t)(b * NGRP + g) * SEQ * 16;
        const int a_time0 = 256 * (2 * wave + ((n0 >> 2) & 1)) + (n0 & 3) + 4 * (n0 >> 3);
        const bf16* ap = up + (size_t)a_time0 * 16 + 8 * h2;
        LAS float* E = (LAS float*)(lds + E_OFF); LAS float* Hs = (LAS float*)(lds + H_OFF);
        const int seg = 2 * wave + h2;
        { float xr[2] = {0.f, 0.f}, xi[2] = {0.f, 0.f};
          bf16x8 An = *(const bf16x8*)ap;
          for (int tile = 0; tile < 16; ++tile) { const bf16x8 A = An; if (tile < 15) An = *(const bf16x8*)(ap + (size_t)(tile + 1) * 256);
#pragma unroll
              for (int nt = 0; nt < 2; ++nt) { f32x16 cr = {}, ci = {};
                  cr = __builtin_amdgcn_mfma_f32_32x32x16_bf16(A, Bfr[nt][0], cr, 0, 0, 0); ci = __builtin_amdgcn_mfma_f32_32x32x16_bf16(A, Bfr[nt][1], ci, 0, 0, 0);
#pragma unroll
                  for (int i = 0; i < 16; ++i) { const float nr = ar[nt] * xr[nt] - ai[nt] * xi[nt] + cr[i], ni = ar[nt] * xi[nt] + ai[nt] * xr[nt] + ci[i]; xr[nt] = nr; xi[nt] = ni; } } }
#pragma unroll
          for (int nt = 0; nt < 2; ++nt) { E[(seg * 64 + n0 + 32 * nt) * 2] = xr[nt]; E[(seg * 64 + n0 + 32 * nt) * 2 + 1] = xi[nt]; } }
        __syncthreads();
        if (wave == 0) { const size_t gn = gbase * SST + lane;
            const float lre = fminf(((const float*)a->in[I_LRE])[gn], -1e-4f), lim = ((const float*)a->in[I_LIM])[gn];
            const float mag = expf(lre * dt), ang = lim * dt; float pr_ = mag * cosf(ang), pi_ = mag * sinf(ang);
#pragma unroll
            for (int q = 0; q < 8; ++q) { const float t0 = pr_ * pr_ - pi_ * pi_, t1 = 2.0f * pr_ * pi_; pr_ = t0; pi_ = t1; }
            float hr = 0.f, hi_ = 0.f; Hs[lane * 2] = 0.f; Hs[lane * 2 + 1] = 0.f;
            for (int s = 0; s < 16; ++s) { const float er = E[(s * 64 + lane) * 2], ei = E[(s * 64 + lane) * 2 + 1];
                const float nr = pr_ * hr - pi_ * hi_ + er, ni = pr_ * hi_ + pi_ * hr + ei; hr = nr; hi_ = ni; Hs[((s + 1) * 64 + lane) * 2] = hr; Hs[((s + 1) * 64 + lane) * 2 + 1] = hi_; }
            a->out[O_SRP + (((size_t)l * NBATCH + b) * NGRP + g) * SST + lane] = hr; a->out[O_SIP + (((size_t)l * NBATCH + b) * NGRP + g) * SST + lane] = hi_; }
        __syncthreads();
        { float xr[2], xi[2];
#pragma unroll
          for (int nt = 0; nt < 2; ++nt) { xr[nt] = Hs[(seg * 64 + n0 + 32 * nt) * 2]; xi[nt] = Hs[(seg * 64 + n0 + 32 * nt) * 2 + 1]; }
          LAS char* Xt = lds + wave * XT_BYTES; const int xt_addr = (int)(unsigned)(size_t)Xt;
          bf16x8 An = *(const bf16x8*)ap;
          for (int tile = 0; tile < 16; ++tile) { const bf16x8 A = An; if (tile < 15) An = *(const bf16x8*)(ap + (size_t)(tile + 1) * 256);
#pragma unroll
              for (int nt = 0; nt < 2; ++nt) { f32x16 cr = {}, ci = {};
                  cr = __builtin_amdgcn_mfma_f32_32x32x16_bf16(A, Bfr[nt][0], cr, 0, 0, 0); ci = __builtin_amdgcn_mfma_f32_32x32x16_bf16(A, Bfr[nt][1], ci, 0, 0, 0);
                  unsigned pr[8], pi[8];
#pragma unroll
                  for (int i = 0; i < 16; i += 2) { float r0, i0, r1, i1;
                      r0 = ar[nt] * xr[nt] - ai[nt] * xi[nt] + cr[i]; i0 = ar[nt] * xi[nt] + ai[nt] * xr[nt] + ci[i];
                      r1 = ar[nt] * r0 - ai[nt] * i0 + cr[i + 1]; i1 = ar[nt] * i0 + ai[nt] * r0 + ci[i + 1]; xr[nt] = r1; xi[nt] = i1;
                      pr[i >> 1] = pk2(r0, r1); pi[i >> 1] = pk2(i0, i1); }
                  LAS char* rowr = Xt + (nt * 32 + n0) * XSTR + h2 * 32; LAS char* rowi = rowr + 64 * XSTR;
                  *(LAS v4u*)rowr = (v4u){pr[0], pr[1], pr[2], pr[3]}; *(LAS v4u*)(rowr + 16) = (v4u){pr[4], pr[5], pr[6], pr[7]};
                  *(LAS v4u*)rowi = (v4u){pi[0], pi[1], pi[2], pi[3]}; *(LAS v4u*)(rowi + 16) = (v4u){pi[4], pi[5], pi[6], pi[7]}; }
              asm volatile("s_waitcnt lgkmcnt(0)" ::: "memory");
#pragma unroll
              for (int tt = 0; tt < 2; ++tt) { f32x4 acc = {0.f, 0.f, 0.f, 0.f};
                  s16x4 lo[4], hi4[4];
#pragma unroll
                  for (int ks = 0; ks < 4; ++ks) { const int rowk = 32 * ks + 8 * kg + (fj >> 2); const int ad = xt_addr + rowk * XSTR + (16 * tt + 4 * (fj & 3)) * 2;
                      lo[ks] = tr_read(ad); hi4[ks] = tr_read(ad + 4 * XSTR); }
                  asm volatile("s_waitcnt lgkmcnt(0)" ::: "memory"); __builtin_amdgcn_sched_barrier(0);
#pragma unroll
                  for (int ks = 0; ks < 4; ++ks) { const bf16x8 Bx = (bf16x8){lo[ks][0], lo[ks][1], lo[ks][2], lo[ks][3], hi4[ks][0], hi4[ks][1], hi4[ks][2], hi4[ks][3]};
                      acc = __builtin_amdgcn_mfma_f32_16x16x32_bf16(Cf[ks], Bx, acc, 0, 0, 0); }
                  const int time = 256 * (2 * wave + tt) + 16 * tile + fj;
                  const v2u uw = *(const v2u*)(up + (size_t)time * 16 + 4 * kg);
                  const float y0 = acc[0] + dv[0] * bflo(uw.x), y1 = acc[1] + dv[1] * bfhi(uw.x), y2 = acc[2] + dv[2] * bflo(uw.y), y3 = acc[3] + dv[3] * bfhi(uw.y);
                  v2u o; o.x = pk2(gelu_tanh(y0), gelu_tanh(y1)); o.y = pk2(gelu_tanh(y2), gelu_tanh(y3));
                  *(v2u*)(Yb + ((size_t)b * SEQ + time) * 2048 + g * 16 + 4 * kg) = o; }
          } }
        __syncthreads();
    }
    for (int it = gw; it < DBATCH * NGRP; it += NGW) scan_item(a, l, false, it, lane);
}

__device__ __forceinline__ void ph_epi_glu(ArgP a_, int l, int wv_) {
    TID_LOCAL(); GTID_LOCAL();
    unsigned char* ws = a->ws; const float* C = (const float*)(ws + WS_C); const float* bg = (const float*)a->in[I_BGLU] + (size_t)l * DM;
    const bf16* Yb = (const bf16*)(ws + WS_YB); const bf16* Gb = (const bf16*)(ws + WS_GB); bf16* AOb = (bf16*)(ws + WS_AOB);
    for (size_t e = gtid; e < (size_t)MR * (DM / 4); e += GT) { const size_t o = e * 4; const int c = (int)(o % DM);
        const f32x4 cv = *(const f32x4*)(C + o), bv = *(const f32x4*)(bg + c); const v2u yw = *(const v2u*)(Yb + o), gw2 = *(const v2u*)(Gb + o);
        const float y[4] = {bflo(yw.x), bfhi(yw.x), bflo(yw.y), bfhi(yw.y)}, gg[4] = {bflo(gw2.x), bfhi(gw2.x), bflo(gw2.y), bfhi(gw2.y)};
        float r[4];
#pragma unroll
        for (int j = 0; j < 4; ++j) r[j] = y[j] * sigmoidf_(cv[j] + bv[j]) * gg[j];
        v2u w; w.x = pk2(r[0], r[1]); w.y = pk2(r[2], r[3]); *(v2u*)(AOb + o) = w; }
}
__device__ __forceinline__ void ph_final(ArgP a_, int wv_) {
    TID_LOCAL();
    unsigned char* ws = a->ws; const bf16* Hb = (const bf16*)(ws + WS_HBA); const float* ssq = ss_buf(ws, 8); const float* fw = (const float*)a->in[I_FNW];
    for (int r = gw; r < MR; r += NGW) {
        float s;
        if (r < MP) s = (lane < 32) ? ssq[(size_t)r * 32 + lane] : 0.f;
        else s = ssq[(size_t)MPAD * 32 + (size_t)(r - MP) * 128 + lane] + ssq[(size_t)MPAD * 32 + (size_t)(r - MP) * 128 + 64 + lane];
        const float rs = ss2rstd(wave_sum(s));
        float* out = a->out + (r < MP ? O_YP + (size_t)r * DM : O_YS + (size_t)(r - MP) * DM);
#pragma unroll
        for (int j = 0; j < 8; ++j) { const int c = (j * 64 + lane) * 4; const v2u hw = *(const v2u*)(Hb + (size_t)r * DM + c);
            *(f32x4*)(out + c) = (f32x4){bflo(hw.x), bfhi(hw.x), bflo(hw.y), bfhi(hw.y)} * rs * *(const f32x4*)(fw + c); } }
}

constexpr size_t WS_PRJ = WS_C;
constexpr size_t PRJ_STRIDE = (size_t)MPAD * DM * 2;
constexpr size_t WS_SSP = WS_C2;
constexpr size_t SSP_STRIDE = (size_t)MPAD * 32 + (size_t)MS * 128;
__device__ __forceinline__ float* ss_buf(unsigned char* ws, int k) { return (float*)(ws + WS_SSP) + (size_t)k * SSP_STRIDE; }
__device__ __forceinline__ float ss2rstd(float ss) { return 1.0f / sqrtf(ss * (1.0f / DM) + RMS_EPS); }
struct AuxNone {};
__device__ __forceinline__ float ss_row_part(const float* ssp, int r, int q) {
    const f32x4* p = (const f32x4*)(ssp + (size_t)r * 32 + 8 * q); const f32x4 s = p[0] + p[1]; return (s[0] + s[1]) + (s[2] + s[3]); }
__device__ __forceinline__ float ss_srow_part(const float* ssp, int r, int q) {
    const f32x4* p = (const f32x4*)(ssp + (size_t)MPAD * 32 + (size_t)(r - MP) * 128 + 32 * q); f32x4 s = p[0];
#pragma unroll
    for (int i = 1; i < 8; ++i) s += p[i];
    return (s[0] + s[1]) + (s[2] + s[3]); }
__device__ __forceinline__ float ss_row_rstd(const float* ssp, int r) {
    if (r < MP) { const f32x4* p = (const f32x4*)(ssp + (size_t)r * 32); f32x4 s = p[0];
#pragma unroll
        for (int i = 1; i < 8; ++i) s += p[i];
        return ss2rstd((s[0] + s[1]) + (s[2] + s[3])); }
    const f32x4* p = (const f32x4*)(ssp + (size_t)MPAD * 32 + (size_t)(r - MP) * 128); f32x4 s = p[0];
    for (int i = 1; i < 32; ++i) s += p[i];
    return ss2rstd((s[0] + s[1]) + (s[2] + s[3])); }
__device__ __forceinline__ v2u pk4(const f32x4 v) { v2u o; o.x = pk2(v[0], v[1]); o.y = pk2(v[2], v[3]); return o; }
struct FAttnIn { unsigned char* ws; float* out; const float* ssin; int l; static constexpr bool SUMSQ = false, RSTD = true; float* ssout; typedef AuxNone Aux;
    __device__ __forceinline__ void prefetch(int, int, Aux&) const {}
    __device__ __forceinline__ float store4(int r, int c, f32x4 v, float rs, const Aux&) const {
        if (c >= ACOLS) return 0.f;
        v = v * rs;
        if (c < C_K) { v = v * QSCALE; *(v2u*)((bf16*)(ws + WS_QB) + (size_t)r * 2048 + c) = pk4(v); }
        else if (c < C_G) { const bool isv = c >= C_V; const int cc = c - (isv ? C_V : C_K);
            float* o32 = out + (r < MP ? (isv ? O_VP : O_KP) + ((size_t)l * MP + r) * 512 : (isv ? O_VS : O_KS) + ((size_t)l * MS + (r - MP)) * 512) + cc;
            *(f32x4*)o32 = v; *(v2u*)((bf16*)(ws + (isv ? WS_VB : WS_KB)) + (size_t)r * 512 + cc) = pk4(v); }
        else if (c < C_QI) { v2u o; o.x = pk2(siluf_(v[0]), siluf_(v[1])); o.y = pk2(siluf_(v[2]), siluf_(v[3])); *(v2u*)((bf16*)(ws + WS_GB) + (size_t)r * 2048 + (c - C_G)) = o; }
        else if (c < C_KI) { *(v2u*)((bf16*)(ws + WS_QIB) + (size_t)r * 1024 + (c - C_QI)) = pk4(v); }
        else if (c < C_WI) { const int cc = c - C_KI; float* o32 = out + (r < MP ? O_KIP + ((size_t)l * MP + r) * 64 : O_KIS + ((size_t)l * MS + (r - MP)) * 64) + cc;
            *(f32x4*)o32 = v; *(v2u*)((bf16*)(ws + WS_KIB) + (size_t)r * 64 + cc) = pk4(v); }
        else { *(f32x4*)((float*)(ws + WS_WI) + (size_t)r * 16 + (c - C_WI)) = v * WISCALE; }
        return 0.f; } };
struct FResid { unsigned char* ws; float* ssout; const float* ssin; static constexpr bool SUMSQ = true, RSTD = false;
    struct Aux { v2u h; };
    __device__ __forceinline__ void prefetch(int r, int c, Aux& x) const { x.h = *(const v2u*)((const bf16*)(ws + WS_HBA) + (size_t)r * DM + c); }
    __device__ __forceinline__ float store4(int r, int c, f32x4 v, float, const Aux& x) const { const size_t o = (size_t)r * DM + c; const f32x4 h = (f32x4){bflo(x.h.x), bfhi(x.h.x), bflo(x.h.y), bfhi(x.h.y)} + v;
        *(v2u*)((bf16*)(ws + WS_HBB) + o) = pk4(h); return h[0] * h[0] + h[1] * h[1] + h[2] * h[2] + h[3] * h[3]; } };
struct FPleProj { unsigned char* ws; float* ssout; const float* ssin; bf16* prj; static constexpr bool SUMSQ = false, RSTD = false; typedef AuxNone Aux;
    __device__ __forceinline__ void prefetch(int, int, Aux&) const {}
    __device__ __forceinline__ float store4(int r, int c, f32x4 v, float, const Aux&) const { *(v2u*)(prj + (size_t)r * DM + c) = pk4(v); return 0.f; } };
struct FPle { unsigned char* ws; const float* ssin; float* ssout; const bf16* prj; static constexpr bool SUMSQ = true, RSTD = true;
    struct Aux { v2u h; v2u p; };
    __device__ __forceinline__ void prefetch(int r, int c, Aux& x) const { const size_t o = (size_t)r * DM + c; x.h = *(const v2u*)((const bf16*)(ws + WS_HBB) + o); x.p = *(const v2u*)(prj + o); }
    __device__ __forceinline__ float store4(int r, int c, f32x4 v, float rs, const Aux& x) const { const size_t o = (size_t)r * DM + c; f32x4 h = (f32x4){bflo(x.h.x), bfhi(x.h.x), bflo(x.h.y), bfhi(x.h.y)};
        const v2u pw = x.p; const float p[4] = {bflo(pw.x), bfhi(pw.x), bflo(pw.y), bfhi(pw.y)};
#pragma unroll
        for (int j = 0; j < 4; ++j) h[j] += sigmoidf_(v[j] * rs) * p[j];
        *(v2u*)((bf16*)(ws + WS_HBA) + o) = pk4(h); return h[0] * h[0] + h[1] * h[1] + h[2] * h[2] + h[3] * h[3]; } };
struct FSsmIn { unsigned char* ws; const float* ssin; float* ssout; static constexpr bool SUMSQ = false, RSTD = true; typedef AuxNone Aux;
    __device__ __forceinline__ void prefetch(int, int, Aux&) const {}
    __device__ __forceinline__ float store4(int r, int c, f32x4 v, float rs, const Aux&) const { v = v * rs;
        if (c < 2048) { if (r < MP) { const int b = r / SEQ, t = r % SEQ, g = c / 16, j = c % 16; *(v2u*)((bf16*)(ws + WS_UG) + (((size_t)(b * NGRP + g) * SEQ + t) * 16 + j)) = pk4(v); }
                        else *(v2u*)((bf16*)(ws + WS_US) + (size_t)(r - MP) * 2048 + c) = pk4(v); }
        else { v2u o; o.x = pk2(siluf_(v[0]), siluf_(v[1])); o.y = pk2(siluf_(v[2]), siluf_(v[3])); *(v2u*)((bf16*)(ws + WS_GB) + (size_t)r * 2048 + (c - 2048)) = o; }
        return 0.f; } };
struct FGlu { unsigned char* ws; const float* bg; float* ssout; const float* ssin; static constexpr bool SUMSQ = false, RSTD = false;
    struct Aux { f32x4 bv; v2u y, g; };
    __device__ __forceinline__ void prefetch(int r, int c, Aux& x) const { const size_t o = (size_t)r * DM + c; x.bv = *(const f32x4*)(bg + c); x.y = *(const v2u*)((const bf16*)(ws + WS_YB) + o); x.g = *(const v2u*)((const bf16*)(ws + WS_GB) + o); }
    __device__ __forceinline__ float store4(int r, int c, f32x4 v, float, const Aux& x) const { const size_t o = (size_t)r * DM + c; const f32x4 bv = x.bv;
        const v2u yw = x.y, gw2 = x.g;
        const float y[4] = {bflo(yw.x), bfhi(yw.x), bflo(yw.y), bfhi(yw.y)}, gg[4] = {bflo(gw2.x), bfhi(gw2.x), bflo(gw2.y), bfhi(gw2.y)}; f32x4 rr;
#pragma unroll
        for (int j = 0; j < 4; ++j) rr[j] = y[j] * sigmoidf_(v[j] + bv[j]) * gg[j];
        *(v2u*)((bf16*)(ws + WS_AOB) + o) = pk4(rr); return 0.f; } };
template <class F> struct EpiFused { F f;
    __device__ __forceinline__ void operator()(const f32x4 (&acc)[2][2][4][2], const pg8::Unit& u, int wr, int wc, int fr, int fq) const {
        const int row0 = u.pm * 256 + wr * 64 + fr, col0 = u.pn * 256 + wc * 32 + 4 * fq;
#pragma unroll
        for (int ai = 0; ai < 2; ++ai) {
            float rs[4];
            if (F::RSTD) {
#pragma unroll
                for (int m = 0; m < 4; ++m) rs[m] = ss_row_part(f.ssin, row0 + ai * 128 + m * 16, fq);
#pragma unroll
                for (int m = 0; m < 4; ++m) { float s = rs[m]; s += __shfl_xor(s, 16); s += __shfl_xor(s, 32); rs[m] = ss2rstd(s); } }
            else {
#pragma unroll
                for (int m = 0; m < 4; ++m) rs[m] = 0.f; }
            constexpr int RB = (sizeof(typename F::Aux) <= 24) ? 2 : 1;
#pragma unroll
            for (int m0 = 0; m0 < 4; m0 += RB) {
                typename F::Aux cur[RB][4];
#pragma unroll
                for (int j = 0; j < RB; ++j)
#pragma unroll
                    for (int g = 0; g < 4; ++g) f.prefetch(row0 + ai * 128 + (m0 + j) * 16, col0 + (g >> 1) * 128 + (g & 1) * 16, cur[j][g]);
#pragma unroll
                for (int j = 0; j < RB; ++j) { const int m = m0 + j; const int row = row0 + ai * 128 + m * 16; float ss = 0.f;
#pragma unroll
                    for (int g = 0; g < 4; ++g) ss += f.store4(row, col0 + (g >> 1) * 128 + (g & 1) * 16, acc[ai][g >> 1][m][g & 1], rs[m], cur[j][g]);
                    if (F::SUMSQ) { ss += __shfl_xor(ss, 16); ss += __shfl_xor(ss, 32); if (fq == 0) f.ssout[(size_t)row * 32 + u.pn * 4 + wc] = ss; } } } }
    } };
template <int NC, class F>
__device__ __forceinline__ void thin_tile(LAS unsigned char* lds, const bf16* A, const bf16* Bt, int K, int grow0, int gcol0, const F& f, int tid, int lane, int wave) {
    constexpr int NTL = NC / 16, RS = NC + 4, RT = NC / 4;
    const int fr = lane & 15, kg = lane >> 4; const int kw = K >> 3;
    f32x4 acc[2][NTL];
#pragma unroll
    for (int i = 0; i < 2; ++i)
#pragma unroll
        for (int j = 0; j < NTL; ++j) acc[i][j] = (f32x4){0.f, 0.f, 0.f, 0.f};
    const bf16* ap = A + (size_t)fr * K + wave * kw + kg * 8; const bf16* bp = Bt + (size_t)fr * K + wave * kw + kg * 8;
    for (int ks0 = 0; ks0 < kw / 32; ks0 += 2) {
        bf16x8v a0[2], a1[2], bw[2][NTL];
#pragma unroll
        for (int j = 0; j < 2; ++j) { a0[j] = *(const bf16x8v*)(ap + (ks0 + j) * 32); a1[j] = *(const bf16x8v*)(ap + (size_t)16 * K + (ks0 + j) * 32);
#pragma unroll
            for (int nt = 0; nt < NTL; ++nt) bw[j][nt] = *(const bf16x8v*)(bp + (size_t)nt * 16 * K + (ks0 + j) * 32); }
#pragma unroll
        for (int j = 0; j < 2; ++j)
#pragma unroll
            for (int nt = 0; nt < NTL; ++nt) { acc[0][nt] = __builtin_amdgcn_mfma_f32_16x16x32_bf16(bw[j][nt], a0[j], acc[0][nt], 0, 0, 0); acc[1][nt] = __builtin_amdgcn_mfma_f32_16x16x32_bf16(bw[j][nt], a1[j], acc[1][nt], 0, 0, 0); } }
    LAS float* red = (LAS float*)lds;
    __syncthreads();
#pragma unroll
    for (int mt = 0; mt < 2; ++mt)
#pragma unroll
        for (int nt = 0; nt < NTL; ++nt) *(LAS f32x4*)(red + ((wave * 32 + mt * 16 + fr) * RS + nt * 16 + 4 * kg)) = acc[mt][nt];
    __syncthreads();
    for (int it = tid; it < 32 * RT; it += NTHR) { const int m = it / RT, c4 = it % RT; f32x4 v = {0.f, 0.f, 0.f, 0.f};
#pragma unroll
        for (int w = 0; w < 8; ++w) v += *(LAS const f32x4*)(red + ((w * 32 + m) * RS + 4 * c4));
        const float rs = F::RSTD ? ss_row_rstd(f.ssin, grow0 + m) : 0.f; typename F::Aux x; f.prefetch(grow0 + m, gcol0 + 4 * c4, x); f.store4(grow0 + m, gcol0 + 4 * c4, v, rs, x); }
    __syncthreads();
}
template <int KS, class F>
__device__ __forceinline__ void thin_tile16(LAS unsigned char* lds, const bf16* A, const bf16* Bt, int grow0, int gcol0, int slot, const F& f, int tid, int lane, int wave) {
    constexpr int K = KS * 256, RS = 20;
    const int fr = lane & 15, kg = lane >> 4;
    const bf16* ap = A + (size_t)fr * K + wave * (KS * 32) + kg * 8; const bf16* bp = Bt + (size_t)fr * K + wave * (KS * 32) + kg * 8;
    bf16x8v a0[KS], a1[KS], bw[KS];
#pragma unroll
    for (int ks = 0; ks < KS; ++ks) { a0[ks] = *(const bf16x8v*)(ap + ks * 32); a1[ks] = *(const bf16x8v*)(ap + (size_t)16 * K + ks * 32); bw[ks] = *(const bf16x8v*)(bp + ks * 32); }
    f32x4 acc0 = {0.f, 0.f, 0.f, 0.f}, acc1 = {0.f, 0.f, 0.f, 0.f};
#pragma unroll
    for (int ks = 0; ks < KS; ++ks) { acc0 = __builtin_amdgcn_mfma_f32_16x16x32_bf16(bw[ks], a0[ks], acc0, 0, 0, 0); acc1 = __builtin_amdgcn_mfma_f32_16x16x32_bf16(bw[ks], a1[ks], acc1, 0, 0, 0); }
    LAS float* red = (LAS float*)lds;
    __syncthreads();
    *(LAS f32x4*)(red + ((wave * 32 + fr) * RS + 4 * kg)) = acc0; *(LAS f32x4*)(red + ((wave * 32 + 16 + fr) * RS + 4 * kg)) = acc1;
    __syncthreads();
    if (tid < 128) { const int m = tid >> 2, c4 = tid & 3; f32x4 v = {0.f, 0.f, 0.f, 0.f};
#pragma unroll
        for (int w = 0; w < 8; ++w) v += *(LAS const f32x4*)(red + ((w * 32 + m) * RS + 4 * c4));
        typename F::Aux x; f.prefetch(grow0 + m, gcol0 + 4 * c4, x);
        float rs = 0.f; if (F::RSTD) { rs = ss_srow_part(f.ssin, grow0 + m, c4); rs += __shfl_xor(rs, 1); rs += __shfl_xor(rs, 2); rs = ss2rstd(rs); }
        float ss = f.store4(grow0 + m, gcol0 + 4 * c4, v, rs, x);
        if (F::SUMSQ) { ss += __shfl_xor(ss, 1); ss += __shfl_xor(ss, 2); if (c4 == 0) f.ssout[(size_t)MPAD * 32 + (size_t)(grow0 + m - MP) * 128 + slot] = ss; } }
    __syncthreads();
}
template <int KS, class F> __device__ __forceinline__ void thin_sample(LAS unsigned char* lds, const bf16* A, const bf16* Bt, int N, const F& f, int wv_, int wg0 = 0, int nwg = 0) {
    const int wave = wv_, lane = lane_id_fresh(); int tid = wave * 64 + lane; asm volatile("" : "+v"(tid));
    constexpr int K = KS * 256;
    if (nwg == 0) nwg = gridDim.x;
    for (int t = (int)blockIdx.x - wg0; t < (N + 15) / 16; t += nwg) thin_tile16<KS, F>(lds, A + (size_t)MP * K, Bt + (size_t)t * 16 * K, MP, t * 16, t, f, tid, lane, wave);
}

__global__ void __launch_bounds__(NTHR, 2) fwd_kernel(Args args) {
    extern __shared__ __attribute__((aligned(16))) unsigned char lds_raw[];
    LAS unsigned char* lds = (LAS unsigned char*)lds_raw;
    volatile LAS unsigned* MISC = (volatile LAS unsigned*)(lds + MISC_OFF);
    const int wave_u = __builtin_amdgcn_readfirstlane((int)threadIdx.x >> 6);
    for (int u = wave_u * 64 + lane_id_fresh(); u < (LDS_BYTES - 131072) / 4; u += NTHR) ((LAS unsigned*)(lds + 131072))[u] = 0u;
    __syncthreads();
    ArgP kap = (ArgP)__builtin_amdgcn_kernarg_segment_ptr();
    XcdBarrier bar = xcd_barrier_post((unsigned*)(kap->ws + WS_CTL) + CW_BAR, MISC + 8, wave_u);
    int lp = 0;
#if PROF
    unsigned ph = 0; if (blockIdx.x == 0 && wave_u == 0) { const unsigned long long t0_ = __builtin_amdgcn_s_memrealtime(); MISC[16] = (unsigned)t0_; MISC[17] = (unsigned)(t0_ >> 32); }
#endif
#define PH_BEGIN { int l = lp; asm volatile("" : "+s"(l)); const int ia = 2 * l, is = 2 * l + 1; (void)ia; (void)is; ArgP args = kap; asm volatile("" : "+s"(args)); unsigned char* ws = args->ws; (void)ws;
#if PROF
#define PROF_ARRIVE() do { prof_mark(100 + (int)ph, wave_u); } while (0)
#define PROF_EXIT()   do { prof_mark(200 + (int)ph, wave_u); ++ph; } while (0)
#else
#define PROF_ARRIVE() do {} while (0)
#define PROF_EXIT()   do {} while (0)
#endif
#define PH_END   { PROF_ARRIVE(); XcdBarrier b2_ = bar; asm volatile("" : "+s"(b2_.bar), "+s"(b2_.x)); xcd_barrier(b2_, wave_u); PROF_EXIT(); } }
#define PH_LAST  PROF_ARRIVE(); }
#define GEMM_FUSED(FT, fobj, Aptr, Bptr, Ncols, Kdim) do { pg8::Gemm g_{(const pg8::bf16_t*)(Aptr), (const pg8::bf16_t*)(Bptr), MP, (Ncols), (Kdim)}; pg8::StaticOrder S_; S_.init(MP, (Ncols), (int)gridDim.x, (int)blockIdx.x); \
        EpiFused<FT> E_{fobj}; pg8::gemm_phase<EpiFused<FT>, pg8::StaticOrder, true, true>(lds, g_, S_, E_, wave_u); } while (0)

#define GEMM_FUSED_SUB(FT, fobj, Aptr, Bptr, Ncols, Kdim, wg0_, nwg_) do { pg8::Gemm g_{(const pg8::bf16_t*)(Aptr), (const pg8::bf16_t*)(Bptr), MP, (Ncols), (Kdim)}; pg8::StaticOrder S_; S_.init(MP, (Ncols), (nwg_), (int)blockIdx.x - (wg0_)); \
        EpiFused<FT> E_{fobj}; pg8::gemm_phase<EpiFused<FT>, pg8::StaticOrder, true, true>(lds, g_, S_, E_, wave_u); } while (0)

    PH_BEGIN ph_prologue(args, lds, wave_u); PH_END

    lp = 0;
        PH_BEGIN { const bf16* Aa = (const bf16*)(ws + WS_HBA); const bf16* Bw = (const bf16*)(ws + WS_WAIN) + (size_t)l * ACOLS_PAD * DM; FAttnIn f{ws, args->out, ss_buf(ws, 2 * ia), l, nullptr};
                   GEMM_FUSED(FAttnIn, f, Aa, Bw, 6144, DM);
                   { const int wave = wave_u, lane = lane_id_fresh(); int tid = wave * 64 + lane; asm volatile("" : "+v"(tid));
                     for (int rb = blockIdx.x; rb < MP / 32; rb += gridDim.x) thin_tile<96, FAttnIn>(lds, Aa + (size_t)rb * 32 * DM, Bw + (size_t)6144 * DM, DM, rb * 32, 6144, f, tid, lane, wave); }
                   thin_sample<8, FAttnIn>(lds, Aa, Bw, ACOLS, f, wave_u); } PH_END
        PH_BEGIN ph_idx(args, l, lds, wave_u); ph_idx_sample(args, l, wave_u); PMARK(5, wave_u); PH_END
        PH_BEGIN ph_attn(args, lds, wave_u);
                   if ((int)blockIdx.x < MS * NKV || (int)gridDim.x < 2 * MS * NKV) ph_attn_sample(args, l, lds, wave_u);
                   if ((int)blockIdx.x >= MS * NKV || (int)gridDim.x < 2 * MS * NKV) {
                       const int wg0 = ((int)gridDim.x < 2 * MS * NKV) ? 0 : MS * NKV, nwg = (int)gridDim.x - wg0;
                       __syncthreads();
                       for (int q = 0; q < 2; ++q) { const int li = 2 * l + q; const bf16* Ap = (const bf16*)(ws + WS_PB + (size_t)li * PB_STRIDE); const bf16* Bp = (const bf16*)(ws + WS_WPP) + (size_t)li * DM * PLE;
                           FPleProj fp{ws, nullptr, nullptr, (bf16*)(ws + WS_PRJ + (size_t)q * PRJ_STRIDE)};
                           GEMM_FUSED_SUB(FPleProj, fp, Ap, Bp, DM, PLE, wg0, nwg); thin_sample<1, FPleProj>(lds, Ap, Bp, DM, fp, wave_u, wg0, nwg); } } PH_END
        PH_BEGIN { const bf16* Aa = (const bf16*)(ws + WS_AOB); const bf16* Bw = (const bf16*)(ws + WS_WAOUT) + (size_t)l * DM * DM; FResid f{ws, ss_buf(ws, 1 + 2 * ia), nullptr};
                   GEMM_FUSED(FResid, f, Aa, Bw, DM, DM); thin_sample<8, FResid>(lds, Aa, Bw, DM, f, wave_u);
                   } PH_END
        PH_BEGIN { const bf16* Aa = (const bf16*)(ws + WS_HBB); const bf16* Bw = (const bf16*)(ws + WS_WPG) + (size_t)ia * DM * DM; FPle f{ws, ss_buf(ws, 1 + 2 * ia), ss_buf(ws, 2 + 2 * ia), (const bf16*)(ws + WS_PRJ)};
                   GEMM_FUSED(FPle, f, Aa, Bw, DM, DM); PMARK(1, wave_u); thin_sample<8, FPle>(lds, Aa, Bw, DM, f, wave_u); PMARK(2, wave_u); } PH_END
        PH_BEGIN { const bf16* Aa = (const bf16*)(ws + WS_HBA); const bf16* Bw = (const bf16*)(ws + WS_WSIN) + (size_t)l * 4096 * DM; FSsmIn f{ws, ss_buf(ws, 2 * is), nullptr};
                   GEMM_FUSED(FSsmIn, f, Aa, Bw, 4096, DM); thin_sample<8, FSsmIn>(lds, Aa, Bw, 4096, f, wave_u); } PH_END
        PH_BEGIN ph_scan(args, l, lds, wave_u); PH_END
        PH_BEGIN { const bf16* Aa = (const bf16*)(ws + WS_YB); const bf16* Bw = (const bf16*)(ws + WS_WGLU) + (size_t)l * DM * DM; FGlu f{ws, (const float*)args->in[I_BGLU] + (size_t)l * DM, nullptr, nullptr};
                   GEMM_FUSED(FGlu, f, Aa, Bw, DM, DM); thin_sample<8, FGlu>(lds, Aa, Bw, DM, f, wave_u); } PH_END
        PH_BEGIN { const bf16* Aa = (const bf16*)(ws + WS_AOB); const bf16* Bw = (const bf16*)(ws + WS_WSOUT) + (size_t)l * DM * DM; FResid f{ws, ss_buf(ws, 1 + 2 * is), nullptr};
                   GEMM_FUSED(FResid, f, Aa, Bw, DM, DM); thin_sample<8, FResid>(lds, Aa, Bw, DM, f, wave_u);
                   } PH_END
        PH_BEGIN { const bf16* Aa = (const bf16*)(ws + WS_HBB); const bf16* Bw = (const bf16*)(ws + WS_WPG) + (size_t)is * DM * DM; FPle f{ws, ss_buf(ws, 1 + 2 * is), ss_buf(ws, 2 + 2 * is), (const bf16*)(ws + WS_PRJ + PRJ_STRIDE)};
                   GEMM_FUSED(FPle, f, Aa, Bw, DM, DM); PMARK(1, wave_u); thin_sample<8, FPle>(lds, Aa, Bw, DM, f, wave_u); PMARK(2, wave_u); } PH_END
    lp = 1;
        PH_BEGIN { const bf16* Aa = (const bf16*)(ws + WS_HBA); const bf16* Bw = (const bf16*)(ws + WS_WAIN) + (size_t)l * ACOLS_PAD * DM; FAttnIn f{ws, args->out, ss_buf(ws, 2 * ia), l, nullptr};
                   GEMM_FUSED(FAttnIn, f, Aa, Bw, 6144, DM);
                   { const int wave = wave_u, lane = lane_id_fresh(); int tid = wave * 64 + lane; asm volatile("" : "+v"(tid));
                     for (int rb = blockIdx.x; rb < MP / 32; rb += gridDim.x) thin_tile<96, FAttnIn>(lds, Aa + (size_t)rb * 32 * DM, Bw + (size_t)6144 * DM, DM, rb * 32, 6144, f, tid, lane, wave); }
                   thin_sample<8, FAttnIn>(lds, Aa, Bw, ACOLS, f, wave_u); } PH_END
        PH_BEGIN ph_idx(args, l, lds, wave_u); ph_idx_sample(args, l, wave_u); PMARK(5, wave_u); PH_END
        PH_BEGIN ph_attn(args, lds, wave_u);
                   if ((int)blockIdx.x < MS * NKV || (int)gridDim.x < 2 * MS * NKV) ph_attn_sample(args, l, lds, wave_u);
                   if ((int)blockIdx.x >= MS * NKV || (int)gridDim.x < 2 * MS * NKV) {
                       const int wg0 = ((int)gridDim.x < 2 * MS * NKV) ? 0 : MS * NKV, nwg = (int)gridDim.x - wg0;
                       __syncthreads();
                       for (int q = 0; q < 2; ++q) { const int li = 2 * l + q; const bf16* Ap = (const bf16*)(ws + WS_PB + (size_t)li * PB_STRIDE); const bf16* Bp = (const bf16*)(ws + WS_WPP) + (size_t)li * DM * PLE;
                           FPleProj fp{ws, nullptr, nullptr, (bf16*)(ws + WS_PRJ + (size_t)q * PRJ_STRIDE)};
                           GEMM_FUSED_SUB(FPleProj, fp, Ap, Bp, DM, PLE, wg0, nwg); thin_sample<1, FPleProj>(lds, Ap, Bp, DM, fp, wave_u, wg0, nwg); } } PH_END
        PH_BEGIN { const bf16* Aa = (const bf16*)(ws + WS_AOB); const bf16* Bw = (const bf16*)(ws + WS_WAOUT) + (size_t)l * DM * DM; FResid f{ws, ss_buf(ws, 1 + 2 * ia), nullptr};
                   GEMM_FUSED(FResid, f, Aa, Bw, DM, DM); thin_sample<8, FResid>(lds, Aa, Bw, DM, f, wave_u);
                   } PH_END
        PH_BEGIN { const bf16* Aa = (const bf16*)(ws + WS_HBB); const bf16* Bw = (const bf16*)(ws + WS_WPG) + (size_t)ia * DM * DM; FPle f{ws, ss_buf(ws, 1 + 2 * ia), ss_buf(ws, 2 + 2 * ia), (const bf16*)(ws + WS_PRJ)};
                   GEMM_FUSED(FPle, f, Aa, Bw, DM, DM); PMARK(1, wave_u); thin_sample<8, FPle>(lds, Aa, Bw, DM, f, wave_u); PMARK(2, wave_u); } PH_END
        PH_BEGIN { const bf16* Aa = (const bf16*)(ws + WS_HBA); const bf16* Bw = (const bf16*)(ws + WS_WSIN) + (size_t)l * 4096 * DM; FSsmIn f{ws, ss_buf(ws, 2 * is), nullptr};
                   GEMM_FUSED(FSsmIn, f, Aa, Bw, 4096, DM); thin_sample<8, FSsmIn>(lds, Aa, Bw, 4096, f, wave_u); } PH_END
        PH_BEGIN ph_scan(args, l, lds, wave_u); PH_END
        PH_BEGIN { const bf16* Aa = (const bf16*)(ws + WS_YB); const bf16* Bw = (const bf16*)(ws + WS_WGLU) + (size_t)l * DM * DM; FGlu f{ws, (const float*)args->in[I_BGLU] + (size_t)l * DM, nullptr, nullptr};
                   GEMM_FUSED(FGlu, f, Aa, Bw, DM, DM); thin_sample<8, FGlu>(lds, Aa, Bw, DM, f, wave_u); } PH_END
        PH_BEGIN { const bf16* Aa = (const bf16*)(ws + WS_AOB); const bf16* Bw = (const bf16*)(ws + WS_WSOUT) + (size_t)l * DM * DM; FResid f{ws, ss_buf(ws, 1 + 2 * is), nullptr};
                   GEMM_FUSED(FResid, f, Aa, Bw, DM, DM); thin_sample<8, FResid>(lds, Aa, Bw, DM, f, wave_u);
                   } PH_END
        PH_BEGIN { const bf16* Aa = (const bf16*)(ws + WS_HBB); const bf16* Bw = (const bf16*)(ws + WS_WPG) + (size_t)is * DM * DM; FPle f{ws, ss_buf(ws, 1 + 2 * is), ss_buf(ws, 2 + 2 * is), (const bf16*)(ws + WS_PRJ + PRJ_STRIDE)};
                   GEMM_FUSED(FPle, f, Aa, Bw, DM, DM); PMARK(1, wave_u); thin_sample<8, FPle>(lds, Aa, Bw, DM, f, wave_u); PMARK(2, wave_u); } PH_END
    PH_BEGIN ph_final(args, wave_u); PH_LAST
#if PROF
    if (blockIdx.x == 0 && wave_u == 0) { const unsigned accA = MISC[18], accB = MISC[19]; const unsigned qa = min(99u, accA / (100u * PROF_UNIT_US)), qb = min(99u, accB / (100u * PROF_UNIT_US));
        const unsigned long long t_end = __builtin_amdgcn_s_memrealtime() + (unsigned long long)(qa * 20u + qb * 2000u) * 100ull;
        while (__builtin_amdgcn_s_memrealtime() < t_end) __builtin_amdgcn_s_sleep(32); }
#endif
}
constexpr int N_PHASES = 1 + 2 * 24 + 2;

#ifndef MK_PER_PHASE
#define MK_PER_PHASE 0
#endif
extern "C" void kernel_launch(void* const* d_in, const int* in_sizes, int n_in, void* d_out, int out_size, void* d_ws, size_t ws_size, hipStream_t stream) {
    static int grid = 0;
    if (grid == 0) {
        if (n_in != N_IN || out_size != (int)O_END || ws_size < WS_END) { fprintf(stderr, "kernel_launch: unexpected shapes: n_in %d out %d ws %zu (need %zu)\n", n_in, out_size, ws_size, (size_t)WS_END); grid = -1; return; }
        int dev = 0, cus = 0, per_cu = 0;
        if (hipGetDevice(&dev) != hipSuccess || hipDeviceGetAttribute(&cus, hipDeviceAttributeMultiprocessorCount, dev) != hipSuccess) { grid = -1; return; }
        if (hipFuncSetAttribute((const void*)fwd_kernel, hipFuncAttributeMaxDynamicSharedMemorySize, LDS_BYTES) != hipSuccess) { fprintf(stderr, "kernel_launch: hipFuncSetAttribute failed\n"); grid = -1; return; }
        if (hipOccupancyMaxActiveBlocksPerMultiprocessor(&per_cu, (const void*)fwd_kernel, NTHR, LDS_BYTES) != hipSuccess || per_cu < 1) fprintf(stderr, "kernel_launch: occupancy query reports %d\n", per_cu);
        (void)hipGetLastError();
        grid = cus;
    }
    if (grid < 0) return;
    if (hipMemsetAsync((char*)d_ws + WS_CTL, 0, CTL_ZERO_BYTES, stream) != hipSuccess) return;
    Args a{};
    for (int i = 0; i < N_IN; ++i) a.in[i] = d_in[i];
    a.out = (float*)d_out; a.ws = (unsigned char*)d_ws;
    a.ph_lo = 0; a.ph_hi = N_PHASES;
    hipLaunchKernelGGL(fwd_kernel, dim3(grid), dim3(NTHR), LDS_BYTES, stream, a);
    const hipError_t le = hipPeekAtLastError();
    if (le != hipSuccess) fprintf(stderr, "kernel_launch: launch failed: %s\n", hipGetErrorName(le));
}
```

```cpp
#include <hip/hip_runtime.h>
#include <cstdio>
#include <cstdint>
#ifndef PROF
#define PROF 0
#endif
#define PROF_UNIT_US 8u
#define PROF_MATCH_A(id) (false)
#define PROF_MATCH_B(id) (false)

__device__ __forceinline__ int lane_id_fresh();
namespace pg8 {
#define PG8_LAS __attribute__((address_space(3)))
typedef unsigned short bf16_t;
typedef short bf16x8 __attribute__((ext_vector_type(8)));
typedef float f32x4 __attribute__((ext_vector_type(4)));
typedef unsigned u32x4 __attribute__((ext_vector_type(4)));
constexpr int BM = 256, BK = 64, HALF = 128, HTB = HALF * BK * 2, STAGE_BYTES = 8 * HTB, NXCD = 8, WGM = 8;

__host__ __device__ __forceinline__ int lds_byte(int r, int c) { const int st = (r >> 4) * 2 + (c >> 5), rr = r & 15, cc = c & 31, ob = rr * 64 + cc * 2; return st * 1024 + (ob ^ (((ob >> 9) & 1) << 5)); }
__host__ __device__ __forceinline__ void stage_rc(int b, int& R, int& C) { const int st = b / 1024, sb = b % 1024, swz = sb ^ (((sb >> 9) & 1) << 5); R = (st >> 1) * 16 + swz / 64; C = (st & 1) * 32 + (swz % 64) / 2; }

struct Unit { int pm, pn; };
struct Gemm { const bf16_t* A; const bf16_t* Bt; int M, N, K; };

struct StaticOrder {
    int nM, nN, nwg, G, c;
    __host__ __device__ void init(int M, int N, int G_, int c_) { nM = M / BM; nN = N / BM; nwg = nM * nN; G = G_; c = c_; }
    __host__ __device__ bool next(int i, Unit& u) const {
        const long L = (long)i * G + c; if (L >= nwg) return false;
        int wgid = (int)L; { const int q = nwg / NXCD, r = nwg % NXCD, xcd = wgid % NXCD, off = wgid / NXCD; wgid = (xcd < r ? xcd * (q + 1) : r * (q + 1) + (xcd - r) * q) + off; }
        const int nig = WGM * nN, gid = wgid / nig, fm = gid * WGM, gsz = (nM - fm) < WGM ? (nM - fm) : WGM;
        u.pm = fm + ((wgid % nig) % gsz); u.pn = (wgid % nig) / gsz; return true;
    }
    __device__ __forceinline__ void a_ready(const Unit&) const {}
    __device__ __forceinline__ void done(const Unit&) const {}
};

struct EpiF32 {
    float* C; int ldc;
    __device__ __forceinline__ void operator()(const f32x4 (&acc)[2][2][4][2], const Unit& u, int wr, int wc, int fr, int fq) const {
        const int row0 = u.pm * BM + wr * 64 + fr, col0 = u.pn * BM + wc * 32 + 4 * fq;
#pragma unroll
        for (int ai = 0; ai < 2; ++ai)
#pragma unroll
            for (int m = 0; m < 4; ++m) { float* rowp = C + (size_t)(row0 + ai * HALF + m * 16) * ldc + col0;
#pragma unroll
                for (int bj = 0; bj < 2; ++bj)
#pragma unroll
                    for (int n = 0; n < 2; ++n) *(f32x4*)(rowp + bj * HALF + n * 16) = acc[ai][bj][m][n]; }
    }
};

template <class Epi, class Sched, bool ALIGN_EPI = false, bool SP2 = false>
__device__ __forceinline__ void gemm_phase(PG8_LAS unsigned char* lds, const Gemm g, const Sched& S, const Epi& E, int wv) {
    int tid = threadIdx.x; (void)wv; asm volatile("" : "+v"(tid)); __builtin_assume(tid >= 0); __builtin_assume(tid < 512);
    int tidg = tid;
    const int wid = __builtin_amdgcn_readfirstlane(tid >> 6), lane = tid & 63, wr = wid >> 2, wc = wid & 3, fr = lane & 15, fq = lane >> 4;
    const int K = g.K, nt = K / BK;
    unsigned voffA[2], voffB[2];
#pragma unroll
    for (int i = 0; i < 2; ++i) { int R, C; stage_rc(tidg * 16 + i * 8192, R, C); const int Rb = R;
        voffA[i] = (unsigned)(R * K + C) * 2u; voffB[i] = (unsigned)(Rb * K + C) * 2u; }
    const size_t kstep = (size_t)(BK * 2);
    const size_t hstep = (size_t)HALF * K * 2;
    const size_t tstep = 2 * hstep;
    const unsigned ldsw = (unsigned)wid * 1024u;
    const int aoff = lds_byte(wr * 64 + fr, fq * 8), boff = lds_byte(wc * 32 + fr, fq * 8);
#define PG8_SA(b, h) (((b) * 2 + (h)) * HTB)
#define PG8_SB(b, h) ((4 + (b) * 2 + (h)) * HTB)
#define PG8_STAGE(bufoff, gbase, voff) do { _Pragma("unroll") for (int _i = 0; _i < 2; ++_i) \
        __builtin_amdgcn_global_load_lds((const unsigned*)((const char*)(gbase) + (voff)[_i]), (PG8_LAS unsigned*)(lds + (bufoff) + ldsw + _i * 8192), 16, 0, 0); } while (0)
#define PG8_LDA(dst, b, h) do { _Pragma("unroll") for (int m = 0; m < 4; ++m) _Pragma("unroll") for (int k = 0; k < 2; ++k) dst[m][k] = *(const PG8_LAS bf16x8*)(lds + PG8_SA(b, h) + aoff + m * 2048 + k * 1024); } while (0)
#define PG8_LDB(dst, b, h) do { _Pragma("unroll") for (int n = 0; n < 2; ++n) _Pragma("unroll") for (int k = 0; k < 2; ++k) dst[n][k] = *(const PG8_LAS bf16x8*)(lds + PG8_SB(b, h) + boff + n * 2048 + k * 1024); } while (0)
#define PG8_MMA(ai, bj, At, Bt) do { __builtin_amdgcn_s_setprio(1); _Pragma("unroll") for (int m = 0; m < 4; ++m) _Pragma("unroll") for (int n = 0; n < 2; ++n) _Pragma("unroll") for (int k = 0; k < 2; ++k) \
        acc[ai][bj][m][n] = __builtin_amdgcn_mfma_f32_16x16x32_bf16(Bt[n][k], At[m][k], acc[ai][bj][m][n], 0, 0, 0); __builtin_amdgcn_s_setprio(0); } while (0)
#define PG8_WAIT_V(n) asm volatile("s_waitcnt vmcnt(" #n ")" ::: "memory")
#define PG8_WAIT_L(n) asm volatile("s_waitcnt lgkmcnt(" #n ")" ::: "memory")
#define PG8_BAR __builtin_amdgcn_s_barrier()
#define PG8_SCHED __builtin_amdgcn_sched_barrier(0)
    Unit cur, nxt; int ui = 0;
    if (!S.next(0, cur)) return;
    f32x4 acc[2][2][4][2];
#pragma unroll
    for (int a = 0; a < 2; ++a)
#pragma unroll
        for (int b = 0; b < 2; ++b)
#pragma unroll
            for (int m = 0; m < 4; ++m)
#pragma unroll
                for (int n = 0; n < 2; ++n) acc[a][b][m][n] = (f32x4){0.f, 0.f, 0.f, 0.f};
    bf16x8 At[4][2], B0[2][2], B1[2][2];
    const char* cA = (const char*)g.A + (size_t)cur.pm * tstep; const char* cB = (const char*)g.Bt + (size_t)cur.pn * tstep;
    S.a_ready(cur);
    if constexpr (SP2) {
        PG8_STAGE(PG8_SB(0, 0), cB, voffB); PG8_STAGE(PG8_SB(0, 1), cB + hstep, voffB); PG8_STAGE(PG8_SA(0, 0), cA, voffA); PG8_STAGE(PG8_SA(0, 1), cA + hstep, voffA);
        if (wr == 1) PG8_BAR;
        PG8_WAIT_V(2); PG8_BAR;
        PG8_STAGE(PG8_SB(1, 0), cB + kstep, voffB); PG8_STAGE(PG8_SA(1, 0), cA + kstep, voffA); PG8_STAGE(PG8_SB(1, 1), cB + hstep + kstep, voffB);
        PG8_WAIT_V(6); PG8_BAR;
    } else {
        PG8_STAGE(PG8_SB(0, 0), cB, voffB); PG8_STAGE(PG8_SA(0, 0), cA, voffA); PG8_STAGE(PG8_SB(0, 1), cB + hstep, voffB); PG8_STAGE(PG8_SA(0, 1), cA + hstep, voffA);
        if (wr == 1) PG8_BAR;
        PG8_WAIT_V(4); PG8_BAR;
        PG8_STAGE(PG8_SB(1, 0), cB + kstep, voffB); PG8_STAGE(PG8_SA(1, 0), cA + kstep, voffA); PG8_STAGE(PG8_SB(1, 1), cB + hstep + kstep, voffB);
        PG8_WAIT_V(6); PG8_BAR;
    }
    for (;;) {
        const bool has_next = S.next(ui + 1, nxt);
        const char* nA = has_next ? (const char*)g.A + (size_t)nxt.pm * tstep : cA; const char* nB = has_next ? (const char*)g.Bt + (size_t)nxt.pn * tstep : cB;
        for (int t = 0; t < nt; t += 2) {
            const bool last = (t == nt - 2);
            const char* a1 = cA + (size_t)(t + 1) * kstep;
            const char* a2 = last ? nA : cA + (size_t)(t + 2) * kstep; const char* b2 = last ? nB : cB + (size_t)(t + 2) * kstep;
            const char* a3 = a2 + kstep; const char* b3 = b2 + kstep;
            if (last && has_next) S.a_ready(nxt);
            if constexpr (SP2) {
            PG8_LDB(B0, 0, 0); PG8_LDB(B1, 0, 1); PG8_SCHED; PG8_LDA(At, 0, 0); PG8_STAGE(PG8_SA(1, 1), a1 + hstep, voffA);
            PG8_WAIT_V(8); PG8_WAIT_L(0); PG8_BAR; PG8_MMA(0, 0, At, B0); PG8_MMA(0, 1, At, B1); PG8_BAR; PG8_SCHED;
            PG8_LDA(At, 0, 1); PG8_STAGE(PG8_SB(0, 0), b2, voffB); PG8_STAGE(PG8_SB(0, 1), b2 + hstep, voffB); PG8_STAGE(PG8_SA(0, 0), a2, voffA);
            PG8_WAIT_V(8); PG8_WAIT_L(0); PG8_BAR; PG8_MMA(1, 0, At, B0); PG8_MMA(1, 1, At, B1); PG8_BAR; PG8_SCHED;
            PG8_LDB(B0, 1, 0); PG8_LDB(B1, 1, 1); PG8_SCHED; PG8_LDA(At, 1, 0); PG8_STAGE(PG8_SA(0, 1), a2 + hstep, voffA);
            PG8_WAIT_V(8); PG8_WAIT_L(0); PG8_BAR; PG8_MMA(0, 0, At, B0); PG8_MMA(0, 1, At, B1); PG8_BAR; PG8_SCHED;
            PG8_LDA(At, 1, 1); PG8_STAGE(PG8_SB(1, 0), b3, voffB); PG8_STAGE(PG8_SB(1, 1), b3 + hstep, voffB); PG8_STAGE(PG8_SA(1, 0), a3, voffA);
            PG8_WAIT_V(8); PG8_WAIT_L(0); PG8_BAR; PG8_MMA(1, 0, At, B0); PG8_MMA(1, 1, At, B1); PG8_BAR; PG8_SCHED;
            } else {
            PG8_LDB(B0, 0, 0); PG8_SCHED; PG8_LDA(At, 0, 0); PG8_STAGE(PG8_SA(1, 1), a1 + hstep, voffA);
            PG8_WAIT_L(8); PG8_BAR; PG8_WAIT_L(0); PG8_MMA(0, 0, At, B0); PG8_BAR; PG8_SCHED;
            PG8_LDB(B1, 0, 1); PG8_STAGE(PG8_SB(0, 0), b2, voffB);
            PG8_BAR; PG8_WAIT_L(0); PG8_MMA(0, 1, At, B1); PG8_BAR;
            PG8_LDA(At, 0, 1); PG8_STAGE(PG8_SA(0, 0), a2, voffA);
            PG8_BAR; PG8_WAIT_L(0); PG8_MMA(1, 0, At, B0); PG8_BAR; PG8_SCHED;
            PG8_STAGE(PG8_SB(0, 1), b2 + hstep, voffB);
            PG8_WAIT_V(6); PG8_BAR; PG8_MMA(1, 1, At, B1); PG8_BAR;
            PG8_LDB(B0, 1, 0); PG8_SCHED; PG8_LDA(At, 1, 0); PG8_STAGE(PG8_SA(0, 1), a2 + hstep, voffA);
            PG8_WAIT_L(8); PG8_BAR; PG8_WAIT_L(0); PG8_MMA(0, 0, At, B0); PG8_BAR; PG8_SCHED;
            PG8_LDB(B1, 1, 1); PG8_STAGE(PG8_SB(1, 0), b3, voffB);
            PG8_BAR; PG8_WAIT_L(0); PG8_MMA(0, 1, At, B1); PG8_BAR;
            PG8_LDA(At, 1, 1); PG8_STAGE(PG8_SA(1, 0), a3, voffA);
            PG8_BAR; PG8_WAIT_L(0); PG8_MMA(1, 0, At, B0); PG8_BAR; PG8_SCHED;
            PG8_STAGE(PG8_SB(1, 1), b3 + hstep, voffB);
            PG8_WAIT_V(6); PG8_BAR; PG8_MMA(1, 1, At, B1); PG8_BAR;
            }
        }
        if constexpr (ALIGN_EPI) { if (wr == 0) PG8_BAR; }
        E(acc, cur, wr, wc, tidg & 15, (tidg >> 4) & 3); S.done(cur);
        if (!has_next) break;
#pragma unroll
        for (int a = 0; a < 2; ++a)
#pragma unroll
            for (int b = 0; b < 2; ++b)
#pragma unroll
                for (int m = 0; m < 4; ++m)
#pragma unroll
                    for (int n = 0; n < 2; ++n) acc[a][b][m][n] = (f32x4){0.f, 0.f, 0.f, 0.f};
        cur = nxt; cA = nA; cB = nB; ++ui;
        if constexpr (ALIGN_EPI) { if (wr == 1) PG8_BAR; }
    }
    PG8_WAIT_V(0);
    if constexpr (!ALIGN_EPI) { if (wr == 0) PG8_BAR; }
    PG8_BAR;
#undef PG8_SA
#undef PG8_SB
#undef PG8_STAGE
#undef PG8_LDA
#undef PG8_LDB
#undef PG8_MMA
#undef PG8_WAIT_V
#undef PG8_WAIT_L
#undef PG8_BAR
#undef PG8_SCHED
}
}

constexpr int NWAVES = 8, NTHR = NWAVES * 64;
constexpr int DM = 2048, NBATCH = 2, SEQ = 4096, DEPTH = 4, DBATCH = 8, DSEQ = 4, PAST = 16384, PAGE = 128;
constexpr int NPAGES = PAST / PAGE, NPOOL = 1280, NAL = 2, NSL = 2;
constexpr int NH = 16, NKV = 4, HD = 128, KVG = 4, NIH = 16, IDD = 64, TOPK = 256;
constexpr int ACOLS = 6224, ACOLS_PAD = 6400;
constexpr int C_Q = 0, C_K = 2048, C_V = 2560, C_G = 3072, C_QI = 5120, C_KI = 6144, C_WI = 6208;
constexpr int SGRP = 16, NGRP = 128, SST = 64, PLE = 256;
constexpr int MP = NBATCH * SEQ, MS = DBATCH * DSEQ, MR = MP + MS, MPAD = 8448;
constexpr float RMS_EPS = 1e-6f;
constexpr float LOG2E = 1.4426950408889634f;
constexpr float QSCALE = 0.088388347648318440f * LOG2E;
constexpr float WISCALE = 0.25f * 0.125f;
enum { I_XP = 0, I_XS, I_CK, I_CV, I_CKI, I_SRE, I_SIM, I_PT, I_PP, I_PS, I_NW, I_FNW, I_RB, I_AWI, I_AWO, I_SWI, I_LRE, I_LIM, I_LDT, I_BRE, I_BIM, I_CRE, I_CIM, I_SD, I_WGLU, I_BGLU, I_SWO, I_PNW, I_PWG, I_PWP, N_IN };
constexpr size_t O_YP = 0, O_YS = O_YP + (size_t)MP * DM, O_KP = O_YS + (size_t)MS * DM, O_VP = O_KP + (size_t)NAL * MP * 512, O_KIP = O_VP + (size_t)NAL * MP * 512,
    O_SRP = O_KIP + (size_t)NAL * MP * 64, O_SIP = O_SRP + (size_t)NSL * NBATCH * NGRP * SST, O_KS = O_SIP + (size_t)NSL * NBATCH * NGRP * SST, O_VS = O_KS + (size_t)NAL * MS * 512,
    O_KIS = O_VS + (size_t)NAL * MS * 512, O_SRS = O_KIS + (size_t)NAL * MS * 64, O_SIS = O_SRS + (size_t)NSL * DBATCH * NGRP * SST, O_END = O_SIS + (size_t)NSL * DBATCH * NGRP * SST;
static_assert(O_END == 35065856, "output size");

constexpr size_t MiB = 1u << 20;
constexpr size_t WS_CTL = 0, CTL_ZERO_BYTES = 64 * 1024;
constexpr size_t WS_WAIN = 2 * MiB;
constexpr size_t WS_WAOUT = WS_WAIN + 50 * MiB;
constexpr size_t WS_WSIN = WS_WAOUT + 16 * MiB;
constexpr size_t WS_WGLU = WS_WSIN + 32 * MiB;
constexpr size_t WS_WSOUT = WS_WGLU + 16 * MiB;
constexpr size_t WS_WPG = WS_WSOUT + 16 * MiB;
constexpr size_t WS_WPP = WS_WPG + 32 * MiB;
constexpr size_t WS_H = WS_WPP + 4 * MiB;
constexpr size_t WS_HBA = WS_H + 66 * MiB, WS_HBB = WS_HBA + 33 * MiB;
constexpr size_t WS_PB = WS_HBB + 33 * MiB;
constexpr size_t PB_STRIDE = (size_t)MPAD * PLE * 2;
constexpr size_t WS_QB = WS_PB + 17 * MiB;
constexpr size_t WS_KB = WS_QB + 33 * MiB, WS_VB = WS_KB + 9 * MiB;
constexpr size_t WS_GB = WS_VB + 9 * MiB;
constexpr size_t WS_QIB = WS_GB + 33 * MiB;
constexpr size_t WS_KIB = WS_QIB + 17 * MiB;
constexpr size_t WS_WI = WS_KIB + 2 * MiB;
constexpr size_t WS_AOB = WS_WI + 1 * MiB;
constexpr size_t WS_UG = WS_AOB + 33 * MiB;
constexpr size_t WS_US = WS_UG + 32 * MiB;
constexpr size_t WS_YB = WS_US + 1 * MiB;
constexpr size_t WS_RSTD = WS_YB + 33 * MiB;
constexpr size_t WS_C = WS_RSTD + 1 * MiB;
constexpr size_t WS_C2 = WS_C + 207 * MiB;
constexpr size_t WS_SC = WS_C2 + 66 * MiB;
constexpr int SC_LD = SEQ + 64;
constexpr size_t WS_SCS = WS_SC + 130 * MiB;
constexpr int SCS_LD = 16400;
constexpr size_t WS_SEL = WS_SCS + 3 * MiB;
constexpr size_t WS_KM = WS_SEL + 9 * MiB;
constexpr size_t WS_END = WS_KM + 4 * MiB;
constexpr int CW_BAR = 4096;

constexpr int LDS_BYTES = 147456;
constexpr int MISC_OFF = 131072 + 320;

#define GAS __attribute__((address_space(1)))
#define LAS __attribute__((address_space(3)))
typedef unsigned short bf16;
typedef unsigned v4u __attribute__((ext_vector_type(4)));
typedef unsigned v2u __attribute__((ext_vector_type(2)));
typedef float f32x4 __attribute__((ext_vector_type(4)));
#define LDS_WAIT() asm volatile("s_waitcnt lgkmcnt(0)" ::: "memory")
__device__ __forceinline__ int lane_id_fresh() { unsigned ones = ~0u; asm volatile("" : "+s"(ones)); return (int)__builtin_amdgcn_mbcnt_hi(ones, __builtin_amdgcn_mbcnt_lo(ones, 0u)); }
__device__ __forceinline__ unsigned f2bf(float f) { unsigned u = __builtin_bit_cast(unsigned, f); return (u + 0x7fffu + ((u >> 16) & 1u)) >> 16; }
__device__ __forceinline__ unsigned pk2(float lo, float hi) { return f2bf(lo) | (f2bf(hi) << 16); }
__device__ __forceinline__ float bf2f(unsigned short b) { return __builtin_bit_cast(float, ((unsigned)b) << 16); }
__device__ __forceinline__ float bflo(unsigned w) { return __builtin_bit_cast(float, w << 16); }
__device__ __forceinline__ float bfhi(unsigned w) { return __builtin_bit_cast(float, w & 0xffff0000u); }
__device__ __forceinline__ float sigmoidf_(float x) { return 1.0f / (1.0f + __expf(-x)); }
__device__ __forceinline__ float siluf_(float x) { return x * sigmoidf_(x); }
__device__ __forceinline__ float gelu_tanh(float x) { const float u = 0.7978845608028654f * (x + 0.044715f * x * x * x); return x * sigmoidf_(2.0f * u); }
__device__ __forceinline__ float wave_sum(float v) {
#pragma unroll
    for (int o = 1; o < 64; o <<= 1) v += __shfl_xor(v, o);
    return v;
}
__device__ __forceinline__ float* ss_buf(unsigned char* ws, int k);
__device__ __forceinline__ float ss2rstd(float ss);
__device__ __forceinline__ float ss_row_rstd(const float* ssp, int r);
__device__ __forceinline__ int t5_bucket(int n) {
    if (n < 16) return n;
    int b = 16;
    b += (n >= 19) + (n >= 21) + (n >= 24) + (n >= 27) + (n >= 31) + (n >= 35) + (n >= 40) + (n >= 46) + (n >= 52) + (n >= 59) + (n >= 67) + (n >= 77) + (n >= 87) + (n >= 99) + (n >= 113);
    return b;
}

#define XB_TMO      128
#define XB_XCNT(j)  (256  + 64 * (j))
#define XB_XSUB(j)  (1280 + 64 * (j))
#define XB_XGEN(j)  (2304 + 64 * (j))
#define XB_TOP      3328
#define XB_TOPGEN   3392
#define XCD_BAR_WORDS 3456
#define XB_SPIN_CAP (1u << 22)
__device__ __forceinline__ unsigned xb_ld(unsigned* p)              { return __hip_atomic_load(p, __ATOMIC_RELAXED, __HIP_MEMORY_SCOPE_AGENT); }
__device__ __forceinline__ unsigned xb_add(unsigned* p, unsigned v) { return __hip_atomic_fetch_add(p, v, __ATOMIC_RELAXED, __HIP_MEMORY_SCOPE_AGENT); }
__device__ __forceinline__ unsigned xb_xcc_id() { return (unsigned)__builtin_amdgcn_s_getreg((3 << 11) | 20) & 0xFu; }
#define XB_SPIN(cond, bar) do { unsigned _sp = 0; while (cond) { __builtin_amdgcn_s_sleep(1); \
    if ((++_sp & 255u) == 0u) { if (xb_ld(&(bar)[XB_TMO])) break; if (_sp > XB_SPIN_CAP) { atomicAdd(&(bar)[XB_TMO], 1u); break; } } } } while (0)
struct XcdBarrier { unsigned* bar; unsigned x; volatile LAS unsigned* st; };
__device__ __forceinline__ XcdBarrier xcd_barrier_post(unsigned* bar, volatile LAS unsigned* st, int wv) {
    XcdBarrier b; b.bar = bar; b.x = xb_xcc_id(); b.st = st;
    if (wv == 0 && lane_id_fresh() == 0) (void)xb_add(&bar[XB_XCNT(b.x)], 1u);
    return b;
}
__device__ __forceinline__ void xcd_barrier_complete(unsigned* bar, unsigned x, unsigned& nloc, unsigned& nx) {
    const unsigned G = gridDim.x * gridDim.y * gridDim.z;
    unsigned sum, cnt, mine, sp = 0u;
    for (;;) {
        sum = 0u; cnt = 0u; mine = 0u;
#pragma unroll
        for (unsigned j = 0; j < 16; ++j) { const unsigned c = xb_ld(&bar[XB_XCNT(j)]); sum += c; cnt += (c > 0u) ? 1u : 0u; mine = (j == x) ? c : mine; }
        if (sum == G) break;
        __builtin_amdgcn_s_sleep(1);
        if ((++sp & 255u) == 0u) { if (xb_ld(&bar[XB_TMO])) break; if (sp > XB_SPIN_CAP) { atomicAdd(&bar[XB_TMO], 1u); break; } }
    }
    nloc = mine > 0u ? mine : 1u; nx = cnt > 0u ? cnt : 1u;
}
__device__ __forceinline__ void xcd_barrier(const XcdBarrier& b, int wv) {
    asm volatile("s_waitcnt vmcnt(0)" ::: "memory");
    __syncthreads();
    if (wv == 0 && lane_id_fresh() == 0) {
        unsigned* bar = b.bar;
        __builtin_amdgcn_s_waitcnt(0);
        unsigned nloc = b.st[0], nx = b.st[1];
        if (nloc == 0u) { xcd_barrier_complete(bar, b.x, nloc, nx); b.st[0] = nloc; b.st[1] = nx; }
        const unsigned old = xb_add(&bar[XB_XSUB(b.x)], 1u);
        const unsigned gen = old / nloc;
        if (old + 1u == (gen + 1u) * nloc) {
            __builtin_amdgcn_fence(__ATOMIC_RELEASE, "agent");
            asm volatile("s_waitcnt vmcnt(0)" ::: "memory");
            const unsigned og = xb_add(&bar[XB_TOP], 1u);
            const unsigned tg = og / nx;
            if (og + 1u == (tg + 1u) * nx) xb_add(&bar[XB_TOPGEN], 1u);
            else XB_SPIN(xb_ld(&bar[XB_TOPGEN]) == tg, bar);
            __builtin_amdgcn_fence(__ATOMIC_ACQUIRE, "agent");
            xb_add(&bar[XB_XGEN(b.x)], 1u);
            asm volatile("s_waitcnt vmcnt(0)" ::: "memory");
        } else {
            XB_SPIN(xb_ld(&bar[XB_XGEN(b.x)]) == gen, bar);
            __builtin_amdgcn_fence(__ATOMIC_ACQUIRE, "agent");
            asm volatile("s_waitcnt vmcnt(0)" ::: "memory");
        }
    }
    __syncthreads();
}

#if PROF
__device__ __forceinline__ void prof_mark(int id, int wave) {
    extern __shared__ __attribute__((aligned(16))) unsigned char lds_raw[];
    if (blockIdx.x == 0 && wave == 0) { volatile LAS unsigned* M = (volatile LAS unsigned*)((LAS unsigned char*)lds_raw + MISC_OFF);
        const unsigned long long tn = __builtin_amdgcn_s_memrealtime(); const unsigned long long tp = ((unsigned long long)M[17] << 32) | M[16]; const unsigned d = (unsigned)(tn - tp);
        if (PROF_MATCH_A(id)) M[18] = M[18] + d; if (PROF_MATCH_B(id)) M[19] = M[19] + d; M[16] = (unsigned)tn; M[17] = (unsigned)(tn >> 32); }
}
#define PMARK(id, wave) prof_mark(id, wave)
#else
#define PMARK(id, wave) do {} while (0)
#endif
struct Args { const void* in[N_IN]; float* out; unsigned char* ws; int ph_lo, ph_hi; };
typedef const __attribute__((address_space(4))) Args* ArgP;
#define TID_LOCAL() ArgP a = a_; asm volatile("" : "+s"(a)); const int wave = wv_; const int lane = lane_id_fresh(); int tid = wave * 64 + lane; asm volatile("" : "+v"(tid)); const int gw = blockIdx.x * NWAVES + wave, NGW = gridDim.x * NWAVES; (void)lane; (void)wave; (void)gw; (void)NGW
#define GTID_LOCAL() const size_t gtid = (size_t)blockIdx.x * NTHR + tid, GT = (size_t)gridDim.x * NTHR

__device__ __forceinline__ void transpose_item(const float* W, int K, int N, const float* scale, bf16* WT, LAS float* scr, int item, int lane) {
    const int nblk = (N + 31) / 32, kb = item / nblk, nb = item % nblk, k0 = 64 * kb, n0 = 32 * nb;
    const int n = n0 + (lane & 31); const float* wp = W + (size_t)(k0 + (lane >> 5)) * N + n;
    float v[32];
#pragma unroll
    for (int i = 0; i < 32; ++i) v[i] = (n < N) ? wp[(size_t)(2 * i) * N] : 0.f;
#pragma unroll
    for (int i = 0; i < 32; ++i) scr[(2 * i + (lane >> 5)) * 33 + (lane & 31)] = v[i];
    LDS_WAIT(); asm volatile("" ::: "memory");
    const int c = lane & 7;
    f32x4 s0 = {1.f, 1.f, 1.f, 1.f}, s1 = {1.f, 1.f, 1.f, 1.f};
    if (scale) { s0 = *(const f32x4*)(scale + k0 + 8 * c); s1 = *(const f32x4*)(scale + k0 + 8 * c + 4); }
#pragma unroll
    for (int j = 0; j < 4; ++j) { const int nn = (lane >> 3) + 8 * j; const LAS float* s = scr + (8 * c) * 33 + nn;
        v4u o; o.x = pk2(s[0 * 33] * s0[0], s[1 * 33] * s0[1]); o.y = pk2(s[2 * 33] * s0[2], s[3 * 33] * s0[3]); o.z = pk2(s[4 * 33] * s1[0], s[5 * 33] * s1[1]); o.w = pk2(s[6 * 33] * s1[2], s[7 * 33] * s1[3]);
        *(v4u*)(WT + (size_t)(n0 + nn) * K + k0 + 8 * c) = o; }
    LDS_WAIT(); asm volatile("" ::: "memory");
}

__device__ __forceinline__ void ph_prologue(ArgP a_, LAS unsigned char* lds, int wv_) {
    TID_LOCAL();
    LAS float* scr = (LAS float*)(lds + wave * 16384);
    unsigned char* ws = a->ws;
    for (int m = 0; m < 18; ++m) {
        const float* W; int K = DM, N = DM; const float* sc = nullptr; bf16* WT;
        if (m < 2)       { W = (const float*)a->in[I_AWI] + (size_t)m * DM * ACOLS; N = ACOLS; sc = (const float*)a->in[I_NW] + (size_t)(2 * m) * DM; WT = (bf16*)(ws + WS_WAIN) + (size_t)m * ACOLS_PAD * DM; }
        else if (m < 4)  { const int l = m - 2; W = (const float*)a->in[I_AWO] + (size_t)l * DM * DM; WT = (bf16*)(ws + WS_WAOUT) + (size_t)l * DM * DM; }
        else if (m < 6)  { const int l = m - 4; W = (const float*)a->in[I_SWI] + (size_t)l * DM * 4096; N = 4096; sc = (const float*)a->in[I_NW] + (size_t)(2 * l + 1) * DM; WT = (bf16*)(ws + WS_WSIN) + (size_t)l * 4096 * DM; }
        else if (m < 8)  { const int l = m - 6; W = (const float*)a->in[I_WGLU] + (size_t)l * DM * DM; WT = (bf16*)(ws + WS_WGLU) + (size_t)l * DM * DM; }
        else if (m < 10) { const int l = m - 8; W = (const float*)a->in[I_SWO] + (size_t)l * DM * DM; WT = (bf16*)(ws + WS_WSOUT) + (size_t)l * DM * DM; }
        else if (m < 14) { const int i = m - 10; W = (const float*)a->in[I_PWG] + (size_t)i * DM * DM; sc = (const float*)a->in[I_PNW] + (size_t)i * DM; WT = (bf16*)(ws + WS_WPG) + (size_t)i * DM * DM; }
        else             { const int i = m - 14; W = (const float*)a->in[I_PWP] + (size_t)i * PLE * DM; K = PLE; WT = (bf16*)(ws + WS_WPP) + (size_t)i * DM * PLE; }
        const int nitems = (K / 64) * ((N + 31) / 32);
        for (int it = gw; it < nitems; it += NGW) transpose_item(W, K, N, sc, WT, scr, it, lane);
    }
    bf16* Hb = (bf16*)(ws + WS_HBA);
    for (int r = gw; r < MR; r += NGW) {
        const float* src = (r < MP) ? (const float*)a->in[I_XP] + (size_t)r * DM : (const float*)a->in[I_XS] + (size_t)(r - MP) * DM;
        float ssq = 0.f;
#pragma unroll
        for (int j = 0; j < 8; ++j) { const int c = (j * 64 + lane) * 4; const f32x4 v = *(const f32x4*)(src + c); ssq += v[0] * v[0] + v[1] * v[1] + v[2] * v[2] + v[3] * v[3];
            v2u o; o.x = pk2(v[0], v[1]); o.y = pk2(v[2], v[3]); *(v2u*)(Hb + (size_t)r * DM + c) = o; }
        ssq = wave_sum(ssq);
        if (r < MP) { if (lane < 32) ss_buf(ws, 0)[(size_t)r * 32 + lane] = (lane == 0) ? ssq : 0.f; }
        else { float* sp = ss_buf(ws, 0) + (size_t)MPAD * 32 + (size_t)(r - MP) * 128; sp[lane] = (lane == 0) ? ssq : 0.f; sp[64 + lane] = 0.f; }
    }
    for (int q = gw; q < DEPTH * MR; q += NGW) { const int i = q / MR, r = q % MR;
        const float* src = (r < MP) ? (const float*)a->in[I_PP] + ((size_t)i * MP + r) * PLE : (const float*)a->in[I_PS] + ((size_t)i * MS + (r - MP)) * PLE;
        const f32x4 v = *(const f32x4*)(src + lane * 4); v2u o; o.x = pk2(v[0], v[1]); o.y = pk2(v[2], v[3]);
        *(v2u*)((bf16*)(ws + WS_PB + (size_t)i * PB_STRIDE) + (size_t)r * PLE + lane * 4) = o; }
}

__device__ __forceinline__ void ph_rowstat(ArgP a_, int wv_) {
    TID_LOCAL();
    const float* H = (const float*)(a->ws + WS_H); float* rstd = (float*)(a->ws + WS_RSTD);
    for (int r = gw; r < MR; r += NGW) { float s = 0.f;
#pragma unroll
        for (int j = 0; j < 8; ++j) { const f32x4 v = *(const f32x4*)(H + (size_t)r * DM + (j * 64 + lane) * 4); s += v[0] * v[0] + v[1] * v[1] + v[2] * v[2] + v[3] * v[3]; }
        s = wave_sum(s); if (lane == 0) rstd[r] = 1.0f / sqrtf(s * (1.0f / DM) + RMS_EPS); }
}

__device__ __forceinline__ void ph_epi_attn_in(ArgP a_, int l, int wv_) {
    TID_LOCAL(); GTID_LOCAL();
    unsigned char* ws = a->ws; const float* C = (const float*)(ws + WS_C); const float* rstd = (const float*)(ws + WS_RSTD);
    constexpr int NG4 = ACOLS / 4;
    for (size_t e = gtid; e < (size_t)MR * NG4; e += GT) { const int r = (int)(e / NG4), c = (int)(e % NG4) * 4;
        f32x4 v = *(const f32x4*)(C + (size_t)r * ACOLS_PAD + c); const float rs = rstd[r]; v = v * rs;
        if (c < C_K) { v = v * QSCALE; v2u o; o.x = pk2(v[0], v[1]); o.y = pk2(v[2], v[3]); *(v2u*)((bf16*)(ws + WS_QB) + (size_t)r * 2048 + c) = o; }
        else if (c < C_G) { const bool isv = c >= C_V; const int cc = c - (isv ? C_V : C_K);
            float* o32 = a->out + (r < MP ? (isv ? O_VP : O_KP) + ((size_t)l * MP + r) * 512 : (isv ? O_VS : O_KS) + ((size_t)l * MS + (r - MP)) * 512) + cc;
            *(f32x4*)o32 = v; v2u o; o.x = pk2(v[0], v[1]); o.y = pk2(v[2], v[3]); *(v2u*)((bf16*)(ws + (isv ? WS_VB : WS_KB)) + (size_t)r * 512 + cc) = o; }
        else if (c < C_QI) { v2u o; o.x = pk2(siluf_(v[0]), siluf_(v[1])); o.y = pk2(siluf_(v[2]), siluf_(v[3])); *(v2u*)((bf16*)(ws + WS_GB) + (size_t)r * 2048 + (c - C_G)) = o; }
        else if (c < C_KI) { v2u o; o.x = pk2(v[0], v[1]); o.y = pk2(v[2], v[3]); *(v2u*)((bf16*)(ws + WS_QIB) + (size_t)r * 1024 + (c - C_QI)) = o; }
        else if (c < C_WI) { const int cc = c - C_KI; float* o32 = a->out + (r < MP ? O_KIP + ((size_t)l * MP + r) * 64 : O_KIS + ((size_t)l * MS + (r - MP)) * 64) + cc;
            *(f32x4*)o32 = v; v2u o; o.x = pk2(v[0], v[1]); o.y = pk2(v[2], v[3]); *(v2u*)((bf16*)(ws + WS_KIB) + (size_t)r * 64 + cc) = o; }
        else { *(f32x4*)((float*)(ws + WS_WI) + (size_t)r * 16 + (c - C_WI)) = v * WISCALE; }
    }
}


typedef short bf16x8v __attribute__((ext_vector_type(8)));
__device__ __forceinline__ float relu_i(float x) { const int b = __builtin_bit_cast(int, x); return __builtin_bit_cast(float, b > 0 ? b : 0); }
__device__ __forceinline__ unsigned mono_key(float x) { const unsigned b = __builtin_bit_cast(unsigned, x); return b ^ ((unsigned)((int)b >> 31) | 0x80000000u); }
__device__ __forceinline__ int wave_sum_i(int v) {
#pragma unroll
    for (int o = 1; o < 64; o <<= 1) v += __shfl_xor(v, o);
    return v;
}
__device__ __forceinline__ int lane_prefix(unsigned long long m) { return (int)__builtin_amdgcn_mbcnt_hi((unsigned)(m >> 32), __builtin_amdgcn_mbcnt_lo((unsigned)m, 0u)); }
constexpr size_t KM_WORDS = (size_t)NBATCH * 128 * 64 * 32;

__device__ __forceinline__ int cnt_ge4(const v4u k, unsigned cand) { return __popcll(__ballot(k.x >= cand)) + __popcll(__ballot(k.y >= cand)) + __popcll(__ballot(k.z >= cand)) + __popcll(__ballot(k.w >= cand)); }
__device__ __forceinline__ void sel_load(const float* sc, int n, int lane, f32x4 (&v)[16]) {
#pragma unroll
    for (int ch = 0; ch < 16; ++ch) { const int i0 = ch * 256 + 4 * lane; f32x4 t = {0.f, 0.f, 0.f, 0.f}; if (ch * 256 < n) t = *(const f32x4*)(sc + i0); v[ch] = t; }
}
__device__ __forceinline__ void sel_store(const f32x4 (&v)[16], int n, int lane, LAS unsigned* ldsk) {
#pragma unroll
    for (int ch = 0; ch < 16; ++ch) { const int i0 = ch * 256 + 4 * lane;
        v4u k; k.x = (i0 < n) ? mono_key(v[ch][0]) : 0u; k.y = (i0 + 1 < n) ? mono_key(v[ch][1]) : 0u; k.z = (i0 + 2 < n) ? mono_key(v[ch][2]) : 0u; k.w = (i0 + 3 < n) ? mono_key(v[ch][3]) : 0u;
        *(LAS v4u*)(ldsk + i0) = k; }
}
__device__ __forceinline__ void select_core(int n, int lane, LAS unsigned* ldsk, LAS unsigned long long* mrow) {
    const int nc = (n + 255) >> 8, ne = (n + 63) >> 6, ng = (nc + 3) >> 2;
    unsigned T = 0u; int need = TOPK, toteq = 0;
    if (n > TOPK) {
        for (int bit = 31; bit >= 0; --bit) { const unsigned cand = T | (1u << bit); int c = 0;
            for (int g4 = 0; g4 < ng; ++g4) { const LAS v4u* p = (const LAS v4u*)(ldsk + g4 * 1024 + lane * 4); const v4u k0 = p[0], k1 = p[64], k2 = p[128], k3 = p[192];
                c += cnt_ge4(k0, cand) + cnt_ge4(k1, cand) + cnt_ge4(k2, cand) + cnt_ge4(k3, cand); }
            if (c >= TOPK) { T = cand; if (c == TOPK) break; } }
        int cg = 0, ce = 0;
        for (int ch = 0; ch < nc; ++ch) { const v4u k = *(const LAS v4u*)(ldsk + ch * 256 + lane * 4);
            cg += __popcll(__ballot(k.x > T)) + __popcll(__ballot(k.y > T)) + __popcll(__ballot(k.z > T)) + __popcll(__ballot(k.w > T));
            ce += __popcll(__ballot(k.x == T)) + __popcll(__ballot(k.y == T)) + __popcll(__ballot(k.z == T)) + __popcll(__ballot(k.w == T)); }
        need = TOPK - cg;
        toteq = ce;
    }
    const bool all_eq = (toteq <= need);
    int base_eq = 0;
    for (int e0 = 0; e0 < ne; e0 += 4) {
        unsigned kk[4];
#pragma unroll
        for (int u = 0; u < 4; ++u) kk[u] = ldsk[(e0 + u) * 64 + lane];
#pragma unroll
        for (int u = 0; u < 4; ++u) { const int e = e0 + u; const int idx = e * 64 + lane; const unsigned k = kk[u]; const bool valid = idx < n; bool s;
            if (n <= TOPK) s = valid;
            else if (all_eq) s = valid && k >= T;
            else { const bool eq = valid && k == T; const unsigned long long em = __ballot(eq); s = valid && (k > T || (eq && base_eq + lane_prefix(em) < need)); base_eq += __popcll(em); }
            const unsigned long long sm = __ballot(s);
            if (lane == 0 && e < ne) mrow[e * 16] = sm; }
    }
}

__device__ __forceinline__ void ph_idx(ArgP a_, int l, LAS unsigned char* lds, int wv_) {
    TID_LOCAL();
    unsigned char* ws = a->ws;
    const bf16* QIb = (const bf16*)(ws + WS_QIB); const bf16* KIb = (const bf16*)(ws + WS_KIB); const float* WI = (const float*)(ws + WS_WI);
    unsigned long long* KM = (unsigned long long*)(ws + WS_KM);
    for (int vb = blockIdx.x; vb < 256; vb += gridDim.x) {
        const int b = vb >> 7, x = vb & 127;
        int ln = lane; asm volatile("" : "+v"(ln)); const int fr = ln & 15, kg = ln >> 4, qi = fr & 7, hh = fr >> 3;
        LAS unsigned long long* msk = (LAS unsigned long long*)(lds + 132096);
        LAS unsigned* ldsk = (LAS unsigned*)(lds + wave * 16384);
        for (int rnd = 0; rnd < 4; ++rnd) {
            const int qt = (rnd & 2) ? 255 - x : x, qbase = qt * 16 + (rnd & 1) * 8;
            const int nrow = qbase + wave + 1;
            { const int ngk = ((((nrow + 255) >> 8) + 3) >> 2) * 1024; for (int i = (qt + 1) * 16 + lane * 4; i < ngk; i += 256) *(LAS v4u*)(ldsk + i) = (v4u){0u, 0u, 0u, 0u}; }
            const int tq = qbase + qi; const size_t qrow = (size_t)b * SEQ + tq;
            bf16x8v Bq[8][2]; float w[8];
#pragma unroll
            for (int it = 0; it < 8; ++it) { const int h = hh * 8 + it; Bq[it][0] = *(const bf16x8v*)(QIb + qrow * 1024 + h * 64 + kg * 8); Bq[it][1] = *(const bf16x8v*)(QIb + qrow * 1024 + h * 64 + 32 + kg * 8); w[it] = WI[qrow * 16 + h]; }
            const bf16* kbase = KIb + ((size_t)b * SEQ + fr) * 64 + kg * 8;
            bf16x8v A0 = {0, 0, 0, 0, 0, 0, 0, 0}, A1 = A0, N0 = A0, N1 = A0;
            if (wave <= qt) { A0 = *(const bf16x8v*)(kbase + (size_t)wave * 1024); A1 = *(const bf16x8v*)(kbase + (size_t)wave * 1024 + 32); }
            if (wave + NWAVES <= qt) { N0 = *(const bf16x8v*)(kbase + (size_t)(wave + NWAVES) * 1024); N1 = *(const bf16x8v*)(kbase + (size_t)(wave + NWAVES) * 1024 + 32); }
            LAS unsigned* rowp = (LAS unsigned*)(lds + qi * 16384) + kg * 4;
            for (int kt = wave; kt <= qt; kt += NWAVES) {
                bf16x8v M0 = N0, M1 = N1;
                if (kt + 2 * NWAVES <= qt) { M0 = *(const bf16x8v*)(kbase + (size_t)(kt + 2 * NWAVES) * 1024); M1 = *(const bf16x8v*)(kbase + (size_t)(kt + 2 * NWAVES) * 1024 + 32); }
                f32x4 S = {0.f, 0.f, 0.f, 0.f};
#pragma unroll
                for (int it = 0; it < 8; ++it) { f32x4 acc = {0.f, 0.f, 0.f, 0.f};
                    acc = __builtin_amdgcn_mfma_f32_16x16x32_bf16(A0, Bq[it][0], acc, 0, 0, 0); acc = __builtin_amdgcn_mfma_f32_16x16x32_bf16(A1, Bq[it][1], acc, 0, 0, 0);
#pragma unroll
                    for (int j = 0; j < 4; ++j) { const float a_ = acc[j]; S[j] += w[it] * relu_i(a_); } }
                v4u kk;
#pragma unroll
                for (int j = 0; j < 4; ++j) { const float o_ = S[j]; const float s_ = o_ + __builtin_bit_cast(float, __builtin_amdgcn_update_dpp(0, __builtin_bit_cast(int, o_), 0x108, 0xF, 0xF, true));
                    const unsigned key_ = (kt * 16 + kg * 4 + j <= tq) ? mono_key(s_) : 0u; if (j == 0) kk.x = key_; else if (j == 1) kk.y = key_; else if (j == 2) kk.z = key_; else kk.w = key_; }
                if (hh == 0) *(LAS v4u*)(rowp + kt * 16) = kk;
                A0 = N0; A1 = N1; N0 = M0; N1 = M1;
            }
            LDS_WAIT(); __syncthreads();
            select_core(nrow, lane, ldsk, msk + ((rnd & 2) ? ((x >> 2) + 1) * 16 : 0) + (rnd & 1) * 8 + wave);
            __syncthreads();
        }
        { const int ne0 = (x >> 2) + 1, ne1 = ((255 - x) >> 2) + 1;
          for (int i = tid; i < (ne0 + ne1) * 16; i += NTHR) { const int h2 = i >= ne0 * 16, ii = i - (h2 ? ne0 * 16 : 0), e = ii >> 4, tr = ii & 15; const int qt = h2 ? 255 - x : x;
              KM[(((size_t)b * 128 + (qt >> 1)) * 64 + e) * 32 + (qt & 1) * 16 + tr] = msk[i]; } }
        __syncthreads(); PMARK(4, wave);
    }
}


namespace att {
using bf16x8 = __attribute__((ext_vector_type(8))) short;
using s16x4  = __attribute__((ext_vector_type(4))) short;
using f32x16 = __attribute__((ext_vector_type(16))) float;
constexpr int KVBLK = 64;
constexpr int SHM_V = KVBLK * 128 * 2, SHM_K = KVBLK * 128 * 2;
constexpr float THR2 = 8.0f;
#define ATT_SDEPTH 1
#define ATT_KSWZ(row, colB) ((row) * 256 + ((colB) ^ (((row) & 7) << 4)))
#define ATT_SBAR() __builtin_amdgcn_sched_barrier(0)
__device__ __forceinline__ int crow(int r, int hi) { return (r & 3) + 8 * (r >> 2) + 4 * hi; }
__device__ __forceinline__ unsigned cvtpk(float lo, float hi) { unsigned r; asm volatile("v_cvt_pk_bf16_f32 %0, %1, %2" : "=v"(r) : "v"(lo), "v"(hi)); return r; }
__device__ __forceinline__ int v_st(int k, int c) { const int kk = (k & ~0xC) | ((k & 4) << 1) | ((k & 8) >> 1); return ((kk >> 3) * 4 + (c >> 5)) * 512 + ((kk & 7) * 32 + (c & 31)) * 2; }
__device__ __forceinline__ int v_rd_base(int lane) { return ((lane & 3) << 3) | (((lane >> 2) & 3) << 6) | (((lane >> 4) & 1) << 5) | (((lane >> 5) & 1) << 8); }
constexpr int v_rd_off(int d0, int ks, int half) { return d0 * 512 + ks * 4096 + half * 2048; }
template <int OFF> __device__ __forceinline__ s16x4 tr_read(int vb) { s16x4 r; asm volatile("ds_read_b64_tr_b16 %0, %1 offset:%2" : "=&v"(r) : "v"(vb), "i"(OFF) : "memory"); return r; }

__device__ __forceinline__ void partialSM(f32x16& p0, f32x16& p1, float& m_reg, float& mn, float& alpha) {
    float pmax = p0[0];
#pragma unroll
    for (int r = 1; r < 16; ++r) pmax = fmaxf(pmax, p0[r]);
#pragma unroll
    for (int r = 0; r < 16; ++r) pmax = fmaxf(pmax, p1[r]);
    { auto rr = __builtin_amdgcn_permlane32_swap(__builtin_bit_cast(unsigned, pmax), __builtin_bit_cast(unsigned, pmax), false, false);
      const unsigned u0 = rr[0], u1 = rr[1]; pmax = fmaxf(__builtin_bit_cast(float, u0), __builtin_bit_cast(float, u1)); }
    if (__builtin_expect(__all(pmax - m_reg <= THR2), 1)) { mn = m_reg; alpha = 1.f; }
    else { mn = fmaxf(m_reg, pmax); alpha = __builtin_amdgcn_exp2f(m_reg - mn); m_reg = mn; }
#pragma unroll
    for (int r = 0; r < 16; ++r) p0[r] = __builtin_amdgcn_exp2f(p0[r] - mn);
#pragma unroll
    for (int r = 0; r < 16; ++r) p1[r] = p1[r] - mn;
}
__device__ __forceinline__ void partialSMrel(f32x16& p0, f32x16& p1, float& m_reg, float& alpha) {
    float pmax = p0[0];
#pragma unroll
    for (int r = 1; r < 16; ++r) pmax = fmaxf(pmax, p0[r]);
#pragma unroll
    for (int r = 0; r < 16; ++r) pmax = fmaxf(pmax, p1[r]);
    { auto rr = __builtin_amdgcn_permlane32_swap(__builtin_bit_cast(unsigned, pmax), __builtin_bit_cast(unsigned, pmax), false, false);
      const unsigned u0 = rr[0], u1 = rr[1]; pmax = fmaxf(__builtin_bit_cast(float, u0), __builtin_bit_cast(float, u1)); }
    if (__builtin_expect(__all(pmax <= THR2), 1)) { alpha = 1.f; }
    else { const float d = fmaxf(pmax, 0.f); alpha = __builtin_amdgcn_exp2f(-d); m_reg += d;
#pragma unroll
        for (int r = 0; r < 16; ++r) { p0[r] -= d; p1[r] -= d; } }
#pragma unroll
    for (int r = 0; r < 16; ++r) p0[r] = __builtin_amdgcn_exp2f(p0[r]);
}
__device__ __forceinline__ void finishSM(f32x16& p0, f32x16& p1, float alpha, float& l_reg, unsigned long long mk, int hi, bf16x8& pa0, bf16x8& pa1, bf16x8& pa2, bf16x8& pa3) {
#pragma unroll
    for (int r = 0; r < 16; ++r) p1[r] = __builtin_amdgcn_exp2f(p1[r]);
    const unsigned w0 = (unsigned)mk >> (4 * hi), w1 = (unsigned)(mk >> 32) >> (4 * hi);
#pragma unroll
    for (int r = 0; r < 16; ++r) { const int pos = (r & 3) + 8 * (r >> 2);
        const float a0 = p0[r], a1 = p1[r];
        unsigned m0_, m1_; asm("v_bfe_i32 %0, %1, %2, 1" : "=v"(m0_) : "v"(w0), "n"(pos)); asm("v_bfe_i32 %0, %1, %2, 1" : "=v"(m1_) : "v"(w1), "n"(pos));
        p0[r] = __builtin_bit_cast(float, __builtin_bit_cast(unsigned, a0) & m0_);
        p1[r] = __builtin_bit_cast(float, __builtin_bit_cast(unsigned, a1) & m1_); }
    float ps = 0;
#pragma unroll
    for (int r = 0; r < 16; ++r) ps += p0[r];
#pragma unroll
    for (int r = 0; r < 16; ++r) ps += p1[r];
    { auto rr = __builtin_amdgcn_permlane32_swap(__builtin_bit_cast(unsigned, ps), __builtin_bit_cast(unsigned, ps), false, false);
      const unsigned u0 = rr[0], u1 = rr[1]; ps = __builtin_bit_cast(float, u0) + __builtin_bit_cast(float, u1); }
    l_reg = l_reg * alpha + ps;
#define ATT_PK4(P, BASE, OUT) do { unsigned a0 = cvtpk(P[BASE + 0], P[BASE + 1]), a1 = cvtpk(P[BASE + 2], P[BASE + 3]);   \
    unsigned b0 = cvtpk(P[BASE + 4], P[BASE + 5]), b1 = cvtpk(P[BASE + 6], P[BASE + 7]);                              \
    auto r0 = __builtin_amdgcn_permlane32_swap(a0, b0, false, false); auto r1 = __builtin_amdgcn_permlane32_swap(a1, b1, false, false); \
    v4u w = {r0[0], r1[0], r0[1], r1[1]}; OUT = __builtin_bit_cast(bf16x8, w); } while (0)
    ATT_PK4(p0, 0, pa0); ATT_PK4(p0, 8, pa1); ATT_PK4(p1, 0, pa2); ATT_PK4(p1, 8, pa3);
#undef ATT_PK4
}
__device__ __forceinline__ void qkt(f32x16& p0, f32x16& p1, LAS const char* Ks, const bf16x8* qr, int r32, int hi, float init) {
#pragma unroll
    for (int r = 0; r < 16; ++r) { p0[r] = init; p1[r] = init; }
    asm volatile("" : "+v"(r32), "+v"(hi));
#pragma unroll
    for (int d0 = 0; d0 < 8; ++d0) { const int cb = (d0 * 16 + hi * 8) * 2;
        const bf16x8 b0 = *(LAS const bf16x8*)(Ks + ATT_KSWZ(r32, cb));
        const bf16x8 b1 = *(LAS const bf16x8*)(Ks + ATT_KSWZ(32 + r32, cb));
        p0 = __builtin_amdgcn_mfma_f32_32x32x16_bf16(b0, qr[d0], p0, 0, 0, 0);
        p1 = __builtin_amdgcn_mfma_f32_32x32x16_bf16(b1, qr[d0], p1, 0, 0, 0); }
}
template <int D0> __device__ __forceinline__ void pv_one(f32x16& od, int vb, bf16x8 pa0, bf16x8 pa1, bf16x8 pa2, bf16x8 pa3) {
    const s16x4 l0 = tr_read<v_rd_off(D0, 0, 0)>(vb), h0 = tr_read<v_rd_off(D0, 0, 1)>(vb), l1 = tr_read<v_rd_off(D0, 1, 0)>(vb), h1 = tr_read<v_rd_off(D0, 1, 1)>(vb);
    const s16x4 l2 = tr_read<v_rd_off(D0, 2, 0)>(vb), h2 = tr_read<v_rd_off(D0, 2, 1)>(vb), l3 = tr_read<v_rd_off(D0, 3, 0)>(vb), h3 = tr_read<v_rd_off(D0, 3, 1)>(vb);
    asm volatile("s_waitcnt lgkmcnt(0)" ::: "memory"); ATT_SBAR();
#define ATT_PK(L, H) (bf16x8){L[0], L[1], L[2], L[3], H[0], H[1], H[2], H[3]}
    od = __builtin_amdgcn_mfma_f32_32x32x16_bf16(pa0, ATT_PK(l0, h0), od, 0, 0, 0);
    od = __builtin_amdgcn_mfma_f32_32x32x16_bf16(pa1, ATT_PK(l1, h1), od, 0, 0, 0);
    od = __builtin_amdgcn_mfma_f32_32x32x16_bf16(pa2, ATT_PK(l2, h2), od, 0, 0, 0);
    od = __builtin_amdgcn_mfma_f32_32x32x16_bf16(pa3, ATT_PK(l3, h3), od, 0, 0, 0);
#undef ATT_PK
}
__device__ __forceinline__ void pv_d0(f32x16* o, int vb, bf16x8 pa0, bf16x8 pa1, bf16x8 pa2, bf16x8 pa3) {
    pv_one<0>(o[0], vb, pa0, pa1, pa2, pa3); pv_one<1>(o[1], vb, pa0, pa1, pa2, pa3); pv_one<2>(o[2], vb, pa0, pa1, pa2, pa3); pv_one<3>(o[3], vb, pa0, pa1, pa2, pa3);
}
__device__ __forceinline__ void add_bias(f32x16& p0, f32x16& p1, LAS const float* bt2, int dq) {
    LAS const float* p = bt2 + (255 - dq);
#pragma unroll
    for (int r = 0; r < 16; ++r) { const int c = (r & 3) + 8 * (r >> 2); p0[r] += p[c]; p1[r] += p[c + 32]; }
}
}

__device__ __forceinline__ void ph_attn(ArgP a_, LAS unsigned char* ldsb, int wv_) {
    using namespace att;
    TID_LOCAL();
    unsigned char* ws = a->ws;
    const bf16* Qb = (const bf16*)(ws + WS_QB); const bf16* Kb = (const bf16*)(ws + WS_KB); const bf16* Vb = (const bf16*)(ws + WS_VB); const bf16* Gb = (const bf16*)(ws + WS_GB);
    bf16* AOb = (bf16*)(ws + WS_AOB); const unsigned long long* KM = (const unsigned long long*)(ws + WS_KM); const float* rb = (const float*)a->in[I_RB];
    LAS char* lds = (LAS char*)ldsb; LAS char* V_lds = lds; LAS char* K_lds = lds + 2 * SHM_V;
    LAS float* wsf = (LAS float*)(lds + 65536) + wave * 64; LAS float* li_l = wsf; LAS float* al_l = wsf + 32;
    LAS float* btab = (LAS float*)(lds + 65536 + 2048);
    const int r32 = lane & 31, hi = lane >> 5, rh = wave & 3, qs = wave >> 2;
    const int sr = tid >> 4, sc = (tid & 15) * 8, vst0 = v_st(sr, sc), kst0 = ATT_KSWZ(sr, sc * 2);
    const int vb0 = (int)(unsigned)(size_t)V_lds + v_rd_base(lane);
    constexpr int LDK = 512;
    for (int vbk = blockIdx.x; vbk < 256; vbk += gridDim.x) {
        const int b = vbk >> 7, g = (vbk >> 5) & 3, x = vbk & 31, h = g * 4 + rh;
        __syncthreads();
        for (int i = tid; i < 4 * 384; i += NTHR) { const int rr = i / 384, d = 255 - (i % 384), hh = g * 4 + rr; btab[i] = (d >= 0 && d < 113) ? (rb[t5_bucket(d) * NH + hh] - rb[31 * NH + hh]) * LOG2E : 0.f; }
        const bf16* Kh = Kb + (size_t)b * SEQ * LDK + g * HD; const bf16* Vh = Vb + (size_t)b * SEQ * LDK + g * HD;
        for (int half = 0; half < 2; ++half) {
            const int jb = half ? 63 - x : x; const int q0w = jb * 64 + qs * 32; const size_t qrow = (size_t)b * SEQ + q0w + r32;
            const int NT = jb + 1, NTp = (NT + 1) & ~1;
            LAS const float* bt = btab + rh * 384;
            float m_reg = -1e30f, l_reg = 0; f32x16 o[4] = {}; bf16x8 qr[8];
            int lq = lane; asm volatile("" : "+v"(lq));
            const bf16* Qw = Qb + ((size_t)b * SEQ + q0w + (lq & 31)) * 2048 + h * HD + (lq >> 5) * 8;
#pragma unroll
            for (int d0 = 0; d0 < 8; ++d0) qr[d0] = *(const bf16x8*)(Qw + d0 * 16);
            struct { bf16x8 vs0, vs1, ks0, ks1; } sr_[ATT_SDEPTH];
            const unsigned toff = (unsigned)(sr * LDK + sc) * 2u;
#define ATT_SLOAD(i, k0) do { const char* vt_ = (const char*)Vh + (size_t)(k0) * (LDK * 2); const char* kt_ = (const char*)Kh + (size_t)(k0) * (LDK * 2); \
    sr_[i].vs0 = *(const bf16x8*)(vt_ + toff); sr_[i].vs1 = *(const bf16x8*)(vt_ + 32 * LDK * 2 + toff); sr_[i].ks0 = *(const bf16x8*)(kt_ + toff); sr_[i].ks1 = *(const bf16x8*)(kt_ + 32 * LDK * 2 + toff); } while (0)
#define ATT_SWRITE(bb, i) do { *(LAS bf16x8*)(V_lds + (bb) * SHM_V + vst0) = sr_[i].vs0; *(LAS bf16x8*)(V_lds + (bb) * SHM_V + vst0 + 8192) = sr_[i].vs1; \
    *(LAS bf16x8*)(K_lds + (bb) * SHM_K + kst0) = sr_[i].ks0; *(LAS bf16x8*)(K_lds + (bb) * SHM_K + kst0 + 8192) = sr_[i].ks1; } while (0)
#define ATT_SWAIT() do { if (ATT_SDEPTH == 2) asm volatile("s_waitcnt vmcnt(4)" ::: "memory"); else asm volatile("s_waitcnt vmcnt(0)" ::: "memory"); } while (0)
#define ATT_RESC(al) do { if (__any((al) < 1.f)) { if (hi == 0) al_l[r32] = (al); asm volatile("s_waitcnt lgkmcnt(0)" ::: "memory"); \
    _Pragma("unroll") for (int d = 0; d < 4; ++d) _Pragma("unroll") for (int r = 0; r < 16; ++r) o[d][r] *= al_l[crow(r, hi)]; } } while (0)
#define ATT_MASK(kt) (((kt) <= jb) ? ((LAS const unsigned long long*)(lds + 73728))[(qs * 64 + (kt)) * 32 + (lane_id_fresh() & 31)] : 0ull)
#define ATT_BIAS(P0, P1, kt) do { if (64 * (kt) + 176 > q0w) { const int le_ = lane_id_fresh(); add_bias(P0, P1, bt, q0w + (le_ & 31) - 4 * (le_ >> 5) - 64 * (kt)); } } while (0)
            f32x16 pA0, pA1, pB0, pB1; float mnA, mnB, alA, alB; bf16x8 pa0, pa1, pa2, pa3;
            constexpr int SE = 0, SO = ATT_SDEPTH - 1;
            __syncthreads();
            { LAS unsigned long long* mks = (LAS unsigned long long*)(lds + 73728);
              const unsigned long long* kg0 = KM + (((size_t)b * 128 + 2 * jb) * 64) * 32; const int nw = (jb + 1) * 32;
              for (int i = wave * 64 + lane_id_fresh(); i < 2 * nw; i += NTHR) { const int q2 = (i >= nw) ? 1 : 0, j2 = i - q2 * nw; mks[q2 * 2048 + j2] = kg0[(size_t)q2 * 2048 + j2]; } }
            ATT_SLOAD(SE, 0); asm volatile("s_waitcnt vmcnt(0)" ::: "memory"); ATT_SWRITE(0, SE); __syncthreads();
            qkt(pA0, pA1, K_lds, qr, r32, hi, 0.f); ATT_BIAS(pA0, pA1, 0); partialSM(pA0, pA1, m_reg, mnA, alA);
            ATT_SLOAD(SO, KVBLK); if (ATT_SDEPTH == 2 && 2 < NTp) ATT_SLOAD(SE, 2 * KVBLK);
            ATT_SWAIT(); ATT_SWRITE(1, SO); __syncthreads();
            for (int j = 1; j + 1 < NTp; j += 2) {
                ATT_SBAR(); qkt(pB0, pB1, K_lds + SHM_K, qr, r32, hi, -m_reg); ATT_BIAS(pB0, pB1, j);
                finishSM(pA0, pA1, alA, l_reg, ATT_MASK(j - 1), hi, pa0, pa1, pa2, pa3); ATT_SBAR();
                ATT_SLOAD(SO, (j + ATT_SDEPTH) * KVBLK); ATT_SBAR();
                pv_d0(o, vb0, pa0, pa1, pa2, pa3); partialSMrel(pB0, pB1, m_reg, alB);
                __syncthreads(); ATT_SWAIT(); ATT_SWRITE(0, SE);
                ATT_RESC(alB); __syncthreads();
                ATT_SBAR(); qkt(pA0, pA1, K_lds, qr, r32, hi, -m_reg); ATT_BIAS(pA0, pA1, j + 1);
                finishSM(pB0, pB1, alB, l_reg, ATT_MASK(j), hi, pa0, pa1, pa2, pa3); ATT_SBAR();
                if (ATT_SDEPTH == 1 || j + 3 < NTp) ATT_SLOAD(SE, (j + 1 + ATT_SDEPTH) * KVBLK); ATT_SBAR();
                pv_d0(o, vb0 + SHM_V, pa0, pa1, pa2, pa3); partialSMrel(pA0, pA1, m_reg, alA);
                __syncthreads(); ATT_SWAIT(); ATT_SWRITE(1, SO);
                ATT_RESC(alA); __syncthreads();
            }
            ATT_SBAR(); qkt(pB0, pB1, K_lds + SHM_K, qr, r32, hi, -m_reg); ATT_BIAS(pB0, pB1, NTp - 1);
            finishSM(pA0, pA1, alA, l_reg, ATT_MASK(NTp - 2), hi, pa0, pa1, pa2, pa3); ATT_SBAR();
            pv_d0(o, vb0, pa0, pa1, pa2, pa3); partialSMrel(pB0, pB1, m_reg, alB);
            __syncthreads(); ATT_RESC(alB);
            finishSM(pB0, pB1, alB, l_reg, ATT_MASK(NTp - 1), hi, pa0, pa1, pa2, pa3); ATT_SBAR();
            pv_d0(o, vb0 + SHM_V, pa0, pa1, pa2, pa3);
            if (hi == 0) li_l[r32] = l_reg; asm volatile("s_waitcnt lgkmcnt(0)" ::: "memory");
            int lane_e = lane; asm volatile("" : "+v"(lane_e)); const int r32e = lane_e & 31, hie = lane_e >> 5;
#pragma unroll
            for (int r = 0; r < 16; ++r) { const int orow = crow(r, hie); const float rli = __builtin_amdgcn_rcpf(li_l[orow]);
                const size_t ob = ((size_t)b * SEQ + q0w + orow) * 2048 + h * HD + r32e;
#pragma unroll
                for (int d0 = 0; d0 < 4; ++d0) AOb[ob + d0 * 32] = (bf16)f2bf(o[d0][r] * rli * bf2f(Gb[ob + d0 * 32]));
                asm volatile("" ::: "memory"); ATT_SBAR(); }
#undef ATT_SLOAD
#undef ATT_SWRITE
#undef ATT_SWAIT
#undef ATT_RESC
#undef ATT_MASK
#undef ATT_BIAS
        }
    }
}


__device__ __forceinline__ void ph_idx_sample(ArgP a_, int l, int wv_) {
    TID_LOCAL();
    unsigned char* ws = a->ws;
    const bf16* QIb = (const bf16*)(ws + WS_QIB); const bf16* KIb = (const bf16*)(ws + WS_KIB); const float* WI = (const float*)(ws + WS_WI); float* SCS = (float*)(ws + WS_SCS);
    const int* pt = (const int*)a->in[I_PT]; const float* cki = (const float*)a->in[I_CKI] + (size_t)l * NPOOL * PAGE * IDD;
    const int fr = lane & 15, kg = lane >> 4; constexpr int TPB = PAST / 16 + 1, NT = DBATCH * TPB, TPW = 5;
    for (int c0 = gw * TPW; c0 < NT; c0 += NGW * TPW) {
        int curb = -1; bf16x8v Bq[16][2]; float w[16];
        const int cend = (c0 + TPW < NT) ? c0 + TPW : NT;
        f32x4 x0, x1, y0, y1;
        int pg[TPW];
#pragma unroll
        for (int j = 0; j < TPW; ++j) { const int g_ = c0 + j; const int b_ = g_ / TPB, kt_ = g_ % TPB; pg[j] = (g_ < NT && kt_ < PAST / 16) ? pt[b_ * NPAGES + ((kt_ * 16 + fr) >> 7)] : 0; }
#define IDXS_FETCH(gt_) do { const int kt_ = (gt_) % TPB; if (kt_ < PAST / 16) { const int key_ = kt_ * 16 + fr; const int jj_ = (gt_) - c0; \
            const int pgv_ = (jj_ == 0) ? pg[0] : (jj_ == 1) ? pg[1] : (jj_ == 2) ? pg[2] : (jj_ == 3) ? pg[3] : pg[4]; \
            const float* kp_ = cki + ((size_t)pgv_ * PAGE + (key_ & 127)) * IDD + kg * 8; x0 = *(const f32x4*)kp_; x1 = *(const f32x4*)(kp_ + 4); y0 = *(const f32x4*)(kp_ + 32); y1 = *(const f32x4*)(kp_ + 36); } } while (0)
        IDXS_FETCH(c0);
        for (int gt = c0; gt < cend; ++gt) { const int b = gt / TPB, kt = gt % TPB;
            if (b != curb) { curb = b; const size_t qrow = (size_t)MP + b * DSEQ + (fr < DSEQ ? fr : DSEQ - 1);
#pragma unroll
                for (int h = 0; h < 16; ++h) { Bq[h][0] = *(const bf16x8v*)(QIb + qrow * 1024 + h * 64 + kg * 8); Bq[h][1] = *(const bf16x8v*)(QIb + qrow * 1024 + h * 64 + 32 + kg * 8); w[h] = WI[qrow * 16 + h]; } }
            bf16x8v A0, A1;
            if (kt < PAST / 16) { v4u u0, u1; u0.x = pk2(x0[0], x0[1]); u0.y = pk2(x0[2], x0[3]); u0.z = pk2(x1[0], x1[1]); u0.w = pk2(x1[2], x1[3]); u1.x = pk2(y0[0], y0[1]); u1.y = pk2(y0[2], y0[3]); u1.z = pk2(y1[0], y1[1]); u1.w = pk2(y1[2], y1[3]);
                A0 = __builtin_bit_cast(bf16x8v, u0); A1 = __builtin_bit_cast(bf16x8v, u1); }
            else { const bf16* kp = KIb + ((size_t)MP + b * DSEQ + (fr < DSEQ ? fr : DSEQ - 1)) * 64 + kg * 8; A0 = *(const bf16x8v*)kp; A1 = *(const bf16x8v*)(kp + 32); }
            if (gt + 1 < cend) IDXS_FETCH(gt + 1);
            f32x4 S = {0.f, 0.f, 0.f, 0.f};
#pragma unroll
            for (int h = 0; h < 16; ++h) { f32x4 acc = {0.f, 0.f, 0.f, 0.f};
                acc = __builtin_amdgcn_mfma_f32_16x16x32_bf16(A0, Bq[h][0], acc, 0, 0, 0); acc = __builtin_amdgcn_mfma_f32_16x16x32_bf16(A1, Bq[h][1], acc, 0, 0, 0);
#pragma unroll
                for (int j = 0; j < 4; ++j) { const float a_ = acc[j]; S[j] += w[h] * relu_i(a_); } }
            if (fr < DSEQ) *(f32x4*)(SCS + (size_t)(b * DSEQ + fr) * SCS_LD + kt * 16 + kg * 4) = S;
        }
#undef IDXS_FETCH
    }
}
__device__ __forceinline__ void select_block(const float* sc, int n, LAS unsigned* ldsk, LAS int* ldsw, LAS int* sel, int tid, int lane, int wave) {
    const int nc = (n + 2047) >> 11;
    __syncthreads();
    for (int i = tid; i < nc * 2048; i += NTHR) ldsk[i] = (i < n) ? mono_key(sc[i]) : 0u;
    if (tid == 0) ldsw[32] = 0;
    __syncthreads();
    unsigned T = 0u;
    for (int bit = 31; bit >= 0; --bit) { const unsigned cand = T | (1u << bit); int c = 0;
        for (int ch = 0; ch < nc; ++ch) { const v4u k = *(const LAS v4u*)(ldsk + ch * 2048 + tid * 4); c += (k.x >= cand) + (k.y >= cand) + (k.z >= cand) + (k.w >= cand); }
        c = wave_sum_i(c); LAS int* red = ldsw + (bit & 1) * 8; if (lane == 0) red[wave] = c;
        __syncthreads();
        const int tot = ((red[0] + red[1]) + (red[2] + red[3])) + ((red[4] + red[5]) + (red[6] + red[7]));
        if (tot >= TOPK) { T = cand; if (tot == TOPK) break; } }
    int cg = 0, ce = 0;
    for (int ch = 0; ch < nc; ++ch) { const v4u k = *(const LAS v4u*)(ldsk + ch * 2048 + tid * 4); cg += (k.x > T) + (k.y > T) + (k.z > T) + (k.w > T); ce += (k.x == T) + (k.y == T) + (k.z == T) + (k.w == T); }
    cg = wave_sum_i(cg); ce = wave_sum_i(ce);
    __syncthreads();
    if (lane == 0) { ldsw[16 + wave] = cg; ldsw[24 + wave] = ce; }
    __syncthreads();
    int tg = 0, te = 0;
#pragma unroll
    for (int i = 0; i < 8; ++i) { tg += ldsw[16 + i]; te += ldsw[24 + i]; }
    const int need = TOPK - tg; const bool all_eq = te <= need;
    for (int ch = 0; ch < nc; ++ch) { const v4u k4 = *(const LAS v4u*)(ldsk + ch * 2048 + tid * 4); const unsigned kk[4] = {k4.x, k4.y, k4.z, k4.w};
#pragma unroll
        for (int j = 0; j < 4; ++j) { const int idx = ch * 2048 + tid * 4 + j; const unsigned k = kk[j]; bool s = (idx < n) && k > T;
            if ((idx < n) && k == T) { if (all_eq) s = true; else { int rank = 0; for (int q = 0; q < idx; ++q) rank += (ldsk[q] == T) ? 1 : 0; s = rank < need; } }
            if (s) { const int pos = __hip_atomic_fetch_add(ldsw + 32, 1, __ATOMIC_RELAXED, __HIP_MEMORY_SCOPE_WORKGROUP); if (pos < TOPK) sel[pos] = idx; } } }
    __syncthreads();
}
__device__ __forceinline__ f32x4 ld_kvrow(const float* cache, const bf16* fresh, int off, int c) {
    if (off >= 0) return *(const f32x4*)(cache + (size_t)off + 4 * c);
    const v2u w = *(const v2u*)(fresh + (size_t)(-off - 1) + 4 * c); return (f32x4){bflo(w.x), bfhi(w.x), bflo(w.y), bfhi(w.y)};
}
__device__ __forceinline__ void ph_attn_sample(ArgP a_, int l, LAS unsigned char* ldsb, int wv_) {
    TID_LOCAL();
    unsigned char* ws = a->ws;
    const bf16* Qb = (const bf16*)(ws + WS_QB); const bf16* Kb = (const bf16*)(ws + WS_KB); const bf16* Vb = (const bf16*)(ws + WS_VB); const bf16* Gb = (const bf16*)(ws + WS_GB);
    bf16* AOb = (bf16*)(ws + WS_AOB); const int* pt = (const int*)a->in[I_PT]; const float* rb = (const float*)a->in[I_RB];
    const float* ck = (const float*)a->in[I_CK] + (size_t)l * NPOOL * PAGE * 512; const float* cv = (const float*)a->in[I_CV] + (size_t)l * NPOOL * PAGE * 512;
    LAS unsigned* ldsk = (LAS unsigned*)ldsb;
    LAS int* ldsw = (LAS int*)(ldsb + 81920); LAS int* sidx = (LAS int*)(ldsb + 81920 + 256); LAS int* koff = sidx + TOPK; LAS int* kbk = koff + TOPK;
    LAS float* qh = (LAS float*)ldsb; LAS float* lg = (LAS float*)(ldsb + 2048); LAS float* rs = (LAS float*)(ldsb + 2048 + 4096); LAS float* red = (LAS float*)(ldsb + 8192);
    const int par = lane >> 5, c = lane & 31;
    for (int it = blockIdx.x; it < MS * NKV; it += gridDim.x) {
        const int rr = it >> 2, g = it & 3; const int r = MP + rr, b = rr / DSEQ, t = rr % DSEQ, tpos = PAST + t;
        select_block((const float*)(ws + WS_SCS) + (size_t)rr * SCS_LD, tpos + 1, ldsk, ldsw, sidx, tid, lane, wave);
        if (tid < TOPK) { const int s = sidx[tid]; kbk[tid] = t5_bucket(tpos - s);
            koff[tid] = (s < PAST) ? (int)(((unsigned)pt[b * NPAGES + (s >> 7)] * PAGE + (s & 127)) * 512u + g * HD) : -(1 + (int)(((unsigned)MP + b * DSEQ + (s - PAST)) * 512u + g * HD)); }
        qh[tid] = bf2f(Qb[(size_t)r * 2048 + g * 512 + tid]);
        __syncthreads();
        { f32x4 q4[4];
#pragma unroll
          for (int h = 0; h < 4; ++h) q4[h] = *(LAS const f32x4*)(qh + h * HD + 4 * c);
          f32x4 kv[16];
#pragma unroll
          for (int i = 0; i < 16; ++i) kv[i] = ld_kvrow(ck, Kb, koff[wave * 32 + 2 * i + par], c);
#pragma unroll
          for (int i = 0; i < 16; ++i) { float d[4];
#pragma unroll
              for (int h = 0; h < 4; ++h) d[h] = kv[i][0] * q4[h][0] + kv[i][1] * q4[h][1] + kv[i][2] * q4[h][2] + kv[i][3] * q4[h][3];
#pragma unroll
              for (int o = 1; o < 32; o <<= 1) {
#pragma unroll
                  for (int h = 0; h < 4; ++h) d[h] += __shfl_xor(d[h], o); }
              const int k = wave * 32 + 2 * i + par;
              if (c < 4) { const float dd = (c == 0) ? d[0] : (c == 1) ? d[1] : (c == 2) ? d[2] : d[3]; lg[c * TOPK + k] = dd + rb[kbk[k] * NH + g * KVG + c] * LOG2E; } } }
        __syncthreads();
        if (wave < KVG) { LAS float* row = lg + wave * TOPK; float v[4]; float m = -3.0e38f;
#pragma unroll
            for (int j = 0; j < 4; ++j) { v[j] = row[lane + 64 * j]; m = fmaxf(m, v[j]); }
#pragma unroll
            for (int o = 1; o < 64; o <<= 1) m = fmaxf(m, __shfl_xor(m, o));
            float sm = 0.f;
#pragma unroll
            for (int j = 0; j < 4; ++j) { v[j] = exp2f(v[j] - m); sm += v[j]; row[lane + 64 * j] = v[j]; }
            sm = wave_sum(sm); if (lane == 0) rs[wave] = 1.0f / sm; }
        __syncthreads();
        { f32x4 vv[16];
#pragma unroll
          for (int i = 0; i < 16; ++i) vv[i] = ld_kvrow(cv, Vb, koff[wave * 32 + 2 * i + par], c);
          f32x4 o4[4] = {{0.f, 0.f, 0.f, 0.f}, {0.f, 0.f, 0.f, 0.f}, {0.f, 0.f, 0.f, 0.f}, {0.f, 0.f, 0.f, 0.f}};
#pragma unroll
          for (int i = 0; i < 16; ++i) { const int k = wave * 32 + 2 * i + par;
#pragma unroll
              for (int h = 0; h < 4; ++h) o4[h] += vv[i] * lg[h * TOPK + k]; }
#pragma unroll
          for (int h = 0; h < 4; ++h) *(LAS f32x4*)(red + ((wave * 2 + par) * 4 + h) * HD + 4 * c) = o4[h]; }
        __syncthreads();
        { float o = 0.f;
#pragma unroll
          for (int p = 0; p < 16; ++p) o += red[p * 4 * HD + tid];
          const size_t oi = (size_t)r * 2048 + g * 512 + tid;
          AOb[oi] = (bf16)f2bf(o * rs[tid >> 7] * bf2f(Gb[oi])); }
        __syncthreads();
    }
}

__device__ __forceinline__ void ph_epi_resid(ArgP a_, int wv_) {
    TID_LOCAL(); GTID_LOCAL();
    unsigned char* ws = a->ws; const float* C = (const float*)(ws + WS_C); float* H = (float*)(ws + WS_H); bf16* Hb = (bf16*)(ws + WS_HBB);
    for (size_t e = gtid; e < (size_t)MR * (DM / 4); e += GT) { const size_t o = e * 4; const f32x4 v = *(const f32x4*)(H + o) + *(const f32x4*)(C + o);
        *(f32x4*)(H + o) = v; v2u w; w.x = pk2(v[0], v[1]); w.y = pk2(v[2], v[3]); *(v2u*)(Hb + o) = w; }
}
__device__ __forceinline__ void ph_epi_ple(ArgP a_, int wv_) {
    TID_LOCAL(); GTID_LOCAL();
    unsigned char* ws = a->ws; const float* C = (const float*)(ws + WS_C); const float* C2 = (const float*)(ws + WS_C2); const float* rstd = (const float*)(ws + WS_RSTD);
    float* H = (float*)(ws + WS_H); bf16* Hb = (bf16*)(ws + WS_HBA);
    for (size_t e = gtid; e < (size_t)MR * (DM / 4); e += GT) { const size_t o = e * 4; const int r = (int)(e / (DM / 4)); const float rs = rstd[r];
        const f32x4 c = *(const f32x4*)(C + o), p = *(const f32x4*)(C2 + o); f32x4 v = *(const f32x4*)(H + o);
#pragma unroll
        for (int j = 0; j < 4; ++j) v[j] += sigmoidf_(c[j] * rs) * p[j];
        *(f32x4*)(H + o) = v; v2u w; w.x = pk2(v[0], v[1]); w.y = pk2(v[2], v[3]); *(v2u*)(Hb + o) = w; }
}
__device__ __forceinline__ void ph_epi_ssm_in(ArgP a_, int wv_) {
    TID_LOCAL(); GTID_LOCAL();
    unsigned char* ws = a->ws; const float* C = (const float*)(ws + WS_C); const float* rstd = (const float*)(ws + WS_RSTD);
    for (size_t e = gtid; e < (size_t)MR * 1024; e += GT) { const int r = (int)(e / 1024), c = (int)(e % 1024) * 4;
        f32x4 v = *(const f32x4*)(C + (size_t)r * 4096 + c); v = v * rstd[r];
        if (c < 2048) { v2u o; o.x = pk2(v[0], v[1]); o.y = pk2(v[2], v[3]);
            if (r < MP) { const int b = r / SEQ, t = r % SEQ, g = c / 16, j = c % 16; *(v2u*)((bf16*)(ws + WS_UG) + (((size_t)(b * NGRP + g) * SEQ + t) * 16 + j)) = o; }
            else *(v2u*)((bf16*)(ws + WS_US) + (size_t)(r - MP) * 2048 + c) = o; }
        else { v2u o; o.x = pk2(siluf_(v[0]), siluf_(v[1])); o.y = pk2(siluf_(v[2]), siluf_(v[3])); *(v2u*)((bf16*)(ws + WS_GB) + (size_t)r * 2048 + (c - 2048)) = o; }
    }
}
__device__ __forceinline__ void scan_item(ArgP a, int l, bool pr, int item, int lane) {
    unsigned char* ws = a->ws;
    const int b = item / NGRP, g = item % NGRP, n = lane;
    const size_t gn = ((size_t)l * NGRP + g) * SST + n;
    const float lre = fminf(((const float*)a->in[I_LRE])[gn], -1e-4f), lim = ((const float*)a->in[I_LIM])[gn];
    const float dt = expf(((const float*)a->in[I_LDT])[l * NGRP + g]);
    const float mag = expf(lre * dt), ang = lim * dt; const float are = mag * cosf(ang), aim = mag * sinf(ang);
    const float den = lre * lre + lim * lim; const float cre = ((are - 1.0f) * lre + aim * lim) / den, cim = (aim * lre - (are - 1.0f) * lim) / den;
    float bbr[16], bbi[16], ccr[16], cci[16];
#pragma unroll
    for (int j = 0; j < 16; ++j) { const float br = ((const float*)a->in[I_BRE])[gn * 16 + j], bi = ((const float*)a->in[I_BIM])[gn * 16 + j];
        bbr[j] = cre * br - cim * bi; bbi[j] = cre * bi + cim * br;
        const size_t ci = (((size_t)l * NGRP + g) * 16 + j) * SST + n; ccr[j] = ((const float*)a->in[I_CRE])[ci]; cci[j] = ((const float*)a->in[I_CIM])[ci]; }
    const float dj = ((const float*)a->in[I_SD])[(size_t)l * DM + g * 16 + (lane & 15)];
    float xr = 0.f, xi = 0.f;
    if (!pr) { const size_t si = (((size_t)l * DBATCH + b) * NGRP + g) * SST + n; xr = ((const float*)a->in[I_SRE])[si]; xi = ((const float*)a->in[I_SIM])[si]; }
    const int T = pr ? SEQ : DSEQ;
    const bf16* up = pr ? (const bf16*)(ws + WS_UG) + (size_t)(b * NGRP + g) * SEQ * 16 : (const bf16*)(ws + WS_US) + (size_t)(b * DSEQ) * 2048 + g * 16;
    const int ustride = pr ? 16 : 2048;
    bf16* Yb = (bf16*)(ws + WS_YB);
    for (int t = 0; t < T; ++t) {
        const v4u u0 = *(const v4u*)(up + (size_t)t * ustride), u1 = *(const v4u*)(up + (size_t)t * ustride + 8);
        const float u[16] = {bflo(u0.x), bfhi(u0.x), bflo(u0.y), bfhi(u0.y), bflo(u0.z), bfhi(u0.z), bflo(u0.w), bfhi(u0.w), bflo(u1.x), bfhi(u1.x), bflo(u1.y), bfhi(u1.y), bflo(u1.z), bfhi(u1.z), bflo(u1.w), bfhi(u1.w)};
        float br = 0.f, bi = 0.f;
#pragma unroll
        for (int j = 0; j < 16; ++j) { br += bbr[j] * u[j]; bi += bbi[j] * u[j]; }
        const float nr = are * xr - aim * xi + br, ni = are * xi + aim * xr + bi; xr = nr; xi = ni;
        float yj = 0.f, uj = 0.f;
#pragma unroll
        for (int j = 0; j < 16; ++j) { const float s = wave_sum(ccr[j] * xr - cci[j] * xi); if ((lane & 15) == j) { yj = s; uj = u[j]; } }
        if (lane < 16) { const float y = yj + dj * uj; const int row = pr ? b * SEQ + t : MP + b * DSEQ + t; Yb[(size_t)row * 2048 + g * 16 + lane] = (bf16)f2bf(gelu_tanh(y)); }
    }
    float* osr = a->out + (pr ? O_SRP + (((size_t)l * NBATCH + b) * NGRP + g) * SST : O_SRS + (((size_t)l * DBATCH + b) * NGRP + g) * SST);
    float* osi = a->out + (pr ? O_SIP + (((size_t)l * NBATCH + b) * NGRP + g) * SST : O_SIS + (((size_t)l * DBATCH + b) * NGRP + g) * SST);
    osr[n] = xr; osi[n] = xi;
}
__device__ __forceinline__ void ph_scan_naive(ArgP a_, int l, int wv_) {
    TID_LOCAL();
    for (int vb = blockIdx.x; vb < 256; vb += gridDim.x) {
        if (wave == 0) scan_item(a, l, true, vb, lane);
        else { const int item = vb * 7 + (wave - 1); if (item < DBATCH * NGRP) scan_item(a, l, false, item, lane); }
    }
}

namespace s5 {
using bf16x8 = __attribute__((ext_vector_type(8))) short;
using s16x4  = __attribute__((ext_vector_type(4))) short;
using f32x16 = __attribute__((ext_vector_type(16))) float;
constexpr int XSTR = 80;
constexpr int XT_BYTES = 128 * XSTR;
constexpr int E_OFF = 8 * XT_BYTES, H_OFF = E_OFF + 16 * 64 * 8;
__device__ __forceinline__ s16x4 tr_read(int addr) { s16x4 r; asm volatile("ds_read_b64_tr_b16 %0, %1" : "=&v"(r) : "v"(addr) : "memory"); return r; }
}
__device__ __forceinline__ void ph_scan(ArgP a_, int l, LAS unsigned char* ldsb, int wv_) {
    using namespace s5;
    TID_LOCAL();
    unsigned char* ws = a->ws;
    LAS char* lds = (LAS char*)ldsb;
    bf16* Yb = (bf16*)(ws + WS_YB);
    const int n0 = lane & 31, h2 = lane >> 5, fj = lane & 15, kg = lane >> 4;
    for (int vb = blockIdx.x; vb < NBATCH * NGRP; vb += gridDim.x) {
        const int b = vb >> 7, g = vb & 127;
        const size_t gbase = (size_t)l * NGRP + g;
        float ar[2], ai[2]; bf16x8 Bfr[2][2];
        const float dt = expf(((const float*)a->in[I_LDT])[gbase]);
#pragma unroll
        for (int nt = 0; nt < 2; ++nt) { const size_t gn = gbase * SST + n0 + 32 * nt;
            const float lre = fminf(((const float*)a->in[I_LRE])[gn], -1e-4f), lim = ((const float*)a->in[I_LIM])[gn];
            const float mag = expf(lre * dt), ang = lim * dt; const float are = mag * cosf(ang), aim = mag * sinf(ang);
            const float den = lre * lre + lim * lim; const float cre = ((are - 1.0f) * lre + aim * lim) / den, cim = (aim * lre - (are - 1.0f) * lim) / den;
            ar[nt] = are; ai[nt] = aim;
            const f32x4 br0 = *(const f32x4*)((const float*)a->in[I_BRE] + gn * 16 + 8 * h2), br1 = *(const f32x4*)((const float*)a->in[I_BRE] + gn * 16 + 8 * h2 + 4);
            const f32x4 bi0 = *(const f32x4*)((const float*)a->in[I_BIM] + gn * 16 + 8 * h2), bi1 = *(const f32x4*)((const float*)a->in[I_BIM] + gn * 16 + 8 * h2 + 4);
            v4u wr_, wi_;
            wr_.x = pk2(cre * br0[0] - cim * bi0[0], cre * br0[1] - cim * bi0[1]); wr_.y = pk2(cre * br0[2] - cim * bi0[2], cre * br0[3] - cim * bi0[3]);
            wr_.z = pk2(cre * br1[0] - cim * bi1[0], cre * br1[1] - cim * bi1[1]); wr_.w = pk2(cre * br1[2] - cim * bi1[2], cre * br1[3] - cim * bi1[3]);
            wi_.x = pk2(cre * bi0[0] + cim * br0[0], cre * bi0[1] + cim * br0[1]); wi_.y = pk2(cre * bi0[2] + cim * br0[2], cre * bi0[3] + cim * br0[3]);
            wi_.z = pk2(cre * bi1[0] + cim * br1[0], cre * bi1[1] + cim * br1[1]); wi_.w = pk2(cre * bi1[2] + cim * br1[2], cre * bi1[3] + cim * br1[3]);
            Bfr[nt][0] = __builtin_bit_cast(bf16x8, wr_); Bfr[nt][1] = __builtin_bit_cast(bf16x8, wi_); }
        bf16x8 Cf[4];
#pragma unroll
        for (int ks = 0; ks < 4; ++ks) { const float* srcp = (const float*)a->in[(ks >> 1) ? I_CIM : I_CRE] + (gbase * 16 + fj) * SST + (ks & 1) * 32 + kg * 8; const float sg = (ks >> 1) ? -1.0f : 1.0f;
            const f32x4 c0 = *(const f32x4*)srcp, c1 = *(const f32x4*)(srcp + 4);
            v4u w; w.x = pk2(sg * c0[0], sg * c0[1]); w.y = pk2(sg * c0[2], sg * c0[3]); w.z = pk2(sg * c1[0], sg * c1[1]); w.w = pk2(sg * c1[2], sg * c1[3]); Cf[ks] = __builtin_bit_cast(bf16x8, w); }
        const f32x4 dv = *(const f32x4*)((const float*)a->in[I_SD] + (size_t)l * DM + g * 16 + 4 * kg);
        const bf16* up = (const bf16*)(ws + WS_UG) + (size_t)(b * NGRP + g) * SEQ * 16;
        const int a_time0 = 256 * (2 * wave + ((n0 >> 2) & 1)) + (n0 & 3) + 4 * (n0 >> 3);
        const bf16* ap = up + (size_t)a_time0 * 16 + 8 * h2;
        LAS float* E = (LAS float*)(lds + E_OFF); LAS float* Hs = (LAS float*)(lds + H_OFF);
        const int seg = 2 * wave + h2;
        { float xr[2] = {0.f, 0.f}, xi[2] = {0.f, 0.f};
          bf16x8 An = *(const bf16x8*)ap;
          for (int tile = 0; tile < 16; ++tile) { const bf16x8 A = An; if (tile < 15) An = *(const bf16x8*)(ap + (size_t)(tile + 1) * 256);
#pragma unroll
              for (int nt = 0; nt < 2; ++nt) { f32x16 cr = {}, ci = {};
                  cr = __builtin_amdgcn_mfma_f32_32x32x16_bf16(A, Bfr[nt][0], cr, 0, 0, 0); ci = __builtin_amdgcn_mfma_f32_32x32x16_bf16(A, Bfr[nt][1], ci, 0, 0, 0);
#pragma unroll
                  for (int i = 0; i < 16; ++i) { const float nr = ar[nt] * xr[nt] - ai[nt] * xi[nt] + cr[i], ni = ar[nt] * xi[nt] + ai[nt] * xr[nt] + ci[i]; xr[nt] = nr; xi[nt] = ni; } } }
#pragma unroll
          for (int nt = 0; nt < 2; ++nt) { E[(seg * 64 + n0 + 32 * nt) * 2] = xr[nt]; E[(seg * 64 + n0 + 32 * nt) * 2 + 1] = xi[nt]; } }
        __syncthreads();
        if (wave == 0) { const size_t gn = gbase * SST + lane;
            const float lre = fminf(((const float*)a->in[I_LRE])[gn], -1e-4f), lim = ((const float*)a->in[I_LIM])[gn];
            const float mag = expf(lre * dt), ang = lim * dt; float pr_ = mag * cosf(ang), pi_ = mag * sinf(ang);
#pragma unroll
            for (int q = 0; q < 8; ++q) { const float t0 = pr_ * pr_ - pi_ * pi_, t1 = 2.0f * pr_ * pi_; pr_ = t0; pi_ = t1; }
            float hr = 0.f, hi_ = 0.f; Hs[lane * 2] = 0.f; Hs[lane * 2 + 1] = 0.f;
            for (int s = 0; s < 16; ++s) { const float er = E[(s * 64 + lane) * 2], ei = E[(s * 64 + lane) * 2 + 1];
                const float nr = pr_ * hr - pi_ * hi_ + er, ni = pr_ * hi_ + pi_ * hr + ei; hr = nr; hi_ = ni; Hs[((s + 1) * 64 + lane) * 2] = hr; Hs[((s + 1) * 64 + lane) * 2 + 1] = hi_; }
            a->out[O_SRP + (((size_t)l * NBATCH + b) * NGRP + g) * SST + lane] = hr; a->out[O_SIP + (((size_t)l * NBATCH + b) * NGRP + g) * SST + lane] = hi_; }
        __syncthreads();
        { float xr[2], xi[2];
#pragma unroll
          for (int nt = 0; nt < 2; ++nt) { xr[nt] = Hs[(seg * 64 + n0 + 32 * nt) * 2]; xi[nt] = Hs[(seg * 64 + n0 + 32 * nt) * 2 + 1]; }
          LAS char* Xt = lds + wave * XT_BYTES; const int xt_addr = (int)(unsigned)(size_t)Xt;
          bf16x8 An = *(const bf16x8*)ap;
          for (int tile = 0; tile < 16; ++tile) { const bf16x8 A = An; if (tile < 15) An = *(const bf16x8*)(ap + (size_t)(tile + 1) * 256);
#pragma unroll
              for (int nt = 0; nt < 2; ++nt) { f32x16 cr = {}, ci = {};
                  cr = __builtin_amdgcn_mfma_f32_32x32x16_bf16(A, Bfr[nt][0], cr, 0, 0, 0); ci = __builtin_amdgcn_mfma_f32_32x32x16_bf16(A, Bfr[nt][1], ci, 0, 0, 0);
                  unsigned pr[8], pi[8];
#pragma unroll
                  for (int i = 0; i < 16; i += 2) { float r0, i0, r1, i1;
                      r0 = ar[nt] * xr[nt] - ai[nt] * xi[nt] + cr[i]; i0 = ar[nt] * xi[nt] + ai[nt] * xr[nt] + ci[i];
                      r1 = ar[nt] * r0 - ai[nt] * i0 + cr[i + 1]; i1 = ar[nt] * i0 + ai[nt] * r0 + ci[i + 1]; xr[nt] = r1; xi[nt] = i1;
                      pr[i >> 1] = pk2(r0, r1); pi[i >> 1] = pk2(i0, i1); }
                  LAS char* rowr = Xt + (nt * 32 + n0) * XSTR + h2 * 32; LAS char* rowi = rowr + 64 * XSTR;
                  *(LAS v4u*)rowr = (v4u){pr[0], pr[1], pr[2], pr[3]}; *(LAS v4u*)(rowr + 16) = (v4u){pr[4], pr[5], pr[6], pr[7]};
                  *(LAS v4u*)rowi = (v4u){pi[0], pi[1], pi[2], pi[3]}; *(LAS v4u*)(rowi + 16) = (v4u){pi[4], pi[5], pi[6], pi[7]}; }
              asm volatile("s_waitcnt lgkmcnt(0)" ::: "memory");
#pragma unroll
              for (int tt = 0; tt < 2; ++tt) { f32x4 acc = {0.f, 0.f, 0.f, 0.f};
                  s16x4 lo[4], hi4[4];
#pragma unroll
                  for (int ks = 0; ks < 4; ++ks) { const int rowk = 32 * ks + 8 * kg + (fj >> 2); const int ad = xt_addr + rowk * XSTR + (16 * tt + 4 * (fj & 3)) * 2;
                      lo[ks] = tr_read(ad); hi4[ks] = tr_read(ad + 4 * XSTR); }
                  asm volatile("s_waitcnt lgkmcnt(0)" ::: "memory"); __builtin_amdgcn_sched_barrier(0);
#pragma unroll
                  for (int ks = 0; ks < 4; ++ks) { const bf16x8 Bx = (bf16x8){lo[ks][0], lo[ks][1], lo[ks][2], lo[ks][3], hi4[ks][0], hi4[ks][1], hi4[ks][2], hi4[ks][3]};
                      acc = __builtin_amdgcn_mfma_f32_16x16x32_bf16(Cf[ks], Bx, acc, 0, 0, 0); }
                  const int time = 256 * (2 * wave + tt) + 16 * tile + fj;
                  const v2u uw = *(const v2u*)(up + (size_t)time * 16 + 4 * kg);
                  const float y0 = acc[0] + dv[0] * bflo(uw.x), y1 = acc[1] + dv[1] * bfhi(uw.x), y2 = acc[2] + dv[2] * bflo(uw.y), y3 = acc[3] + dv[3] * bfhi(uw.y);
                  v2u o; o.x = pk2(gelu_tanh(y0), gelu_tanh(y1)); o.y = pk2(gelu_tanh(y2), gelu_tanh(y3));
                  *(v2u*)(Yb + ((size_t)b * SEQ + time) * 2048 + g * 16 + 4 * kg) = o; }
          } }
        __syncthreads();
    }
    for (int it = gw; it < DBATCH * NGRP; it += NGW) scan_item(a, l, false, it, lane);
}

__device__ __forceinline__ void ph_epi_glu(ArgP a_, int l, int wv_) {
    TID_LOCAL(); GTID_LOCAL();
    unsigned char* ws = a->ws; const float* C = (const float*)(ws + WS_C); const float* bg = (const float*)a->in[I_BGLU] + (size_t)l * DM;
    const bf16* Yb = (const bf16*)(ws + WS_YB); const bf16* Gb = (const bf16*)(ws + WS_GB); bf16* AOb = (bf16*)(ws + WS_AOB);
    for (size_t e = gtid; e < (size_t)MR * (DM / 4); e += GT) { const size_t o = e * 4; const int c = (int)(o % DM);
        const f32x4 cv = *(const f32x4*)(C + o), bv = *(const f32x4*)(bg + c); const v2u yw = *(const v2u*)(Yb + o), gw2 = *(const v2u*)(Gb + o);
        const float y[4] = {bflo(yw.x), bfhi(yw.x), bflo(yw.y), bfhi(yw.y)}, gg[4] = {bflo(gw2.x), bfhi(gw2.x), bflo(gw2.y), bfhi(gw2.y)};
        float r[4];
#pragma unroll
        for (int j = 0; j < 4; ++j) r[j] = y[j] * sigmoidf_(cv[j] + bv[j]) * gg[j];
        v2u w; w.x = pk2(r[0], r[1]); w.y = pk2(r[2], r[3]); *(v2u*)(AOb + o) = w; }
}
__device__ __forceinline__ void ph_final(ArgP a_, int wv_) {
    TID_LOCAL();
    unsigned char* ws = a->ws; const bf16* Hb = (const bf16*)(ws + WS_HBA); const float* ssq = ss_buf(ws, 8); const float* fw = (const float*)a->in[I_FNW];
    for (int r = gw; r < MR; r += NGW) {
        float s;
        if (r < MP) s = (lane < 32) ? ssq[(size_t)r * 32 + lane] : 0.f;
        else s = ssq[(size_t)MPAD * 32 + (size_t)(r - MP) * 128 + lane] + ssq[(size_t)MPAD * 32 + (size_t)(r - MP) * 128 + 64 + lane];
        const float rs = ss2rstd(wave_sum(s));
        float* out = a->out + (r < MP ? O_YP + (size_t)r * DM : O_YS + (size_t)(r - MP) * DM);
#pragma unroll
        for (int j = 0; j < 8; ++j) { const int c = (j * 64 + lane) * 4; const v2u hw = *(const v2u*)(Hb + (size_t)r * DM + c);
            *(f32x4*)(out + c) = (f32x4){bflo(hw.x), bfhi(hw.x), bflo(hw.y), bfhi(hw.y)} * rs * *(const f32x4*)(fw + c); } }
}

constexpr size_t WS_PRJ = WS_C;
constexpr size_t PRJ_STRIDE = (size_t)MPAD * DM * 2;
constexpr size_t WS_SSP = WS_C2;
constexpr size_t SSP_STRIDE = (size_t)MPAD * 32 + (size_t)MS * 128;
__device__ __forceinline__ float* ss_buf(unsigned char* ws, int k) { return (float*)(ws + WS_SSP) + (size_t)k * SSP_STRIDE; }
__device__ __forceinline__ float ss2rstd(float ss) { return 1.0f / sqrtf(ss * (1.0f / DM) + RMS_EPS); }
struct AuxNone {};
__device__ __forceinline__ float ss_row_part(const float* ssp, int r, int q) {
    const f32x4* p = (const f32x4*)(ssp + (size_t)r * 32 + 8 * q); const f32x4 s = p[0] + p[1]; return (s[0] + s[1]) + (s[2] + s[3]); }
__device__ __forceinline__ float ss_srow_part(const float* ssp, int r, int q) {
    const f32x4* p = (const f32x4*)(ssp + (size_t)MPAD * 32 + (size_t)(r - MP) * 128 + 32 * q); f32x4 s = p[0];
#pragma unroll
    for (int i = 1; i < 8; ++i) s += p[i];
    return (s[0] + s[1]) + (s[2] + s[3]); }
__device__ __forceinline__ float ss_row_rstd(const float* ssp, int r) {
    if (r < MP) { const f32x4* p = (const f32x4*)(ssp + (size_t)r * 32); f32x4 s = p[0];
#pragma unroll
        for (int i = 1; i < 8; ++i) s += p[i];
        return ss2rstd((s[0] + s[1]) + (s[2] + s[3])); }
    const f32x4* p = (const f32x4*)(ssp + (size_t)MPAD * 32 + (size_t)(r - MP) * 128); f32x4 s = p[0];
    for (int i = 1; i < 32; ++i) s += p[i];
    return ss2rstd((s[0] + s[1]) + (s[2] + s[3])); }
__device__ __forceinline__ v2u pk4(const f32x4 v) { v2u o; o.x = pk2(v[0], v[1]); o.y = pk2(v[2], v[3]); return o; }
struct FAttnIn { unsigned char* ws; float* out; const float* ssin; int l; static constexpr bool SUMSQ = false, RSTD = true; float* ssout; typedef AuxNone Aux;
    __device__ __forceinline__ void prefetch(int, int, Aux&) const {}
    __device__ __forceinline__ float store4(int r, int c, f32x4 v, float rs, const Aux&) const {
        if (c >= ACOLS) return 0.f;
        v = v * rs;
        if (c < C_K) { v = v * QSCALE; *(v2u*)((bf16*)(ws + WS_QB) + (size_t)r * 2048 + c) = pk4(v); }
        else if (c < C_G) { const bool isv = c >= C_V; const int cc = c - (isv ? C_V : C_K);
            float* o32 = out + (r < MP ? (isv ? O_VP : O_KP) + ((size_t)l * MP + r) * 512 : (isv ? O_VS : O_KS) + ((size_t)l * MS + (r - MP)) * 512) + cc;
            *(f32x4*)o32 = v; *(v2u*)((bf16*)(ws + (isv ? WS_VB : WS_KB)) + (size_t)r * 512 + cc) = pk4(v); }
        else if (c < C_QI) { v2u o; o.x = pk2(siluf_(v[0]), siluf_(v[1])); o.y = pk2(siluf_(v[2]), siluf_(v[3])); *(v2u*)((bf16*)(ws + WS_GB) + (size_t)r * 2048 + (c - C_G)) = o; }
        else if (c < C_KI) { *(v2u*)((bf16*)(ws + WS_QIB) + (size_t)r * 1024 + (c - C_QI)) = pk4(v); }
        else if (c < C_WI) { const int cc = c - C_KI; float* o32 = out + (r < MP ? O_KIP + ((size_t)l * MP + r) * 64 : O_KIS + ((size_t)l * MS + (r - MP)) * 64) + cc;
            *(f32x4*)o32 = v; *(v2u*)((bf16*)(ws + WS_KIB) + (size_t)r * 64 + cc) = pk4(v); }
        else { *(f32x4*)((float*)(ws + WS_WI) + (size_t)r * 16 + (c - C_WI)) = v * WISCALE; }
        return 0.f; } };
struct FResid { unsigned char* ws; float* ssout; const float* ssin; static constexpr bool SUMSQ = true, RSTD = false;
    struct Aux { v2u h; };
    __device__ __forceinline__ void prefetch(int r, int c, Aux& x) const { x.h = *(const v2u*)((const bf16*)(ws + WS_HBA) + (size_t)r * DM + c); }
    __device__ __forceinline__ float store4(int r, int c, f32x4 v, float, const Aux& x) const { const size_t o = (size_t)r * DM + c; const f32x4 h = (f32x4){bflo(x.h.x), bfhi(x.h.x), bflo(x.h.y), bfhi(x.h.y)} + v;
        *(v2u*)((bf16*)(ws + WS_HBB) + o) = pk4(h); return h[0] * h[0] + h[1] * h[1] + h[2] * h[2] + h[3] * h[3]; } };
struct FPleProj { unsigned char* ws; float* ssout; const float* ssin; bf16* prj; static constexpr bool SUMSQ = false, RSTD = false; typedef AuxNone Aux;
    __device__ __forceinline__ void prefetch(int, int, Aux&) const {}
    __device__ __forceinline__ float store4(int r, int c, f32x4 v, float, const Aux&) const { *(v2u*)(prj + (size_t)r * DM + c) = pk4(v); return 0.f; } };
struct FPle { unsigned char* ws; const float* ssin; float* ssout; const bf16* prj; static constexpr bool SUMSQ = true, RSTD = true;
    struct Aux { v2u h; v2u p; };
    __device__ __forceinline__ void prefetch(int r, int c, Aux& x) const { const size_t o = (size_t)r * DM + c; x.h = *(const v2u*)((const bf16*)(ws + WS_HBB) + o); x.p = *(const v2u*)(prj + o); }
    __device__ __forceinline__ float store4(int r, int c, f32x4 v, float rs, const Aux& x) const { const size_t o = (size_t)r * DM + c; f32x4 h = (f32x4){bflo(x.h.x), bfhi(x.h.x), bflo(x.h.y), bfhi(x.h.y)};
        const v2u pw = x.p; const float p[4] = {bflo(pw.x), bfhi(pw.x), bflo(pw.y), bfhi(pw.y)};
#pragma unroll
        for (int j = 0; j < 4; ++j) h[j] += sigmoidf_(v[j] * rs) * p[j];
        *(v2u*)((bf16*)(ws + WS_HBA) + o) = pk4(h); return h[0] * h[0] + h[1] * h[1] + h[2] * h[2] + h[3] * h[3]; } };
struct FSsmIn { unsigned char* ws; const float* ssin; float* ssout; static constexpr bool SUMSQ = false, RSTD = true; typedef AuxNone Aux;
    __device__ __forceinline__ void prefetch(int, int, Aux&) const {}
    __device__ __forceinline__ float store4(int r, int c, f32x4 v, float rs, const Aux&) const { v = v * rs;
        if (c < 2048) { if (r < MP) { const int b = r / SEQ, t = r % SEQ, g = c / 16, j = c % 16; *(v2u*)((bf16*)(ws + WS_UG) + (((size_t)(b * NGRP + g) * SEQ + t) * 16 + j)) = pk4(v); }
                        else *(v2u*)((bf16*)(ws + WS_US) + (size_t)(r - MP) * 2048 + c) = pk4(v); }
        else { v2u o; o.x = pk2(siluf_(v[0]), siluf_(v[1])); o.y = pk2(siluf_(v[2]), siluf_(v[3])); *(v2u*)((bf16*)(ws + WS_GB) + (size_t)r * 2048 + (c - 2048)) = o; }
        return 0.f; } };
struct FGlu { unsigned char* ws; const float* bg; float* ssout; const float* ssin; static constexpr bool SUMSQ = false, RSTD = false;
    struct Aux { f32x4 bv; v2u y, g; };
    __device__ __forceinline__ void prefetch(int r, int c, Aux& x) const { const size_t o = (size_t)r * DM + c; x.bv = *(const f32x4*)(bg + c); x.y = *(const v2u*)((const bf16*)(ws + WS_YB) + o); x.g = *(const v2u*)((const bf16*)(ws + WS_GB) + o); }
    __device__ __forceinline__ float store4(int r, int c, f32x4 v, float, const Aux& x) const { const size_t o = (size_t)r * DM + c; const f32x4 bv = x.bv;
        const v2u yw = x.y, gw2 = x.g;
        const float y[4] = {bflo(yw.x), bfhi(yw.x), bflo(yw.y), bfhi(yw.y)}, gg[4] = {bflo(gw2.x), bfhi(gw2.x), bflo(gw2.y), bfhi(gw2.y)}; f32x4 rr;
#pragma unroll
        for (int j = 0; j < 4; ++j) rr[j] = y[j] * sigmoidf_(v[j] + bv[j]) * gg[j];
        *(v2u*)((bf16*)(ws + WS_AOB) + o) = pk4(rr); return 0.f; } };
template <class F> struct EpiFused { F f;
    __device__ __forceinline__ void operator()(const f32x4 (&acc)[2][2][4][2], const pg8::Unit& u, int wr, int wc, int fr, int fq) const {
        const int row0 = u.pm * 256 + wr * 64 + fr, col0 = u.pn * 256 + wc * 32 + 4 * fq;
#pragma unroll
        for (int ai = 0; ai < 2; ++ai) {
            float rs[4];
            if (F::RSTD) {
#pragma unroll
                for (int m = 0; m < 4; ++m) rs[m] = ss_row_part(f.ssin, row0 + ai * 128 + m * 16, fq);
#pragma unroll
                for (int m = 0; m < 4; ++m) { float s = rs[m]; s += __shfl_xor(s, 16); s += __shfl_xor(s, 32); rs[m] = ss2rstd(s); } }
            else {
#pragma unroll
                for (int m = 0; m < 4; ++m) rs[m] = 0.f; }
            constexpr int RB = (sizeof(typename F::Aux) <= 24) ? 2 : 1;
#pragma unroll
            for (int m0 = 0; m0 < 4; m0 += RB) {
                typename F::Aux cur[RB][4];
#pragma unroll
                for (int j = 0; j < RB; ++j)
#pragma unroll
                    for (int g = 0; g < 4; ++g) f.prefetch(row0 + ai * 128 + (m0 + j) * 16, col0 + (g >> 1) * 128 + (g & 1) * 16, cur[j][g]);
#pragma unroll
                for (int j = 0; j < RB; ++j) { const int m = m0 + j; const int row = row0 + ai * 128 + m * 16; float ss = 0.f;
#pragma unroll
                    for (int g = 0; g < 4; ++g) ss += f.store4(row, col0 + (g >> 1) * 128 + (g & 1) * 16, acc[ai][g >> 1][m][g & 1], rs[m], cur[j][g]);
                    if (F::SUMSQ) { ss += __shfl_xor(ss, 16); ss += __shfl_xor(ss, 32); if (fq == 0) f.ssout[(size_t)row * 32 + u.pn * 4 + wc] = ss; } } } }
    } };
template <int NC, class F>
__device__ __forceinline__ void thin_tile(LAS unsigned char* lds, const bf16* A, const bf16* Bt, int K, int grow0, int gcol0, const F& f, int tid, int lane, int wave) {
    constexpr int NTL = NC / 16, RS = NC + 4, RT = NC / 4;
    const int fr = lane & 15, kg = lane >> 4; const int kw = K >> 3;
    f32x4 acc[2][NTL];
#pragma unroll
    for (int i = 0; i < 2; ++i)
#pragma unroll
        for (int j = 0; j < NTL; ++j) acc[i][j] = (f32x4){0.f, 0.f, 0.f, 0.f};
    const bf16* ap = A + (size_t)fr * K + wave * kw + kg * 8; const bf16* bp = Bt + (size_t)fr * K + wave * kw + kg * 8;
    for (int ks0 = 0; ks0 < kw / 32; ks0 += 2) {
        bf16x8v a0[2], a1[2], bw[2][NTL];
#pragma unroll
        for (int j = 0; j < 2; ++j) { a0[j] = *(const bf16x8v*)(ap + (ks0 + j) * 32); a1[j] = *(const bf16x8v*)(ap + (size_t)16 * K + (ks0 + j) * 32);
#pragma unroll
            for (int nt = 0; nt < NTL; ++nt) bw[j][nt] = *(const bf16x8v*)(bp + (size_t)nt * 16 * K + (ks0 + j) * 32); }
#pragma unroll
        for (int j = 0; j < 2; ++j)
#pragma unroll
            for (int nt = 0; nt < NTL; ++nt) { acc[0][nt] = __builtin_amdgcn_mfma_f32_16x16x32_bf16(bw[j][nt], a0[j], acc[0][nt], 0, 0, 0); acc[1][nt] = __builtin_amdgcn_mfma_f32_16x16x32_bf16(bw[j][nt], a1[j], acc[1][nt], 0, 0, 0); } }
    LAS float* red = (LAS float*)lds;
    __syncthreads();
#pragma unroll
    for (int mt = 0; mt < 2; ++mt)
#pragma unroll
        for (int nt = 0; nt < NTL; ++nt) *(LAS f32x4*)(red + ((wave * 32 + mt * 16 + fr) * RS + nt * 16 + 4 * kg)) = acc[mt][nt];
    __syncthreads();
    for (int it = tid; it < 32 * RT; it += NTHR) { const int m = it / RT, c4 = it % RT; f32x4 v = {0.f, 0.f, 0.f, 0.f};
#pragma unroll
        for (int w = 0; w < 8; ++w) v += *(LAS const f32x4*)(red + ((w * 32 + m) * RS + 4 * c4));
        const float rs = F::RSTD ? ss_row_rstd(f.ssin, grow0 + m) : 0.f; typename F::Aux x; f.prefetch(grow0 + m, gcol0 + 4 * c4, x); f.store4(grow0 + m, gcol0 + 4 * c4, v, rs, x); }
    __syncthreads();
}
template <int KS, class F>
__device__ __forceinline__ void thin_tile16(LAS unsigned char* lds, const bf16* A, const bf16* Bt, int grow0, int gcol0, int slot, const F& f, int tid, int lane, int wave) {
    constexpr int K = KS * 256, RS = 20;
    const int fr = lane & 15, kg = lane >> 4;
    const bf16* ap = A + (size_t)fr * K + wave * (KS * 32) + kg * 8; const bf16* bp = Bt + (size_t)fr * K + wave * (KS * 32) + kg * 8;
    bf16x8v a0[KS], a1[KS], bw[KS];
#pragma unroll
    for (int ks = 0; ks < KS; ++ks) { a0[ks] = *(const bf16x8v*)(ap + ks * 32); a1[ks] = *(const bf16x8v*)(ap + (size_t)16 * K + ks * 32); bw[ks] = *(const bf16x8v*)(bp + ks * 32); }
    f32x4 acc0 = {0.f, 0.f, 0.f, 0.f}, acc1 = {0.f, 0.f, 0.f, 0.f};
#pragma unroll
    for (int ks = 0; ks < KS; ++ks) { acc0 = __builtin_amdgcn_mfma_f32_16x16x32_bf16(bw[ks], a0[ks], acc0, 0, 0, 0); acc1 = __builtin_amdgcn_mfma_f32_16x16x32_bf16(bw[ks], a1[ks], acc1, 0, 0, 0); }
    LAS float* red = (LAS float*)lds;
    __syncthreads();
    *(LAS f32x4*)(red + ((wave * 32 + fr) * RS + 4 * kg)) = acc0; *(LAS f32x4*)(red + ((wave * 32 + 16 + fr) * RS + 4 * kg)) = acc1;
    __syncthreads();
    if (tid < 128) { const int m = tid >> 2, c4 = tid & 3; f32x4 v = {0.f, 0.f, 0.f, 0.f};
#pragma unroll
        for (int w = 0; w < 8; ++w) v += *(LAS const f32x4*)(red + ((w * 32 + m) * RS + 4 * c4));
        typename F::Aux x; f.prefetch(grow0 + m, gcol0 + 4 * c4, x);
        float rs = 0.f; if (F::RSTD) { rs = ss_srow_part(f.ssin, grow0 + m, c4); rs += __shfl_xor(rs, 1); rs += __shfl_xor(rs, 2); rs = ss2rstd(rs); }
        float ss = f.store4(grow0 + m, gcol0 + 4 * c4, v, rs, x);
        if (F::SUMSQ) { ss += __shfl_xor(ss, 1); ss += __shfl_xor(ss, 2); if (c4 == 0) f.ssout[(size_t)MPAD * 32 + (size_t)(grow0 + m - MP) * 128 + slot] = ss; } }
    __syncthreads();
}
template <int KS, class F> __device__ __forceinline__ void thin_sample(LAS unsigned char* lds, const bf16* A, const bf16* Bt, int N, const F& f, int wv_, int wg0 = 0, int nwg = 0) {
    const int wave = wv_, lane = lane_id_fresh(); int tid = wave * 64 + lane; asm volatile("" : "+v"(tid));
    constexpr int K = KS * 256;
    if (nwg == 0) nwg = gridDim.x;
    for (int t = (int)blockIdx.x - wg0; t < (N + 15) / 16; t += nwg) thin_tile16<KS, F>(lds, A + (size_t)MP * K, Bt + (size_t)t * 16 * K, MP, t * 16, t, f, tid, lane, wave);
}

__global__ void __launch_bounds__(NTHR, 2) fwd_kernel(Args args) {
    extern __shared__ __attribute__((aligned(16))) unsigned char lds_raw[];
    LAS unsigned char* lds = (LAS unsigned char*)lds_raw;
    volatile LAS unsigned* MISC = (volatile LAS unsigned*)(lds + MISC_OFF);
    const int wave_u = __builtin_amdgcn_readfirstlane((int)threadIdx.x >> 6);
    for (int u = wave_u * 64 + lane_id_fresh(); u < (LDS_BYTES - 131072) / 4; u += NTHR) ((LAS unsigned*)(lds + 131072))[u] = 0u;
    __syncthreads();
    ArgP kap = (ArgP)__builtin_amdgcn_kernarg_segment_ptr();
    XcdBarrier bar = xcd_barrier_post((unsigned*)(kap->ws + WS_CTL) + CW_BAR, MISC + 8, wave_u);
    int lp = 0;
#if PROF
    unsigned ph = 0; if (blockIdx.x == 0 && wave_u == 0) { const unsigned long long t0_ = __builtin_amdgcn_s_memrealtime(); MISC[16] = (unsigned)t0_; MISC[17] = (unsigned)(t0_ >> 32); }
#endif
#define PH_BEGIN { int l = lp; asm volatile("" : "+s"(l)); const int ia = 2 * l, is = 2 * l + 1; (void)ia; (void)is; ArgP args = kap; asm volatile("" : "+s"(args)); unsigned char* ws = args->ws; (void)ws;
#if PROF
#define PROF_ARRIVE() do { prof_mark(100 + (int)ph, wave_u); } while (0)
#define PROF_EXIT()   do { prof_mark(200 + (int)ph, wave_u); ++ph; } while (0)
#else
#define PROF_ARRIVE() do {} while (0)
#define PROF_EXIT()   do {} while (0)
#endif
#define PH_END   { PROF_ARRIVE(); XcdBarrier b2_ = bar; asm volatile("" : "+s"(b2_.bar), "+s"(b2_.x)); xcd_barrier(b2_, wave_u); PROF_EXIT(); } }
#define PH_LAST  PROF_ARRIVE(); }
#define GEMM_FUSED(FT, fobj, Aptr, Bptr, Ncols, Kdim) do { pg8::Gemm g_{(const pg8::bf16_t*)(Aptr), (const pg8::bf16_t*)(Bptr), MP, (Ncols), (Kdim)}; pg8::StaticOrder S_; S_.init(MP, (Ncols), (int)gridDim.x, (int)blockIdx.x); \
        EpiFused<FT> E_{fobj}; pg8::gemm_phase<EpiFused<FT>, pg8::StaticOrder, true, true>(lds, g_, S_, E_, wave_u); } while (0)

#define GEMM_FUSED_SUB(FT, fobj, Aptr, Bptr, Ncols, Kdim, wg0_, nwg_) do { pg8::Gemm g_{(const pg8::bf16_t*)(Aptr), (const pg8::bf16_t*)(Bptr), MP, (Ncols), (Kdim)}; pg8::StaticOrder S_; S_.init(MP, (Ncols), (nwg_), (int)blockIdx.x - (wg0_)); \
        EpiFused<FT> E_{fobj}; pg8::gemm_phase<EpiFused<FT>, pg8::StaticOrder, true, true>(lds, g_, S_, E_, wave_u); } while (0)

    PH_BEGIN ph_prologue(args, lds, wave_u); PH_END

    lp = 0;
        PH_BEGIN { const bf16* Aa = (const bf16*)(ws + WS_HBA); const bf16* Bw = (const bf16*)(ws + WS_WAIN) + (size_t)l * ACOLS_PAD * DM; FAttnIn f{ws, args->out, ss_buf(ws, 2 * ia), l, nullptr};
                   GEMM_FUSED(FAttnIn, f, Aa, Bw, 6144, DM);
                   { const int wave = wave_u, lane = lane_id_fresh(); int tid = wave * 64 + lane; asm volatile("" : "+v"(tid));
                     for (int rb = blockIdx.x; rb < MP / 32; rb += gridDim.x) thin_tile<96, FAttnIn>(lds, Aa + (size_t)rb * 32 * DM, Bw + (size_t)6144 * DM, DM, rb * 32, 6144, f, tid, lane, wave); }
                   thin_sample<8, FAttnIn>(lds, Aa, Bw, ACOLS, f, wave_u); } PH_END
        PH_BEGIN ph_idx(args, l, lds, wave_u); ph_idx_sample(args, l, wave_u); PMARK(5, wave_u); PH_END
        PH_BEGIN ph_attn(args, lds, wave_u);
                   if ((int)blockIdx.x < MS * NKV || (int)gridDim.x < 2 * MS * NKV) ph_attn_sample(args, l, lds, wave_u);
                   if ((int)blockIdx.x >= MS * NKV || (int)gridDim.x < 2 * MS * NKV) {
                       const int wg0 = ((int)gridDim.x < 2 * MS * NKV) ? 0 : MS * NKV, nwg = (int)gridDim.x - wg0;
                       __syncthreads();
                       for (int q = 0; q < 2; ++q) { const int li = 2 * l + q; const bf16* Ap = (const bf16*)(ws + WS_PB + (size_t)li * PB_STRIDE); const bf16* Bp = (const bf16*)(ws + WS_WPP) + (size_t)li * DM * PLE;
                           FPleProj fp{ws, nullptr, nullptr, (bf16*)(ws + WS_PRJ + (size_t)q * PRJ_STRIDE)};
                           GEMM_FUSED_SUB(FPleProj, fp, Ap, Bp, DM, PLE, wg0, nwg); thin_sample<1, FPleProj>(lds, Ap, Bp, DM, fp, wave_u, wg0, nwg); } } PH_END
        PH_BEGIN { const bf16* Aa = (const bf16*)(ws + WS_AOB); const bf16* Bw = (const bf16*)(ws + WS_WAOUT) + (size_t)l * DM * DM; FResid f{ws, ss_buf(ws, 1 + 2 * ia), nullptr};
                   GEMM_FUSED(FResid, f, Aa, Bw, DM, DM); thin_sample<8, FResid>(lds, Aa, Bw, DM, f, wave_u);
                   } PH_END
        PH_BEGIN { const bf16* Aa = (const bf16*)(ws + WS_HBB); const bf16* Bw = (const bf16*)(ws + WS_WPG) + (size_t)ia * DM * DM; FPle f{ws, ss_buf(ws, 1 + 2 * ia), ss_buf(ws, 2 + 2 * ia), (const bf16*)(ws + WS_PRJ)};
                   GEMM_FUSED(FPle, f, Aa, Bw, DM, DM); PMARK(1, wave_u); thin_sample<8, FPle>(lds, Aa, Bw, DM, f, wave_u); PMARK(2, wave_u); } PH_END
        PH_BEGIN { const bf16* Aa = (const bf16*)(ws + WS_HBA); const bf16* Bw = (const bf16*)(ws + WS_WSIN) + (size_t)l * 4096 * DM; FSsmIn f{ws, ss_buf(ws, 2 * is), nullptr};
                   GEMM_FUSED(FSsmIn, f, Aa, Bw, 4096, DM); thin_sample<8, FSsmIn>(lds, Aa, Bw, 4096, f, wave_u); } PH_END
        PH_BEGIN ph_scan(args, l, lds, wave_u); PH_END
        PH_BEGIN { const bf16* Aa = (const bf16*)(ws + WS_YB); const bf16* Bw = (const bf16*)(ws + WS_WGLU) + (size_t)l * DM * DM; FGlu f{ws, (const float*)args->in[I_BGLU] + (size_t)l * DM, nullptr, nullptr};
                   GEMM_FUSED(FGlu, f, Aa, Bw, DM, DM); thin_sample<8, FGlu>(lds, Aa, Bw, DM, f, wave_u); } PH_END
        PH_BEGIN { const bf16* Aa = (const bf16*)(ws + WS_AOB); const bf16* Bw = (const bf16*)(ws + WS_WSOUT) + (size_t)l * DM * DM; FResid f{ws, ss_buf(ws, 1 + 2 * is), nullptr};
                   GEMM_FUSED(FResid, f, Aa, Bw, DM, DM); thin_sample<8, FResid>(lds, Aa, Bw, DM, f, wave_u);
                   } PH_END
        PH_BEGIN { const bf16* Aa = (const bf16*)(ws + WS_HBB); const bf16* Bw = (const bf16*)(ws + WS_WPG) + (size_t)is * DM * DM; FPle f{ws, ss_buf(ws, 1 + 2 * is), ss_buf(ws, 2 + 2 * is), (const bf16*)(ws + WS_PRJ + PRJ_STRIDE)};
                   GEMM_FUSED(FPle, f, Aa, Bw, DM, DM); PMARK(1, wave_u); thin_sample<8, FPle>(lds, Aa, Bw, DM, f, wave_u); PMARK(2, wave_u); } PH_END
    lp = 1;
        PH_BEGIN { const bf16* Aa = (const bf16*)(ws + WS_HBA); const bf16* Bw = (const bf16*)(ws + WS_WAIN) + (size_t)l * ACOLS_PAD * DM; FAttnIn f{ws, args->out, ss_buf(ws, 2 * ia), l, nullptr};
                   GEMM_FUSED(FAttnIn, f, Aa, Bw, 6144, DM);
                   { const int wave = wave_u, lane = lane_id_fresh(); int tid = wave * 64 + lane; asm volatile("" : "+v"(tid));
                     for (int rb = blockIdx.x; rb < MP / 32; rb += gridDim.x) thin_tile<96, FAttnIn>(lds, Aa + (size_t)rb * 32 * DM, Bw + (size_t)6144 * DM, DM, rb * 32, 6144, f, tid, lane, wave); }
                   thin_sample<8, FAttnIn>(lds, Aa, Bw, ACOLS, f, wave_u); } PH_END
        PH_BEGIN ph_idx(args, l, lds, wave_u); ph_idx_sample(args, l, wave_u); PMARK(5, wave_u); PH_END
        PH_BEGIN ph_attn(args, lds, wave_u);
                   if ((int)blockIdx.x < MS * NKV || (int)gridDim.x < 2 * MS * NKV) ph_attn_sample(args, l, lds, wave_u);
                   if ((int)blockIdx.x >= MS * NKV || (int)gridDim.x < 2 * MS * NKV) {
                       const int wg0 = ((int)gridDim.x < 2 * MS * NKV) ? 0 : MS * NKV, nwg = (int)gridDim.x - wg0;
                       __syncthreads();
                       for (int q = 0; q < 2; ++q) { const int li = 2 * l + q; const bf16* Ap = (const bf16*)(ws + WS_PB + (size_t)li * PB_STRIDE); const bf16* Bp = (const bf16*)(ws + WS_WPP) + (size_t)li * DM * PLE;
                           FPleProj fp{ws, nullptr, nullptr, (bf16*)(ws + WS_PRJ + (size_t)q * PRJ_STRIDE)};
                           GEMM_FUSED_SUB(FPleProj, fp, Ap, Bp, DM, PLE, wg0, nwg); thin_sample<1, FPleProj>(lds, Ap, Bp, DM, fp, wave_u, wg0, nwg); } } PH_END
        PH_BEGIN { const bf16* Aa = (const bf16*)(ws + WS_AOB); const bf16* Bw = (const bf16*)(ws + WS_WAOUT) + (size_t)l * DM * DM; FResid f{ws, ss_buf(ws, 1 + 2 * ia), nullptr};
                   GEMM_FUSED(FResid, f, Aa, Bw, DM, DM); thin_sample<8, FResid>(lds, Aa, Bw, DM, f, wave_u);
                   } PH_END
        PH_BEGIN { const bf16* Aa = (const bf16*)(ws + WS_HBB); const bf16* Bw = (const bf16*)(ws + WS_WPG) + (size_t)ia * DM * DM; FPle f{ws, ss_buf(ws, 1 + 2 * ia), ss_buf(ws, 2 + 2 * ia), (const bf16*)(ws + WS_PRJ)};
                   GEMM_FUSED(FPle, f, Aa, Bw, DM, DM); PMARK(1, wave_u); thin_sample<8, FPle>(lds, Aa, Bw, DM, f, wave_u); PMARK(2, wave_u); } PH_END
        PH_BEGIN { const bf16* Aa = (const bf16*)(ws + WS_HBA); const bf16* Bw = (const bf16*)(ws + WS_WSIN) + (size_t)l * 4096 * DM; FSsmIn f{ws, ss_buf(ws, 2 * is), nullptr};
                   GEMM_FUSED(FSsmIn, f, Aa, Bw, 4096, DM); thin_sample<8, FSsmIn>(lds, Aa, Bw, 4096, f, wave_u); } PH_END
        PH_BEGIN ph_scan(args, l, lds, wave_u); PH_END
        PH_BEGIN { const bf16* Aa = (const bf16*)(ws + WS_YB); const bf16* Bw = (const bf16*)(ws + WS_WGLU) + (size_t)l * DM * DM; FGlu f{ws, (const float*)args->in[I_BGLU] + (size_t)l * DM, nullptr, nullptr};
                   GEMM_FUSED(FGlu, f, Aa, Bw, DM, DM); thin_sample<8, FGlu>(lds, Aa, Bw, DM, f, wave_u); } PH_END
        PH_BEGIN { const bf16* Aa = (const bf16*)(ws + WS_AOB); const bf16* Bw = (const bf16*)(ws + WS_WSOUT) + (size_t)l * DM * DM; FResid f{ws, ss_buf(ws, 1 + 2 * is), nullptr};
                   GEMM_FUSED(FResid, f, Aa, Bw, DM, DM); thin_sample<8, FResid>(lds, Aa, Bw, DM, f, wave_u);
                   } PH_END
        PH_BEGIN { const bf16* Aa = (const bf16*)(ws + WS_HBB); const bf16* Bw = (const bf16*)(ws + WS_WPG) + (size_t)is * DM * DM; FPle f{ws, ss_buf(ws, 1 + 2 * is), ss_buf(ws, 2 + 2 * is), (const bf16*)(ws + WS_PRJ + PRJ_STRIDE)};
                   GEMM_FUSED(FPle, f, Aa, Bw, DM, DM); PMARK(1, wave_u); thin_sample<8, FPle>(lds, Aa, Bw, DM, f, wave_u); PMARK(2, wave_u); } PH_END
    PH_BEGIN ph_final(args, wave_u); PH_LAST
#if PROF
    if (blockIdx.x == 0 && wave_u == 0) { const unsigned accA = MISC[18], accB = MISC[19]; const unsigned qa = min(99u, accA / (100u * PROF_UNIT_US)), qb = min(99u, accB / (100u * PROF_UNIT_US));
        const unsigned long long t_end = __builtin_amdgcn_s_memrealtime() + (unsigned long long)(qa * 20u + qb * 2000u) * 100ull;
        while (__builtin_amdgcn_s_memrealtime() < t_end) __builtin_amdgcn_s_sleep(32); }
#endif
}
constexpr int N_PHASES = 1 + 2 * 24 + 2;

#ifndef MK_PER_PHASE
#define MK_PER_PHASE 0
#endif
extern "C" void kernel_launch(void* const* d_in, const int* in_sizes, int n_in, void* d_out, int out_size, void* d_ws, size_t ws_size, hipStream_t stream) {
    static int grid = 0;
    if (grid == 0) {
        if (n_in != N_IN || out_size != (int)O_END || ws_size < WS_END) { fprintf(stderr, "kernel_launch: unexpected shapes: n_in %d out %d ws %zu (need %zu)\n", n_in, out_size, ws_size, (size_t)WS_END); grid = -1; return; }
        int dev = 0, cus = 0, per_cu = 0;
        if (hipGetDevice(&dev) != hipSuccess || hipDeviceGetAttribute(&cus, hipDeviceAttributeMultiprocessorCount, dev) != hipSuccess) { grid = -1; return; }
        if (hipFuncSetAttribute((const void*)fwd_kernel, hipFuncAttributeMaxDynamicSharedMemorySize, LDS_BYTES) != hipSuccess) { fprintf(stderr, "kernel_launch: hipFuncSetAttribute failed\n"); grid = -1; return; }
        if (hipOccupancyMaxActiveBlocksPerMultiprocessor(&per_cu, (const void*)fwd_kernel, NTHR, LDS_BYTES) != hipSuccess || per_cu < 1) fprintf(stderr, "kernel_launch: occupancy query reports %d\n", per_cu);
        (void)hipGetLastError();
        grid = cus;
    }
    if (grid < 0) return;
    if (hipMemsetAsync((char*)d_ws + WS_CTL, 0, CTL_ZERO_BYTES, stream) != hipSuccess) return;
    Args a{};
    for (int i = 0; i < N_IN; ++i) a.in[i] = d_in[i];
    a.out = (float*)d_out; a.ws = (unsigned char*)d_ws;
    a.ph_lo = 0; a.ph_hi = N_PHASES;
    hipLaunchKernelGGL(fwd_kernel, dim3(grid), dim3(NTHR), LDS_BYTES, stream, a);
    const hipError_t le = hipPeekAtLastError();
    if (le != hipSuccess) fprintf(stderr, "kernel_launch: launch failed: %s\n", hipGetErrorName(le));
}
```

```cpp
#include <hip/hip_runtime.h>
#include <cstdio>
#include <cstdint>
#ifndef PROF
#define PROF 0
#endif
#define PROF_UNIT_US 8u
#define PROF_MATCH_A(id) (false)
#define PROF_MATCH_B(id) (false)

__device__ __forceinline__ int lane_id_fresh();
namespace pg8 {
#define PG8_LAS __attribute__((address_space(3)))
typedef unsigned short bf16_t;
typedef short bf16x8 __attribute__((ext_vector_type(8)));
typedef float f32x4 __attribute__((ext_vector_type(4)));
typedef unsigned u32x4 __attribute__((ext_vector_type(4)));
constexpr int BM = 256, BK = 64, HALF = 128, HTB = HALF * BK * 2, STAGE_BYTES = 8 * HTB, NXCD = 8, WGM = 8;

__host__ __device__ __forceinline__ int lds_byte(int r, int c) { const int st = (r >> 4) * 2 + (c >> 5), rr = r & 15, cc = c & 31, ob = rr * 64 + cc * 2; return st * 1024 + (ob ^ (((ob >> 9) & 1) << 5)); }
__host__ __device__ __forceinline__ void stage_rc(int b, int& R, int& C) { const int st = b / 1024, sb = b % 1024, swz = sb ^ (((sb >> 9) & 1) << 5); R = (st >> 1) * 16 + swz / 64; C = (st & 1) * 32 + (swz % 64) / 2; }

struct Unit { int pm, pn; };
struct Gemm { const bf16_t* A; const bf16_t* Bt; int M, N, K; };

struct StaticOrder {
    int nM, nN, nwg, G, c;
    __host__ __device__ void init(int M, int N, int G_, int c_) { nM = M / BM; nN = N / BM; nwg = nM * nN; G = G_; c = c_; }
    __host__ __device__ bool next(int i, Unit& u) const {
        const long L = (long)i * G + c; if (L >= nwg) return false;
        int wgid = (int)L; { const int q = nwg / NXCD, r = nwg % NXCD, xcd = wgid % NXCD, off = wgid / NXCD; wgid = (xcd < r ? xcd * (q + 1) : r * (q + 1) + (xcd - r) * q) + off; }
        const int nig = WGM * nN, gid = wgid / nig, fm = gid * WGM, gsz = (nM - fm) < WGM ? (nM - fm) : WGM;
        u.pm = fm + ((wgid % nig) % gsz); u.pn = (wgid % nig) / gsz; return true;
    }
    __device__ __forceinline__ void a_ready(const Unit&) const {}
    __device__ __forceinline__ void done(const Unit&) const {}
};

struct EpiF32 {
    float* C; int ldc;
    __device__ __forceinline__ void operator()(const f32x4 (&acc)[2][2][4][2], const Unit& u, int wr, int wc, int fr, int fq) const {
        const int row0 = u.pm * BM + wr * 64 + fr, col0 = u.pn * BM + wc * 32 + 4 * fq;
#pragma unroll
        for (int ai = 0; ai < 2; ++ai)
#pragma unroll
            for (int m = 0; m < 4; ++m) { float* rowp = C + (size_t)(row0 + ai * HALF + m * 16) * ldc + col0;
#pragma unroll
                for (int bj = 0; bj < 2; ++bj)
#pragma unroll
                    for (int n = 0; n < 2; ++n) *(f32x4*)(rowp + bj * HALF + n * 16) = acc[ai][bj][m][n]; }
    }
};

template <class Epi, class Sched, bool ALIGN_EPI = false, bool SP2 = false>
__device__ __forceinline__ void gemm_phase(PG8_LAS unsigned char* lds, const Gemm g, const Sched& S, const Epi& E, int wv) {
    int tid = threadIdx.x; (void)wv; asm volatile("" : "+v"(tid)); __builtin_assume(tid >= 0); __builtin_assume(tid < 512);
    int tidg = tid;
    const int wid = __builtin_amdgcn_readfirstlane(tid >> 6), lane = tid & 63, wr = wid >> 2, wc = wid & 3, fr = lane & 15, fq = lane >> 4;
    const int K = g.K, nt = K / BK;
    unsigned voffA[2], voffB[2];
#pragma unroll
    for (int i = 0; i < 2; ++i) { int R, C; stage_rc(tidg * 16 + i * 8192, R, C); const int Rb = R;
        voffA[i] = (unsigned)(R * K + C) * 2u; voffB[i] = (unsigned)(Rb * K + C) * 2u; }
    const size_t kstep = (size_t)(BK * 2);
    const size_t hstep = (size_t)HALF * K * 2;
    const size_t tstep = 2 * hstep;
    const unsigned ldsw = (unsigned)wid * 1024u;
    const int aoff = lds_byte(wr * 64 + fr, fq * 8), boff = lds_byte(wc * 32 + fr, fq * 8);
#define PG8_SA(b, h) (((b) * 2 + (h)) * HTB)
#define PG8_SB(b, h) ((4 + (b) * 2 + (h)) * HTB)
#define PG8_STAGE(bufoff, gbase, voff) do { _Pragma("unroll") for (int _i = 0; _i < 2; ++_i) \
        __builtin_amdgcn_global_load_lds((const unsigned*)((const char*)(gbase) + (voff)[_i]), (PG8_LAS unsigned*)(lds + (bufoff) + ldsw + _i * 8192), 16, 0, 0); } while (0)
#define PG8_LDA(dst, b, h) do { _Pragma("unroll") for (int m = 0; m < 4; ++m) _Pragma("unroll") for (int k = 0; k < 2; ++k) dst[m][k] = *(const PG8_LAS bf16x8*)(lds + PG8_SA(b, h) + aoff + m * 2048 + k * 1024); } while (0)
#define PG8_LDB(dst, b, h) do { _Pragma("unroll") for (int n = 0; n < 2; ++n) _Pragma("unroll") for (int k = 0; k < 2; ++k) dst[n][k] = *(const PG8_LAS bf16x8*)(lds + PG8_SB(b, h) + boff + n * 2048 + k * 1024); } while (0)
#define PG8_MMA(ai, bj, At, Bt) do { __builtin_amdgcn_s_setprio(1); _Pragma("unroll") for (int m = 0; m < 4; ++m) _Pragma("unroll") for (int n = 0; n < 2; ++n) _Pragma("unroll") for (int k = 0; k < 2; ++k) \
        acc[ai][bj][m][n] = __builtin_amdgcn_mfma_f32_16x16x32_bf16(Bt[n][k], At[m][k], acc[ai][bj][m][n], 0, 0, 0); __builtin_amdgcn_s_setprio(0); } while (0)
#define PG8_WAIT_V(n) asm volatile("s_waitcnt vmcnt(" #n ")" ::: "memory")
#define PG8_WAIT_L(n) asm volatile("s_waitcnt lgkmcnt(" #n ")" ::: "memory")
#define PG8_BAR __builtin_amdgcn_s_barrier()
#define PG8_SCHED __builtin_amdgcn_sched_barrier(0)
    Unit cur, nxt; int ui = 0;
    if (!S.next(0, cur)) return;
    f32x4 acc[2][2][4][2];
#pragma unroll
    for (int a = 0; a < 2; ++a)
#pragma unroll
        for (int b = 0; b < 2; ++b)
#pragma unroll
            for (int m = 0; m < 4; ++m)
#pragma unroll
                for (int n = 0; n < 2; ++n) acc[a][b][m][n] = (f32x4){0.f, 0.f, 0.f, 0.f};
    bf16x8 At[4][2], B0[2][2], B1[2][2];
    const char* cA = (const char*)g.A + (size_t)cur.pm * tstep; const char* cB = (const char*)g.Bt + (size_t)cur.pn * tstep;
    S.a_ready(cur);
    if constexpr (SP2) {
        PG8_STAGE(PG8_SB(0, 0), cB, voffB); PG8_STAGE(PG8_SB(0, 1), cB + hstep, voffB); PG8_STAGE(PG8_SA(0, 0), cA, voffA); PG8_STAGE(PG8_SA(0, 1), cA + hstep, voffA);
        if (wr == 1) PG8_BAR;
        PG8_WAIT_V(2); PG8_BAR;
        PG8_STAGE(PG8_SB(1, 0), cB + kstep, voffB); PG8_STAGE(PG8_SA(1, 0), cA + kstep, voffA); PG8_STAGE(PG8_SB(1, 1), cB + hstep + kstep, voffB);
        PG8_WAIT_V(6); PG8_BAR;
    } else {
        PG8_STAGE(PG8_SB(0, 0), cB, voffB); PG8_STAGE(PG8_SA(0, 0), cA, voffA); PG8_STAGE(PG8_SB(0, 1), cB + hstep, voffB); PG8_STAGE(PG8_SA(0, 1), cA + hstep, voffA);
        if (wr == 1) PG8_BAR;
        PG8_WAIT_V(4); PG8_BAR;
        PG8_STAGE(PG8_SB(1, 0), cB + kstep, voffB); PG8_STAGE(PG8_SA(1, 0), cA + kstep, voffA); PG8_STAGE(PG8_SB(1, 1), cB + hstep + kstep, voffB);
        PG8_WAIT_V(6); PG8_BAR;
    }
    for (;;) {
        const bool has_next = S.next(ui + 1, nxt);
        const char* nA = has_next ? (const char*)g.A + (size_t)nxt.pm * tstep : cA; const char* nB = has_next ? (const char*)g.Bt + (size_t)nxt.pn * tstep : cB;
        for (int t = 0; t < nt; t += 2) {
            const bool last = (t == nt - 2);
            const char* a1 = cA + (size_t)(t + 1) * kstep;
            const char* a2 = last ? nA : cA + (size_t)(t + 2) * kstep; const char* b2 = last ? nB : cB + (size_t)(t + 2) * kstep;
            const char* a3 = a2 + kstep; const char* b3 = b2 + kstep;
            if (last && has_next) S.a_ready(nxt);
            if constexpr (SP2) {
            PG8_LDB(B0, 0, 0); PG8_LDB(B1, 0, 1); PG8_SCHED; PG8_LDA(At, 0, 0); PG8_STAGE(PG8_SA(1, 1), a1 + hstep, voffA);
            PG8_WAIT_V(8); PG8_WAIT_L(0); PG8_BAR; PG8_MMA(0, 0, At, B0); PG8_MMA(0, 1, At, B1); PG8_BAR; PG8_SCHED;
            PG8_LDA(At, 0, 1); PG8_STAGE(PG8_SB(0, 0), b2, voffB); PG8_STAGE(PG8_SB(0, 1), b2 + hstep, voffB); PG8_STAGE(PG8_SA(0, 0), a2, voffA);
            PG8_WAIT_V(8); PG8_WAIT_L(0); PG8_BAR; PG8_MMA(1, 0, At, B0); PG8_MMA(1, 1, At, B1); PG8_BAR; PG8_SCHED;
            PG8_LDB(B0, 1, 0); PG8_LDB(B1, 1, 1); PG8_SCHED; PG8_LDA(At, 1, 0); PG8_STAGE(PG8_SA(0, 1), a2 + hstep, voffA);
            PG8_WAIT_V(8); PG8_WAIT_L(0); PG8_BAR; PG8_MMA(0, 0, At, B0); PG8_MMA(0, 1, At, B1); PG8_BAR; PG8_SCHED;
            PG8_LDA(At, 1, 1); PG8_STAGE(PG8_SB(1, 0), b3, voffB); PG8_STAGE(PG8_SB(1, 1), b3 + hstep, voffB); PG8_STAGE(PG8_SA(1, 0), a3, voffA);
            PG8_WAIT_V(8); PG8_WAIT_L(0); PG8_BAR; PG8_MMA(1, 0, At, B0); PG8_MMA(1, 1, At, B1); PG8_BAR; PG8_SCHED;
            } else {
            PG8_LDB(B0, 0, 0); PG8_SCHED; PG8_LDA(At, 0, 0); PG8_STAGE(PG8_SA(1, 1), a1 + hstep, voffA);
            PG8_WAIT_L(8); PG8_BAR; PG8_WAIT_L(0); PG8_MMA(0, 0, At, B0); PG8_BAR; PG8_SCHED;
            PG8_LDB(B1, 0, 1); PG8_STAGE(PG8_SB(0, 0), b2, voffB);
            PG8_BAR; PG8_WAIT_L(0); PG8_MMA(0, 1, At, B1); PG8_BAR;
            PG8_LDA(At, 0, 1); PG8_STAGE(PG8_SA(0, 0), a2, voffA);
            PG8_BAR; PG8_WAIT_L(0); PG8_MMA(1, 0, At, B0); PG8_BAR; PG8_SCHED;
            PG8_STAGE(PG8_SB(0, 1), b2 + hstep, voffB);
            PG8_WAIT_V(6); PG8_BAR; PG8_MMA(1, 1, At, B1); PG8_BAR;
            PG8_LDB(B0, 1, 0); PG8_SCHED; PG8_LDA(At, 1, 0); PG8_STAGE(PG8_SA(0, 1), a2 + hstep, voffA);
            PG8_WAIT_L(8); PG8_BAR; PG8_WAIT_L(0); PG8_MMA(0, 0, At, B0); PG8_BAR; PG8_SCHED;
            PG8_LDB(B1, 1, 1); PG8_STAGE(PG8_SB(1, 0), b3, voffB);
            PG8_BAR; PG8_WAIT_L(0); PG8_MMA(0, 1, At, B1); PG8_BAR;
            PG8_LDA(At, 1, 1); PG8_STAGE(PG8_SA(1, 0), a3, voffA);
            PG8_BAR; PG8_WAIT_L(0); PG8_MMA(1, 0, At, B0); PG8_BAR; PG8_SCHED;
            PG8_STAGE(PG8_SB(1, 1), b3 + hstep, voffB);
            PG8_WAIT_V(6); PG8_BAR; PG8_MMA(1, 1, At, B1); PG8_BAR;
            }
        }
        if constexpr (ALIGN_EPI) { if (wr == 0) PG8_BAR; }
        E(acc, cur, wr, wc, tidg & 15, (tidg >> 4) & 3); S.done(cur);
        if (!has_next) break;
#pragma unroll
        for (int a = 0; a < 2; ++a)
#pragma unroll
            for (int b = 0; b < 2; ++b)
#pragma unroll
                for (int m = 0; m < 4; ++m)
#pragma unroll
                    for (int n = 0; n < 2; ++n) acc[a][b][m][n] = (f32x4){0.f, 0.f, 0.f, 0.f};
        cur = nxt; cA = nA; cB = nB; ++ui;
        if constexpr (ALIGN_EPI) { if (wr == 1) PG8_BAR; }
    }
    PG8_WAIT_V(0);
    if constexpr (!ALIGN_EPI) { if (wr == 0) PG8_BAR; }
    PG8_BAR;
#undef PG8_SA
#undef PG8_SB
#undef PG8_STAGE
#undef PG8_LDA
#undef PG8_LDB
#undef PG8_MMA
#undef PG8_WAIT_V
#undef PG8_WAIT_L
#undef PG8_BAR
#undef PG8_SCHED
}
}

constexpr int NWAVES = 8, NTHR = NWAVES * 64;
constexpr int DM = 2048, NBATCH = 2, SEQ = 4096, DEPTH = 4, DBATCH = 8, DSEQ = 4, PAST = 16384, PAGE = 128;
constexpr int NPAGES = PAST / PAGE, NPOOL = 1280, NAL = 2, NSL = 2;
constexpr int NH = 16, NKV = 4, HD = 128, KVG = 4, NIH = 16, IDD = 64, TOPK = 256;
constexpr int ACOLS = 6224, ACOLS_PAD = 6400;
constexpr int C_Q = 0, C_K = 2048, C_V = 2560, C_G = 3072, C_QI = 5120, C_KI = 6144, C_WI = 6208;
constexpr int SGRP = 16, NGRP = 128, SST = 64, PLE = 256;
constexpr int MP = NBATCH * SEQ, MS = DBATCH * DSEQ, MR = MP + MS, MPAD = 8448;
constexpr float RMS_EPS = 1e-6f;
constexpr float LOG2E = 1.4426950408889634f;
constexpr float QSCALE = 0.088388347648318440f * LOG2E;
constexpr float WISCALE = 0.25f * 0.125f;
enum { I_XP = 0, I_XS, I_CK, I_CV, I_CKI, I_SRE, I_SIM, I_PT, I_PP, I_PS, I_NW, I_FNW, I_RB, I_AWI, I_AWO, I_SWI, I_LRE, I_LIM, I_LDT, I_BRE, I_BIM, I_CRE, I_CIM, I_SD, I_WGLU, I_BGLU, I_SWO, I_PNW, I_PWG, I_PWP, N_IN };
constexpr size_t O_YP = 0, O_YS = O_YP + (size_t)MP * DM, O_KP = O_YS + (size_t)MS * DM, O_VP = O_KP + (size_t)NAL * MP * 512, O_KIP = O_VP + (size_t)NAL * MP * 512,
    O_SRP = O_KIP + (size_t)NAL * MP * 64, O_SIP = O_SRP + (size_t)NSL * NBATCH * NGRP * SST, O_KS = O_SIP + (size_t)NSL * NBATCH * NGRP * SST, O_VS = O_KS + (size_t)NAL * MS * 512,
    O_KIS = O_VS + (size_t)NAL * MS * 512, O_SRS = O_KIS + (size_t)NAL * MS * 64, O_SIS = O_SRS + (size_t)NSL * DBATCH * NGRP * SST, O_END = O_SIS + (size_t)NSL * DBATCH * NGRP * SST;
static_assert(O_END == 35065856, "output size");

constexpr size_t MiB = 1u << 20;
constexpr size_t WS_CTL = 0, CTL_ZERO_BYTES = 64 * 1024;
constexpr size_t WS_WAIN = 2 * MiB;
constexpr size_t WS_WAOUT = WS_WAIN + 50 * MiB;
constexpr size_t WS_WSIN = WS_WAOUT + 16 * MiB;
constexpr size_t WS_WGLU = WS_WSIN + 32 * MiB;
constexpr size_t WS_WSOUT = WS_WGLU + 16 * MiB;
constexpr size_t WS_WPG = WS_WSOUT + 16 * MiB;
constexpr size_t WS_WPP = WS_WPG + 32 * MiB;
constexpr size_t WS_H = WS_WPP + 4 * MiB;
constexpr size_t WS_HBA = WS_H + 66 * MiB, WS_HBB = WS_HBA + 33 * MiB;
constexpr size_t WS_PB = WS_HBB + 33 * MiB;
constexpr size_t PB_STRIDE = (size_t)MPAD * PLE * 2;
constexpr size_t WS_QB = WS_PB + 17 * MiB;
constexpr size_t WS_KB = WS_QB + 33 * MiB, WS_VB = WS_KB + 9 * MiB;
constexpr size_t WS_GB = WS_VB + 9 * MiB;
constexpr size_t WS_QIB = WS_GB + 33 * MiB;
constexpr size_t WS_KIB = WS_QIB + 17 * MiB;
constexpr size_t WS_WI = WS_KIB + 2 * MiB;
constexpr size_t WS_AOB = WS_WI + 1 * MiB;
constexpr size_t WS_UG = WS_AOB + 33 * MiB;
constexpr size_t WS_US = WS_UG + 32 * MiB;
constexpr size_t WS_YB = WS_US + 1 * MiB;
constexpr size_t WS_RSTD = WS_YB + 33 * MiB;
constexpr size_t WS_C = WS_RSTD + 1 * MiB;
constexpr size_t WS_C2 = WS_C + 207 * MiB;
constexpr size_t WS_SC = WS_C2 + 66 * MiB;
constexpr int SC_LD = SEQ + 64;
constexpr size_t WS_SCS = WS_SC + 130 * MiB;
constexpr int SCS_LD = 16400;
constexpr size_t WS_SEL = WS_SCS + 3 * MiB;
constexpr size_t WS_KM = WS_SEL + 9 * MiB;
constexpr size_t WS_END = WS_KM + 4 * MiB;
constexpr int CW_BAR = 4096;

constexpr int LDS_BYTES = 147456;
constexpr int MISC_OFF = 131072 + 320;

#define GAS __attribute__((address_space(1)))
#define LAS __attribute__((address_space(3)))
typedef unsigned short bf16;
typedef unsigned v4u __attribute__((ext_vector_type(4)));
typedef unsigned v2u __attribute__((ext_vector_type(2)));
typedef float f32x4 __attribute__((ext_vector_type(4)));
#define LDS_WAIT() asm volatile("s_waitcnt lgkmcnt(0)" ::: "memory")
__device__ __forceinline__ int lane_id_fresh() { unsigned ones = ~0u; asm volatile("" : "+s"(ones)); return (int)__builtin_amdgcn_mbcnt_hi(ones, __builtin_amdgcn_mbcnt_lo(ones, 0u)); }
__device__ __forceinline__ unsigned pk2(float lo, float hi) { unsigned r; asm("v_cvt_pk_bf16_f32 %0, %1, %2" : "=v"(r) : "v"(lo), "v"(hi)); return r; }
__device__ __forceinline__ unsigned f2bf(float f) { return pk2(f, 0.f) & 0xffffu; }
__device__ __forceinline__ float bf2f(unsigned short b) { return __builtin_bit_cast(float, ((unsigned)b) << 16); }
__device__ __forceinline__ float bflo(unsigned w) { return __builtin_bit_cast(float, w << 16); }
__device__ __forceinline__ float bfhi(unsigned w) { return __builtin_bit_cast(float, w & 0xffff0000u); }
__device__ __forceinline__ float sigmoidf_(float x) { return __builtin_amdgcn_rcpf(1.0f + __expf(-x)); }
__device__ __forceinline__ float siluf_(float x) { return x * sigmoidf_(x); }
__device__ __forceinline__ float gelu_tanh(float x) { const float u = 0.7978845608028654f * (x + 0.044715f * x * x * x); return x * sigmoidf_(2.0f * u); }
__device__ __forceinline__ float wave_sum(float v) {
#pragma unroll
    for (int o = 1; o < 64; o <<= 1) v += __shfl_xor(v, o);
    return v;
}
__device__ __forceinline__ float* ss_buf(unsigned char* ws, int k);
__device__ __forceinline__ float ss2rstd(float ss);
__device__ __forceinline__ float ss_row_rstd(const float* ssp, int r);
__device__ __forceinline__ int t5_bucket(int n) {
    if (n < 16) return n;
    int b = 16;
    b += (n >= 19) + (n >= 21) + (n >= 24) + (n >= 27) + (n >= 31) + (n >= 35) + (n >= 40) + (n >= 46) + (n >= 52) + (n >= 59) + (n >= 67) + (n >= 77) + (n >= 87) + (n >= 99) + (n >= 113);
    return b;
}

#define XB_TMO      128
#define XB_XCNT(j)  (256  + 64 * (j))
#define XB_XSUB(j)  (1280 + 64 * (j))
#define XB_XGEN(j)  (2304 + 64 * (j))
#define XB_TOP      3328
#define XB_TOPGEN   3392
#define XCD_BAR_WORDS 3456
#define XB_SPIN_CAP (1u << 22)
__device__ __forceinline__ unsigned xb_ld(unsigned* p)              { return __hip_atomic_load(p, __ATOMIC_RELAXED, __HIP_MEMORY_SCOPE_AGENT); }
__device__ __forceinline__ unsigned xb_add(unsigned* p, unsigned v) { return __hip_atomic_fetch_add(p, v, __ATOMIC_RELAXED, __HIP_MEMORY_SCOPE_AGENT); }
__device__ __forceinline__ unsigned xb_xcc_id() { return (unsigned)__builtin_amdgcn_s_getreg((3 << 11) | 20) & 0xFu; }
#define XB_SPIN(cond, bar) do { unsigned _sp = 0; while (cond) { __builtin_amdgcn_s_sleep(1); \
    if ((++_sp & 255u) == 0u) { if (xb_ld(&(bar)[XB_TMO])) break; if (_sp > XB_SPIN_CAP) { atomicAdd(&(bar)[XB_TMO], 1u); break; } } } } while (0)
struct XcdBarrier { unsigned* bar; unsigned x; volatile LAS unsigned* st; };
__device__ __forceinline__ XcdBarrier xcd_barrier_post(unsigned* bar, volatile LAS unsigned* st, int wv) {
    XcdBarrier b; b.bar = bar; b.x = xb_xcc_id(); b.st = st;
    if (wv == 0 && lane_id_fresh() == 0) (void)xb_add(&bar[XB_XCNT(b.x)], 1u);
    return b;
}
__device__ __forceinline__ void xcd_barrier_complete(unsigned* bar, unsigned x, unsigned& nloc, unsigned& nx) {
    const unsigned G = gridDim.x * gridDim.y * gridDim.z;
    unsigned sum, cnt, mine, sp = 0u;
    for (;;) {
        sum = 0u; cnt = 0u; mine = 0u;
#pragma unroll
        for (unsigned j = 0; j < 16; ++j) { const unsigned c = xb_ld(&bar[XB_XCNT(j)]); sum += c; cnt += (c > 0u) ? 1u : 0u; mine = (j == x) ? c : mine; }
        if (sum == G) break;
        __builtin_amdgcn_s_sleep(1);
        if ((++sp & 255u) == 0u) { if (xb_ld(&bar[XB_TMO])) break; if (sp > XB_SPIN_CAP) { atomicAdd(&bar[XB_TMO], 1u); break; } }
    }
    nloc = mine > 0u ? mine : 1u; nx = cnt > 0u ? cnt : 1u;
}
__device__ __forceinline__ void xcd_barrier(const XcdBarrier& b, int wv) {
    asm volatile("s_waitcnt vmcnt(0)" ::: "memory");
    __syncthreads();
    if (wv == 0 && lane_id_fresh() == 0) {
        unsigned* bar = b.bar;
        __builtin_amdgcn_s_waitcnt(0);
        unsigned nloc = b.st[0], nx = b.st[1];
        if (nloc == 0u) { xcd_barrier_complete(bar, b.x, nloc, nx); b.st[0] = nloc; b.st[1] = nx; }
        const unsigned old = xb_add(&bar[XB_XSUB(b.x)], 1u);
        const unsigned gen = old / nloc;
        if (old + 1u == (gen + 1u) * nloc) {
            __builtin_amdgcn_fence(__ATOMIC_RELEASE, "agent");
            asm volatile("s_waitcnt vmcnt(0)" ::: "memory");
            const unsigned og = xb_add(&bar[XB_TOP], 1u);
            const unsigned tg = og / nx;
            if (og + 1u == (tg + 1u) * nx) xb_add(&bar[XB_TOPGEN], 1u);
            else XB_SPIN(xb_ld(&bar[XB_TOPGEN]) == tg, bar);
            __builtin_amdgcn_fence(__ATOMIC_ACQUIRE, "agent");
            xb_add(&bar[XB_XGEN(b.x)], 1u);
            asm volatile("s_waitcnt vmcnt(0)" ::: "memory");
        } else {
            XB_SPIN(xb_ld(&bar[XB_XGEN(b.x)]) == gen, bar);
            __builtin_amdgcn_fence(__ATOMIC_ACQUIRE, "agent");
            asm volatile("s_waitcnt vmcnt(0)" ::: "memory");
        }
    }
    __syncthreads();
}

#if PROF
__device__ __forceinline__ void prof_mark(int id, int wave) {
    extern __shared__ __attribute__((aligned(16))) unsigned char lds_raw[];
    if (blockIdx.x == 0 && wave == 0) { volatile LAS unsigned* M = (volatile LAS unsigned*)((LAS unsigned char*)lds_raw + MISC_OFF);
        const unsigned long long tn = __builtin_amdgcn_s_memrealtime(); const unsigned long long tp = ((unsigned long long)M[17] << 32) | M[16]; const unsigned d = (unsigned)(tn - tp);
        if (PROF_MATCH_A(id)) M[18] = M[18] + d; if (PROF_MATCH_B(id)) M[19] = M[19] + d; M[16] = (unsigned)tn; M[17] = (unsigned)(tn >> 32); }
}
#define PMARK(id, wave) prof_mark(id, wave)
#else
#define PMARK(id, wave) do {} while (0)
#endif
struct Args { const void* in[N_IN]; float* out; unsigned char* ws; int ph_lo, ph_hi; };
typedef const __attribute__((address_space(4))) Args* ArgP;
#define TID_LOCAL() ArgP a = a_; asm volatile("" : "+s"(a)); const int wave = wv_; const int lane = lane_id_fresh(); int tid = wave * 64 + lane; asm volatile("" : "+v"(tid)); const int gw = blockIdx.x * NWAVES + wave, NGW = gridDim.x * NWAVES; (void)lane; (void)wave; (void)gw; (void)NGW
#define GTID_LOCAL() const size_t gtid = (size_t)blockIdx.x * NTHR + tid, GT = (size_t)gridDim.x * NTHR

__device__ __forceinline__ void transpose_item(const float* W, int K, int N, const float* scale, bf16* WT, LAS float* scr, int item, int lane) {
    const int nblk = (N + 31) / 32, kb = item / nblk, nb = item % nblk, k0 = 64 * kb, n0 = 32 * nb;
    const int n = n0 + (lane & 31); const float* wp = W + (size_t)(k0 + (lane >> 5)) * N + n;
    float v[32];
#pragma unroll
    for (int i = 0; i < 32; ++i) v[i] = (n < N) ? wp[(size_t)(2 * i) * N] : 0.f;
#pragma unroll
    for (int i = 0; i < 32; ++i) scr[(2 * i + (lane >> 5)) * 33 + (lane & 31)] = v[i];
    LDS_WAIT(); asm volatile("" ::: "memory");
    const int c = lane & 7;
    f32x4 s0 = {1.f, 1.f, 1.f, 1.f}, s1 = {1.f, 1.f, 1.f, 1.f};
    if (scale) { s0 = *(const f32x4*)(scale + k0 + 8 * c); s1 = *(const f32x4*)(scale + k0 + 8 * c + 4); }
#pragma unroll
    for (int j = 0; j < 4; ++j) { const int nn = (lane >> 3) + 8 * j; const LAS float* s = scr + (8 * c) * 33 + nn;
        v4u o; o.x = pk2(s[0 * 33] * s0[0], s[1 * 33] * s0[1]); o.y = pk2(s[2 * 33] * s0[2], s[3 * 33] * s0[3]); o.z = pk2(s[4 * 33] * s1[0], s[5 * 33] * s1[1]); o.w = pk2(s[6 * 33] * s1[2], s[7 * 33] * s1[3]);
        *(v4u*)(WT + (size_t)(n0 + nn) * K + k0 + 8 * c) = o; }
    LDS_WAIT(); asm volatile("" ::: "memory");
}

__device__ __forceinline__ void ph_prologue(ArgP a_, LAS unsigned char* lds, int wv_) {
    TID_LOCAL();
    LAS float* scr = (LAS float*)(lds + wave * 16384);
    unsigned char* ws = a->ws;
    for (int m = 0; m < 18; ++m) {
        const float* W; int K = DM, N = DM; const float* sc = nullptr; bf16* WT;
        if (m < 2)       { W = (const float*)a->in[I_AWI] + (size_t)m * DM * ACOLS; N = ACOLS; sc = (const float*)a->in[I_NW] + (size_t)(2 * m) * DM; WT = (bf16*)(ws + WS_WAIN) + (size_t)m * ACOLS_PAD * DM; }
        else if (m < 4)  { const int l = m - 2; W = (const float*)a->in[I_AWO] + (size_t)l * DM * DM; WT = (bf16*)(ws + WS_WAOUT) + (size_t)l * DM * DM; }
        else if (m < 6)  { const int l = m - 4; W = (const float*)a->in[I_SWI] + (size_t)l * DM * 4096; N = 4096; sc = (const float*)a->in[I_NW] + (size_t)(2 * l + 1) * DM; WT = (bf16*)(ws + WS_WSIN) + (size_t)l * 4096 * DM; }
        else if (m < 8)  { const int l = m - 6; W = (const float*)a->in[I_WGLU] + (size_t)l * DM * DM; WT = (bf16*)(ws + WS_WGLU) + (size_t)l * DM * DM; }
        else if (m < 10) { const int l = m - 8; W = (const float*)a->in[I_SWO] + (size_t)l * DM * DM; WT = (bf16*)(ws + WS_WSOUT) + (size_t)l * DM * DM; }
        else if (m < 14) { const int i = m - 10; W = (const float*)a->in[I_PWG] + (size_t)i * DM * DM; sc = (const float*)a->in[I_PNW] + (size_t)i * DM; WT = (bf16*)(ws + WS_WPG) + (size_t)i * DM * DM; }
        else             { const int i = m - 14; W = (const float*)a->in[I_PWP] + (size_t)i * PLE * DM; K = PLE; WT = (bf16*)(ws + WS_WPP) + (size_t)i * DM * PLE; }
        const int nitems = (K / 64) * ((N + 31) / 32);
        for (int it = gw; it < nitems; it += NGW) transpose_item(W, K, N, sc, WT, scr, it, lane);
    }
    bf16* Hb = (bf16*)(ws + WS_HBA);
    for (int r = gw; r < MR; r += NGW) {
        const float* src = (r < MP) ? (const float*)a->in[I_XP] + (size_t)r * DM : (const float*)a->in[I_XS] + (size_t)(r - MP) * DM;
        float ssq = 0.f;
#pragma unroll
        for (int j = 0; j < 8; ++j) { const int c = (j * 64 + lane) * 4; const f32x4 v = *(const f32x4*)(src + c); ssq += v[0] * v[0] + v[1] * v[1] + v[2] * v[2] + v[3] * v[3];
            v2u o; o.x = pk2(v[0], v[1]); o.y = pk2(v[2], v[3]); *(v2u*)(Hb + (size_t)r * DM + c) = o; }
        ssq = wave_sum(ssq);
        if (r < MP) { if (lane < 32) ss_buf(ws, 0)[(size_t)r * 32 + lane] = (lane == 0) ? ssq : 0.f; }
        else { float* sp = ss_buf(ws, 0) + (size_t)MPAD * 32 + (size_t)(r - MP) * 128; sp[lane] = (lane == 0) ? ssq : 0.f; sp[64 + lane] = 0.f; }
    }
    for (int q = gw; q < DEPTH * MR; q += NGW) { const int i = q / MR, r = q % MR;
        const float* src = (r < MP) ? (const float*)a->in[I_PP] + ((size_t)i * MP + r) * PLE : (const float*)a->in[I_PS] + ((size_t)i * MS + (r - MP)) * PLE;
        const f32x4 v = *(const f32x4*)(src + lane * 4); v2u o; o.x = pk2(v[0], v[1]); o.y = pk2(v[2], v[3]);
        *(v2u*)((bf16*)(ws + WS_PB + (size_t)i * PB_STRIDE) + (size_t)r * PLE + lane * 4) = o; }
}

__device__ __forceinline__ void ph_rowstat(ArgP a_, int wv_) {
    TID_LOCAL();
    const float* H = (const float*)(a->ws + WS_H); float* rstd = (float*)(a->ws + WS_RSTD);
    for (int r = gw; r < MR; r += NGW) { float s = 0.f;
#pragma unroll
        for (int j = 0; j < 8; ++j) { const f32x4 v = *(const f32x4*)(H + (size_t)r * DM + (j * 64 + lane) * 4); s += v[0] * v[0] + v[1] * v[1] + v[2] * v[2] + v[3] * v[3]; }
        s = wave_sum(s); if (lane == 0) rstd[r] = 1.0f / sqrtf(s * (1.0f / DM) + RMS_EPS); }
}

__device__ __forceinline__ void ph_epi_attn_in(ArgP a_, int l, int wv_) {
    TID_LOCAL(); GTID_LOCAL();
    unsigned char* ws = a->ws; const float* C = (const float*)(ws + WS_C); const float* rstd = (const float*)(ws + WS_RSTD);
    constexpr int NG4 = ACOLS / 4;
    for (size_t e = gtid; e < (size_t)MR * NG4; e += GT) { const int r = (int)(e / NG4), c = (int)(e % NG4) * 4;
        f32x4 v = *(const f32x4*)(C + (size_t)r * ACOLS_PAD + c); const float rs = rstd[r]; v = v * rs;
        if (c < C_K) { v = v * QSCALE; v2u o; o.x = pk2(v[0], v[1]); o.y = pk2(v[2], v[3]); *(v2u*)((bf16*)(ws + WS_QB) + (size_t)r * 2048 + c) = o; }
        else if (c < C_G) { const bool isv = c >= C_V; const int cc = c - (isv ? C_V : C_K);
            float* o32 = a->out + (r < MP ? (isv ? O_VP : O_KP) + ((size_t)l * MP + r) * 512 : (isv ? O_VS : O_KS) + ((size_t)l * MS + (r - MP)) * 512) + cc;
            *(f32x4*)o32 = v; v2u o; o.x = pk2(v[0], v[1]); o.y = pk2(v[2], v[3]); *(v2u*)((bf16*)(ws + (isv ? WS_VB : WS_KB)) + (size_t)r * 512 + cc) = o; }
        else if (c < C_QI) { v2u o; o.x = pk2(siluf_(v[0]), siluf_(v[1])); o.y = pk2(siluf_(v[2]), siluf_(v[3])); *(v2u*)((bf16*)(ws + WS_GB) + (size_t)r * 2048 + (c - C_G)) = o; }
        else if (c < C_KI) { v2u o; o.x = pk2(v[0], v[1]); o.y = pk2(v[2], v[3]); *(v2u*)((bf16*)(ws + WS_QIB) + (size_t)r * 1024 + (c - C_QI)) = o; }
        else if (c < C_WI) { const int cc = c - C_KI; float* o32 = a->out + (r < MP ? O_KIP + ((size_t)l * MP + r) * 64 : O_KIS + ((size_t)l * MS + (r - MP)) * 64) + cc;
            *(f32x4*)o32 = v; v2u o; o.x = pk2(v[0], v[1]); o.y = pk2(v[2], v[3]); *(v2u*)((bf16*)(ws + WS_KIB) + (size_t)r * 64 + cc) = o; }
        else { *(f32x4*)((float*)(ws + WS_WI) + (size_t)r * 16 + (c - C_WI)) = v * WISCALE; }
    }
}


typedef short bf16x8v __attribute__((ext_vector_type(8)));
__device__ __forceinline__ float relu_i(float x) { const int b = __builtin_bit_cast(int, x); return __builtin_bit_cast(float, b > 0 ? b : 0); }
__device__ __forceinline__ unsigned mono_key(float x) { const unsigned b = __builtin_bit_cast(unsigned, x); return b ^ ((unsigned)((int)b >> 31) | 0x80000000u); }
__device__ __forceinline__ int wave_sum_i(int v) {
#pragma unroll
    for (int o = 1; o < 64; o <<= 1) v += __shfl_xor(v, o);
    return v;
}
__device__ __forceinline__ int lane_prefix(unsigned long long m) { return (int)__builtin_amdgcn_mbcnt_hi((unsigned)(m >> 32), __builtin_amdgcn_mbcnt_lo((unsigned)m, 0u)); }
constexpr size_t KM_WORDS = (size_t)NBATCH * 128 * 64 * 32;

__device__ __forceinline__ int cnt_ge4(const v4u k, unsigned cand) { return __popcll(__ballot(k.x >= cand)) + __popcll(__ballot(k.y >= cand)) + __popcll(__ballot(k.z >= cand)) + __popcll(__ballot(k.w >= cand)); }
__device__ __forceinline__ void sel_load(const float* sc, int n, int lane, f32x4 (&v)[16]) {
#pragma unroll
    for (int ch = 0; ch < 16; ++ch) { const int i0 = ch * 256 + 4 * lane; f32x4 t = {0.f, 0.f, 0.f, 0.f}; if (ch * 256 < n) t = *(const f32x4*)(sc + i0); v[ch] = t; }
}
__device__ __forceinline__ void sel_store(const f32x4 (&v)[16], int n, int lane, LAS unsigned* ldsk) {
#pragma unroll
    for (int ch = 0; ch < 16; ++ch) { const int i0 = ch * 256 + 4 * lane;
        v4u k; k.x = (i0 < n) ? mono_key(v[ch][0]) : 0u; k.y = (i0 + 1 < n) ? mono_key(v[ch][1]) : 0u; k.z = (i0 + 2 < n) ? mono_key(v[ch][2]) : 0u; k.w = (i0 + 3 < n) ? mono_key(v[ch][3]) : 0u;
        *(LAS v4u*)(ldsk + i0) = k; }
}
__device__ __forceinline__ void select_core(int n, int lane, LAS unsigned* ldsk, LAS unsigned long long* mrow) {
    const int nc = (n + 255) >> 8, ne = (n + 63) >> 6, ng = (nc + 3) >> 2;
    unsigned T = 0u; int need = TOPK, toteq = 0;
    if (n > TOPK) {
        for (int bit = 31; bit >= 0; --bit) { const unsigned cand = T | (1u << bit); int c = 0;
            for (int g4 = 0; g4 < ng; ++g4) { const LAS v4u* p = (const LAS v4u*)(ldsk + g4 * 1024 + lane * 4); const v4u k0 = p[0], k1 = p[64], k2 = p[128], k3 = p[192];
                c += cnt_ge4(k0, cand) + cnt_ge4(k1, cand) + cnt_ge4(k2, cand) + cnt_ge4(k3, cand); }
            if (c >= TOPK) { T = cand; if (c == TOPK) break; } }
        int cg = 0, ce = 0;
        for (int ch = 0; ch < nc; ++ch) { const v4u k = *(const LAS v4u*)(ldsk + ch * 256 + lane * 4);
            cg += __popcll(__ballot(k.x > T)) + __popcll(__ballot(k.y > T)) + __popcll(__ballot(k.z > T)) + __popcll(__ballot(k.w > T));
            ce += __popcll(__ballot(k.x == T)) + __popcll(__ballot(k.y == T)) + __popcll(__ballot(k.z == T)) + __popcll(__ballot(k.w == T)); }
        need = TOPK - cg;
        toteq = ce;
    }
    const bool all_eq = (toteq <= need);
    int base_eq = 0;
    for (int e0 = 0; e0 < ne; e0 += 4) {
        unsigned kk[4];
#pragma unroll
        for (int u = 0; u < 4; ++u) kk[u] = ldsk[(e0 + u) * 64 + lane];
#pragma unroll
        for (int u = 0; u < 4; ++u) { const int e = e0 + u; const int idx = e * 64 + lane; const unsigned k = kk[u]; const bool valid = idx < n; bool s;
            if (n <= TOPK) s = valid;
            else if (all_eq) s = valid && k >= T;
            else { const bool eq = valid && k == T; const unsigned long long em = __ballot(eq); s = valid && (k > T || (eq && base_eq + lane_prefix(em) < need)); base_eq += __popcll(em); }
            const unsigned long long sm = __ballot(s);
            if (lane == 0 && e < ne) mrow[e * 16] = sm; }
    }
}

__device__ __forceinline__ void ph_idx(ArgP a_, int l, LAS unsigned char* lds, int wv_) {
    TID_LOCAL();
    unsigned char* ws = a->ws;
    const bf16* QIb = (const bf16*)(ws + WS_QIB); const bf16* KIb = (const bf16*)(ws + WS_KIB); const float* WI = (const float*)(ws + WS_WI);
    unsigned long long* KM = (unsigned long long*)(ws + WS_KM);
    for (int vb = blockIdx.x; vb < 256; vb += gridDim.x) {
        const int b = vb >> 7, x = vb & 127;
        int ln = lane; asm volatile("" : "+v"(ln)); const int fr = ln & 15, kg = ln >> 4, qi = fr & 7, hh = fr >> 3;
        LAS unsigned long long* msk = (LAS unsigned long long*)(lds + 132096);
        LAS unsigned* ldsk = (LAS unsigned*)(lds + wave * 16384);
        for (int rnd = 0; rnd < 4; ++rnd) {
            const int qt = (rnd & 2) ? 255 - x : x, qbase = qt * 16 + (rnd & 1) * 8;
            const int nrow = qbase + wave + 1;
            { const int ngk = ((((nrow + 255) >> 8) + 3) >> 2) * 1024; for (int i = (qt + 1) * 16 + lane * 4; i < ngk; i += 256) *(LAS v4u*)(ldsk + i) = (v4u){0u, 0u, 0u, 0u}; }
            const int tq = qbase + qi; const size_t qrow = (size_t)b * SEQ + tq;
            bf16x8v Bq[8][2]; float w[8];
#pragma unroll
            for (int it = 0; it < 8; ++it) { const int h = hh * 8 + it; Bq[it][0] = *(const bf16x8v*)(QIb + qrow * 1024 + h * 64 + kg * 8); Bq[it][1] = *(const bf16x8v*)(QIb + qrow * 1024 + h * 64 + 32 + kg * 8); w[it] = WI[qrow * 16 + h]; }
            const bf16* kbase = KIb + ((size_t)b * SEQ + fr) * 64 + kg * 8;
            bf16x8v A0 = {0, 0, 0, 0, 0, 0, 0, 0}, A1 = A0, N0 = A0, N1 = A0;
            if (wave <= qt) { A0 = *(const bf16x8v*)(kbase + (size_t)wave * 1024); A1 = *(const bf16x8v*)(kbase + (size_t)wave * 1024 + 32); }
            if (wave + NWAVES <= qt) { N0 = *(const bf16x8v*)(kbase + (size_t)(wave + NWAVES) * 1024); N1 = *(const bf16x8v*)(kbase + (size_t)(wave + NWAVES) * 1024 + 32); }
            LAS unsigned* rowp = (LAS unsigned*)(lds + qi * 16384) + kg * 4;
            for (int kt = wave; kt <= qt; kt += NWAVES) {
                bf16x8v M0 = N0, M1 = N1;
                if (kt + 2 * NWAVES <= qt) { M0 = *(const bf16x8v*)(kbase + (size_t)(kt + 2 * NWAVES) * 1024); M1 = *(const bf16x8v*)(kbase + (size_t)(kt + 2 * NWAVES) * 1024 + 32); }
                f32x4 S = {0.f, 0.f, 0.f, 0.f};
#pragma unroll
                for (int it = 0; it < 8; ++it) { f32x4 acc = {0.f, 0.f, 0.f, 0.f};
                    acc = __builtin_amdgcn_mfma_f32_16x16x32_bf16(A0, Bq[it][0], acc, 0, 0, 0); acc = __builtin_amdgcn_mfma_f32_16x16x32_bf16(A1, Bq[it][1], acc, 0, 0, 0);
#pragma unroll
                    for (int j = 0; j < 4; ++j) { const float a_ = acc[j]; S[j] += w[it] * relu_i(a_); } }
                v4u kk;
#pragma unroll
                for (int j = 0; j < 4; ++j) { const float o_ = S[j]; const float s_ = o_ + __builtin_bit_cast(float, __builtin_amdgcn_update_dpp(0, __builtin_bit_cast(int, o_), 0x108, 0xF, 0xF, true));
                    const unsigned key_ = (kt * 16 + kg * 4 + j <= tq) ? mono_key(s_) : 0u; if (j == 0) kk.x = key_; else if (j == 1) kk.y = key_; else if (j == 2) kk.z = key_; else kk.w = key_; }
                if (hh == 0) *(LAS v4u*)(rowp + kt * 16) = kk;
                A0 = N0; A1 = N1; N0 = M0; N1 = M1;
            }
            LDS_WAIT(); __syncthreads();
            select_core(nrow, lane, ldsk, msk + ((rnd & 2) ? ((x >> 2) + 1) * 16 : 0) + (rnd & 1) * 8 + wave);
            __syncthreads();
        }
        { const int ne0 = (x >> 2) + 1, ne1 = ((255 - x) >> 2) + 1;
          for (int i = tid; i < (ne0 + ne1) * 16; i += NTHR) { const int h2 = i >= ne0 * 16, ii = i - (h2 ? ne0 * 16 : 0), e = ii >> 4, tr = ii & 15; const int qt = h2 ? 255 - x : x;
              KM[(((size_t)b * 128 + (qt >> 1)) * 64 + e) * 32 + (qt & 1) * 16 + tr] = msk[i]; } }
        __syncthreads(); PMARK(4, wave);
    }
}


namespace att {
using bf16x8 = __attribute__((ext_vector_type(8))) short;
using s16x4  = __attribute__((ext_vector_type(4))) short;
using f32x16 = __attribute__((ext_vector_type(16))) float;
constexpr int KVBLK = 64;
constexpr int SHM_V = KVBLK * 128 * 2, SHM_K = KVBLK * 128 * 2;
constexpr float THR2 = 8.0f;
#define ATT_SDEPTH 1
#define ATT_KSWZ(row, colB) ((row) * 256 + ((colB) ^ (((row) & 7) << 4)))
#define ATT_SBAR() __builtin_amdgcn_sched_barrier(0)
__device__ __forceinline__ int crow(int r, int hi) { return (r & 3) + 8 * (r >> 2) + 4 * hi; }
__device__ __forceinline__ unsigned cvtpk(float lo, float hi) { unsigned r; asm volatile("v_cvt_pk_bf16_f32 %0, %1, %2" : "=v"(r) : "v"(lo), "v"(hi)); return r; }
__device__ __forceinline__ int v_st(int k, int c) { const int kk = (k & ~0xC) | ((k & 4) << 1) | ((k & 8) >> 1); return ((kk >> 3) * 4 + (c >> 5)) * 512 + ((kk & 7) * 32 + (c & 31)) * 2; }
__device__ __forceinline__ int v_rd_base(int lane) { return ((lane & 3) << 3) | (((lane >> 2) & 3) << 6) | (((lane >> 4) & 1) << 5) | (((lane >> 5) & 1) << 8); }
constexpr int v_rd_off(int d0, int ks, int half) { return d0 * 512 + ks * 4096 + half * 2048; }
template <int OFF> __device__ __forceinline__ s16x4 tr_read(int vb) { s16x4 r; asm volatile("ds_read_b64_tr_b16 %0, %1 offset:%2" : "=&v"(r) : "v"(vb), "i"(OFF) : "memory"); return r; }

__device__ __forceinline__ void partialSM(f32x16& p0, f32x16& p1, float& m_reg, float& mn, float& alpha) {
    float pmax = p0[0];
#pragma unroll
    for (int r = 1; r < 16; ++r) pmax = fmaxf(pmax, p0[r]);
#pragma unroll
    for (int r = 0; r < 16; ++r) pmax = fmaxf(pmax, p1[r]);
    { auto rr = __builtin_amdgcn_permlane32_swap(__builtin_bit_cast(unsigned, pmax), __builtin_bit_cast(unsigned, pmax), false, false);
      const unsigned u0 = rr[0], u1 = rr[1]; pmax = fmaxf(__builtin_bit_cast(float, u0), __builtin_bit_cast(float, u1)); }
    if (__builtin_expect(__all(pmax - m_reg <= THR2), 1)) { mn = m_reg; alpha = 1.f; }
    else { mn = fmaxf(m_reg, pmax); alpha = __builtin_amdgcn_exp2f(m_reg - mn); m_reg = mn; }
#pragma unroll
    for (int r = 0; r < 16; ++r) p0[r] = __builtin_amdgcn_exp2f(p0[r] - mn);
#pragma unroll
    for (int r = 0; r < 16; ++r) p1[r] = p1[r] - mn;
}
__device__ __forceinline__ void partialSMrel(f32x16& p0, f32x16& p1, float& m_reg, float& alpha) {
    float pmax = p0[0];
#pragma unroll
    for (int r = 1; r < 16; ++r) pmax = fmaxf(pmax, p0[r]);
#pragma unroll
    for (int r = 0; r < 16; ++r) pmax = fmaxf(pmax, p1[r]);
    { auto rr = __builtin_amdgcn_permlane32_swap(__builtin_bit_cast(unsigned, pmax), __builtin_bit_cast(unsigned, pmax), false, false);
      const unsigned u0 = rr[0], u1 = rr[1]; pmax = fmaxf(__builtin_bit_cast(float, u0), __builtin_bit_cast(float, u1)); }
    if (__builtin_expect(__all(pmax <= THR2), 1)) { alpha = 1.f; }
    else { const float d = fmaxf(pmax, 0.f); alpha = __builtin_amdgcn_exp2f(-d); m_reg += d;
#pragma unroll
        for (int r = 0; r < 16; ++r) { p0[r] -= d; p1[r] -= d; } }
#pragma unroll
    for (int r = 0; r < 16; ++r) p0[r] = __builtin_amdgcn_exp2f(p0[r]);
}
__device__ __forceinline__ void finishSM(f32x16& p0, f32x16& p1, float alpha, float& l_reg, unsigned long long mk, int hi, bf16x8& pa0, bf16x8& pa1, bf16x8& pa2, bf16x8& pa3) {
#pragma unroll
    for (int r = 0; r < 16; ++r) p1[r] = __builtin_amdgcn_exp2f(p1[r]);
    const unsigned w0 = (unsigned)mk >> (4 * hi), w1 = (unsigned)(mk >> 32) >> (4 * hi);
#pragma unroll
    for (int r = 0; r < 16; ++r) { const int pos = (r & 3) + 8 * (r >> 2);
        const float a0 = p0[r], a1 = p1[r];
        unsigned m0_, m1_; asm("v_bfe_i32 %0, %1, %2, 1" : "=v"(m0_) : "v"(w0), "n"(pos)); asm("v_bfe_i32 %0, %1, %2, 1" : "=v"(m1_) : "v"(w1), "n"(pos));
        p0[r] = __builtin_bit_cast(float, __builtin_bit_cast(unsigned, a0) & m0_);
        p1[r] = __builtin_bit_cast(float, __builtin_bit_cast(unsigned, a1) & m1_); }
    float ps = 0;
#pragma unroll
    for (int r = 0; r < 16; ++r) ps += p0[r];
#pragma unroll
    for (int r = 0; r < 16; ++r) ps += p1[r];
    { auto rr = __builtin_amdgcn_permlane32_swap(__builtin_bit_cast(unsigned, ps), __builtin_bit_cast(unsigned, ps), false, false);
      const unsigned u0 = rr[0], u1 = rr[1]; ps = __builtin_bit_cast(float, u0) + __builtin_bit_cast(float, u1); }
    l_reg = l_reg * alpha + ps;
#define ATT_PK4(P, BASE, OUT) do { unsigned a0 = cvtpk(P[BASE + 0], P[BASE + 1]), a1 = cvtpk(P[BASE + 2], P[BASE + 3]);   \
    unsigned b0 = cvtpk(P[BASE + 4], P[BASE + 5]), b1 = cvtpk(P[BASE + 6], P[BASE + 7]);                              \
    auto r0 = __builtin_amdgcn_permlane32_swap(a0, b0, false, false); auto r1 = __builtin_amdgcn_permlane32_swap(a1, b1, false, false); \
    v4u w = {r0[0], r1[0], r0[1], r1[1]}; OUT = __builtin_bit_cast(bf16x8, w); } while (0)
    ATT_PK4(p0, 0, pa0); ATT_PK4(p0, 8, pa1); ATT_PK4(p1, 0, pa2); ATT_PK4(p1, 8, pa3);
#undef ATT_PK4
}
__device__ __forceinline__ void qkt(f32x16& p0, f32x16& p1, LAS const char* Ks, const bf16x8* qr, int r32, int hi, float init) {
#pragma unroll
    for (int r = 0; r < 16; ++r) { p0[r] = init; p1[r] = init; }
    asm volatile("" : "+v"(r32), "+v"(hi));
#pragma unroll
    for (int d0 = 0; d0 < 8; ++d0) { const int cb = (d0 * 16 + hi * 8) * 2;
        const bf16x8 b0 = *(LAS const bf16x8*)(Ks + ATT_KSWZ(r32, cb));
        const bf16x8 b1 = *(LAS const bf16x8*)(Ks + ATT_KSWZ(32 + r32, cb));
        p0 = __builtin_amdgcn_mfma_f32_32x32x16_bf16(b0, qr[d0], p0, 0, 0, 0);
        p1 = __builtin_amdgcn_mfma_f32_32x32x16_bf16(b1, qr[d0], p1, 0, 0, 0); }
}
template <int D0> __device__ __forceinline__ void pv_one(f32x16& od, int vb, bf16x8 pa0, bf16x8 pa1, bf16x8 pa2, bf16x8 pa3) {
    const s16x4 l0 = tr_read<v_rd_off(D0, 0, 0)>(vb), h0 = tr_read<v_rd_off(D0, 0, 1)>(vb), l1 = tr_read<v_rd_off(D0, 1, 0)>(vb), h1 = tr_read<v_rd_off(D0, 1, 1)>(vb);
    const s16x4 l2 = tr_read<v_rd_off(D0, 2, 0)>(vb), h2 = tr_read<v_rd_off(D0, 2, 1)>(vb), l3 = tr_read<v_rd_off(D0, 3, 0)>(vb), h3 = tr_read<v_rd_off(D0, 3, 1)>(vb);
    asm volatile("s_waitcnt lgkmcnt(0)" ::: "memory"); ATT_SBAR();
#define ATT_PK(L, H) (bf16x8){L[0], L[1], L[2], L[3], H[0], H[1], H[2], H[3]}
    od = __builtin_amdgcn_mfma_f32_32x32x16_bf16(pa0, ATT_PK(l0, h0), od, 0, 0, 0);
    od = __builtin_amdgcn_mfma_f32_32x32x16_bf16(pa1, ATT_PK(l1, h1), od, 0, 0, 0);
    od = __builtin_amdgcn_mfma_f32_32x32x16_bf16(pa2, ATT_PK(l2, h2), od, 0, 0, 0);
    od = __builtin_amdgcn_mfma_f32_32x32x16_bf16(pa3, ATT_PK(l3, h3), od, 0, 0, 0);
#undef ATT_PK
}
__device__ __forceinline__ void pv_d0(f32x16* o, int vb, bf16x8 pa0, bf16x8 pa1, bf16x8 pa2, bf16x8 pa3) {
    pv_one<0>(o[0], vb, pa0, pa1, pa2, pa3); pv_one<1>(o[1], vb, pa0, pa1, pa2, pa3); pv_one<2>(o[2], vb, pa0, pa1, pa2, pa3); pv_one<3>(o[3], vb, pa0, pa1, pa2, pa3);
}
__device__ __forceinline__ void add_bias(f32x16& p0, f32x16& p1, LAS const float* bt2, int dq) {
    LAS const float* p = bt2 + (255 - dq);
#pragma unroll
    for (int r = 0; r < 16; ++r) { const int c = (r & 3) + 8 * (r >> 2); p0[r] += p[c]; p1[r] += p[c + 32]; }
}
}

__device__ __forceinline__ void ph_attn(ArgP a_, LAS unsigned char* ldsb, int wv_) {
    using namespace att;
    TID_LOCAL();
    unsigned char* ws = a->ws;
    const bf16* Qb = (const bf16*)(ws + WS_QB); const bf16* Kb = (const bf16*)(ws + WS_KB); const bf16* Vb = (const bf16*)(ws + WS_VB); const bf16* Gb = (const bf16*)(ws + WS_GB);
    bf16* AOb = (bf16*)(ws + WS_AOB); const unsigned long long* KM = (const unsigned long long*)(ws + WS_KM); const float* rb = (const float*)a->in[I_RB];
    LAS char* lds = (LAS char*)ldsb; LAS char* V_lds = lds; LAS char* K_lds = lds + 2 * SHM_V;
    LAS float* wsf = (LAS float*)(lds + 65536) + wave * 64; LAS float* li_l = wsf; LAS float* al_l = wsf + 32;
    LAS float* btab = (LAS float*)(lds + 65536 + 2048);
    const int r32 = lane & 31, hi = lane >> 5, rh = wave & 3, qs = wave >> 2;
    const int sr = tid >> 4, sc = (tid & 15) * 8, vst0 = v_st(sr, sc), kst0 = ATT_KSWZ(sr, sc * 2);
    const int vb0 = (int)(unsigned)(size_t)V_lds + v_rd_base(lane);
    constexpr int LDK = 512;
    for (int vbk = blockIdx.x; vbk < 256; vbk += gridDim.x) {
        const int b = vbk >> 7, g = (vbk >> 5) & 3, x = vbk & 31, h = g * 4 + rh;
        __syncthreads();
        for (int i = tid; i < 4 * 384; i += NTHR) { const int rr = i / 384, d = 255 - (i % 384), hh = g * 4 + rr; btab[i] = (d >= 0 && d < 113) ? (rb[t5_bucket(d) * NH + hh] - rb[31 * NH + hh]) * LOG2E : 0.f; }
        const bf16* Kh = Kb + (size_t)b * SEQ * LDK + g * HD; const bf16* Vh = Vb + (size_t)b * SEQ * LDK + g * HD;
        for (int half = 0; half < 2; ++half) {
            const int jb = half ? 63 - x : x; const int q0w = jb * 64 + qs * 32; const size_t qrow = (size_t)b * SEQ + q0w + r32;
            const int NT = jb + 1, NTp = (NT + 1) & ~1;
            LAS const float* bt = btab + rh * 384;
            float m_reg = -1e30f, l_reg = 0; f32x16 o[4] = {}; bf16x8 qr[8];
            int lq = lane; asm volatile("" : "+v"(lq));
            const bf16* Qw = Qb + ((size_t)b * SEQ + q0w + (lq & 31)) * 2048 + h * HD + (lq >> 5) * 8;
#pragma unroll
            for (int d0 = 0; d0 < 8; ++d0) qr[d0] = *(const bf16x8*)(Qw + d0 * 16);
            struct { bf16x8 vs0, vs1, ks0, ks1; } sr_[ATT_SDEPTH];
            const unsigned toff = (unsigned)(sr * LDK + sc) * 2u;
#define ATT_SLOAD(i, k0) do { const char* vt_ = (const char*)Vh + (size_t)(k0) * (LDK * 2); const char* kt_ = (const char*)Kh + (size_t)(k0) * (LDK * 2); \
    sr_[i].vs0 = *(const bf16x8*)(vt_ + toff); sr_[i].vs1 = *(const bf16x8*)(vt_ + 32 * LDK * 2 + toff); sr_[i].ks0 = *(const bf16x8*)(kt_ + toff); sr_[i].ks1 = *(const bf16x8*)(kt_ + 32 * LDK * 2 + toff); } while (0)
#define ATT_SWRITE(bb, i) do { *(LAS bf16x8*)(V_lds + (bb) * SHM_V + vst0) = sr_[i].vs0; *(LAS bf16x8*)(V_lds + (bb) * SHM_V + vst0 + 8192) = sr_[i].vs1; \
    *(LAS bf16x8*)(K_lds + (bb) * SHM_K + kst0) = sr_[i].ks0; *(LAS bf16x8*)(K_lds + (bb) * SHM_K + kst0 + 8192) = sr_[i].ks1; } while (0)
#define ATT_SWAIT() do { if (ATT_SDEPTH == 2) asm volatile("s_waitcnt vmcnt(4)" ::: "memory"); else asm volatile("s_waitcnt vmcnt(0)" ::: "memory"); } while (0)
#define ATT_RESC(al) do { if (__any((al) < 1.f)) { if (hi == 0) al_l[r32] = (al); asm volatile("s_waitcnt lgkmcnt(0)" ::: "memory"); \
    _Pragma("unroll") for (int d = 0; d < 4; ++d) _Pragma("unroll") for (int r = 0; r < 16; ++r) o[d][r] *= al_l[crow(r, hi)]; } } while (0)
#define ATT_MASK(kt) (((kt) <= jb) ? ((LAS const unsigned long long*)(lds + 73728))[(qs * 64 + (kt)) * 32 + (lane_id_fresh() & 31)] : 0ull)
#define ATT_BIAS(P0, P1, kt) do { if (64 * (kt) + 176 > q0w) { const int le_ = lane_id_fresh(); add_bias(P0, P1, bt, q0w + (le_ & 31) - 4 * (le_ >> 5) - 64 * (kt)); } } while (0)
            f32x16 pA0, pA1, pB0, pB1; float mnA, mnB, alA, alB; bf16x8 pa0, pa1, pa2, pa3;
            constexpr int SE = 0, SO = ATT_SDEPTH - 1;
            __syncthreads();
            { LAS unsigned long long* mks = (LAS unsigned long long*)(lds + 73728);
              const unsigned long long* kg0 = KM + (((size_t)b * 128 + 2 * jb) * 64) * 32; const int nw = (jb + 1) * 32;
              for (int i = wave * 64 + lane_id_fresh(); i < 2 * nw; i += NTHR) { const int q2 = (i >= nw) ? 1 : 0, j2 = i - q2 * nw; mks[q2 * 2048 + j2] = kg0[(size_t)q2 * 2048 + j2]; } }
            ATT_SLOAD(SE, 0); asm volatile("s_waitcnt vmcnt(0)" ::: "memory"); ATT_SWRITE(0, SE); __syncthreads();
            qkt(pA0, pA1, K_lds, qr, r32, hi, 0.f); ATT_BIAS(pA0, pA1, 0); partialSM(pA0, pA1, m_reg, mnA, alA);
            ATT_SLOAD(SO, KVBLK); if (ATT_SDEPTH == 2 && 2 < NTp) ATT_SLOAD(SE, 2 * KVBLK);
            ATT_SWAIT(); ATT_SWRITE(1, SO); __syncthreads();
            for (int j = 1; j + 1 < NTp; j += 2) {
                ATT_SBAR(); qkt(pB0, pB1, K_lds + SHM_K, qr, r32, hi, -m_reg); ATT_BIAS(pB0, pB1, j);
                finishSM(pA0, pA1, alA, l_reg, ATT_MASK(j - 1), hi, pa0, pa1, pa2, pa3); ATT_SBAR();
                ATT_SLOAD(SO, (j + ATT_SDEPTH) * KVBLK); ATT_SBAR();
                pv_d0(o, vb0, pa0, pa1, pa2, pa3); partialSMrel(pB0, pB1, m_reg, alB);
                __syncthreads(); ATT_SWAIT(); ATT_SWRITE(0, SE);
                ATT_RESC(alB); __syncthreads();
                ATT_SBAR(); qkt(pA0, pA1, K_lds, qr, r32, hi, -m_reg); ATT_BIAS(pA0, pA1, j + 1);
                finishSM(pB0, pB1, alB, l_reg, ATT_MASK(j), hi, pa0, pa1, pa2, pa3); ATT_SBAR();
                if (ATT_SDEPTH == 1 || j + 3 < NTp) ATT_SLOAD(SE, (j + 1 + ATT_SDEPTH) * KVBLK); ATT_SBAR();
                pv_d0(o, vb0 + SHM_V, pa0, pa1, pa2, pa3); partialSMrel(pA0, pA1, m_reg, alA);
                __syncthreads(); ATT_SWAIT(); ATT_SWRITE(1, SO);
                ATT_RESC(alA); __syncthreads();
            }
            ATT_SBAR(); qkt(pB0, pB1, K_lds + SHM_K, qr, r32, hi, -m_reg); ATT_BIAS(pB0, pB1, NTp - 1);
            finishSM(pA0, pA1, alA, l_reg, ATT_MASK(NTp - 2), hi, pa0, pa1, pa2, pa3); ATT_SBAR();
            pv_d0(o, vb0, pa0, pa1, pa2, pa3); partialSMrel(pB0, pB1, m_reg, alB);
            __syncthreads(); ATT_RESC(alB);
            finishSM(pB0, pB1, alB, l_reg, ATT_MASK(NTp - 1), hi, pa0, pa1, pa2, pa3); ATT_SBAR();
            pv_d0(o, vb0 + SHM_V, pa0, pa1, pa2, pa3);
            if (hi == 0) li_l[r32] = l_reg; asm volatile("s_waitcnt lgkmcnt(0)" ::: "memory");
            int lane_e = lane; asm volatile("" : "+v"(lane_e)); const int r32e = lane_e & 31, hie = lane_e >> 5;
#pragma unroll
            for (int r = 0; r < 16; ++r) { const int orow = crow(r, hie); const float rli = __builtin_amdgcn_rcpf(li_l[orow]);
                const size_t ob = ((size_t)b * SEQ + q0w + orow) * 2048 + h * HD + r32e;
#pragma unroll
                for (int d0 = 0; d0 < 4; ++d0) AOb[ob + d0 * 32] = (bf16)f2bf(o[d0][r] * rli * bf2f(Gb[ob + d0 * 32]));
                asm volatile("" ::: "memory"); ATT_SBAR(); }
#undef ATT_SLOAD
#undef ATT_SWRITE
#undef ATT_SWAIT
#undef ATT_RESC
#undef ATT_MASK
#undef ATT_BIAS
        }
    }
}


__device__ __forceinline__ void ph_idx_sample(ArgP a_, int l, int wv_) {
    TID_LOCAL();
    unsigned char* ws = a->ws;
    const bf16* QIb = (const bf16*)(ws + WS_QIB); const bf16* KIb = (const bf16*)(ws + WS_KIB); const float* WI = (const float*)(ws + WS_WI); float* SCS = (float*)(ws + WS_SCS);
    const int* pt = (const int*)a->in[I_PT]; const float* cki = (const float*)a->in[I_CKI] + (size_t)l * NPOOL * PAGE * IDD;
    const int fr = lane & 15, kg = lane >> 4; constexpr int TPB = PAST / 16 + 1, NT = DBATCH * TPB, TPW = 5;
    for (int c0 = gw * TPW; c0 < NT; c0 += NGW * TPW) {
        int curb = -1; bf16x8v Bq[16][2]; float w[16];
        const int cend = (c0 + TPW < NT) ? c0 + TPW : NT;
        f32x4 x0, x1, y0, y1;
        int pg[TPW];
#pragma unroll
        for (int j = 0; j < TPW; ++j) { const int g_ = c0 + j; const int b_ = g_ / TPB, kt_ = g_ % TPB; pg[j] = (g_ < NT && kt_ < PAST / 16) ? pt[b_ * NPAGES + ((kt_ * 16 + fr) >> 7)] : 0; }
#define IDXS_FETCH(gt_) do { const int kt_ = (gt_) % TPB; if (kt_ < PAST / 16) { const int key_ = kt_ * 16 + fr; const int jj_ = (gt_) - c0; \
            const int pgv_ = (jj_ == 0) ? pg[0] : (jj_ == 1) ? pg[1] : (jj_ == 2) ? pg[2] : (jj_ == 3) ? pg[3] : pg[4]; \
            const float* kp_ = cki + ((size_t)pgv_ * PAGE + (key_ & 127)) * IDD + kg * 8; x0 = *(const f32x4*)kp_; x1 = *(const f32x4*)(kp_ + 4); y0 = *(const f32x4*)(kp_ + 32); y1 = *(const f32x4*)(kp_ + 36); } } while (0)
        IDXS_FETCH(c0);
        for (int gt = c0; gt < cend; ++gt) { const int b = gt / TPB, kt = gt % TPB;
            if (b != curb) { curb = b; const size_t qrow = (size_t)MP + b * DSEQ + (fr < DSEQ ? fr : DSEQ - 1);
#pragma unroll
                for (int h = 0; h < 16; ++h) { Bq[h][0] = *(const bf16x8v*)(QIb + qrow * 1024 + h * 64 + kg * 8); Bq[h][1] = *(const bf16x8v*)(QIb + qrow * 1024 + h * 64 + 32 + kg * 8); w[h] = WI[qrow * 16 + h]; } }
            bf16x8v A0, A1;
            if (kt < PAST / 16) { v4u u0, u1; u0.x = pk2(x0[0], x0[1]); u0.y = pk2(x0[2], x0[3]); u0.z = pk2(x1[0], x1[1]); u0.w = pk2(x1[2], x1[3]); u1.x = pk2(y0[0], y0[1]); u1.y = pk2(y0[2], y0[3]); u1.z = pk2(y1[0], y1[1]); u1.w = pk2(y1[2], y1[3]);
                A0 = __builtin_bit_cast(bf16x8v, u0); A1 = __builtin_bit_cast(bf16x8v, u1); }
            else { const bf16* kp = KIb + ((size_t)MP + b * DSEQ + (fr < DSEQ ? fr : DSEQ - 1)) * 64 + kg * 8; A0 = *(const bf16x8v*)kp; A1 = *(const bf16x8v*)(kp + 32); }
            if (gt + 1 < cend) IDXS_FETCH(gt + 1);
            f32x4 S = {0.f, 0.f, 0.f, 0.f};
#pragma unroll
            for (int h = 0; h < 16; ++h) { f32x4 acc = {0.f, 0.f, 0.f, 0.f};
                acc = __builtin_amdgcn_mfma_f32_16x16x32_bf16(A0, Bq[h][0], acc, 0, 0, 0); acc = __builtin_amdgcn_mfma_f32_16x16x32_bf16(A1, Bq[h][1], acc, 0, 0, 0);
#pragma unroll
                for (int j = 0; j < 4; ++j) { const float a_ = acc[j]; S[j] += w[h] * relu_i(a_); } }
            if (fr < DSEQ) *(f32x4*)(SCS + (size_t)(b * DSEQ + fr) * SCS_LD + kt * 16 + kg * 4) = S;
        }
#undef IDXS_FETCH
    }
}
__device__ __forceinline__ void select_block(const float* sc, int n, LAS unsigned* ldsk, LAS int* ldsw, LAS int* sel, int tid, int lane, int wave) {
    const int nc = (n + 2047) >> 11;
    __syncthreads();
    for (int i = tid; i < nc * 2048; i += NTHR) ldsk[i] = (i < n) ? mono_key(sc[i]) : 0u;
    if (tid == 0) ldsw[32] = 0;
    __syncthreads();
    unsigned T = 0u;
    for (int bit = 31; bit >= 0; --bit) { const unsigned cand = T | (1u << bit); int c = 0;
        for (int ch = 0; ch < nc; ++ch) { const v4u k = *(const LAS v4u*)(ldsk + ch * 2048 + tid * 4); c += (k.x >= cand) + (k.y >= cand) + (k.z >= cand) + (k.w >= cand); }
        c = wave_sum_i(c); LAS int* red = ldsw + (bit & 1) * 8; if (lane == 0) red[wave] = c;
        __syncthreads();
        const int tot = ((red[0] + red[1]) + (red[2] + red[3])) + ((red[4] + red[5]) + (red[6] + red[7]));
        if (tot >= TOPK) { T = cand; if (tot == TOPK) break; } }
    int cg = 0, ce = 0;
    for (int ch = 0; ch < nc; ++ch) { const v4u k = *(const LAS v4u*)(ldsk + ch * 2048 + tid * 4); cg += (k.x > T) + (k.y > T) + (k.z > T) + (k.w > T); ce += (k.x == T) + (k.y == T) + (k.z == T) + (k.w == T); }
    cg = wave_sum_i(cg); ce = wave_sum_i(ce);
    __syncthreads();
    if (lane == 0) { ldsw[16 + wave] = cg; ldsw[24 + wave] = ce; }
    __syncthreads();
    int tg = 0, te = 0;
#pragma unroll
    for (int i = 0; i < 8; ++i) { tg += ldsw[16 + i]; te += ldsw[24 + i]; }
    const int need = TOPK - tg; const bool all_eq = te <= need;
    for (int ch = 0; ch < nc; ++ch) { const v4u k4 = *(const LAS v4u*)(ldsk + ch * 2048 + tid * 4); const unsigned kk[4] = {k4.x, k4.y, k4.z, k4.w};
#pragma unroll
        for (int j = 0; j < 4; ++j) { const int idx = ch * 2048 + tid * 4 + j; const unsigned k = kk[j]; bool s = (idx < n) && k > T;
            if ((idx < n) && k == T) { if (all_eq) s = true; else { int rank = 0; for (int q = 0; q < idx; ++q) rank += (ldsk[q] == T) ? 1 : 0; s = rank < need; } }
            if (s) { const int pos = __hip_atomic_fetch_add(ldsw + 32, 1, __ATOMIC_RELAXED, __HIP_MEMORY_SCOPE_WORKGROUP); if (pos < TOPK) sel[pos] = idx; } } }
    __syncthreads();
}
__device__ __forceinline__ f32x4 ld_kvrow(const float* cache, const bf16* fresh, int off, int c) {
    if (off >= 0) return *(const f32x4*)(cache + (size_t)off + 4 * c);
    const v2u w = *(const v2u*)(fresh + (size_t)(-off - 1) + 4 * c); return (f32x4){bflo(w.x), bfhi(w.x), bflo(w.y), bfhi(w.y)};
}
__device__ __forceinline__ void ph_attn_sample(ArgP a_, int l, LAS unsigned char* ldsb, int wv_) {
    TID_LOCAL();
    unsigned char* ws = a->ws;
    const bf16* Qb = (const bf16*)(ws + WS_QB); const bf16* Kb = (const bf16*)(ws + WS_KB); const bf16* Vb = (const bf16*)(ws + WS_VB); const bf16* Gb = (const bf16*)(ws + WS_GB);
    bf16* AOb = (bf16*)(ws + WS_AOB); const int* pt = (const int*)a->in[I_PT]; const float* rb = (const float*)a->in[I_RB];
    const float* ck = (const float*)a->in[I_CK] + (size_t)l * NPOOL * PAGE * 512; const float* cv = (const float*)a->in[I_CV] + (size_t)l * NPOOL * PAGE * 512;
    LAS unsigned* ldsk = (LAS unsigned*)ldsb;
    LAS int* ldsw = (LAS int*)(ldsb + 81920); LAS int* sidx = (LAS int*)(ldsb + 81920 + 256); LAS int* koff = sidx + TOPK; LAS int* kbk = koff + TOPK;
    LAS float* qh = (LAS float*)ldsb; LAS float* lg = (LAS float*)(ldsb + 2048); LAS float* rs = (LAS float*)(ldsb + 2048 + 4096); LAS float* red = (LAS float*)(ldsb + 8192);
    const int par = lane >> 5, c = lane & 31;
    for (int it = blockIdx.x; it < MS * NKV; it += gridDim.x) {
        const int rr = it >> 2, g = it & 3; const int r = MP + rr, b = rr / DSEQ, t = rr % DSEQ, tpos = PAST + t;
        select_block((const float*)(ws + WS_SCS) + (size_t)rr * SCS_LD, tpos + 1, ldsk, ldsw, sidx, tid, lane, wave);
        if (tid < TOPK) { const int s = sidx[tid]; kbk[tid] = t5_bucket(tpos - s);
            koff[tid] = (s < PAST) ? (int)(((unsigned)pt[b * NPAGES + (s >> 7)] * PAGE + (s & 127)) * 512u + g * HD) : -(1 + (int)(((unsigned)MP + b * DSEQ + (s - PAST)) * 512u + g * HD)); }
        qh[tid] = bf2f(Qb[(size_t)r * 2048 + g * 512 + tid]);
        __syncthreads();
        { f32x4 q4[4];
#pragma unroll
          for (int h = 0; h < 4; ++h) q4[h] = *(LAS const f32x4*)(qh + h * HD + 4 * c);
          f32x4 kv[16];
#pragma unroll
          for (int i = 0; i < 16; ++i) kv[i] = ld_kvrow(ck, Kb, koff[wave * 32 + 2 * i + par], c);
#pragma unroll
          for (int i = 0; i < 16; ++i) { float d[4];
#pragma unroll
              for (int h = 0; h < 4; ++h) d[h] = kv[i][0] * q4[h][0] + kv[i][1] * q4[h][1] + kv[i][2] * q4[h][2] + kv[i][3] * q4[h][3];
#pragma unroll
              for (int o = 1; o < 32; o <<= 1) {
#pragma unroll
                  for (int h = 0; h < 4; ++h) d[h] += __shfl_xor(d[h], o); }
              const int k = wave * 32 + 2 * i + par;
              if (c < 4) { const float dd = (c == 0) ? d[0] : (c == 1) ? d[1] : (c == 2) ? d[2] : d[3]; lg[c * TOPK + k] = dd + rb[kbk[k] * NH + g * KVG + c] * LOG2E; } } }
        __syncthreads();
        if (wave < KVG) { LAS float* row = lg + wave * TOPK; float v[4]; float m = -3.0e38f;
#pragma unroll
            for (int j = 0; j < 4; ++j) { v[j] = row[lane + 64 * j]; m = fmaxf(m, v[j]); }
#pragma unroll
            for (int o = 1; o < 64; o <<= 1) m = fmaxf(m, __shfl_xor(m, o));
            float sm = 0.f;
#pragma unroll
            for (int j = 0; j < 4; ++j) { v[j] = exp2f(v[j] - m); sm += v[j]; row[lane + 64 * j] = v[j]; }
            sm = wave_sum(sm); if (lane == 0) rs[wave] = 1.0f / sm; }
        __syncthreads();
        { f32x4 vv[16];
#pragma unroll
          for (int i = 0; i < 16; ++i) vv[i] = ld_kvrow(cv, Vb, koff[wave * 32 + 2 * i + par], c);
          f32x4 o4[4] = {{0.f, 0.f, 0.f, 0.f}, {0.f, 0.f, 0.f, 0.f}, {0.f, 0.f, 0.f, 0.f}, {0.f, 0.f, 0.f, 0.f}};
#pragma unroll
          for (int i = 0; i < 16; ++i) { const int k = wave * 32 + 2 * i + par;
#pragma unroll
              for (int h = 0; h < 4; ++h) o4[h] += vv[i] * lg[h * TOPK + k]; }
#pragma unroll
          for (int h = 0; h < 4; ++h) *(LAS f32x4*)(red + ((wave * 2 + par) * 4 + h) * HD + 4 * c) = o4[h]; }
        __syncthreads();
        { float o = 0.f;
#pragma unroll
          for (int p = 0; p < 16; ++p) o += red[p * 4 * HD + tid];
          const size_t oi = (size_t)r * 2048 + g * 512 + tid;
          AOb[oi] = (bf16)f2bf(o * rs[tid >> 7] * bf2f(Gb[oi])); }
        __syncthreads();
    }
}

__device__ __forceinline__ void ph_epi_resid(ArgP a_, int wv_) {
    TID_LOCAL(); GTID_LOCAL();
    unsigned char* ws = a->ws; const float* C = (const float*)(ws + WS_C); float* H = (float*)(ws + WS_H); bf16* Hb = (bf16*)(ws + WS_HBB);
    for (size_t e = gtid; e < (size_t)MR * (DM / 4); e += GT) { const size_t o = e * 4; const f32x4 v = *(const f32x4*)(H + o) + *(const f32x4*)(C + o);
        *(f32x4*)(H + o) = v; v2u w; w.x = pk2(v[0], v[1]); w.y = pk2(v[2], v[3]); *(v2u*)(Hb + o) = w; }
}
__device__ __forceinline__ void ph_epi_ple(ArgP a_, int wv_) {
    TID_LOCAL(); GTID_LOCAL();
    unsigned char* ws = a->ws; const float* C = (const float*)(ws + WS_C); const float* C2 = (const float*)(ws + WS_C2); const float* rstd = (const float*)(ws + WS_RSTD);
    float* H = (float*)(ws + WS_H); bf16* Hb = (bf16*)(ws + WS_HBA);
    for (size_t e = gtid; e < (size_t)MR * (DM / 4); e += GT) { const size_t o = e * 4; const int r = (int)(e / (DM / 4)); const float rs = rstd[r];
        const f32x4 c = *(const f32x4*)(C + o), p = *(const f32x4*)(C2 + o); f32x4 v = *(const f32x4*)(H + o);
#pragma unroll
        for (int j = 0; j < 4; ++j) v[j] += sigmoidf_(c[j] * rs) * p[j];
        *(f32x4*)(H + o) = v; v2u w; w.x = pk2(v[0], v[1]); w.y = pk2(v[2], v[3]); *(v2u*)(Hb + o) = w; }
}
__device__ __forceinline__ void ph_epi_ssm_in(ArgP a_, int wv_) {
    TID_LOCAL(); GTID_LOCAL();
    unsigned char* ws = a->ws; const float* C = (const float*)(ws + WS_C); const float* rstd = (const float*)(ws + WS_RSTD);
    for (size_t e = gtid; e < (size_t)MR * 1024; e += GT) { const int r = (int)(e / 1024), c = (int)(e % 1024) * 4;
        f32x4 v = *(const f32x4*)(C + (size_t)r * 4096 + c); v = v * rstd[r];
        if (c < 2048) { v2u o; o.x = pk2(v[0], v[1]); o.y = pk2(v[2], v[3]);
            if (r < MP) { const int b = r / SEQ, t = r % SEQ, g = c / 16, j = c % 16; *(v2u*)((bf16*)(ws + WS_UG) + (((size_t)(b * NGRP + g) * SEQ + t) * 16 + j)) = o; }
            else *(v2u*)((bf16*)(ws + WS_US) + (size_t)(r - MP) * 2048 + c) = o; }
        else { v2u o; o.x = pk2(siluf_(v[0]), siluf_(v[1])); o.y = pk2(siluf_(v[2]), siluf_(v[3])); *(v2u*)((bf16*)(ws + WS_GB) + (size_t)r * 2048 + (c - 2048)) = o; }
    }
}
__device__ __forceinline__ void scan_item(ArgP a, int l, bool pr, int item, int lane) {
    unsigned char* ws = a->ws;
    const int b = item / NGRP, g = item % NGRP, n = lane;
    const size_t gn = ((size_t)l * NGRP + g) * SST + n;
    const float lre = fminf(((const float*)a->in[I_LRE])[gn], -1e-4f), lim = ((const float*)a->in[I_LIM])[gn];
    const float dt = expf(((const float*)a->in[I_LDT])[l * NGRP + g]);
    const float mag = expf(lre * dt), ang = lim * dt; const float are = mag * cosf(ang), aim = mag * sinf(ang);
    const float den = lre * lre + lim * lim; const float cre = ((are - 1.0f) * lre + aim * lim) / den, cim = (aim * lre - (are - 1.0f) * lim) / den;
    float bbr[16], bbi[16], ccr[16], cci[16];
#pragma unroll
    for (int j = 0; j < 16; ++j) { const float br = ((const float*)a->in[I_BRE])[gn * 16 + j], bi = ((const float*)a->in[I_BIM])[gn * 16 + j];
        bbr[j] = cre * br - cim * bi; bbi[j] = cre * bi + cim * br;
        const size_t ci = (((size_t)l * NGRP + g) * 16 + j) * SST + n; ccr[j] = ((const float*)a->in[I_CRE])[ci]; cci[j] = ((const float*)a->in[I_CIM])[ci]; }
    const float dj = ((const float*)a->in[I_SD])[(size_t)l * DM + g * 16 + (lane & 15)];
    float xr = 0.f, xi = 0.f;
    if (!pr) { const size_t si = (((size_t)l * DBATCH + b) * NGRP + g) * SST + n; xr = ((const float*)a->in[I_SRE])[si]; xi = ((const float*)a->in[I_SIM])[si]; }
    const int T = pr ? SEQ : DSEQ;
    const bf16* up = pr ? (const bf16*)(ws + WS_UG) + (size_t)(b * NGRP + g) * SEQ * 16 : (const bf16*)(ws + WS_US) + (size_t)(b * DSEQ) * 2048 + g * 16;
    const int ustride = pr ? 16 : 2048;
    bf16* Yb = (bf16*)(ws + WS_YB);
    for (int t = 0; t < T; ++t) {
        const v4u u0 = *(const v4u*)(up + (size_t)t * ustride), u1 = *(const v4u*)(up + (size_t)t * ustride + 8);
        const float u[16] = {bflo(u0.x), bfhi(u0.x), bflo(u0.y), bfhi(u0.y), bflo(u0.z), bfhi(u0.z), bflo(u0.w), bfhi(u0.w), bflo(u1.x), bfhi(u1.x), bflo(u1.y), bfhi(u1.y), bflo(u1.z), bfhi(u1.z), bflo(u1.w), bfhi(u1.w)};
        float br = 0.f, bi = 0.f;
#pragma unroll
        for (int j = 0; j < 16; ++j) { br += bbr[j] * u[j]; bi += bbi[j] * u[j]; }
        const float nr = are * xr - aim * xi + br, ni = are * xi + aim * xr + bi; xr = nr; xi = ni;
        float yj = 0.f, uj = 0.f;
#pragma unroll
        for (int j = 0; j < 16; ++j) { const float s = wave_sum(ccr[j] * xr - cci[j] * xi); if ((lane & 15) == j) { yj = s; uj = u[j]; } }
        if (lane < 16) { const float y = yj + dj * uj; const int row = pr ? b * SEQ + t : MP + b * DSEQ + t; Yb[(size_t)row * 2048 + g * 16 + lane] = (bf16)f2bf(gelu_tanh(y)); }
    }
    float* osr = a->out + (pr ? O_SRP + (((size_t)l * NBATCH + b) * NGRP + g) * SST : O_SRS + (((size_t)l * DBATCH + b) * NGRP + g) * SST);
    float* osi = a->out + (pr ? O_SIP + (((size_t)l * NBATCH + b) * NGRP + g) * SST : O_SIS + (((size_t)l * DBATCH + b) * NGRP + g) * SST);
    osr[n] = xr; osi[n] = xi;
}
__device__ __forceinline__ void ph_scan_naive(ArgP a_, int l, int wv_) {
    TID_LOCAL();
    for (int vb = blockIdx.x; vb < 256; vb += gridDim.x) {
        if (wave == 0) scan_item(a, l, true, vb, lane);
        else { const int item = vb * 7 + (wave - 1); if (item < DBATCH * NGRP) scan_item(a, l, false, item, lane); }
    }
}

namespace s5 {
using bf16x8 = __attribute__((ext_vector_type(8))) short;
using s16x4  = __attribute__((ext_vector_type(4))) short;
using f32x16 = __attribute__((ext_vector_type(16))) float;
constexpr int XSTR = 80;
constexpr int XT_BYTES = 128 * XSTR;
constexpr int E_OFF = 8 * XT_BYTES, H_OFF = E_OFF + 16 * 64 * 8;
__device__ __forceinline__ s16x4 tr_read(int addr) { s16x4 r; asm volatile("ds_read_b64_tr_b16 %0, %1" : "=&v"(r) : "v"(addr) : "memory"); return r; }
}
__device__ __forceinline__ void ph_scan(ArgP a_, int l, LAS unsigned char* ldsb, int wv_) {
    using namespace s5;
    TID_LOCAL();
    unsigned char* ws = a->ws;
    LAS char* lds = (LAS char*)ldsb;
    bf16* Yb = (bf16*)(ws + WS_YB);
    const int n0 = lane & 31, h2 = lane >> 5, fj = lane & 15, kg = lane >> 4;
    for (int vb = blockIdx.x; vb < NBATCH * NGRP; vb += gridDim.x) {
        const int b = vb >> 7, g = vb & 127;
        const size_t gbase = (size_t)l * NGRP + g;
        float ar[2], ai[2]; bf16x8 Bfr[2][2];
        const float dt = expf(((const float*)a->in[I_LDT])[gbase]);
#pragma unroll
        for (int nt = 0; nt < 2; ++nt) { const size_t gn = gbase * SST + n0 + 32 * nt;
            const float lre = fminf(((const float*)a->in[I_LRE])[gn], -1e-4f), lim = ((const float*)a->in[I_LIM])[gn];
            const float mag = expf(lre * dt), ang = lim * dt; const float are = mag * cosf(ang), aim = mag * sinf(ang);
            const float den = lre * lre + lim * lim; const float cre = ((are - 1.0f) * lre + aim * lim) / den, cim = (aim * lre - (are - 1.0f) * lim) / den;
            ar[nt] = are; ai[nt] = aim;
            const f32x4 br0 = *(const f32x4*)((const float*)a->in[I_BRE] + gn * 16 + 8 * h2), br1 = *(const f32x4*)((const float*)a->in[I_BRE] + gn * 16 + 8 * h2 + 4);
            const f32x4 bi0 = *(const f32x4*)((const float*)a->in[I_BIM] + gn * 16 + 8 * h2), bi1 = *(const f32x4*)((const float*)a->in[I_BIM] + gn * 16 + 8 * h2 + 4);
            v4u wr_, wi_;
            wr_.x = pk2(cre * br0[0] - cim * bi0[0], cre * br0[1] - cim * bi0[1]); wr_.y = pk2(cre * br0[2] - cim * bi0[2], cre * br0[3] - cim * bi0[3]);
            wr_.z = pk2(cre * br1[0] - cim * bi1[0], cre * br1[1] - cim * bi1[1]); wr_.w = pk2(cre * br1[2] - cim * bi1[2], cre * br1[3] - cim * bi1[3]);
            wi_.x = pk2(cre * bi0[0] + cim * br0[0], cre * bi0[1] + cim * br0[1]); wi_.y = pk2(cre * bi0[2] + cim * br0[2], cre * bi0[3] + cim * br0[3]);
            wi_.z = pk2(cre * bi1[0] + cim * br1[0], cre * bi1[1] + cim * br1[1]); wi_.w = pk2(cre * bi1[2] + cim * br1[2], cre * bi1[3] + cim * br1[3]);
            Bfr[nt][0] = __builtin_bit_cast(bf16x8, wr_); Bfr[nt][1] = __builtin_bit_cast(bf16x8, wi_); }
        bf16x8 Cf[4];
#pragma unroll
        for (int ks = 0; ks < 4; ++ks) { const float* srcp = (const float*)a->in[(ks >> 1) ? I_CIM : I_CRE] + (gbase * 16 + fj) * SST + (ks & 1) * 32 + kg * 8; const float sg = (ks >> 1) ? -1.0f : 1.0f;
            const f32x4 c0 = *(const f32x4*)srcp, c1 = *(const f32x4*)(srcp + 4);
            v4u w; w.x = pk2(sg * c0[0], sg * c0[1]); w.y = pk2(sg * c0[2], sg * c0[3]); w.z = pk2(sg * c1[0], sg * c1[1]); w.w = pk2(sg * c1[2], sg * c1[3]); Cf[ks] = __builtin_bit_cast(bf16x8, w); }
        const f32x4 dv = *(const f32x4*)((const float*)a->in[I_SD] + (size_t)l * DM + g * 16 + 4 * kg);
        const bf16* up = (const bf16*)(ws + WS_UG) + (size_t)(b * NGRP + g) * SEQ * 16;
        const int a_time0 = 256 * (2 * wave + ((n0 >> 2) & 1)) + (n0 & 3) + 4 * (n0 >> 3);
        const bf16* ap = up + (size_t)a_time0 * 16 + 8 * h2;
        LAS float* E = (LAS float*)(lds + E_OFF); LAS float* Hs = (LAS float*)(lds + H_OFF);
        const int seg = 2 * wave + h2;
        { float xr[2] = {0.f, 0.f}, xi[2] = {0.f, 0.f};
          bf16x8 An = *(const bf16x8*)ap;
          for (int tile = 0; tile < 16; ++tile) { const bf16x8 A = An; if (tile < 15) An = *(const bf16x8*)(ap + (size_t)(tile + 1) * 256);
#pragma unroll
              for (int nt = 0; nt < 2; ++nt) { f32x16 cr = {}, ci = {};
                  cr = __builtin_amdgcn_mfma_f32_32x32x16_bf16(A, Bfr[nt][0], cr, 0, 0, 0); ci = __builtin_amdgcn_mfma_f32_32x32x16_bf16(A, Bfr[nt][1], ci, 0, 0, 0);
#pragma unroll
                  for (int i = 0; i < 16; ++i) { const float nr = ar[nt] * xr[nt] - ai[nt] * xi[nt] + cr[i], ni = ar[nt] * xi[nt] + ai[nt] * xr[nt] + ci[i]; xr[nt] = nr; xi[nt] = ni; } } }
#pragma unroll
          for (int nt = 0; nt < 2; ++nt) { E[(seg * 64 + n0 + 32 * nt) * 2] = xr[nt]; E[(seg * 64 + n0 + 32 * nt) * 2 + 1] = xi[nt]; } }
        __syncthreads();
        if (wave == 0) { const size_t gn = gbase * SST + lane;
            const float lre = fminf(((const float*)a->in[I_LRE])[gn], -1e-4f), lim = ((const float*)a->in[I_LIM])[gn];
            const float mag = expf(lre * dt), ang = lim * dt; float pr_ = mag * cosf(ang), pi_ = mag * sinf(ang);
#pragma unroll
            for (int q = 0; q < 8; ++q) { const float t0 = pr_ * pr_ - pi_ * pi_, t1 = 2.0f * pr_ * pi_; pr_ = t0; pi_ = t1; }
            float hr = 0.f, hi_ = 0.f; Hs[lane * 2] = 0.f; Hs[lane * 2 + 1] = 0.f;
            for (int s = 0; s < 16; ++s) { const float er = E[(s * 64 + lane) * 2], ei = E[(s * 64 + lane) * 2 + 1];
                const float nr = pr_ * hr - pi_ * hi_ + er, ni = pr_ * hi_ + pi_ * hr + ei; hr = nr; hi_ = ni; Hs[((s + 1) * 64 + lane) * 2] = hr; Hs[((s + 1) * 64 + lane) * 2 + 1] = hi_; }
            a->out[O_SRP + (((size_t)l * NBATCH + b) * NGRP + g) * SST + lane] = hr; a->out[O_SIP + (((size_t)l * NBATCH + b) * NGRP + g) * SST + lane] = hi_; }
        __syncthreads();
        { float xr[2], xi[2];
#pragma unroll
          for (int nt = 0; nt < 2; ++nt) { xr[nt] = Hs[(seg * 64 + n0 + 32 * nt) * 2]; xi[nt] = Hs[(seg * 64 + n0 + 32 * nt) * 2 + 1]; }
          LAS char* Xt = lds + wave * XT_BYTES; const int xt_addr = (int)(unsigned)(size_t)Xt;
          bf16x8 An = *(const bf16x8*)ap;
          for (int tile = 0; tile < 16; ++tile) { const bf16x8 A = An; if (tile < 15) An = *(const bf16x8*)(ap + (size_t)(tile + 1) * 256);
#pragma unroll
              for (int nt = 0; nt < 2; ++nt) { f32x16 cr = {}, ci = {};
                  cr = __builtin_amdgcn_mfma_f32_32x32x16_bf16(A, Bfr[nt][0], cr, 0, 0, 0); ci = __builtin_amdgcn_mfma_f32_32x32x16_bf16(A, Bfr[nt][1], ci, 0, 0, 0);
                  unsigned pr[8], pi[8];
#pragma unroll
                  for (int i = 0; i < 16; i += 2) { float r0, i0, r1, i1;
                      r0 = ar[nt] * xr[nt] - ai[nt] * xi[nt] + cr[i]; i0 = ar[nt] * xi[nt] + ai[nt] * xr[nt] + ci[i];
                      r1 = ar[nt] * r0 - ai[nt] * i0 + cr[i + 1]; i1 = ar[nt] * i0 + ai[nt] * r0 + ci[i + 1]; xr[nt] = r1; xi[nt] = i1;
                      pr[i >> 1] = pk2(r0, r1); pi[i >> 1] = pk2(i0, i1); }
                  LAS char* rowr = Xt + (nt * 32 + n0) * XSTR + h2 * 32; LAS char* rowi = rowr + 64 * XSTR;
                  *(LAS v4u*)rowr = (v4u){pr[0], pr[1], pr[2], pr[3]}; *(LAS v4u*)(rowr + 16) = (v4u){pr[4], pr[5], pr[6], pr[7]};
                  *(LAS v4u*)rowi = (v4u){pi[0], pi[1], pi[2], pi[3]}; *(LAS v4u*)(rowi + 16) = (v4u){pi[4], pi[5], pi[6], pi[7]}; }
              asm volatile("s_waitcnt lgkmcnt(0)" ::: "memory");
#pragma unroll
              for (int tt = 0; tt < 2; ++tt) { f32x4 acc = {0.f, 0.f, 0.f, 0.f};
                  s16x4 lo[4], hi4[4];
#pragma unroll
                  for (int ks = 0; ks < 4; ++ks) { const int rowk = 32 * ks + 8 * kg + (fj >> 2); const int ad = xt_addr + rowk * XSTR + (16 * tt + 4 * (fj & 3)) * 2;
                      lo[ks] = tr_read(ad); hi4[ks] = tr_read(ad + 4 * XSTR); }
                  asm volatile("s_waitcnt lgkmcnt(0)" ::: "memory"); __builtin_amdgcn_sched_barrier(0);
#pragma unroll
                  for (int ks = 0; ks < 4; ++ks) { const bf16x8 Bx = (bf16x8){lo[ks][0], lo[ks][1], lo[ks][2], lo[ks][3], hi4[ks][0], hi4[ks][1], hi4[ks][2], hi4[ks][3]};
                      acc = __builtin_amdgcn_mfma_f32_16x16x32_bf16(Cf[ks], Bx, acc, 0, 0, 0); }
                  const int time = 256 * (2 * wave + tt) + 16 * tile + fj;
                  const v2u uw = *(const v2u*)(up + (size_t)time * 16 + 4 * kg);
                  const float y0 = acc[0] + dv[0] * bflo(uw.x), y1 = acc[1] + dv[1] * bfhi(uw.x), y2 = acc[2] + dv[2] * bflo(uw.y), y3 = acc[3] + dv[3] * bfhi(uw.y);
                  v2u o; o.x = pk2(gelu_tanh(y0), gelu_tanh(y1)); o.y = pk2(gelu_tanh(y2), gelu_tanh(y3));
                  *(v2u*)(Yb + ((size_t)b * SEQ + time) * 2048 + g * 16 + 4 * kg) = o; }
          } }
        __syncthreads();
    }
    for (int it = gw; it < DBATCH * NGRP; it += NGW) scan_item(a, l, false, it, lane);
}

__device__ __forceinline__ void ph_epi_glu(ArgP a_, int l, int wv_) {
    TID_LOCAL(); GTID_LOCAL();
    unsigned char* ws = a->ws; const float* C = (const float*)(ws + WS_C); const float* bg = (const float*)a->in[I_BGLU] + (size_t)l * DM;
    const bf16* Yb = (const bf16*)(ws + WS_YB); const bf16* Gb = (const bf16*)(ws + WS_GB); bf16* AOb = (bf16*)(ws + WS_AOB);
    for (size_t e = gtid; e < (size_t)MR * (DM / 4); e += GT) { const size_t o = e * 4; const int c = (int)(o % DM);
        const f32x4 cv = *(const f32x4*)(C + o), bv = *(const f32x4*)(bg + c); const v2u yw = *(const v2u*)(Yb + o), gw2 = *(const v2u*)(Gb + o);
        const float y[4] = {bflo(yw.x), bfhi(yw.x), bflo(yw.y), bfhi(yw.y)}, gg[4] = {bflo(gw2.x), bfhi(gw2.x), bflo(gw2.y), bfhi(gw2.y)};
        float r[4];
#pragma unroll
        for (int j = 0; j < 4; ++j) r[j] = y[j] * sigmoidf_(cv[j] + bv[j]) * gg[j];
        v2u w; w.x = pk2(r[0], r[1]); w.y = pk2(r[2], r[3]); *(v2u*)(AOb + o) = w; }
}
__device__ __forceinline__ void ph_final(ArgP a_, int wv_) {
    TID_LOCAL();
    unsigned char* ws = a->ws; const bf16* Hb = (const bf16*)(ws + WS_HBA); const float* ssq = ss_buf(ws, 8); const float* fw = (const float*)a->in[I_FNW];
    for (int r = gw; r < MR; r += NGW) {
        float s;
        if (r < MP) s = (lane < 32) ? ssq[(size_t)r * 32 + lane] : 0.f;
        else s = ssq[(size_t)MPAD * 32 + (size_t)(r - MP) * 128 + lane] + ssq[(size_t)MPAD * 32 + (size_t)(r - MP) * 128 + 64 + lane];
        const float rs = ss2rstd(wave_sum(s));
        float* out = a->out + (r < MP ? O_YP + (size_t)r * DM : O_YS + (size_t)(r - MP) * DM);
#pragma unroll
        for (int j = 0; j < 8; ++j) { const int c = (j * 64 + lane) * 4; const v2u hw = *(const v2u*)(Hb + (size_t)r * DM + c);
            *(f32x4*)(out + c) = (f32x4){bflo(hw.x), bfhi(hw.x), bflo(hw.y), bfhi(hw.y)} * rs * *(const f32x4*)(fw + c); } }
}

constexpr size_t WS_PRJ = WS_C;
constexpr size_t PRJ_STRIDE = (size_t)MPAD * DM * 2;
constexpr size_t WS_SSP = WS_C2;
constexpr size_t SSP_STRIDE = (size_t)MPAD * 32 + (size_t)MS * 128;
__device__ __forceinline__ float* ss_buf(unsigned char* ws, int k) { return (float*)(ws + WS_SSP) + (size_t)k * SSP_STRIDE; }
__device__ __forceinline__ float ss2rstd(float ss) { return __builtin_amdgcn_rsqf(ss * (1.0f / DM) + RMS_EPS); }
struct AuxNone {};
__device__ __forceinline__ float ss_row_part(const float* ssp, int r, int q) {
    const f32x4* p = (const f32x4*)(ssp + (size_t)r * 32 + 8 * q); const f32x4 s = p[0] + p[1]; return (s[0] + s[1]) + (s[2] + s[3]); }
__device__ __forceinline__ float ss_srow_part(const float* ssp, int r, int q) {
    const f32x4* p = (const f32x4*)(ssp + (size_t)MPAD * 32 + (size_t)(r - MP) * 128 + 32 * q); f32x4 s = p[0];
#pragma unroll
    for (int i = 1; i < 8; ++i) s += p[i];
    return (s[0] + s[1]) + (s[2] + s[3]); }
__device__ __forceinline__ float ss_row_rstd(const float* ssp, int r) {
    if (r < MP) { const f32x4* p = (const f32x4*)(ssp + (size_t)r * 32); f32x4 s = p[0];
#pragma unroll
        for (int i = 1; i < 8; ++i) s += p[i];
        return ss2rstd((s[0] + s[1]) + (s[2] + s[3])); }
    const f32x4* p = (const f32x4*)(ssp + (size_t)MPAD * 32 + (size_t)(r - MP) * 128); f32x4 s = p[0];
    for (int i = 1; i < 32; ++i) s += p[i];
    return ss2rstd((s[0] + s[1]) + (s[2] + s[3])); }
__device__ __forceinline__ v2u pk4(const f32x4 v) { v2u o; o.x = pk2(v[0], v[1]); o.y = pk2(v[2], v[3]); return o; }
struct FAttnIn { unsigned char* ws; float* out; const float* ssin; int l; static constexpr bool SUMSQ = false, RSTD = true; float* ssout; typedef AuxNone Aux;
    __device__ __forceinline__ void prefetch(int, int, Aux&) const {}
    __device__ __forceinline__ float store4(int r, int c, f32x4 v, float rs, const Aux&) const {
        if (c >= ACOLS) return 0.f;
        v = v * rs;
        if (c < C_K) { v = v * QSCALE; *(v2u*)((bf16*)(ws + WS_QB) + (size_t)r * 2048 + c) = pk4(v); }
        else if (c < C_G) { const bool isv = c >= C_V; const int cc = c - (isv ? C_V : C_K);
            float* o32 = out + (r < MP ? (isv ? O_VP : O_KP) + ((size_t)l * MP + r) * 512 : (isv ? O_VS : O_KS) + ((size_t)l * MS + (r - MP)) * 512) + cc;
            *(f32x4*)o32 = v; *(v2u*)((bf16*)(ws + (isv ? WS_VB : WS_KB)) + (size_t)r * 512 + cc) = pk4(v); }
        else if (c < C_QI) { v2u o; o.x = pk2(siluf_(v[0]), siluf_(v[1])); o.y = pk2(siluf_(v[2]), siluf_(v[3])); *(v2u*)((bf16*)(ws + WS_GB) + (size_t)r * 2048 + (c - C_G)) = o; }
        else if (c < C_KI) { *(v2u*)((bf16*)(ws + WS_QIB) + (size_t)r * 1024 + (c - C_QI)) = pk4(v); }
        else if (c < C_WI) { const int cc = c - C_KI; float* o32 = out + (r < MP ? O_KIP + ((size_t)l * MP + r) * 64 : O_KIS + ((size_t)l * MS + (r - MP)) * 64) + cc;
            *(f32x4*)o32 = v; *(v2u*)((bf16*)(ws + WS_KIB) + (size_t)r * 64 + cc) = pk4(v); }
        else { *(f32x4*)((float*)(ws + WS_WI) + (size_t)r * 16 + (c - C_WI)) = v * WISCALE; }
        return 0.f; } };
struct FResid { unsigned char* ws; float* ssout; const float* ssin; static constexpr bool SUMSQ = true, RSTD = false;
    struct Aux { v2u h; };
    __device__ __forceinline__ void prefetch(int r, int c, Aux& x) const { x.h = *(const v2u*)((const bf16*)(ws + WS_HBA) + (size_t)r * DM + c); }
    __device__ __forceinline__ float store4(int r, int c, f32x4 v, float, const Aux& x) const { const size_t o = (size_t)r * DM + c; const f32x4 h = (f32x4){bflo(x.h.x), bfhi(x.h.x), bflo(x.h.y), bfhi(x.h.y)} + v;
        *(v2u*)((bf16*)(ws + WS_HBB) + o) = pk4(h); return h[0] * h[0] + h[1] * h[1] + h[2] * h[2] + h[3] * h[3]; } };
struct FPleProj { unsigned char* ws; float* ssout; const float* ssin; bf16* prj; static constexpr bool SUMSQ = false, RSTD = false; typedef AuxNone Aux;
    __device__ __forceinline__ void prefetch(int, int, Aux&) const {}
    __device__ __forceinline__ float store4(int r, int c, f32x4 v, float, const Aux&) const { *(v2u*)(prj + (size_t)r * DM + c) = pk4(v); return 0.f; } };
struct FPle { unsigned char* ws; const float* ssin; float* ssout; const bf16* prj; static constexpr bool SUMSQ = true, RSTD = true;
    struct Aux { v2u h; v2u p; };
    __device__ __forceinline__ void prefetch(int r, int c, Aux& x) const { const size_t o = (size_t)r * DM + c; x.h = *(const v2u*)((const bf16*)(ws + WS_HBB) + o); x.p = *(const v2u*)(prj + o); }
    __device__ __forceinline__ float store4(int r, int c, f32x4 v, float rs, const Aux& x) const { const size_t o = (size_t)r * DM + c; f32x4 h = (f32x4){bflo(x.h.x), bfhi(x.h.x), bflo(x.h.y), bfhi(x.h.y)};
        const v2u pw = x.p; const float p[4] = {bflo(pw.x), bfhi(pw.x), bflo(pw.y), bfhi(pw.y)};
#pragma unroll
        for (int j = 0; j < 4; ++j) h[j] += sigmoidf_(v[j] * rs) * p[j];
        *(v2u*)((bf16*)(ws + WS_HBA) + o) = pk4(h); return h[0] * h[0] + h[1] * h[1] + h[2] * h[2] + h[3] * h[3]; } };
struct FSsmIn { unsigned char* ws; const float* ssin; float* ssout; static constexpr bool SUMSQ = false, RSTD = true; typedef AuxNone Aux;
    __device__ __forceinline__ void prefetch(int, int, Aux&) const {}
    __device__ __forceinline__ float store4(int r, int c, f32x4 v, float rs, const Aux&) const { v = v * rs;
        if (c < 2048) { if (r < MP) { const int b = r / SEQ, t = r % SEQ, g = c / 16, j = c % 16; *(v2u*)((bf16*)(ws + WS_UG) + (((size_t)(b * NGRP + g) * SEQ + t) * 16 + j)) = pk4(v); }
                        else *(v2u*)((bf16*)(ws + WS_US) + (size_t)(r - MP) * 2048 + c) = pk4(v); }
        else { v2u o; o.x = pk2(siluf_(v[0]), siluf_(v[1])); o.y = pk2(siluf_(v[2]), siluf_(v[3])); *(v2u*)((bf16*)(ws + WS_GB) + (size_t)r * 2048 + (c - 2048)) = o; }
        return 0.f; } };
struct FGlu { unsigned char* ws; const float* bg; float* ssout; const float* ssin; static constexpr bool SUMSQ = false, RSTD = false;
    struct Aux { f32x4 bv; v2u y, g; };
    __device__ __forceinline__ void prefetch(int r, int c, Aux& x) const { const size_t o = (size_t)r * DM + c; x.bv = *(const f32x4*)(bg + c); x.y = *(const v2u*)((const bf16*)(ws + WS_YB) + o); x.g = *(const v2u*)((const bf16*)(ws + WS_GB) + o); }
    __device__ __forceinline__ float store4(int r, int c, f32x4 v, float, const Aux& x) const { const size_t o = (size_t)r * DM + c; const f32x4 bv = x.bv;
        const v2u yw = x.y, gw2 = x.g;
        const float y[4] = {bflo(yw.x), bfhi(yw.x), bflo(yw.y), bfhi(yw.y)}, gg[4] = {bflo(gw2.x), bfhi(gw2.x), bflo(gw2.y), bfhi(gw2.y)}; f32x4 rr;
#pragma unroll
        for (int j = 0; j < 4; ++j) rr[j] = y[j] * sigmoidf_(v[j] + bv[j]) * gg[j];
        *(v2u*)((bf16*)(ws + WS_AOB) + o) = pk4(rr); return 0.f; } };
template <class F> struct EpiFused { F f;
    __device__ __forceinline__ void operator()(const f32x4 (&acc)[2][2][4][2], const pg8::Unit& u, int wr, int wc, int fr, int fq) const {
        const int row0 = u.pm * 256 + wr * 64 + fr, col0 = u.pn * 256 + wc * 32 + 4 * fq;
#pragma unroll
        for (int ai = 0; ai < 2; ++ai) {
            float rs[4];
            if (F::RSTD) {
#pragma unroll
                for (int m = 0; m < 4; ++m) rs[m] = ss_row_part(f.ssin, row0 + ai * 128 + m * 16, fq);
#pragma unroll
                for (int m = 0; m < 4; ++m) { float s = rs[m]; s += __shfl_xor(s, 16); s += __shfl_xor(s, 32); rs[m] = ss2rstd(s); } }
            else {
#pragma unroll
                for (int m = 0; m < 4; ++m) rs[m] = 0.f; }
            constexpr int RB = (sizeof(typename F::Aux) <= 24) ? 2 : 1;
#pragma unroll
            for (int m0 = 0; m0 < 4; m0 += RB) {
                typename F::Aux cur[RB][4];
#pragma unroll
                for (int j = 0; j < RB; ++j)
#pragma unroll
                    for (int g = 0; g < 4; ++g) f.prefetch(row0 + ai * 128 + (m0 + j) * 16, col0 + (g >> 1) * 128 + (g & 1) * 16, cur[j][g]);
#pragma unroll
                for (int j = 0; j < RB; ++j) { const int m = m0 + j; const int row = row0 + ai * 128 + m * 16; float ss = 0.f;
#pragma unroll
                    for (int g = 0; g < 4; ++g) ss += f.store4(row, col0 + (g >> 1) * 128 + (g & 1) * 16, acc[ai][g >> 1][m][g & 1], rs[m], cur[j][g]);
                    if (F::SUMSQ) { ss += __shfl_xor(ss, 16); ss += __shfl_xor(ss, 32); if (fq == 0) f.ssout[(size_t)row * 32 + u.pn * 4 + wc] = ss; } } } }
    } };
template <int NC, class F>
__device__ __forceinline__ void thin_tile(LAS unsigned char* lds, const bf16* A, const bf16* Bt, int K, int grow0, int gcol0, const F& f, int tid, int lane, int wave) {
    constexpr int NTL = NC / 16, RS = NC + 4, RT = NC / 4;
    const int fr = lane & 15, kg = lane >> 4; const int kw = K >> 3;
    f32x4 acc[2][NTL];
#pragma unroll
    for (int i = 0; i < 2; ++i)
#pragma unroll
        for (int j = 0; j < NTL; ++j) acc[i][j] = (f32x4){0.f, 0.f, 0.f, 0.f};
    const bf16* ap = A + (size_t)fr * K + wave * kw + kg * 8; const bf16* bp = Bt + (size_t)fr * K + wave * kw + kg * 8;
    for (int ks0 = 0; ks0 < kw / 32; ks0 += 2) {
        bf16x8v a0[2], a1[2], bw[2][NTL];
#pragma unroll
        for (int j = 0; j < 2; ++j) { a0[j] = *(const bf16x8v*)(ap + (ks0 + j) * 32); a1[j] = *(const bf16x8v*)(ap + (size_t)16 * K + (ks0 + j) * 32);
#pragma unroll
            for (int nt = 0; nt < NTL; ++nt) bw[j][nt] = *(const bf16x8v*)(bp + (size_t)nt * 16 * K + (ks0 + j) * 32); }
#pragma unroll
        for (int j = 0; j < 2; ++j)
#pragma unroll
            for (int nt = 0; nt < NTL; ++nt) { acc[0][nt] = __builtin_amdgcn_mfma_f32_16x16x32_bf16(bw[j][nt], a0[j], acc[0][nt], 0, 0, 0); acc[1][nt] = __builtin_amdgcn_mfma_f32_16x16x32_bf16(bw[j][nt], a1[j], acc[1][nt], 0, 0, 0); } }
    LAS float* red = (LAS float*)lds;
    __syncthreads();
#pragma unroll
    for (int mt = 0; mt < 2; ++mt)
#pragma unroll
        for (int nt = 0; nt < NTL; ++nt) *(LAS f32x4*)(red + ((wave * 32 + mt * 16 + fr) * RS + nt * 16 + 4 * kg)) = acc[mt][nt];
    __syncthreads();
    for (int it = tid; it < 32 * RT; it += NTHR) { const int m = it / RT, c4 = it % RT; f32x4 v = {0.f, 0.f, 0.f, 0.f};
#pragma unroll
        for (int w = 0; w < 8; ++w) v += *(LAS const f32x4*)(red + ((w * 32 + m) * RS + 4 * c4));
        const float rs = F::RSTD ? ss_row_rstd(f.ssin, grow0 + m) : 0.f; typename F::Aux x; f.prefetch(grow0 + m, gcol0 + 4 * c4, x); f.store4(grow0 + m, gcol0 + 4 * c4, v, rs, x); }
    __syncthreads();
}
template <int KS, class F>
__device__ __forceinline__ void thin_tile16(LAS unsigned char* lds, const bf16* A, const bf16* Bt, int grow0, int gcol0, int slot, const F& f, int tid, int lane, int wave) {
    constexpr int K = KS * 256, RS = 20;
    const int fr = lane & 15, kg = lane >> 4;
    const bf16* ap = A + (size_t)fr * K + wave * (KS * 32) + kg * 8; const bf16* bp = Bt + (size_t)fr * K + wave * (KS * 32) + kg * 8;
    bf16x8v a0[KS], a1[KS], bw[KS];
#pragma unroll
    for (int ks = 0; ks < KS; ++ks) { a0[ks] = *(const bf16x8v*)(ap + ks * 32); a1[ks] = *(const bf16x8v*)(ap + (size_t)16 * K + ks * 32); bw[ks] = *(const bf16x8v*)(bp + ks * 32); }
    f32x4 acc0 = {0.f, 0.f, 0.f, 0.f}, acc1 = {0.f, 0.f, 0.f, 0.f};
#pragma unroll
    for (int ks = 0; ks < KS; ++ks) { acc0 = __builtin_amdgcn_mfma_f32_16x16x32_bf16(bw[ks], a0[ks], acc0, 0, 0, 0); acc1 = __builtin_amdgcn_mfma_f32_16x16x32_bf16(bw[ks], a1[ks], acc1, 0, 0, 0); }
    LAS float* red = (LAS float*)lds;
    __syncthreads();
    *(LAS f32x4*)(red + ((wave * 32 + fr) * RS + 4 * kg)) = acc0; *(LAS f32x4*)(red + ((wave * 32 + 16 + fr) * RS + 4 * kg)) = acc1;
    __syncthreads();
    if (tid < 128) { const int m = tid >> 2, c4 = tid & 3; f32x4 v = {0.f, 0.f, 0.f, 0.f};
#pragma unroll
        for (int w = 0; w < 8; ++w) v += *(LAS const f32x4*)(red + ((w * 32 + m) * RS + 4 * c4));
        typename F::Aux x; f.prefetch(grow0 + m, gcol0 + 4 * c4, x);
        float rs = 0.f; if (F::RSTD) { rs = ss_srow_part(f.ssin, grow0 + m, c4); rs += __shfl_xor(rs, 1); rs += __shfl_xor(rs, 2); rs = ss2rstd(rs); }
        float ss = f.store4(grow0 + m, gcol0 + 4 * c4, v, rs, x);
        if (F::SUMSQ) { ss += __shfl_xor(ss, 1); ss += __shfl_xor(ss, 2); if (c4 == 0) f.ssout[(size_t)MPAD * 32 + (size_t)(grow0 + m - MP) * 128 + slot] = ss; } }
    __syncthreads();
}
template <int KS, class F> __device__ __forceinline__ void thin_sample(LAS unsigned char* lds, const bf16* A, const bf16* Bt, int N, const F& f, int wv_, int wg0 = 0, int nwg = 0) {
    const int wave = wv_, lane = lane_id_fresh(); int tid = wave * 64 + lane; asm volatile("" : "+v"(tid));
    constexpr int K = KS * 256;
    if (nwg == 0) nwg = gridDim.x;
    for (int t = (int)blockIdx.x - wg0; t < (N + 15) / 16; t += nwg) thin_tile16<KS, F>(lds, A + (size_t)MP * K, Bt + (size_t)t * 16 * K, MP, t * 16, t, f, tid, lane, wave);
}

__global__ void __launch_bounds__(NTHR, 2) fwd_kernel(Args args) {
    extern __shared__ __attribute__((aligned(16))) unsigned char lds_raw[];
    LAS unsigned char* lds = (LAS unsigned char*)lds_raw;
    volatile LAS unsigned* MISC = (volatile LAS unsigned*)(lds + MISC_OFF);
    const int wave_u = __builtin_amdgcn_readfirstlane((int)threadIdx.x >> 6);
    for (int u = wave_u * 64 + lane_id_fresh(); u < (LDS_BYTES - 131072) / 4; u += NTHR) ((LAS unsigned*)(lds + 131072))[u] = 0u;
    __syncthreads();
    ArgP kap = (ArgP)__builtin_amdgcn_kernarg_segment_ptr();
    XcdBarrier bar = xcd_barrier_post((unsigned*)(kap->ws + WS_CTL) + CW_BAR, MISC + 8, wave_u);
    int lp = 0;
#if PROF
    unsigned ph = 0; if (blockIdx.x == 0 && wave_u == 0) { const unsigned long long t0_ = __builtin_amdgcn_s_memrealtime(); MISC[16] = (unsigned)t0_; MISC[17] = (unsigned)(t0_ >> 32); }
#endif
#define PH_BEGIN { int l = lp; asm volatile("" : "+s"(l)); const int ia = 2 * l, is = 2 * l + 1; (void)ia; (void)is; ArgP args = kap; asm volatile("" : "+s"(args)); unsigned char* ws = args->ws; (void)ws;
#if PROF
#define PROF_ARRIVE() do { prof_mark(100 + (int)ph, wave_u); } while (0)
#define PROF_EXIT()   do { prof_mark(200 + (int)ph, wave_u); ++ph; } while (0)
#else
#define PROF_ARRIVE() do {} while (0)
#define PROF_EXIT()   do {} while (0)
#endif
#define PH_END   { PROF_ARRIVE(); XcdBarrier b2_ = bar; asm volatile("" : "+s"(b2_.bar), "+s"(b2_.x)); xcd_barrier(b2_, wave_u); PROF_EXIT(); } }
#define PH_LAST  PROF_ARRIVE(); }
#define GEMM_FUSED(FT, fobj, Aptr, Bptr, Ncols, Kdim) do { pg8::Gemm g_{(const pg8::bf16_t*)(Aptr), (const pg8::bf16_t*)(Bptr), MP, (Ncols), (Kdim)}; pg8::StaticOrder S_; S_.init(MP, (Ncols), (int)gridDim.x, (int)blockIdx.x); \
        EpiFused<FT> E_{fobj}; pg8::gemm_phase<EpiFused<FT>, pg8::StaticOrder, true, true>(lds, g_, S_, E_, wave_u); } while (0)

#define GEMM_FUSED_SUB(FT, fobj, Aptr, Bptr, Ncols, Kdim, wg0_, nwg_) do { pg8::Gemm g_{(const pg8::bf16_t*)(Aptr), (const pg8::bf16_t*)(Bptr), MP, (Ncols), (Kdim)}; pg8::StaticOrder S_; S_.init(MP, (Ncols), (nwg_), (int)blockIdx.x - (wg0_)); \
        EpiFused<FT> E_{fobj}; pg8::gemm_phase<EpiFused<FT>, pg8::StaticOrder, true, true>(lds, g_, S_, E_, wave_u); } while (0)

    PH_BEGIN ph_prologue(args, lds, wave_u); PH_END

    lp = 0;
        PH_BEGIN { const bf16* Aa = (const bf16*)(ws + WS_HBA); const bf16* Bw = (const bf16*)(ws + WS_WAIN) + (size_t)l * ACOLS_PAD * DM; FAttnIn f{ws, args->out, ss_buf(ws, 2 * ia), l, nullptr};
                   GEMM_FUSED(FAttnIn, f, Aa, Bw, 6144, DM);
                   { const int wave = wave_u, lane = lane_id_fresh(); int tid = wave * 64 + lane; asm volatile("" : "+v"(tid));
                     for (int rb = blockIdx.x; rb < MP / 32; rb += gridDim.x) thin_tile<96, FAttnIn>(lds, Aa + (size_t)rb * 32 * DM, Bw + (size_t)6144 * DM, DM, rb * 32, 6144, f, tid, lane, wave); }
                   thin_sample<8, FAttnIn>(lds, Aa, Bw, ACOLS, f, wave_u); } PH_END
        PH_BEGIN ph_idx(args, l, lds, wave_u); ph_idx_sample(args, l, wave_u); PMARK(5, wave_u); PH_END
        PH_BEGIN ph_attn(args, lds, wave_u);
                   if ((int)blockIdx.x < MS * NKV || (int)gridDim.x < 2 * MS * NKV) ph_attn_sample(args, l, lds, wave_u);
                   if ((int)blockIdx.x >= MS * NKV || (int)gridDim.x < 2 * MS * NKV) {
                       const int wg0 = ((int)gridDim.x < 2 * MS * NKV) ? 0 : MS * NKV, nwg = (int)gridDim.x - wg0;
                       __syncthreads();
                       for (int q = 0; q < 2; ++q) { const int li = 2 * l + q; const bf16* Ap = (const bf16*)(ws + WS_PB + (size_t)li * PB_STRIDE); const bf16* Bp = (const bf16*)(ws + WS_WPP) + (size_t)li * DM * PLE;
                           FPleProj fp{ws, nullptr, nullptr, (bf16*)(ws + WS_PRJ + (size_t)q * PRJ_STRIDE)};
                           GEMM_FUSED_SUB(FPleProj, fp, Ap, Bp, DM, PLE, wg0, nwg); thin_sample<1, FPleProj>(lds, Ap, Bp, DM, fp, wave_u, wg0, nwg); } } PH_END
        PH_BEGIN { const bf16* Aa = (const bf16*)(ws + WS_AOB); const bf16* Bw = (const bf16*)(ws + WS_WAOUT) + (size_t)l * DM * DM; FResid f{ws, ss_buf(ws, 1 + 2 * ia), nullptr};
                   GEMM_FUSED(FResid, f, Aa, Bw, DM, DM); thin_sample<8, FResid>(lds, Aa, Bw, DM, f, wave_u);
                   } PH_END
        PH_BEGIN { const bf16* Aa = (const bf16*)(ws + WS_HBB); const bf16* Bw = (const bf16*)(ws + WS_WPG) + (size_t)ia * DM * DM; FPle f{ws, ss_buf(ws, 1 + 2 * ia), ss_buf(ws, 2 + 2 * ia), (const bf16*)(ws + WS_PRJ)};
                   GEMM_FUSED(FPle, f, Aa, Bw, DM, DM); PMARK(1, wave_u); thin_sample<8, FPle>(lds, Aa, Bw, DM, f, wave_u); PMARK(2, wave_u); } PH_END
        PH_BEGIN { const bf16* Aa = (const bf16*)(ws + WS_HBA); const bf16* Bw = (const bf16*)(ws + WS_WSIN) + (size_t)l * 4096 * DM; FSsmIn f{ws, ss_buf(ws, 2 * is), nullptr};
                   GEMM_FUSED(FSsmIn, f, Aa, Bw, 4096, DM); thin_sample<8, FSsmIn>(lds, Aa, Bw, 4096, f, wave_u); } PH_END
        PH_BEGIN ph_scan(args, l, lds, wave_u); PH_END
        PH_BEGIN { const bf16* Aa = (const bf16*)(ws + WS_YB); const bf16* Bw = (const bf16*)(ws + WS_WGLU) + (size_t)l * DM * DM; FGlu f{ws, (const float*)args->in[I_BGLU] + (size_t)l * DM, nullptr, nullptr};
                   GEMM_FUSED(FGlu, f, Aa, Bw, DM, DM); thin_sample<8, FGlu>(lds, Aa, Bw, DM, f, wave_u); } PH_END
        PH_BEGIN { const bf16* Aa = (const bf16*)(ws + WS_AOB); const bf16* Bw = (const bf16*)(ws + WS_WSOUT) + (size_t)l * DM * DM; FResid f{ws, ss_buf(ws, 1 + 2 * is), nullptr};
                   GEMM_FUSED(FResid, f, Aa, Bw, DM, DM); thin_sample<8, FResid>(lds, Aa, Bw, DM, f, wave_u);
                   } PH_END
        PH_BEGIN { const bf16* Aa = (const bf16*)(ws + WS_HBB); const bf16* Bw = (const bf16*)(ws + WS_WPG) + (size_t)is * DM * DM; FPle f{ws, ss_buf(ws, 1 + 2 * is), ss_buf(ws, 2 + 2 * is), (const bf16*)(ws + WS_PRJ + PRJ_STRIDE)};
                   GEMM_FUSED(FPle, f, Aa, Bw, DM, DM); PMARK(1, wave_u); thin_sample<8, FPle>(lds, Aa, Bw, DM, f, wave_u); PMARK(2, wave_u); } PH_END
    lp = 1;
        PH_BEGIN { const bf16* Aa = (const bf16*)(ws + WS_HBA); const bf16* Bw = (const bf16*)(ws + WS_WAIN) + (size_t)l * ACOLS_PAD * DM; FAttnIn f{ws, args->out, ss_buf(ws, 2 * ia), l, nullptr};
                   GEMM_FUSED(FAttnIn, f, Aa, Bw, 6144, DM);
                   { const int wave = wave_u, lane = lane_id_fresh(); int tid = wave * 64 + lane; asm volatile("" : "+v"(tid));
                     for (int rb = blockIdx.x; rb < MP / 32; rb += gridDim.x) thin_tile<96, FAttnIn>(lds, Aa + (size_t)rb * 32 * DM, Bw + (size_t)6144 * DM, DM, rb * 32, 6144, f, tid, lane, wave); }
                   thin_sample<8, FAttnIn>(lds, Aa, Bw, ACOLS, f, wave_u); } PH_END
        PH_BEGIN ph_idx(args, l, lds, wave_u); ph_idx_sample(args, l, wave_u); PMARK(5, wave_u); PH_END
        PH_BEGIN ph_attn(args, lds, wave_u);
                   if ((int)blockIdx.x < MS * NKV || (int)gridDim.x < 2 * MS * NKV) ph_attn_sample(args, l, lds, wave_u);
                   if ((int)blockIdx.x >= MS * NKV || (int)gridDim.x < 2 * MS * NKV) {
                       const int wg0 = ((int)gridDim.x < 2 * MS * NKV) ? 0 : MS * NKV, nwg = (int)gridDim.x - wg0;
                       __syncthreads();
                       for (int q = 0; q < 2; ++q) { const int li = 2 * l + q; const bf16* Ap = (const bf16*)(ws + WS_PB + (size_t)li * PB_STRIDE); const bf16* Bp = (const bf16*)(ws + WS_WPP) + (size_t)li * DM * PLE;
                           FPleProj fp{ws, nullptr, nullptr, (bf16*)(ws + WS_PRJ + (size_t)q * PRJ_STRIDE)};
                           GEMM_FUSED_SUB(FPleProj, fp, Ap, Bp, DM, PLE, wg0, nwg); thin_sample<1, FPleProj>(lds, Ap, Bp, DM, fp, wave_u, wg0, nwg); } } PH_END
        PH_BEGIN { const bf16* Aa = (const bf16*)(ws + WS_AOB); const bf16* Bw = (const bf16*)(ws + WS_WAOUT) + (size_t)l * DM * DM; FResid f{ws, ss_buf(ws, 1 + 2 * ia), nullptr};
                   GEMM_FUSED(FResid, f, Aa, Bw, DM, DM); thin_sample<8, FResid>(lds, Aa, Bw, DM, f, wave_u);
                   } PH_END
        PH_BEGIN { const bf16* Aa = (const bf16*)(ws + WS_HBB); const bf16* Bw = (const bf16*)(ws + WS_WPG) + (size_t)ia * DM * DM; FPle f{ws, ss_buf(ws, 1 + 2 * ia), ss_buf(ws, 2 + 2 * ia), (const bf16*)(ws + WS_PRJ)};
                   GEMM_FUSED(FPle, f, Aa, Bw, DM, DM); PMARK(1, wave_u); thin_sample<8, FPle>(lds, Aa, Bw, DM, f, wave_u); PMARK(2, wave_u); } PH_END
        PH_BEGIN { const bf16* Aa = (const bf16*)(ws + WS_HBA); const bf16* Bw = (const bf16*)(ws + WS_WSIN) + (size_t)l * 4096 * DM; FSsmIn f{ws, ss_buf(ws, 2 * is), nullptr};
                   GEMM_FUSED(FSsmIn, f, Aa, Bw, 4096, DM); thin_sample<8, FSsmIn>(lds, Aa, Bw, 4096, f, wave_u); } PH_END
        PH_BEGIN ph_scan(args, l, lds, wave_u); PH_END
        PH_BEGIN { const bf16* Aa = (const bf16*)(ws + WS_YB); const bf16* Bw = (const bf16*)(ws + WS_WGLU) + (size_t)l * DM * DM; FGlu f{ws, (const float*)args->in[I_BGLU] + (size_t)l * DM, nullptr, nullptr};
                   GEMM_FUSED(FGlu, f, Aa, Bw, DM, DM); thin_sample<8, FGlu>(lds, Aa, Bw, DM, f, wave_u); } PH_END
        PH_BEGIN { const bf16* Aa = (const bf16*)(ws + WS_AOB); const bf16* Bw = (const bf16*)(ws + WS_WSOUT) + (size_t)l * DM * DM; FResid f{ws, ss_buf(ws, 1 + 2 * is), nullptr};
                   GEMM_FUSED(FResid, f, Aa, Bw, DM, DM); thin_sample<8, FResid>(lds, Aa, Bw, DM, f, wave_u);
                   } PH_END
        PH_BEGIN { const bf16* Aa = (const bf16*)(ws + WS_HBB); const bf16* Bw = (const bf16*)(ws + WS_WPG) + (size_t)is * DM * DM; FPle f{ws, ss_buf(ws, 1 + 2 * is), ss_buf(ws, 2 + 2 * is), (const bf16*)(ws + WS_PRJ + PRJ_STRIDE)};
                   GEMM_FUSED(FPle, f, Aa, Bw, DM, DM); PMARK(1, wave_u); thin_sample<8, FPle>(lds, Aa, Bw, DM, f, wave_u); PMARK(2, wave_u); } PH_END
    PH_BEGIN ph_final(args, wave_u); PH_LAST
#if PROF
    if (blockIdx.x == 0 && wave_u == 0) { const unsigned accA = MISC[18], accB = MISC[19]; const unsigned qa = min(99u, accA / (100u * PROF_UNIT_US)), qb = min(99u, accB / (100u * PROF_UNIT_US));
        const unsigned long long t_end = __builtin_amdgcn_s_memrealtime() + (unsigned long long)(qa * 20u + qb * 2000u) * 100ull;
        while (__builtin_amdgcn_s_memrealtime() < t_end) __builtin_amdgcn_s_sleep(32); }
#endif
}
constexpr int N_PHASES = 1 + 2 * 24 + 2;

#ifndef MK_PER_PHASE
#define MK_PER_PHASE 0
#endif
extern "C" void kernel_launch(void* const* d_in, const int* in_sizes, int n_in, void* d_out, int out_size, void* d_ws, size_t ws_size, hipStream_t stream) {
    static int grid = 0;
    if (grid == 0) {
        if (n_in != N_IN || out_size != (int)O_END || ws_size < WS_END) { fprintf(stderr, "kernel_launch: unexpected shapes: n_in %d out %d ws %zu (need %zu)\n", n_in, out_size, ws_size, (size_t)WS_END); grid = -1; return; }
        int dev = 0, cus = 0, per_cu = 0;
        if (hipGetDevice(&dev) != hipSuccess || hipDeviceGetAttribute(&cus, hipDeviceAttributeMultiprocessorCount, dev) != hipSuccess) { grid = -1; return; }
        if (hipFuncSetAttribute((const void*)fwd_kernel, hipFuncAttributeMaxDynamicSharedMemorySize, LDS_BYTES) != hipSuccess) { fprintf(stderr, "kernel_launch: hipFuncSetAttribute failed\n"); grid = -1; return; }
        if (hipOccupancyMaxActiveBlocksPerMultiprocessor(&per_cu, (const void*)fwd_kernel, NTHR, LDS_BYTES) != hipSuccess || per_cu < 1) fprintf(stderr, "kernel_launch: occupancy query reports %d\n", per_cu);
        (void)hipGetLastError();
        grid = cus;
    }
    if (grid < 0) return;
    if (hipMemsetAsync((char*)d_ws + WS_CTL, 0, CTL_ZERO_BYTES, stream) != hipSuccess) return;
    Args a{};
    for (int i = 0; i < N_IN; ++i) a.in[i] = d_in[i];
    a.out = (float*)d_out; a.ws = (unsigned char*)d_ws;
    a.ph_lo = 0; a.ph_hi = N_PHASES;
    hipLaunchKernelGGL(fwd_kernel, dim3(grid), dim3(NTHR), LDS_BYTES, stream, a);
    const hipError_t le = hipPeekAtLastError();
    if (le != hipSuccess) fprintf(stderr, "kernel_launch: launch failed: %s\n", hipGetErrorName(le));
}
```
